# Optimizing an MI355X kernel written in HIP

```python
import math
import jax, jax.numpy as jnp
from jax import lax
import numpy as np

D_MODEL = 1024
BATCH = 8
SEQ = 2048
DEPTH = 1
DEC_BATCH = 32
DEC_SEQ = 4
PAST_LEN = 8192
PAGE_SIZE = 128

H_A = 8
HD_A = 64
DILATED_BRANCHES = ((128, 1), (512, 4), (2048, 16))
WIN_MAX = 2048
BLK = 128
ROT_DIM = HD_A // 4
ROPE_THETA = 500000.0
H_B = 4
DK_B = 64
DV_B = 128
GATE_RANK = 16
GATE_NORM = 16.0
GLA_CHUNK = 64
MIX_W = H_A * HD_A + H_B * DV_B
D_FF = 2816
D_PLE = 256
EPS = 1e-6
PROJ_SPLITS = (H_A * HD_A, H_A * HD_A, H_A * HD_A, H_B * DK_B, H_B * DK_B, H_B * DV_B, GATE_RANK, H_B * DV_B)
PROJ_W = sum(PROJ_SPLITS)

kernel_name = 'hymba_dilated_swa_gla_macaron_step'


def rmsnorm(x, g):
    xf = x.astype(jnp.float32)
    y = xf * lax.rsqrt(jnp.mean(xf * xf, axis=-1, keepdims=True) + EPS)
    return (y * g.astype(jnp.float32)).astype(x.dtype)


def swiglu(x, w_gu, w_down):
    gate, up = jnp.split(x @ w_gu, 2, axis=-1)
    return (jax.nn.silu(gate) * up) @ w_down


def partial_rope(x, pos):
    half = ROT_DIM // 2
    inv_freq = ROPE_THETA ** (-jnp.arange(half, dtype=jnp.float32) * (2.0 / ROT_DIM))
    ang = pos.astype(jnp.float32)[:, None] * inv_freq[None, :]
    cos = jnp.cos(ang)[None, :, None, :]
    sin = jnp.sin(ang)[None, :, None, :]
    xr = x[..., :ROT_DIM].astype(jnp.float32)
    x1, x2 = xr[..., :half], xr[..., half:]
    rot = jnp.concatenate([x1 * cos - x2 * sin, x2 * cos + x1 * sin], axis=-1)
    return jnp.concatenate([rot.astype(x.dtype), x[..., ROT_DIM:]], axis=-1)


def dilated_branch_prompt(q, k, v, window, dil):
    B, S, H, Dh = q.shape
    n_back = window // dil
    L = S // dil
    nb = -(-L // BLK)
    Lp = nb * BLK

    def to_sub(t):
        t = t.reshape(B, L, dil, H, Dh)
        return jnp.pad(t, ((0, 0), (0, Lp - L), (0, 0), (0, 0), (0, 0)))

    def key_blocks(t):
        tp = jnp.pad(to_sub(t), ((0, 0), (BLK, 0), (0, 0), (0, 0), (0, 0)))
        prev = tp[:, :Lp].reshape(B, nb, BLK, dil, H, Dh)
        cur = tp[:, BLK:].reshape(B, nb, BLK, dil, H, Dh)
        return jnp.concatenate([prev, cur], axis=2)

    qs = to_sub(q).reshape(B, nb, BLK, dil, H, Dh)
    kb, vb = key_blocks(k), key_blocks(v)
    s = jnp.einsum('bnqrhd,bnkrhd->bnrhqk', qs, kb) * (Dh ** -0.5)
    qi = jnp.arange(BLK)[:, None]
    ki = jnp.arange(2 * BLK)[None, :]
    dist = qi + BLK - ki
    band = (dist >= 0) & (dist <= n_back)
    key_sub = jnp.arange(nb)[:, None] * BLK - BLK + ki
    mask = band[None] & (key_sub >= 0)[:, None, :]
    s = jnp.where(mask[None, :, None, None], s, -jnp.inf)
    m = jnp.max(s, axis=-1, keepdims=True)
    p = jnp.exp(s - m)
    den = jnp.sum(p, axis=-1)
    o = jnp.einsum('bnrhqk,bnkrhd->bnqrhd', p, vb)
    den_t = jnp.transpose(den, (0, 1, 4, 2, 3))
    o = o / den_t[..., None]
    lse = jnp.transpose(m[..., 0], (0, 1, 4, 2, 3)) + jnp.log(den_t)
    o = o.reshape(B, Lp, dil, H, Dh)[:, :L].reshape(B, S, H, Dh)
    lse = lse.reshape(B, Lp, dil, H)[:, :L].reshape(B, S, H)
    return o, lse


def dilated_branch_sample(q, k_all, v_all, window, dil):
    B, T, H, Dh = q.shape
    n_back = window // dil
    buf = k_all.shape[1] - T
    idx = buf + jnp.arange(T)[:, None] - dil * jnp.arange(n_back + 1)[None, :]
    valid = idx >= 0
    idx = jnp.maximum(idx, 0)
    kg = jnp.take(k_all, idx, axis=1)
    vg = jnp.take(v_all, idx, axis=1)
    s = jnp.einsum('bthd,btjhd->bthj', q, kg) * (Dh ** -0.5)
    s = jnp.where(valid[None, :, None, :], s, -jnp.inf)
    m = jnp.max(s, axis=-1, keepdims=True)
    p = jnp.exp(s - m)
    den = jnp.sum(p, axis=-1)
    o = jnp.einsum('bthj,btjhd->bthd', p, vg) / den[..., None]
    lse = m[..., 0] + jnp.log(den)
    return o, lse


def combine_branches(outs, lses):
    w = jax.nn.softmax(jnp.stack(lses, axis=0), axis=0)
    return jnp.sum(w[..., None] * jnp.stack(outs, axis=0), axis=0)


def gla_chunked(q, k, v, gk, s0, chunk):
    B, T, H, dk = q.shape
    dv = v.shape[-1]
    n = T // chunk

    def blocks(t):
        return jnp.swapaxes(t.reshape(B, n, chunk, H, t.shape[-1]), 0, 1)

    causal = jnp.tril(jnp.ones((chunk, chunk), dtype=bool))

    def step(S, inp):
        qc, kc, vc, gc = inp
        bcum = jnp.cumsum(gc, axis=1)
        o_inter = jnp.einsum('bchk,bhkv->bchv', qc * jnp.exp(bcum), S)
        diff = bcum[:, :, None] - bcum[:, None, :]
        decay = jnp.exp(jnp.where(causal[None, :, :, None, None], diff, -jnp.inf))
        A = jnp.einsum('bihk,bjhk,bijhk->bhij', qc, kc, decay)
        o_intra = jnp.einsum('bhij,bjhv->bihv', A, vc)
        btot = bcum[:, -1]
        kdec = kc * jnp.exp(btot[:, None] - bcum)
        S_new = jnp.exp(btot)[..., None] * S + jnp.einsum('bchk,bchv->bhkv', kdec, vc)
        return S_new, o_inter + o_intra

    s_fin, o = lax.scan(step, s0, (blocks(q), blocks(k), blocks(v), blocks(gk)))
    o = jnp.swapaxes(o, 0, 1).reshape(B, T, H, dv)
    return o, s_fin


def parallel_mixer(xn, pos, k_buf, v_buf, s_gla, w_in, w_gla_a2, b_gla_a, g_gla_out, w_out):
    B, T, _ = xn.shape
    f32 = jnp.float32
    offs = [int(o) for o in np.cumsum(PROJ_SPLITS)[:-1]]
    qa, ka, va, qb, kb, vb, a1, gb = jnp.split(xn @ w_in, offs, axis=-1)
    qa = partial_rope(qa.reshape(B, T, H_A, HD_A), pos)
    ka = partial_rope(ka.reshape(B, T, H_A, HD_A), pos)
    va = va.reshape(B, T, H_A, HD_A)
    outs, lses = [], []
    if k_buf is None:
        for window, dil in DILATED_BRANCHES:
            o, l = dilated_branch_prompt(qa.astype(f32), ka.astype(f32), va.astype(f32), window, dil)
            outs.append(o)
            lses.append(l)
        keep = min(WIN_MAX, T)
        new_k, new_v = ka[:, T - keep:], va[:, T - keep:]
        s0 = jnp.zeros((B, H_B, DK_B, DV_B), f32)
    else:
        k_all = jnp.concatenate([k_buf.astype(ka.dtype), ka], axis=1)
        v_all = jnp.concatenate([v_buf.astype(va.dtype), va], axis=1)
        for window, dil in DILATED_BRANCHES:
            o, l = dilated_branch_sample(qa.astype(f32), k_all.astype(f32), v_all.astype(f32), window, dil)
            outs.append(o)
            lses.append(l)
        keep = k_buf.shape[1]
        new_k, new_v = k_all[:, T:T + keep], v_all[:, T:T + keep]
        s0 = s_gla.astype(f32)
    att = combine_branches(outs, lses).astype(xn.dtype).reshape(B, T, H_A * HD_A)
    qg = qb.reshape(B, T, H_B, DK_B).astype(f32) * (DK_B ** -0.5)
    kg = kb.reshape(B, T, H_B, DK_B).astype(f32)
    vg = vb.reshape(B, T, H_B, DV_B).astype(f32)
    gk = jax.nn.log_sigmoid((a1 @ w_gla_a2 + b_gla_a).astype(f32)) / GATE_NORM
    gk = gk.reshape(B, T, H_B, DK_B)
    o_gla, s_fin = gla_chunked(qg, kg, vg, gk, s0, math.gcd(T, GLA_CHUNK))
    o_gla = rmsnorm(o_gla, g_gla_out) * jax.nn.silu(gb.reshape(B, T, H_B, DV_B).astype(f32))
    o_gla = o_gla.astype(xn.dtype).reshape(B, T, H_B * DV_B)
    out = jnp.concatenate([att, o_gla], axis=-1) @ w_out
    return out, new_k, new_v, s_fin.astype(xn.dtype)


def decoder_layer(h, p, pos, k_buf, v_buf, s_gla, g_ffn1, w_ffn1_gu, w_ffn1_down, g_mix, w_in,
                  w_gla_a2, b_gla_a, g_gla_out, w_out, g_ffn2, w_ffn2_gu, w_ffn2_down,
                  g_ple, w_ple_gate, w_ple_proj):
    h = h + 0.5 * swiglu(rmsnorm(h, g_ffn1), w_ffn1_gu, w_ffn1_down)
    m, nk, nv, ns = parallel_mixer(rmsnorm(h, g_mix), pos, k_buf, v_buf, s_gla,
                                   w_in, w_gla_a2, b_gla_a, g_gla_out, w_out)
    h = h + m
    h = h + 0.5 * swiglu(rmsnorm(h, g_ffn2), w_ffn2_gu, w_ffn2_down)
    h = h + jax.nn.sigmoid(rmsnorm(h, g_ple) @ w_ple_gate) * (p @ w_ple_proj)
    return h, nk, nv, ns


def setup_inputs(seed: int = 0) -> dict:
    key = jax.random.key(seed)
    ks = jax.random.split(key, 32)
    win_buf = min(WIN_MAX, PAST_LEN)

    def nrm(k, shape, scale):
        return jax.random.normal(k, shape, jnp.float32) * scale

    def gain(k, shape):
        return 1.0 + nrm(k, shape, 0.01)

    return {
        'x_prompt': nrm(ks[0], (BATCH, SEQ, D_MODEL), 1.0),
        'x_sample': nrm(ks[1], (DEC_BATCH, DEC_SEQ, D_MODEL), 1.0),
        'cache_k_win': nrm(ks[2], (DEPTH, DEC_BATCH, win_buf, H_A, HD_A), 1.0),
        'cache_v_win': nrm(ks[3], (DEPTH, DEC_BATCH, win_buf, H_A, HD_A), 1.0),
        'state_gla': nrm(ks[4], (DEPTH, DEC_BATCH, H_B, DK_B, DV_B), 0.5),
        'p_prompt': nrm(ks[5], (DEPTH, BATCH, SEQ, D_PLE), 1.0),
        'p_sample': nrm(ks[6], (DEPTH, DEC_BATCH, DEC_SEQ, D_PLE), 1.0),
        'g_ffn1': gain(ks[7], (DEPTH, D_MODEL)),
        'w_ffn1_gu': nrm(ks[8], (DEPTH, D_MODEL, 2 * D_FF), D_MODEL ** -0.5),
        'w_ffn1_down': nrm(ks[9], (DEPTH, D_FF, D_MODEL), D_FF ** -0.5),
        'g_mix': gain(ks[10], (DEPTH, D_MODEL)),
        'w_in': nrm(ks[11], (DEPTH, D_MODEL, PROJ_W), D_MODEL ** -0.5),
        'w_gla_a2': nrm(ks[12], (DEPTH, GATE_RANK, H_B * DK_B), GATE_RANK ** -0.5),
        'b_gla_a': nrm(ks[13], (DEPTH, H_B * DK_B), 0.01),
        'g_gla_out': gain(ks[14], (DEPTH, DV_B)),
        'w_out': nrm(ks[15], (DEPTH, MIX_W, D_MODEL), MIX_W ** -0.5),
        'g_ffn2': gain(ks[16], (DEPTH, D_MODEL)),
        'w_ffn2_gu': nrm(ks[17], (DEPTH, D_MODEL, 2 * D_FF), D_MODEL ** -0.5),
        'w_ffn2_down': nrm(ks[18], (DEPTH, D_FF, D_MODEL), D_FF ** -0.5),
        'g_ple': gain(ks[19], (DEPTH, D_MODEL)),
        'w_ple_gate': nrm(ks[20], (DEPTH, D_MODEL, D_MODEL), D_MODEL ** -0.5),
        'w_ple_proj': nrm(ks[21], (DEPTH, D_PLE, D_MODEL), D_PLE ** -0.5),
        'g_final': gain(ks[22], (D_MODEL,)),
    }


def reference(x_prompt, x_sample, cache_k_win, cache_v_win, state_gla, p_prompt, p_sample,
              g_ffn1, w_ffn1_gu, w_ffn1_down, g_mix, w_in, w_gla_a2, b_gla_a, g_gla_out, w_out,
              g_ffn2, w_ffn2_gu, w_ffn2_down, g_ple, w_ple_gate, w_ple_proj, g_final):
    pos_p = jnp.arange(x_prompt.shape[1], dtype=jnp.int32)
    pos_s = PAST_LEN + jnp.arange(x_sample.shape[1], dtype=jnp.int32)
    hp, hs = x_prompt, x_sample
    kp_l, vp_l, sp_l, ks_l, vs_l, ss_l = [], [], [], [], [], []
    for i in range(DEPTH):
        lw = (g_ffn1[i], w_ffn1_gu[i], w_ffn1_down[i], g_mix[i], w_in[i], w_gla_a2[i], b_gla_a[i],
              g_gla_out[i], w_out[i], g_ffn2[i], w_ffn2_gu[i], w_ffn2_down[i], g_ple[i],
              w_ple_gate[i], w_ple_proj[i])
        hp, nk, nv, ns = decoder_layer(hp, p_prompt[i], pos_p, None, None, None, *lw)
        kp_l.append(nk)
        vp_l.append(nv)
        sp_l.append(ns)
        hs, nk, nv, ns = decoder_layer(hs, p_sample[i], pos_s, cache_k_win[i], cache_v_win[i],
                                       state_gla[i], *lw)
        ks_l.append(nk)
        vs_l.append(nv)
        ss_l.append(ns)
    y_prompt = rmsnorm(hp, g_final)
    y_sample = rmsnorm(hs, g_final)
    k_win_prompt = jnp.stack(kp_l, axis=0)
    v_win_prompt = jnp.stack(vp_l, axis=0)
    state_gla_prompt = jnp.stack(sp_l, axis=0)
    k_win_sample = jnp.stack(ks_l, axis=0)
    v_win_sample = jnp.stack(vs_l, axis=0)
    state_gla_sample = jnp.stack(ss_l, axis=0)
    return (y_prompt, y_sample, k_win_prompt, v_win_prompt, state_gla_prompt, k_win_sample, v_win_sample, state_gla_sample)
```

```cpp
#include <hip/hip_runtime.h>
#include <cstdio>
#include <cstdint>

#ifndef PROBE_EPI2
#define PROBE_EPI2 0
#endif
#ifndef PROBE_SK2
#define PROBE_SK2 0
#endif
#ifndef MK_PER_PHASE
#define MK_PER_PHASE 0
#endif

#define LAS __attribute__((address_space(3)))
#define GAS __attribute__((address_space(1)))
typedef unsigned short bf16_t;
typedef short bf16x8 __attribute__((ext_vector_type(8)));
typedef short s16x4 __attribute__((ext_vector_type(4)));
typedef float f32x4 __attribute__((ext_vector_type(4)));
typedef float f32x2 __attribute__((ext_vector_type(2)));
typedef float f32x16 __attribute__((ext_vector_type(16)));
typedef unsigned u32x4 __attribute__((ext_vector_type(4)));
typedef unsigned u32x2 __attribute__((ext_vector_type(2)));

constexpr int DM = 1024, NBATCH = 8, SEQ = 2048, MPROMPT = NBATCH * SEQ, DEC_B = 32, DEC_T = 4, MSAMP = DEC_B * DEC_T;
constexpr int MTOT = MPROMPT + MSAMP  , MPAD = 16640  ;
constexpr int DFF = 2816, NGU = 2 * DFF, NPROJ = 3328  , DPLE = 256, PAST = 8192, WINB = 2048;
constexpr int HA = 8, HDA = 64, HB_ = 4, DKB = 64, DVB = 128;
constexpr float EPS = 1e-6f;
constexpr float C2Q = 0.125f * 1.4426950408889634f;
constexpr size_t OFF_Y = 0, OFF_KWP = (size_t)MTOT * DM, OFF_VWP = OFF_KWP + (size_t)MPROMPT * 512, OFF_SGP = OFF_VWP + (size_t)MPROMPT * 512,
                 OFF_KWS = OFF_SGP + (size_t)NBATCH * 4 * 64 * 128, OFF_VWS = OFF_KWS + (size_t)DEC_B * WINB * 512, OFF_SGS = OFF_VWS + (size_t)DEC_B * WINB * 512,
                 OUT_TOTAL = OFF_SGS + (size_t)DEC_B * 4 * 64 * 128;

constexpr size_t al256(size_t x) { return (x + 255) & ~(size_t)255; }
constexpr size_t WS_CTL = 0, CTL_BYTES = 1u << 20;
constexpr size_t WS_WGU1 = CTL_BYTES,                                   SZ_WGU = (size_t)NGU * DM * 2;
constexpr size_t WS_WGU2 = WS_WGU1 + SZ_WGU;
constexpr size_t WS_WD1 = WS_WGU2 + SZ_WGU,                             SZ_WD = (size_t)DM * DFF * 2;
constexpr size_t WS_WD2 = WS_WD1 + SZ_WD;
constexpr size_t WS_WIN = WS_WD2 + SZ_WD,                               SZ_WIN = (size_t)NPROJ * DM * 2;
constexpr size_t WS_WOUT = WS_WIN + SZ_WIN,                             SZ_W1K = (size_t)DM * DM * 2;
constexpr size_t WS_WPG = WS_WOUT + SZ_W1K;
constexpr size_t WS_WPP = WS_WPG + SZ_W1K,                              SZ_WPP = (size_t)DM * DPLE * 2;
constexpr size_t WS_HB = WS_WPP + SZ_WPP,                               SZ_HB = (size_t)MPAD * DM * 2;
constexpr size_t WS_ACT = WS_HB + SZ_HB,                                SZ_ACT = (size_t)MPAD * DFF * 2;
constexpr size_t WS_H32 = WS_ACT + SZ_ACT,                              SZ_H32 = (size_t)MPAD * DM * 4;
constexpr size_t WS_PROJ = WS_H32 + SZ_H32;
constexpr size_t WS_QA = WS_PROJ + SZ_HB,                               SZ_512 = (size_t)MPAD * 512 * 2, SZ_256 = (size_t)MPAD * 256 * 2;
constexpr size_t WS_KA = WS_QA + SZ_512, WS_VA = WS_KA + SZ_512, WS_QB = WS_VA + SZ_512, WS_KB = WS_QB + SZ_256, WS_VB = WS_KB + SZ_256, WS_GB = WS_VB + SZ_512;
constexpr size_t WS_A1 = WS_GB + SZ_512,                                SZ_A1 = (size_t)MPAD * 16 * 4;
constexpr size_t WS_A2 = WS_A1 + SZ_A1;
constexpr size_t WS_PB = WS_A2 + SZ_HB;
constexpr size_t WS_SSQ = WS_PB + SZ_256,                               SZ_SSQ = (size_t)MPAD * 16 * 4;
constexpr size_t WS_ROPE = WS_SSQ + 5 * SZ_SSQ,                         SZ_ROPE = al256((size_t)2052 * 16 * 4);
constexpr size_t WS_BTOT = WS_ROPE + SZ_ROPE,                           SZ_BTOT = (size_t)1024 * 64 * 4;
constexpr size_t WS_END = WS_BTOT + SZ_BTOT;
constexpr size_t WS_HCT = WS_ACT, SZ_HCT = (size_t)1024 * 8192 * 4;
constexpr size_t WS_SPT = WS_HCT + SZ_HCT, SZ_SPT = (size_t)1024 * 8192 * 2;
static_assert(SZ_HCT + SZ_SPT <= SZ_ACT, "overlay fits");
static_assert(WS_END <= (size_t)500 * 1024 * 1024, "workspace budget");

constexpr int RING_BYTES = 131072, LDSCTL_OFF = RING_BYTES, MISC_OFF = LDSCTL_OFF + 320, LDS_BYTES = 147456;
constexpr int NWAVES = 8;

#define LDS_WAIT() asm volatile("s_waitcnt lgkmcnt(0)" ::: "memory")
#define VM_WAIT() asm volatile("s_waitcnt vmcnt(0)" ::: "memory")
__device__ __forceinline__ unsigned f2bf(float f) { unsigned u = __builtin_bit_cast(unsigned, f); return (u + 0x7fffu + ((u >> 16) & 1u)) >> 16; }
__device__ __forceinline__ unsigned pk2(float lo, float hi) { return f2bf(lo) | (f2bf(hi) << 16); }
typedef __bf16 bf16x2_t __attribute__((ext_vector_type(2)));
__device__ __forceinline__ unsigned cvt_pk_bf16(float lo, float hi) { const f32x2 v = {lo, hi}; return __builtin_bit_cast(unsigned, __builtin_convertvector(v, bf16x2_t)); }
__device__ __forceinline__ float bf2f(unsigned short b) { return __uint_as_float(((unsigned)b) << 16); }
__device__ __forceinline__ float bflo(unsigned w) { return __uint_as_float(w << 16); }
__device__ __forceinline__ float bfhi(unsigned w) { return __uint_as_float(w & 0xffff0000u); }
__device__ __forceinline__ float fexp(float x) { return __builtin_amdgcn_exp2f(x * 1.4426950408889634f); }
__device__ __forceinline__ float sigmoidf_(float x) { return __builtin_amdgcn_rcpf(1.f + fexp(-x)); }
__device__ __forceinline__ float siluf_(float x) { return x * sigmoidf_(x); }
__device__ __forceinline__ float logsigf_(float x) { return fminf(x, 0.f) - __logf(1.f + fexp(-fabsf(x))); }
__device__ __forceinline__ float wave_sum(float v) {
#pragma unroll
    for (int o = 1; o < 64; o <<= 1) v += __shfl_xor(v, o);
    return v;
}
__device__ __forceinline__ int launder_v(int x) { asm volatile("" : "+v"(x)); return x; }
template <class T> __device__ __forceinline__ T* launder_s(T* p) { asm volatile("" : "+s"(p)); return p; }
#define TOT(ws_, i) ((unsigned*)((ws_) + WS_SSQ + (size_t)(i) * SZ_SSQ))
constexpr float SSQ_SCALE = 16384.f, SSQ_INV = 1.0f / (16384.f * DM);
__device__ __forceinline__ float rs_from_tot(unsigned t) { return rsqrtf((float)t * SSQ_INV + EPS); }
__device__ __forceinline__ void ssq_add(unsigned* tot, int row, float ss) { __hip_atomic_fetch_add(tot + row, (unsigned)(ss * SSQ_SCALE + 0.5f), __ATOMIC_RELAXED, __HIP_MEMORY_SCOPE_AGENT); }
__device__ __forceinline__ float row_rs(const unsigned* tot, int row) { return rs_from_tot(tot[row]); }
__device__ __forceinline__ void row_tot8(const unsigned* tot, int row0, unsigned (&t)[2][4]) {
#pragma unroll
    for (int ai = 0; ai < 2; ++ai)
#pragma unroll
        for (int m = 0; m < 4; ++m) t[ai][m] = tot[row0 + ai * 128 + m * 16];
}

constexpr int CPQ_ELEMS = (WINB - DEC_T) * 128 / 4  , CP_STEPS = (CPQ_ELEMS + 511) / 512  ;
struct CopyCur { const f32x4* src; f32x4* dst; int it; };
__device__ __forceinline__ CopyCur copy_cursor_init(const float* ck, const float* cv, float* out, int w) {
    const int seg = w >> 2, q = w & 3, tensor = seg >> 5, b = seg & 31;
    CopyCur c; c.src = (const f32x4*)(tensor ? cv : ck) + (size_t)b * (WINB * 128) + DEC_T * 128 + (size_t)q * CPQ_ELEMS;
    c.dst = (f32x4*)(out + (tensor ? OFF_VWS : OFF_KWS)) + (size_t)b * (WINB * 128) + (size_t)q * CPQ_ELEMS; c.it = 0; return c;
}
__device__ __forceinline__ void copy_cleanup(CopyCur& c, int tid) {
    for (; c.it < CP_STEPS; ++c.it) { const int e = c.it * 512 + tid; if (e < CPQ_ELEMS) __builtin_nontemporal_store(__builtin_nontemporal_load(c.src + e), c.dst + e); }
}

namespace pg8 {
constexpr int BM = 256, BK = 64, HALF = 128, HTB = HALF * BK * 2, STAGE_BYTES = 8 * HTB, NXCD = 8, WGM = 8;
__host__ __device__ __forceinline__ int lds_byte(int r, int c) { const int st = (r >> 4) * 2 + (c >> 5), rr = r & 15, cc = c & 31, ob = rr * 64 + cc * 2; return st * 1024 + (ob ^ (((ob >> 9) & 1) << 5)); }
__host__ __device__ __forceinline__ void stage_rc(int b, int& R, int& C) { const int st = b / 1024, sb = b % 1024, swz = sb ^ (((sb >> 9) & 1) << 5); R = (st >> 1) * 16 + swz / 64; C = (st & 1) * 32 + (swz % 64) / 2; }
__host__ __device__ __forceinline__ int perm32(int rho) { const int n = rho >> 4, i = rho & 15; return 8 * (i >> 2) + 4 * n + (i & 3); }
struct Unit { int pm, pn; };
struct Gemm { const bf16_t* A; const bf16_t* Bt; int M, N, K; };
struct StaticOrder {
    int nM, nN, nwg, G, c;
    __host__ __device__ void init(int M, int N, int G_, int c_) { nM = M / BM; nN = N / BM; nwg = nM * nN; G = G_; c = c_; }
    __host__ __device__ bool next(int i, Unit& u) const {
        const long L = (long)i * G + c; if (L >= nwg) return false;
        int wgid = (int)L; { const int q = nwg / NXCD, r = nwg % NXCD, xcd = wgid % NXCD, off = wgid / NXCD; wgid = (xcd < r ? xcd * (q + 1) : r * (q + 1) + (xcd - r) * q) + off; }
        const int nig = WGM * nN, gid = wgid / nig, fm = gid * WGM, gsz = (nM - fm) < WGM ? (nM - fm) : WGM;
        u.pm = fm + ((wgid % nig) % gsz); u.pn = (wgid % nig) / gsz; return true;
    }
    __device__ __forceinline__ void a_ready(const Unit&) const {}
    __device__ __forceinline__ void done(const Unit&) const {}
};

template <class Epi, class Sched, bool ALIGN_EPI>
__device__ __forceinline__ void gemm_phase(LAS unsigned char* lds, const Gemm g, const Sched& S, const Epi& E, CopyCur& cp) {
    const int tid = launder_v(threadIdx.x), wid = __builtin_amdgcn_readfirstlane(tid >> 6), lane = tid & 63, wr = wid >> 2, wc = wid & 3, fr = lane & 15, fq = lane >> 4;
    const int K = g.K, nt = K / BK;
    unsigned voffA[2], voffB[2];
#pragma unroll
    for (int i = 0; i < 2; ++i) { int R, C; stage_rc(tid * 16 + i * 8192, R, C); const int Rb = Epi::PERM ? ((R & ~31) + perm32(R & 31)) : R;
        voffA[i] = (unsigned)(R * K + C) * 2u; voffB[i] = (unsigned)(Rb * K + C) * 2u; }
    const size_t kstep = (size_t)(BK * 2);
    const size_t hstep = (size_t)HALF * K * 2;
    const size_t tstep = 2 * hstep;
    const unsigned ldsw = (unsigned)wid * 1024u;
    const int aoff = lds_byte(wr * 64 + fr, fq * 8), boff = lds_byte(wc * 32 + fr, fq * 8);
#define PG8_SA(b, h) (((b) * 2 + (h)) * HTB)
#define PG8_SB(b, h) ((4 + (b) * 2 + (h)) * HTB)
#define PG8_STAGE(bufoff, gbase, voff) do { _Pragma("unroll") for (int _i = 0; _i < 2; ++_i) \
        __builtin_amdgcn_global_load_lds((const unsigned*)((const char*)(gbase) + (voff)[_i]), (LAS unsigned*)(lds + (bufoff) + ldsw + _i * 8192), 16, 0, 0); } while (0)
#define PG8_LDA(dst, b, h) do { _Pragma("unroll") for (int m = 0; m < 4; ++m) _Pragma("unroll") for (int k = 0; k < 2; ++k) dst[m][k] = *(const LAS bf16x8*)(lds + PG8_SA(b, h) + aoff + m * 2048 + k * 1024); } while (0)
#define PG8_LDB(dst, b, h) do { _Pragma("unroll") for (int n = 0; n < 2; ++n) _Pragma("unroll") for (int k = 0; k < 2; ++k) dst[n][k] = *(const LAS bf16x8*)(lds + PG8_SB(b, h) + boff + n * 2048 + k * 1024); } while (0)
#define PG8_MMA(ai, bj, At, Bt) do { __builtin_amdgcn_s_setprio(1); _Pragma("unroll") for (int m = 0; m < 4; ++m) _Pragma("unroll") for (int n = 0; n < 2; ++n) _Pragma("unroll") for (int k = 0; k < 2; ++k) \
        acc[ai][bj][m][n] = __builtin_amdgcn_mfma_f32_16x16x32_bf16(Bt[n][k], At[m][k], acc[ai][bj][m][n], 0, 0, 0); __builtin_amdgcn_s_setprio(0); } while (0)
#define PG8_WAIT_V(n) asm volatile("s_waitcnt vmcnt(" #n ")" ::: "memory")
#define PG8_WAIT_VC() do { if (ncp == 0) PG8_WAIT_V(8); else if (ncp == 1) PG8_WAIT_V(9); else PG8_WAIT_V(10); } while (0)
#define PG8_WAIT_L(n) asm volatile("s_waitcnt lgkmcnt(" #n ")" ::: "memory")
#define PG8_BAR __builtin_amdgcn_s_barrier()
#define PG8_SCHED __builtin_amdgcn_sched_barrier(0)
    Unit cur, nxt; int ui = 0;
    if (!S.next(0, cur)) return;
    unsigned pre[2][4] = {{0u, 0u, 0u, 0u}, {0u, 0u, 0u, 0u}};
    if constexpr (Epi::PRE) E.prefetch(cur, wr, fr, pre);
    f32x4 acc[2][2][4][2];
#pragma unroll
    for (int a = 0; a < 2; ++a)
#pragma unroll
        for (int b = 0; b < 2; ++b)
#pragma unroll
            for (int m = 0; m < 4; ++m)
#pragma unroll
                for (int n = 0; n < 2; ++n) acc[a][b][m][n] = (f32x4){0.f, 0.f, 0.f, 0.f};
    bf16x8 At[4][2], B0[2][2], B1[2][2];
    f32x4 cp_data = (f32x4){0.f, 0.f, 0.f, 0.f}; int cp_e = 0; bool cp_pending = false;
    const char* cA = (const char*)g.A + (size_t)cur.pm * tstep; const char* cB = (const char*)g.Bt + (size_t)cur.pn * tstep;
    S.a_ready(cur);
    PG8_STAGE(PG8_SB(0, 0), cB, voffB); PG8_STAGE(PG8_SB(0, 1), cB + hstep, voffB); PG8_STAGE(PG8_SA(0, 0), cA, voffA); PG8_STAGE(PG8_SA(0, 1), cA + hstep, voffA);
    if (wr == 1) PG8_BAR;
    PG8_WAIT_V(2); PG8_BAR;
    PG8_STAGE(PG8_SB(1, 0), cB + kstep, voffB); PG8_STAGE(PG8_SA(1, 0), cA + kstep, voffA); PG8_STAGE(PG8_SB(1, 1), cB + hstep + kstep, voffB);
    PG8_WAIT_V(6); PG8_BAR;
    for (;;) {
        const bool has_next = S.next(ui + 1, nxt);
        const char* nA = has_next ? (const char*)g.A + (size_t)nxt.pm * tstep : cA; const char* nB = has_next ? (const char*)g.Bt + (size_t)nxt.pn * tstep : cB;
#pragma nounroll
        for (int t = 0; t < nt; t += 2) {
            const bool last = (t == nt - 2);
            const char* a1 = cA + (size_t)(t + 1) * kstep;
            const char* a2 = last ? nA : cA + (size_t)(t + 2) * kstep; const char* b2 = last ? nB : cB + (size_t)(t + 2) * kstep;
            const char* a3 = a2 + kstep; const char* b3 = b2 + kstep;
            if (last && has_next) S.a_ready(nxt);
            PG8_LDB(B0, 0, 0); PG8_LDB(B1, 0, 1); PG8_SCHED; PG8_LDA(At, 0, 0); PG8_STAGE(PG8_SA(1, 1), a1 + hstep, voffA);
            int ncp = 0;
            if (cp_pending) { asm volatile("global_store_dwordx4 %0, %1, off nt\n\ts_nop 1" :: "v"(cp.dst + cp_e), "v"(cp_data) : "memory"); ncp = 1; cp_pending = false; }
            if (cp.it < CP_STEPS && !last) {
                cp_e = cp.it * 512 + tid; ++cp.it;
                if (cp.it * 512 - 512 + wid * 64 < CPQ_ELEMS) { asm volatile("global_load_dwordx4 %0, %1, off nt" : "=v"(cp_data) : "v"(cp.src + cp_e) : "memory"); ++ncp; cp_pending = true; }
            }
            PG8_WAIT_VC(); PG8_WAIT_L(0); PG8_BAR; PG8_MMA(0, 0, At, B0); PG8_MMA(0, 1, At, B1); PG8_BAR; PG8_SCHED;
            PG8_LDA(At, 0, 1); PG8_STAGE(PG8_SB(0, 0), b2, voffB); PG8_STAGE(PG8_SB(0, 1), b2 + hstep, voffB); PG8_STAGE(PG8_SA(0, 0), a2, voffA);
            PG8_WAIT_VC(); PG8_WAIT_L(0); PG8_BAR; PG8_MMA(1, 0, At, B0); PG8_MMA(1, 1, At, B1); PG8_BAR; PG8_SCHED;
            PG8_LDB(B0, 1, 0); PG8_LDB(B1, 1, 1); PG8_SCHED; PG8_LDA(At, 1, 0); PG8_STAGE(PG8_SA(0, 1), a2 + hstep, voffA);
            PG8_WAIT_VC(); PG8_WAIT_L(0); PG8_BAR; PG8_MMA(0, 0, At, B0); PG8_MMA(0, 1, At, B1); PG8_BAR; PG8_SCHED;
            PG8_LDA(At, 1, 1); PG8_STAGE(PG8_SB(1, 0), b3, voffB); PG8_STAGE(PG8_SB(1, 1), b3 + hstep, voffB); PG8_STAGE(PG8_SA(1, 0), a3, voffA);
            PG8_WAIT_V(8); PG8_WAIT_L(0); PG8_BAR; PG8_MMA(1, 0, At, B0); PG8_MMA(1, 1, At, B1); PG8_BAR; PG8_SCHED;
        }
        if constexpr (ALIGN_EPI) { if (wr == 0) PG8_BAR; }
#if PROBE_EPI2
        if constexpr (Epi::PROBE2) { Epi Ed = E; Ed.dry = 1; Ed(acc, cur, wr, wc, fr, fq, pre); asm volatile("s_waitcnt vmcnt(0)" ::: "memory"); }
#endif
        E(acc, cur, wr, wc, fr, fq, pre); S.done(cur);
        if (!has_next) break;
        if constexpr (Epi::PRE) E.prefetch(nxt, wr, fr, pre);
#pragma unroll
        for (int a = 0; a < 2; ++a)
#pragma unroll
            for (int b = 0; b < 2; ++b)
#pragma unroll
                for (int m = 0; m < 4; ++m)
#pragma unroll
                    for (int n = 0; n < 2; ++n) acc[a][b][m][n] = (f32x4){0.f, 0.f, 0.f, 0.f};
        cur = nxt; cA = nA; cB = nB; ++ui;
        if constexpr (ALIGN_EPI) { if (wr == 1) PG8_BAR; }
    }
    PG8_WAIT_V(0);
    if constexpr (!ALIGN_EPI) { if (wr == 0) PG8_BAR; }
    PG8_BAR;
#undef PG8_SA
#undef PG8_SB
#undef PG8_STAGE
#undef PG8_LDA
#undef PG8_LDB
#undef PG8_MMA
#undef PG8_WAIT_V
#undef PG8_WAIT_VC
#undef PG8_WAIT_L
#undef PG8_BAR
#undef PG8_SCHED
}


template <int SSQI> struct EpiSwiGLU {
    static constexpr bool PERM = true, PROBE2 = true, PRE = true;
    unsigned char* ws; int dry;
    __device__ __forceinline__ void prefetch(const Unit& u, int wr, int fr, unsigned (&pre)[2][4]) const { row_tot8(TOT(ws, SSQI), u.pm * BM + wr * 64 + fr, pre); }
    __device__ __forceinline__ void operator()(const f32x4 (&acc)[2][2][4][2], const Unit& u, int wr, int wc, int fr, int fq, const unsigned (&pre)[2][4]) const {
        bf16_t* O = (bf16_t*)(ws + WS_ACT);
        const int row0 = u.pm * BM + wr * 64 + fr, col0 = u.pn * 128 + wc * 32 + 8 * fq;
#pragma unroll
        for (int ai = 0; ai < 2; ++ai)
#pragma unroll
            for (int m = 0; m < 4; ++m) {
                const int row = row0 + ai * HALF + m * 16; const float rs = rs_from_tot(pre[ai][m]);
                float o[8];
#pragma unroll
                for (int n = 0; n < 2; ++n)
#pragma unroll
                    for (int j = 0; j < 4; ++j) { const float gt = acc[ai][0][m][n][j] * rs, up = acc[ai][1][m][n][j] * rs; o[n * 4 + j] = siluf_(gt) * up; }
                u32x4 w; w.x = cvt_pk_bf16(o[0], o[1]); w.y = cvt_pk_bf16(o[2], o[3]); w.z = cvt_pk_bf16(o[4], o[5]); w.w = cvt_pk_bf16(o[6], o[7]);
                *(u32x4*)(O + (size_t)row * DFF + col0) = w;
            }
    }
};
struct EpiPlainBf16 {
    static constexpr bool PERM = true, PROBE2 = true, PRE = false;
    unsigned char* ws; int dry;
    __device__ __forceinline__ void operator()(const f32x4 (&acc)[2][2][4][2], const Unit& u, int wr, int wc, int fr, int fq, const unsigned (&)[2][4]) const {
        bf16_t* O = (bf16_t*)(ws + WS_PROJ); constexpr int ldc = DM;
        const int row0 = u.pm * BM + wr * 64 + fr, col0 = u.pn * BM + wc * 32 + 8 * fq;
#pragma unroll
        for (int ai = 0; ai < 2; ++ai)
#pragma unroll
            for (int m = 0; m < 4; ++m) { bf16_t* rowp = O + (size_t)(row0 + ai * HALF + m * 16) * ldc + col0;
#pragma unroll
                for (int bj = 0; bj < 2; ++bj) { const f32x4 v0 = acc[ai][bj][m][0], v1 = acc[ai][bj][m][1];
                    u32x4 w; w.x = cvt_pk_bf16(v0[0], v0[1]); w.y = cvt_pk_bf16(v0[2], v0[3]); w.z = cvt_pk_bf16(v1[0], v1[1]); w.w = cvt_pk_bf16(v1[2], v1[3]);
                    *(u32x4*)(rowp + bj * HALF) = w; } }
    }
};
template <int MODE  , int SSQO, bool FROM_X  > struct EpiResid {
    static constexpr bool PERM = true, PROBE2 = true, PRE = false;
    const float* xP; unsigned char* ws; float scale; int dry;
    __device__ __forceinline__ void operator()(const f32x4 (&acc)[2][2][4][2], const Unit& u, int wr, int wc, int fr, int fq, const unsigned (&)[2][4]) const {
        bf16_t* HBp = (bf16_t*)(ws + WS_HB); unsigned* ssq_out = TOT(ws, SSQO);
        const int col0 = u.pn * BM + wc * 32 + 8 * fq, row00 = u.pm * BM + wr * 64 + fr;
        u32x4 bn_[2];
#pragma unroll
        for (int bj = 0; bj < 2; ++bj) bn_[bj] = *(const u32x4*)(HBp + (size_t)row00 * DM + col0 + bj * HALF);
#pragma unroll
        for (int ai = 0; ai < 2; ++ai)
#pragma unroll
            for (int m = 0; m < 4; ++m) {
                const int row = row00 + ai * HALF + m * 16;
                u32x4 bc[2];
#pragma unroll
                for (int bj = 0; bj < 2; ++bj) bc[bj] = bn_[bj];
                if (ai * 4 + m < 7) { const int rown = row00 + ((ai * 4 + m + 1) >> 2) * HALF + ((ai * 4 + m + 1) & 3) * 16;
#pragma unroll
                    for (int bj = 0; bj < 2; ++bj) bn_[bj] = *(const u32x4*)(HBp + (size_t)rown * DM + col0 + bj * HALF); }
                float ss = 0.f;
#pragma unroll
                for (int bj = 0; bj < 2; ++bj) {
                    const u32x4 w0 = bc[bj];
                    const f32x4 v0 = (f32x4){bflo(w0.x), bfhi(w0.x), bflo(w0.y), bfhi(w0.y)} + acc[ai][bj][m][0] * scale;
                    const f32x4 v1 = (f32x4){bflo(w0.z), bfhi(w0.z), bflo(w0.w), bfhi(w0.w)} + acc[ai][bj][m][1] * scale;
                    if (!dry) { u32x4 w; w.x = cvt_pk_bf16(v0[0], v0[1]); w.y = cvt_pk_bf16(v0[2], v0[3]); w.z = cvt_pk_bf16(v1[0], v1[1]); w.w = cvt_pk_bf16(v1[2], v1[3]);
                        *(u32x4*)(HBp + (size_t)row * DM + col0 + bj * HALF) = w; }
                    ss += ((v0[0] * v0[0] + v0[1] * v0[1]) + (v0[2] * v0[2] + v0[3] * v0[3])) + ((v1[0] * v1[0] + v1[1] * v1[1]) + (v1[2] * v1[2] + v1[3] * v1[3])); }
                ss += __shfl_xor(ss, 16); ss += __shfl_xor(ss, 32);
                if (fq == 0 && !dry) ssq_add(ssq_out, row, ss);
            }
    }
};
constexpr int CW_PANEL = 8192;
struct EpiPleNorm {
    static constexpr bool PERM = true, PROBE2 = false, PRE = true;
    unsigned char* ws; float* out; const float* gfin; unsigned want; int dry;
    __device__ __forceinline__ void prefetch(const Unit& u, int wr, int fr, unsigned (&pre)[2][4]) const { row_tot8(TOT(ws, 3), u.pm * BM + wr * 64 + fr, pre); }
    __device__ __forceinline__ void operator()(f32x4 (&acc)[2][2][4][2], const Unit& u, int wr, int wc, int fr, int fq, const unsigned (&pre)[2][4]) const {
        const bf16_t* HBp = (const bf16_t*)(ws + WS_HB); const bf16_t* proj = (const bf16_t*)(ws + WS_PROJ);
        unsigned* ssq4 = TOT(ws, 4);
        const int col0 = u.pn * BM + wc * 32 + 8 * fq, row00 = u.pm * BM + wr * 64 + fr;
        u32x4 pn_[2], bn_[2];
#pragma unroll
        for (int bj = 0; bj < 2; ++bj) { pn_[bj] = *(const u32x4*)(proj + (size_t)row00 * DM + col0 + bj * HALF); bn_[bj] = *(const u32x4*)(HBp + (size_t)row00 * DM + col0 + bj * HALF); }
#pragma unroll
        for (int ai = 0; ai < 2; ++ai)
#pragma unroll
            for (int m = 0; m < 4; ++m) {
                const int row = row00 + ai * HALF + m * 16;
                const float rs = rs_from_tot(pre[ai][m]);
                u32x4 pc[2], bc[2];
#pragma unroll
                for (int bj = 0; bj < 2; ++bj) { pc[bj] = pn_[bj]; bc[bj] = bn_[bj]; }
                if (ai * 4 + m < 7) { const int rown = row00 + ((ai * 4 + m + 1) >> 2) * HALF + ((ai * 4 + m + 1) & 3) * 16;
#pragma unroll
                    for (int bj = 0; bj < 2; ++bj) { pn_[bj] = *(const u32x4*)(proj + (size_t)rown * DM + col0 + bj * HALF); bn_[bj] = *(const u32x4*)(HBp + (size_t)rown * DM + col0 + bj * HALF); } }
                float ss = 0.f;
#pragma unroll
                for (int bj = 0; bj < 2; ++bj) {
                    const u32x4 b0 = bc[bj], p0 = pc[bj];
                    const f32x4 a0 = acc[ai][bj][m][0] * rs, a1 = acc[ai][bj][m][1] * rs; f32x4 v0, v1;
                    v0[0] = bflo(b0.x) + sigmoidf_(a0[0]) * bflo(p0.x); v0[1] = bfhi(b0.x) + sigmoidf_(a0[1]) * bfhi(p0.x); v0[2] = bflo(b0.y) + sigmoidf_(a0[2]) * bflo(p0.y); v0[3] = bfhi(b0.y) + sigmoidf_(a0[3]) * bfhi(p0.y);
                    v1[0] = bflo(b0.z) + sigmoidf_(a1[0]) * bflo(p0.z); v1[1] = bfhi(b0.z) + sigmoidf_(a1[1]) * bfhi(p0.z); v1[2] = bflo(b0.w) + sigmoidf_(a1[2]) * bflo(p0.w); v1[3] = bfhi(b0.w) + sigmoidf_(a1[3]) * bfhi(p0.w);
                    acc[ai][bj][m][0] = v0; acc[ai][bj][m][1] = v1;
                    ss += ((v0[0] * v0[0] + v0[1] * v0[1]) + (v0[2] * v0[2] + v0[3] * v0[3])) + ((v1[0] * v1[0] + v1[1] * v1[1]) + (v1[2] * v1[2] + v1[3] * v1[3])); }
                ss += __shfl_xor(ss, 16); ss += __shfl_xor(ss, 32);
                if (fq == 0 && !dry) ssq_add(ssq4, row, ss);
            }
        asm volatile("s_waitcnt vmcnt(0)" ::: "memory");
        unsigned* cnt = (unsigned*)(ws + WS_CTL) + CW_PANEL + 64 * u.pm;
        if (fr == 0 && fq == 0) __hip_atomic_fetch_add(cnt, 1u, __ATOMIC_RELAXED, __HIP_MEMORY_SCOPE_AGENT);
        if (wr == 0 && wc == 0) {
            unsigned sp = 0;
            while ((unsigned)__builtin_amdgcn_readfirstlane(__hip_atomic_load(cnt, __ATOMIC_RELAXED, __HIP_MEMORY_SCOPE_AGENT)) < want) { __builtin_amdgcn_s_sleep(2); if (++sp > (1u << 20)) break; }
        }
        asm volatile("s_waitcnt vmcnt(0) lgkmcnt(0)" ::: "memory"); __builtin_amdgcn_s_barrier(); asm volatile("" ::: "memory");
        f32x4 g[2][2];
#pragma unroll
        for (int bj = 0; bj < 2; ++bj)
#pragma unroll
            for (int n = 0; n < 2; ++n) g[bj][n] = *(const f32x4*)(gfin + col0 + bj * HALF + n * 4);
#pragma unroll
        for (int ai = 0; ai < 2; ++ai)
#pragma unroll
            for (int m = 0; m < 4; ++m) {
                const int row = row00 + ai * HALF + m * 16;
                const float rs4 = rs_from_tot(__hip_atomic_load(ssq4 + row, __ATOMIC_RELAXED, __HIP_MEMORY_SCOPE_AGENT));
                if (!dry) {
#pragma unroll
                    for (int bj = 0; bj < 2; ++bj)
#pragma unroll
                        for (int n = 0; n < 2; ++n) __builtin_nontemporal_store(acc[ai][bj][m][n] * rs4 * g[bj][n], (f32x4*)(out + OFF_Y + (size_t)row * DM + col0 + bj * HALF + n * 4));
                }
            }
    }
};
struct EpiMix {
    static constexpr bool PERM = true, PROBE2 = true, PRE = true;
    unsigned char* ws; float* out; int dry;
    __device__ __forceinline__ void prefetch(const Unit& u, int wr, int fr, unsigned (&pre)[2][4]) const { row_tot8(TOT(ws, 1), u.pm * BM + wr * 64 + fr, pre); }
    __device__ __forceinline__ void operator()(const f32x4 (&acc)[2][2][4][2], const Unit& u, int wr, int wc, int fr, int fq, const unsigned (&pre)[2][4]) const {
        const float* rope = (const float*)(ws + WS_ROPE);
        bf16_t *QA = (bf16_t*)(ws + WS_QA), *KA = (bf16_t*)(ws + WS_KA), *VA = (bf16_t*)(ws + WS_VA), *QB = (bf16_t*)(ws + WS_QB), *KB = (bf16_t*)(ws + WS_KB), *VB = (bf16_t*)(ws + WS_VB), *GB = (bf16_t*)(ws + WS_GB);
        float* A1 = (float*)(ws + WS_A1);
        const int pn = u.pn;
        if (pn == 12 && wc != 0) return;
        const bool do_rope = (pn < 4) && ((wc & 1) == 0);
        const int row00 = u.pm * BM + wr * 64 + fr, cb = wc * 32 + 8 * fq;
        f32x4 tn[4];
#pragma unroll
        for (int k = 0; k < 4; ++k) tn[k] = (f32x4){0.f, 0.f, 0.f, 0.f};
        if (do_rope) { const int posidx = row00 & (SEQ - 1);
#pragma unroll
            for (int k = 0; k < 4; ++k) tn[k] = *(const f32x4*)(rope + (size_t)posidx * 16 + 4 * k); }
#pragma unroll
        for (int ai = 0; ai < 2; ++ai)
#pragma unroll
            for (int m = 0; m < 4; ++m) {
                const int row = row00 + ai * HALF + m * 16;
                const float rs = rs_from_tot(pre[ai][m]);
                f32x4 v[2][2];
#pragma unroll
                for (int bj = 0; bj < 2; ++bj)
#pragma unroll
                    for (int n = 0; n < 2; ++n) v[bj][n] = acc[ai][bj][m][n] * rs;
                if (do_rope) {
                    f32x4 t[4];
#pragma unroll
                    for (int k = 0; k < 4; ++k) t[k] = tn[k];
                    if (ai * 4 + m < 7) { const int rown = row00 + ((ai * 4 + m + 1) >> 2) * HALF + ((ai * 4 + m + 1) & 3) * 16; const int posn = rown & (SEQ - 1);
#pragma unroll
                        for (int k = 0; k < 4; ++k) tn[k] = *(const f32x4*)(rope + (size_t)posn * 16 + 4 * k); }
#pragma unroll
                    for (int bj = 0; bj < 2; ++bj)
#pragma unroll
                        for (int n = 0; n < 2; ++n)
#pragma unroll
                            for (int j = 0; j < 4; ++j) { const float cs = t[2 * n + (j >> 1)][2 * (j & 1)], sn = t[2 * n + (j >> 1)][2 * (j & 1) + 1];
                                const float x = v[bj][n][j], w = __shfl_xor(x, 16);
                                if (fq < 2) v[bj][n][j] = (fq == 0) ? (x * cs - w * sn) : (x * cs + w * sn); }
                }
                if (pn < 6) {
                    const int kind = pn >> 1, c0 = (pn & 1) * 256 + cb;
                    bf16_t* dst = (kind == 0 ? QA : (kind == 1 ? KA : VA)) + (size_t)row * 512 + c0;
                    const float sc = kind == 0 ? C2Q : 1.f;
                    float* fo = kind == 0 ? nullptr : out + (kind == 1 ? OFF_KWP : OFF_VWP) + (size_t)row * 512 + c0;
#pragma unroll
                    for (int bj = 0; bj < 2; ++bj) { const f32x4 x0 = v[bj][0], x1 = v[bj][1];
                        u32x4 w; w.x = cvt_pk_bf16(x0[0] * sc, x0[1] * sc); w.y = cvt_pk_bf16(x0[2] * sc, x0[3] * sc); w.z = cvt_pk_bf16(x1[0] * sc, x1[1] * sc); w.w = cvt_pk_bf16(x1[2] * sc, x1[3] * sc);
                        *(u32x4*)(dst + bj * HALF) = w;
                        if (fo) { *(f32x4*)(fo + bj * HALF) = x0; *(f32x4*)(fo + bj * HALF + 4) = x1; } }
                } else if (pn < 12) {
                    bf16_t* dst; float sc = 1.f;
                    if (pn == 6) { dst = QB + (size_t)row * 256; sc = 0.125f; }
                    else if (pn == 7) dst = KB + (size_t)row * 256;
                    else if (pn < 10) dst = VB + (size_t)row * 512 + (pn - 8) * 256;
                    else dst = GB + (size_t)row * 512 + (pn - 10) * 256;
                    dst += cb;
#pragma unroll
                    for (int bj = 0; bj < 2; ++bj) { const f32x4 x0 = v[bj][0] * sc, x1 = v[bj][1] * sc;
                        u32x4 w; w.x = cvt_pk_bf16(x0[0], x0[1]); w.y = cvt_pk_bf16(x0[2], x0[3]); w.z = cvt_pk_bf16(x1[0], x1[1]); w.w = cvt_pk_bf16(x1[2], x1[3]);
                        *(u32x4*)(dst + bj * HALF) = w; }
                } else if (fq < 2) {
                    *(f32x4*)(A1 + (size_t)row * 16 + 8 * fq) = v[0][0]; *(f32x4*)(A1 + (size_t)row * 16 + 8 * fq + 4) = v[0][1];
                }
            }
    }
};
}


namespace sk {
template <class Epi> __device__ __forceinline__ void tile1(const bf16_t* A, int K, const bf16_t* Bt, const Epi& E, int task, int lane, int wave, LAS unsigned char* lds) {
    const int tn = task >> 1, rh = task & 1, fr = lane & 15, fq = lane >> 4;
    const int kw = K >> 3, nks = kw >> 5;
    const bf16_t* ap = A + (size_t)(64 * rh + fr) * K + wave * kw + 8 * fq;
    const bf16_t* bp[4];
#pragma unroll
    for (int f = 0; f < 4; ++f) bp[f] = Bt + (size_t)Epi::brow(tn, f, fr) * K + wave * kw + 8 * fq;
    f32x4 acc[4][4];
#pragma unroll
    for (int m = 0; m < 4; ++m)
#pragma unroll
        for (int f = 0; f < 4; ++f) acc[m][f] = (f32x4){0.f, 0.f, 0.f, 0.f};
#pragma nounroll
    for (int k0 = 0; k0 < nks; k0 += 4) {
        bf16x8 a[4][4], b[4][4];
#pragma unroll
        for (int q = 0; q < 4; ++q) {
            const int ks = (k0 + q < nks) ? k0 + q : nks - 1;
#pragma unroll
            for (int m = 0; m < 4; ++m) a[q][m] = *(const bf16x8*)(ap + (size_t)m * 16 * K + 32 * ks);
#pragma unroll
            for (int f = 0; f < 4; ++f) b[q][f] = *(const bf16x8*)(bp[f] + 32 * ks);
        }
#pragma unroll
        for (int q = 0; q < 4; ++q) {
            if (k0 + q < nks) {
#pragma unroll
                for (int m = 0; m < 4; ++m)
#pragma unroll
                    for (int f = 0; f < 4; ++f) acc[m][f] = __builtin_amdgcn_mfma_f32_16x16x32_bf16(b[q][f], a[q][m], acc[m][f], 0, 0, 0);
            }
        }
    }
    LAS f32x4* red = (LAS f32x4*)lds;
#pragma unroll
    for (int m = 0; m < 4; ++m)
#pragma unroll
        for (int f = 0; f < 4; ++f) red[(wave * 16 + m * 4 + f) * 64 + lane] = acc[m][f];
    LDS_WAIT(); __syncthreads();
    if (wave < 4) {
        f32x4 r[4];
#pragma unroll
        for (int f = 0; f < 4; ++f) { f32x4 sacc = red[(wave * 4 + f) * 64 + lane];
#pragma unroll
            for (int w = 1; w < 8; ++w) sacc += red[(w * 16 + wave * 4 + f) * 64 + lane];
            r[f] = sacc; }
        E(tn, 64 * rh + 16 * wave + fr, fq, r);
    }
    LDS_WAIT(); __syncthreads();
}
template <class Epi> __device__ __forceinline__ void tile(const bf16_t* A, int K, const bf16_t* Bt, const Epi& E, int task, int lane, int wave, LAS unsigned char* lds) {
#if PROBE_SK2
    { Epi Ed = E; Ed.dry = 1; tile1(A, K, Bt, Ed, task, lane, wave, lds); }
#endif
    tile1(A, K, Bt, E, task, lane, wave, lds);
}
__device__ __forceinline__ void st_bf4(bf16_t* p, const f32x4 v) { u32x2 w; w.x = cvt_pk_bf16(v[0], v[1]); w.y = cvt_pk_bf16(v[2], v[3]); *(u32x2*)p = w; }
template <int SSQI> struct EpiSwiGLU {
    unsigned char* ws; int dry;
    static __device__ __forceinline__ int brow(int tn, int f, int n) { const int gc = 32 * tn + 16 * (f & 1) + n; return 256 * (gc >> 7) + 128 * (f >> 1) + (gc & 127); }
    __device__ __forceinline__ void operator()(int tn, int srow, int fq, const f32x4 (&acc)[4]) const {
        const int row = MPROMPT + srow; const float rs = row_rs(TOT(ws, SSQI), row);
        bf16_t* O = (bf16_t*)(ws + WS_ACT) + (size_t)row * DFF + 32 * tn + 4 * fq;
#pragma unroll
        for (int f = 0; f < 2; ++f) { f32x4 o;
#pragma unroll
            for (int j = 0; j < 4; ++j) o[j] = siluf_(acc[f][j] * rs) * (acc[f + 2][j] * rs);
            st_bf4(O + 16 * f, o); }
    }
};
struct EpiPlain {
    unsigned char* ws; int dry;
    static __device__ __forceinline__ int brow(int tn, int f, int n) { return 64 * tn + 16 * f + n; }
    __device__ __forceinline__ void operator()(int tn, int srow, int fq, const f32x4 (&acc)[4]) const {
        bf16_t* O = (bf16_t*)(ws + WS_PROJ) + (size_t)(MPROMPT + srow) * DM + 64 * tn + 4 * fq;
#pragma unroll
        for (int f = 0; f < 4; ++f) st_bf4(O + 16 * f, acc[f]);
    }
};
template <int MODE, int SSQO, bool FROM_X> struct EpiResid {
    const float* xS; unsigned char* ws; float scale; int dry;
    static __device__ __forceinline__ int brow(int tn, int f, int n) { return 64 * tn + 16 * f + n; }
    __device__ __forceinline__ void operator()(int tn, int srow, int fq, const f32x4 (&acc)[4]) const {
        const int row = MPROMPT + srow;
        bf16_t* HBp = (bf16_t*)(ws + WS_HB) + (size_t)row * DM + 64 * tn + 4 * fq; bf16_t* Out = MODE == 0 ? HBp : (bf16_t*)(ws + WS_A2) + (size_t)row * DM + 64 * tn + 4 * fq;
        const float* xp = xS + (size_t)srow * DM + 64 * tn + 4 * fq;
        const bf16_t* pj = (const bf16_t*)(ws + WS_PROJ) + (size_t)row * DM + 64 * tn + 4 * fq;
        float rs = 1.f; if (MODE == 1) rs = row_rs(TOT(ws, SSQO - 1), row);
        float ss = 0.f;
#pragma unroll
        for (int f = 0; f < 4; ++f) { f32x4 bq;
            if (FROM_X) bq = *(const f32x4*)(xp + 16 * f);
            else { const u32x2 bw = *(const u32x2*)(HBp + 16 * f); bq = (f32x4){bflo(bw.x), bfhi(bw.x), bflo(bw.y), bfhi(bw.y)}; }
            f32x4 v;
            if (MODE == 0) v = bq + acc[f] * scale;
            else { const u32x2 pw = *(const u32x2*)(pj + 16 * f); const f32x4 a = acc[f] * rs;
                v[0] = bq[0] + sigmoidf_(a[0]) * bflo(pw.x); v[1] = bq[1] + sigmoidf_(a[1]) * bfhi(pw.x); v[2] = bq[2] + sigmoidf_(a[2]) * bflo(pw.y); v[3] = bq[3] + sigmoidf_(a[3]) * bfhi(pw.y); }
            if (!dry) st_bf4(Out + 16 * f, v);
            ss += (v[0] * v[0] + v[1] * v[1]) + (v[2] * v[2] + v[3] * v[3]); }
        ss += __shfl_xor(ss, 16); ss += __shfl_xor(ss, 32);
        if (fq == 0 && !dry) ssq_add(TOT(ws, SSQO), row, ss);
    }
};
struct EpiMix {
    unsigned char* ws; float* out; int dry;
    static __device__ __forceinline__ int brow(int tn, int f, int n) { return 64 * tn + 16 * f + n; }
    __device__ __forceinline__ void operator()(int tn, int srow, int fq, const f32x4 (&acc)[4]) const {
        const int row = MPROMPT + srow; const float rs = row_rs(TOT(ws, 1), row);
        f32x4 v[4];
#pragma unroll
        for (int f = 0; f < 4; ++f) v[f] = acc[f] * rs;
        if (tn < 16) {
            const float* rope = (const float*)(ws + WS_ROPE) + (size_t)(2048 + (srow & 3)) * 16 + 8 * (fq & 1);
            const f32x4 t0 = *(const f32x4*)rope, t1 = *(const f32x4*)(rope + 4);
            const float cs[4] = {t0[0], t0[2], t1[0], t1[2]}, sn[4] = {t0[1], t0[3], t1[1], t1[3]};
#pragma unroll
            for (int j = 0; j < 4; ++j) { const float x = v[0][j], w = __shfl_xor(x, 32); v[0][j] = (fq < 2) ? (x * cs[j] - w * sn[j]) : (x * cs[j] + w * sn[j]); }
        }
        if (tn < 24) {
            const int kind = tn >> 3, c0 = (tn & 7) * 64 + 4 * fq;
            bf16_t* dst = (bf16_t*)(ws + (kind == 0 ? WS_QA : (kind == 1 ? WS_KA : WS_VA))) + (size_t)row * 512 + c0;
            const float sc = kind == 0 ? C2Q : 1.f;
            float* fo = kind == 0 ? nullptr : out + (kind == 1 ? OFF_KWS : OFF_VWS) + ((size_t)(srow >> 2) * WINB + (WINB - DEC_T) + (srow & 3)) * 512 + c0;
#pragma unroll
            for (int f = 0; f < 4; ++f) { st_bf4(dst + 16 * f, v[f] * sc); if (fo) *(f32x4*)(fo + 16 * f) = v[f]; }
        } else if (tn < 48) {
            bf16_t* dst; float sc = 1.f;
            if (tn < 28) { dst = (bf16_t*)(ws + WS_QB) + (size_t)row * 256 + (tn - 24) * 64; sc = 0.125f; }
            else if (tn < 32) dst = (bf16_t*)(ws + WS_KB) + (size_t)row * 256 + (tn - 28) * 64;
            else if (tn < 40) dst = (bf16_t*)(ws + WS_VB) + (size_t)row * 512 + (tn - 32) * 64;
            else dst = (bf16_t*)(ws + WS_GB) + (size_t)row * 512 + (tn - 40) * 64;
            dst += 4 * fq;
#pragma unroll
            for (int f = 0; f < 4; ++f) st_bf4(dst + 16 * f, v[f] * sc);
        } else {
            *(f32x4*)((float*)(ws + WS_A1) + (size_t)row * 16 + 4 * fq) = v[0];
        }
    }
};
}

#define XB_TMO      128
#define XB_XCNT(j)  (256  + 64 * (j))
#define XB_XSUB(j)  (1280 + 64 * (j))
#define XB_XGEN(j)  (2304 + 64 * (j))
#define XB_TOP      3328
#define XB_TOPGEN   3392
#define XCD_BAR_WORDS 3456
#define XB_SPIN_CAP (1u << 18)
__device__ __forceinline__ unsigned xb_ld(unsigned* p)              { return __hip_atomic_load(p, __ATOMIC_RELAXED, __HIP_MEMORY_SCOPE_AGENT); }
__device__ __forceinline__ unsigned xb_add(unsigned* p, unsigned v) { return __hip_atomic_fetch_add(p, v, __ATOMIC_RELAXED, __HIP_MEMORY_SCOPE_AGENT); }
__device__ __forceinline__ unsigned xb_xcc_id() { return (unsigned)__builtin_amdgcn_s_getreg((3 << 11) | 20) & 0xFu; }
#define XB_SPIN(cond, bar) do { unsigned _sp = 0; while (cond) { __builtin_amdgcn_s_sleep(1); \
    if ((++_sp & 255u) == 0u) { if (xb_ld(&(bar)[XB_TMO])) break; if (_sp > XB_SPIN_CAP) { atomicAdd(&(bar)[XB_TMO], 1u); break; } } } } while (0)
struct XcdBarrier { unsigned* bar; unsigned x; volatile LAS unsigned* st; };
__device__ __forceinline__ XcdBarrier xcd_barrier_post(unsigned* bar, volatile LAS unsigned* st) {
    XcdBarrier b; b.bar = bar; b.x = xb_xcc_id(); b.st = st;
    if (threadIdx.x == 0) (void)xb_add(&bar[XB_XCNT(b.x)], 1u);
    return b;
}
__device__ __forceinline__ void xcd_barrier_complete(unsigned* bar, unsigned x, unsigned& nloc, unsigned& nx) {
    const unsigned G = gridDim.x * gridDim.y * gridDim.z;
    unsigned sum, cnt, mine, sp = 0u;
    for (;;) {
        sum = 0u; cnt = 0u; mine = 0u;
#pragma unroll
        for (unsigned j = 0; j < 16; ++j) { const unsigned c = xb_ld(&bar[XB_XCNT(j)]); sum += c; cnt += (c > 0u) ? 1u : 0u; mine = (j == x) ? c : mine; }
        if (sum == G) break;
        __builtin_amdgcn_s_sleep(1);
        if ((++sp & 255u) == 0u) { if (xb_ld(&bar[XB_TMO])) break; if (sp > XB_SPIN_CAP) { atomicAdd(&bar[XB_TMO], 1u); break; } }
    }
    nloc = mine > 0u ? mine : 1u; nx = cnt > 0u ? cnt : 1u;
}
__device__ __forceinline__ void xcd_barrier(const XcdBarrier& b) {
    asm volatile("s_waitcnt vmcnt(0)" ::: "memory");
    __syncthreads();
    if (threadIdx.x == 0) {
        unsigned* bar = b.bar;
        __builtin_amdgcn_s_waitcnt(0);
        unsigned nloc = b.st[0], nx = b.st[1];
        if (nloc == 0u) { xcd_barrier_complete(bar, b.x, nloc, nx); b.st[0] = nloc; b.st[1] = nx; }
        const unsigned old = xb_add(&bar[XB_XSUB(b.x)], 1u);
        const unsigned gen = old / nloc;
        if (old + 1u == (gen + 1u) * nloc) {
            __builtin_amdgcn_fence(__ATOMIC_RELEASE, "agent");
            asm volatile("s_waitcnt vmcnt(0)" ::: "memory");
            const unsigned og = xb_add(&bar[XB_TOP], 1u);
            const unsigned tg = og / nx;
            if (og + 1u == (tg + 1u) * nx) xb_add(&bar[XB_TOPGEN], 1u);
            else XB_SPIN(xb_ld(&bar[XB_TOPGEN]) == tg, bar);
            __builtin_amdgcn_fence(__ATOMIC_ACQUIRE, "agent");
            xb_add(&bar[XB_XGEN(b.x)], 1u);
            asm volatile("s_waitcnt vmcnt(0)" ::: "memory");
        } else {
            XB_SPIN(xb_ld(&bar[XB_XGEN(b.x)]) == gen, bar);
            __builtin_amdgcn_fence(__ATOMIC_ACQUIRE, "agent");
            asm volatile("s_waitcnt vmcnt(0)" ::: "memory");
        }
    }
    __syncthreads();
}

struct Args { const float* in[23]; float* out; unsigned char* ws; int ph_lo, ph_hi; };
struct Frame {
    LAS unsigned char* lds;
    int tid, lane, wave, vcu, G;
    const Args* a; float* out; unsigned char* ws;
};
#define FIN(i) (F.a->in[i])
#define WSP(T, off) ((T*)(F.ws + (off)))

__device__ __forceinline__ void tr_item(const float* W, int K, int Nsrc, const float* g, bf16_t* WT, int kind, LAS float* scr, int item, int nblk, int lane) {
    const int kb = item / nblk, nb = item % nblk, k0 = 64 * kb, n0 = 32 * nb;
    int src0 = n0, nval = 32;
    if (kind == 1) { const int pn = n0 >> 8, j = n0 & 255; src0 = (j < 128) ? 128 * pn + j : DFF + 128 * pn + (j - 128); }
    else if (kind == 2) { if (n0 < 2560) src0 = n0; else if (n0 < 3072) src0 = n0 + 16; else if (n0 == 3072) { src0 = 2560; nval = 16; } else { src0 = 0; nval = 0; } }
    const int r8 = lane >> 3, c4 = (lane & 7) * 4;
    f32x4 wv[8];
#pragma unroll
    for (int i = 0; i < 8; ++i) { const int kk = 8 * i + r8; wv[i] = (c4 < nval) ? *(const f32x4*)(W + (size_t)(k0 + kk) * Nsrc + src0 + c4) : (f32x4){0.f, 0.f, 0.f, 0.f}; }
    if (g) {
#pragma unroll
        for (int i = 0; i < 8; ++i) wv[i] = wv[i] * g[k0 + 8 * i + r8];
    }
#pragma unroll
    for (int i = 0; i < 8; ++i) { LAS float* d = scr + (8 * i + r8) * 33 + c4; d[0] = wv[i][0]; d[1] = wv[i][1]; d[2] = wv[i][2]; d[3] = wv[i][3]; }
    LDS_WAIT(); asm volatile("" ::: "memory");
    const int cc = lane & 7;
#pragma unroll
    for (int j = 0; j < 4; ++j) { const int n = (lane >> 3) + 8 * j; const LAS float* s = scr + (8 * cc) * 33 + n;
        u32x4 o; o.x = pk2(s[0 * 33], s[1 * 33]); o.y = pk2(s[2 * 33], s[3 * 33]); o.z = pk2(s[4 * 33], s[5 * 33]); o.w = pk2(s[6 * 33], s[7 * 33]);
        *(u32x4*)(WT + (size_t)(n0 + n) * K + k0 + 8 * cc) = o; }
    LDS_WAIT(); asm volatile("" ::: "memory");
}
__device__ __forceinline__ void sincos_red(double ang, float& c, float& s) {
    const double TWO_PI = 6.283185307179586476925, HALF_PI = 1.5707963267948966192;
    double r = ang - TWO_PI * __builtin_rint(ang / TWO_PI);
    const double q = __builtin_rint(r / HALF_PI); r -= q * HALF_PI;
    const int qi = ((int)q) & 3;
    const double y2 = r * r;
    const double sn = r * (1.0 + y2 * (-1.0 / 6 + y2 * (1.0 / 120 + y2 * (-1.0 / 5040 + y2 * (1.0 / 362880 - y2 * (1.0 / 39916800))))));
    const double cs = 1.0 + y2 * (-0.5 + y2 * (1.0 / 24 + y2 * (-1.0 / 720 + y2 * (1.0 / 40320 + y2 * (-1.0 / 3628800 + y2 * (1.0 / 479001600))))));
    double co, si;
    if (qi == 0) { co = cs; si = sn; } else if (qi == 1) { co = -sn; si = cs; } else if (qi == 2) { co = -cs; si = -sn; } else { co = sn; si = -cs; }
    c = (float)co; s = (float)si;
}
template <int SET> __device__ __forceinline__ void convert_weights(Frame& F, int gw, int NGW) {
    LAS float* scr = (LAS float*)(F.lds + F.wave * 16384);
    constexpr int I_GU = (DM / 64) * (NGU / 32), I_D = (DFF / 64) * (DM / 32), I_IN = (DM / 64) * (NPROJ / 32), I_1K = (DM / 64) * (DM / 32), I_PP = (DPLE / 64) * (DM / 32);
    if (SET == 0) {
        for (int it = gw; it < I_GU + I_PP; it += NGW) {
            if (it < I_GU) tr_item(FIN(8), DM, NGU, FIN(7), WSP(bf16_t, WS_WGU1), 1, scr, it, NGU / 32, F.lane);
            else tr_item(FIN(21), DPLE, DM, nullptr, WSP(bf16_t, WS_WPP), 0, scr, it - I_GU, DM / 32, F.lane);
        }
    } else if (SET == 1) {
        for (int it = gw; it < I_D + I_IN; it += NGW) {
            if (it < I_D) tr_item(FIN(9), DFF, DM, nullptr, WSP(bf16_t, WS_WD1), 0, scr, it, DM / 32, F.lane);
            else tr_item(FIN(11), DM, 3088, FIN(10), WSP(bf16_t, WS_WIN), 2, scr, it - I_D, NPROJ / 32, F.lane);
        }
    } else {
        for (int it = gw; it < I_GU + I_D + 2 * I_1K; it += NGW) {
            int r = it;
            if (r < I_GU) { tr_item(FIN(17), DM, NGU, FIN(16), WSP(bf16_t, WS_WGU2), 1, scr, r, NGU / 32, F.lane); continue; } r -= I_GU;
            if (r < I_D) { tr_item(FIN(18), DFF, DM, nullptr, WSP(bf16_t, WS_WD2), 0, scr, r, DM / 32, F.lane); continue; } r -= I_D;
            if (r < I_1K) { tr_item(FIN(15), DM, DM, nullptr, WSP(bf16_t, WS_WOUT), 0, scr, r, DM / 32, F.lane); continue; } r -= I_1K;
            tr_item(FIN(20), DM, DM, FIN(19), WSP(bf16_t, WS_WPG), 0, scr, r, DM / 32, F.lane);
        }
    }
}
__device__ __forceinline__ void p0_prologue(Frame& F) {
    const int gw = F.vcu * NWAVES + F.wave, NGW = F.G * NWAVES;
    convert_weights<0>(F, gw, NGW);
    bf16_t* HB = WSP(bf16_t, WS_HB); bf16_t* PB = WSP(bf16_t, WS_PB); unsigned* ssq0 = TOT(F.ws, 0);
    for (int e = F.vcu * 512 + F.tid; e < 4 * MPAD; e += F.G * 512) TOT(F.ws, 1 + e / MPAD)[e % MPAD] = 0u;
    for (int m0 = gw; m0 < MTOT; m0 += 4 * NGW) {
        f32x4 v[4][4], pv[4];
#pragma unroll
        for (int u = 0; u < 4; ++u) { const int m = m0 + u * NGW; const bool ok = m < MTOT;
            const float* xr = m < MPROMPT ? FIN(0) + (size_t)m * DM : FIN(1) + (size_t)(m - MPROMPT) * DM;
            const float* pr = m < MPROMPT ? FIN(5) + (size_t)m * DPLE : FIN(6) + (size_t)(m - MPROMPT) * DPLE;
#pragma unroll
            for (int j = 0; j < 4; ++j) v[u][j] = ok ? *((const f32x4*)xr + F.lane + 64 * j) : (f32x4){0.f, 0.f, 0.f, 0.f};
            pv[u] = ok ? *((const f32x4*)pr + F.lane) : (f32x4){0.f, 0.f, 0.f, 0.f}; }
#pragma unroll
        for (int u = 0; u < 4; ++u) { const int m = m0 + u * NGW; if (m >= MTOT) continue;
            float s = 0.f;
#pragma unroll
            for (int j = 0; j < 4; ++j) s += (v[u][j][0] * v[u][j][0] + v[u][j][1] * v[u][j][1]) + (v[u][j][2] * v[u][j][2] + v[u][j][3] * v[u][j][3]);
            s = wave_sum(s);
#pragma unroll
            for (int j = 0; j < 4; ++j) { u32x2 w; w.x = pk2(v[u][j][0], v[u][j][1]); w.y = pk2(v[u][j][2], v[u][j][3]); *((u32x2*)(HB + (size_t)m * DM) + F.lane + 64 * j) = w; }
            if (F.lane == 0) ssq0[m] = (unsigned)(s * SSQ_SCALE + 0.5f);
            u32x2 w; w.x = pk2(pv[u][0], pv[u][1]); w.y = pk2(pv[u][2], pv[u][3]); *((u32x2*)(PB + (size_t)m * DPLE) + F.lane) = w; }
    }
    float* rope = WSP(float, WS_ROPE);
    for (int e = F.vcu * 512 + F.tid; e < 2052 * 8; e += F.G * 512) {
        const int posidx = e >> 3, i = e & 7; const int pos = posidx < 2048 ? posidx : PAST + (posidx - 2048);
        const double inv = exp2(-(double)i * 0.125 * 18.931568569324174087);
        float c, s; sincos_red((double)pos * inv, c, s);
        rope[2 * e] = c; rope[2 * e + 1] = s;
    }
}


constexpr size_t CP_PER_B = (size_t)(WINB - DEC_T) * 512 / 4, CP_TOTAL = (size_t)DEC_B * CP_PER_B, CP_C1 = 0, CP_C3 = (CP_TOTAL * 6 / 10) & ~(size_t)511;
__device__ __forceinline__ void cache_copy_chunk(Frame& F, size_t e0, size_t e1, int rank, int nshare) {
    if (rank < 0) return;
    constexpr int U = 8;
    const size_t stride = (size_t)nshare * 512 * U;
    for (size_t eb = e0 + (size_t)rank * 512 * U + F.tid; eb < e1; eb += stride) {
        f32x4 kv[U], vv[U]; size_t dst[U];
#pragma unroll
        for (int u = 0; u < U; ++u) { const size_t e = eb + (size_t)u * 512; const size_t ec = e < e1 ? e : e1 - 1; const size_t b = ec / CP_PER_B, r = ec - b * CP_PER_B;
            const size_t src = b * ((size_t)WINB * 128) + DEC_T * 128 + r; dst[u] = b * ((size_t)WINB * 128) + r;
            kv[u] = __builtin_nontemporal_load((const f32x4*)FIN(2) + src); vv[u] = __builtin_nontemporal_load((const f32x4*)FIN(3) + src); }
#pragma unroll
        for (int u = 0; u < U; ++u) { __builtin_nontemporal_store(kv[u], (f32x4*)(F.out + OFF_KWS) + dst[u]); __builtin_nontemporal_store(vv[u], (f32x4*)(F.out + OFF_VWS) + dst[u]); }
    }
}

constexpr int AT_VW = 6144  , AT_VPITCH = 192, AT_STO = 8 * AT_VW, AT_SPITCH = 136, AT_SROWS = 528, AT_STM = AT_STO + AT_SROWS * AT_SPITCH, AT_STL = AT_STM + AT_SROWS * 4;
static_assert(AT_STL + AT_SROWS * 4 <= RING_BYTES, "attention LDS");
__device__ __forceinline__ int crow(int r, int hi) { return (r & 3) + 8 * (r >> 2) + 4 * hi; }
__device__ __forceinline__ s16x4 tr_read(LAS const unsigned char* p) { typedef short v4i16 __attribute__((ext_vector_type(4))); return __builtin_bit_cast(s16x4, __builtin_amdgcn_ds_read_tr16_b64_v4i16((LAS v4i16*)p)); }

template <int NQ> __device__ __forceinline__ void attn_task(Frame& F, int b, int h, int P0, int br, int dil, int r, int s0) {
    const int lane = F.lane, qi = lane & 31, hi = lane >> 5;
    const bf16_t* QA = WSP(bf16_t, WS_QA); const bf16_t* KA = WSP(bf16_t, WS_KA); const bf16_t* VA = WSP(bf16_t, WS_VA);
    LAS unsigned char* Vw = F.lds + F.wave * AT_VW;
    const size_t rowbase = (size_t)b * SEQ;
    const char* Qb = (const char*)(QA + rowbase * 512 + h * 64); const char* Kb = (const char*)(KA + rowbase * 512 + h * 64); const char* Vb = (const char*)(VA + rowbase * 512 + h * 64);
    bf16x8 qf[NQ][4]; f32x16 o0[NQ], o1[NQ]; float mrun[NQ], lrun[NQ];
#define POSQ(n) ((s0 + 32 * (n) + qi) * dil + r)
#define RHO(n) ((((POSQ(n) - P0) & 15) * 33) + ((POSQ(n) - P0) >> 4))
#pragma unroll
    for (int n = 0; n < NQ; ++n) {
        const unsigned qoff = (unsigned)POSQ(n) * 1024u + hi * 16u;
#pragma unroll
        for (int kk = 0; kk < 4; ++kk) qf[n][kk] = *(const bf16x8*)(Qb + qoff + 32 * kk);
        if (br == 0) {
#pragma unroll
            for (int i = 0; i < 16; ++i) { o0[n][i] = 0.f; o1[n][i] = 0.f; }
            mrun[n] = -1e30f; lrun[n] = 0.f;
        } else {
            const LAS unsigned char* sp = F.lds + AT_STO + RHO(n) * AT_SPITCH + 8 * hi;
#pragma unroll
            for (int g = 0; g < 4; ++g) {
                const u32x2 a = *(const LAS u32x2*)(sp + 16 * g), c = *(const LAS u32x2*)(sp + 64 + 16 * g);
                o0[n][4 * g] = bflo(a.x); o0[n][4 * g + 1] = bfhi(a.x); o0[n][4 * g + 2] = bflo(a.y); o0[n][4 * g + 3] = bfhi(a.y);
                o1[n][4 * g] = bflo(c.x); o1[n][4 * g + 1] = bfhi(c.x); o1[n][4 * g + 2] = bflo(c.y); o1[n][4 * g + 3] = bfhi(c.y);
            }
            mrun[n] = *(const LAS float*)(F.lds + AT_STM + RHO(n) * 4); lrun[n] = *(const LAS float*)(F.lds + AT_STL + RHO(n) * 4);
        }
    }
    const int kt0 = s0 >= 128 ? 0 : ((128 - s0) >> 5), ktend = 5 + (NQ - 1);
    const int q4 = (lane & 15) >> 2, p4 = lane & 3, blk = (lane >> 4) & 1;
    const LAS unsigned char* trb = Vw + (4 * hi + q4) * AT_VPITCH + (16 * blk + 4 * p4) * 2;
    bf16x8 kn[4]; u32x4 vr[4];
    {   const int sk0 = s0 - 128 + 32 * kt0;
        const unsigned koff = (unsigned)((sk0 + qi) * dil + r) * 1024u + hi * 16u;
#pragma unroll
        for (int kk = 0; kk < 4; ++kk) kn[kk] = *(const bf16x8*)(Kb + koff + 32 * kk);
#pragma unroll
        for (int c = 0; c < 4; ++c) { const int cid = lane + 64 * c, vrow = cid >> 3, ch = cid & 7;
            vr[c] = *(const u32x4*)(Vb + (unsigned)((sk0 + vrow) * dil + r) * 1024u + ch * 16u); } }
#pragma nounroll
    for (int kt = kt0; kt < ktend; ++kt) {
        bf16x8 kf[4];
#pragma unroll
        for (int kk = 0; kk < 4; ++kk) kf[kk] = kn[kk];
#pragma unroll
        for (int c = 0; c < 4; ++c) { const int cid = lane + 64 * c, vrow = cid >> 3, ch = cid & 7; *(LAS u32x4*)(Vw + vrow * AT_VPITCH + ch * 16) = vr[c]; }
        if (kt + 1 < ktend) {
            const int sk1 = s0 - 128 + 32 * (kt + 1);
            const unsigned koff = (unsigned)((sk1 + qi) * dil + r) * 1024u + hi * 16u;
#pragma unroll
            for (int kk = 0; kk < 4; ++kk) kn[kk] = *(const bf16x8*)(Kb + koff + 32 * kk);
#pragma unroll
            for (int c = 0; c < 4; ++c) { const int cid = lane + 64 * c, vrow = cid >> 3, ch = cid & 7;
                vr[c] = *(const u32x4*)(Vb + (unsigned)((sk1 + vrow) * dil + r) * 1024u + ch * 16u); }
        }
        LDS_WAIT();
        bf16x8 va[2][2];
#pragma unroll
        for (int dt = 0; dt < 2; ++dt) {
            const s16x4 lo0 = tr_read(trb + dt * 64), hi0 = tr_read(trb + dt * 64 + 8 * AT_VPITCH);
            const s16x4 lo1 = tr_read(trb + dt * 64 + 16 * AT_VPITCH), hi1 = tr_read(trb + dt * 64 + 24 * AT_VPITCH);
            va[dt][0] = __builtin_shufflevector(lo0, hi0, 0, 1, 2, 3, 4, 5, 6, 7); va[dt][1] = __builtin_shufflevector(lo1, hi1, 0, 1, 2, 3, 4, 5, 6, 7);
        }
#pragma unroll
        for (int n = 0; n < NQ; ++n) {
            const int kr = kt - n;
            if (kr < 0 || kr > 4) continue;
            f32x16 p;
#pragma unroll
            for (int i = 0; i < 16; ++i) p[i] = 0.f;
#pragma unroll
            for (int kk = 0; kk < 4; ++kk) p = __builtin_amdgcn_mfma_f32_32x32x16_bf16(kf[kk], qf[n][kk], p, 0, 0, 0);
            if (kr == 0) {
#pragma unroll
                for (int i = 0; i < 16; ++i) if (crow(i, hi) < qi) p[i] = -INFINITY;
            } else if (kr == 4) {
#pragma unroll
                for (int i = 0; i < 16; ++i) if (crow(i, hi) > qi) p[i] = -INFINITY;
            }
            float mx = p[0];
#pragma unroll
            for (int i = 1; i < 16; ++i) mx = fmaxf(mx, p[i]);
            mx = fmaxf(mx, __shfl_xor(mx, 32));
            const float mn = fmaxf(mrun[n], mx), al = __builtin_amdgcn_exp2f(mrun[n] - mn);
            float rsum = 0.f;
#pragma unroll
            for (int i = 0; i < 16; ++i) { p[i] = __builtin_amdgcn_exp2f(p[i] - mn); rsum += p[i]; }
            rsum += __shfl_xor(rsum, 32);
            lrun[n] = lrun[n] * al + rsum; mrun[n] = mn;
#pragma unroll
            for (int i = 0; i < 16; ++i) { o0[n][i] *= al; o1[n][i] *= al; }
            u32x4 pw0, pw1;
            pw0.x = cvt_pk_bf16(p[0], p[1]); pw0.y = cvt_pk_bf16(p[2], p[3]); pw0.z = cvt_pk_bf16(p[4], p[5]); pw0.w = cvt_pk_bf16(p[6], p[7]);
            pw1.x = cvt_pk_bf16(p[8], p[9]); pw1.y = cvt_pk_bf16(p[10], p[11]); pw1.z = cvt_pk_bf16(p[12], p[13]); pw1.w = cvt_pk_bf16(p[14], p[15]);
            const bf16x8 pb0 = __builtin_bit_cast(bf16x8, pw0), pb1 = __builtin_bit_cast(bf16x8, pw1);
            o0[n] = __builtin_amdgcn_mfma_f32_32x32x16_bf16(va[0][0], pb0, o0[n], 0, 0, 0); o0[n] = __builtin_amdgcn_mfma_f32_32x32x16_bf16(va[0][1], pb1, o0[n], 0, 0, 0);
            o1[n] = __builtin_amdgcn_mfma_f32_32x32x16_bf16(va[1][0], pb0, o1[n], 0, 0, 0); o1[n] = __builtin_amdgcn_mfma_f32_32x32x16_bf16(va[1][1], pb1, o1[n], 0, 0, 0);
        }
    }
#pragma unroll
    for (int n = 0; n < NQ; ++n) {
        if (br < 2) {
            LAS unsigned char* sp = F.lds + AT_STO + RHO(n) * AT_SPITCH + 8 * hi;
#pragma unroll
            for (int g = 0; g < 4; ++g) {
                u32x2 a, c; a.x = cvt_pk_bf16(o0[n][4 * g], o0[n][4 * g + 1]); a.y = cvt_pk_bf16(o0[n][4 * g + 2], o0[n][4 * g + 3]); c.x = cvt_pk_bf16(o1[n][4 * g], o1[n][4 * g + 1]); c.y = cvt_pk_bf16(o1[n][4 * g + 2], o1[n][4 * g + 3]);
                *(LAS u32x2*)(sp + 16 * g) = a; *(LAS u32x2*)(sp + 64 + 16 * g) = c;
            }
            if (hi == 0) { *(LAS float*)(F.lds + AT_STM + RHO(n) * 4) = mrun[n]; *(LAS float*)(F.lds + AT_STL + RHO(n) * 4) = lrun[n]; }
        } else {
            const float inv = 1.f / lrun[n];
            bf16_t* op = WSP(bf16_t, WS_A2) + (rowbase + POSQ(n)) * DM + h * 64 + 4 * hi;
#pragma unroll
            for (int g = 0; g < 4; ++g) {
                u32x2 a, c; a.x = cvt_pk_bf16(o0[n][4 * g] * inv, o0[n][4 * g + 1] * inv); a.y = cvt_pk_bf16(o0[n][4 * g + 2] * inv, o0[n][4 * g + 3] * inv);
                c.x = cvt_pk_bf16(o1[n][4 * g] * inv, o1[n][4 * g + 1] * inv); c.y = cvt_pk_bf16(o1[n][4 * g + 2] * inv, o1[n][4 * g + 3] * inv);
                *(u32x2*)(op + 8 * g) = a; *(u32x2*)(op + 32 + 8 * g) = c;
            }
        }
    }
    LDS_WAIT();
#undef POSQ
#undef RHO
}
__device__ __forceinline__ void attn_prompt_item(Frame& F, int item) {
    const int b = item >> 5, h = (item >> 2) & 7, blk = item & 3, P0 = blk * 512;
    attn_task<2>(F, b, h, P0, 0, 1, 0, P0 + 64 * F.wave);
    LDS_WAIT(); __syncthreads();
    attn_task<2>(F, b, h, P0, 1, 4, F.wave & 3, P0 / 4 + 64 * (F.wave >> 2));
    LDS_WAIT(); __syncthreads();
    for (int u = 0; u < 2; ++u) attn_task<1>(F, b, h, P0, 2, 16, F.wave * 2 + u, P0 / 16);
    LDS_WAIT(); __syncthreads();
}

__device__ __forceinline__ void attn_sample_task(Frame& F, int task, int half) {
    const int h = task & 7, bt = task >> 3, b = bt >> 2, t = bt & 3, row = MPROMPT + bt;
    const int lane = F.lane, grp = lane >> 2, sub = lane & 3;
    const bf16_t* KA = WSP(bf16_t, WS_KA); const bf16_t* VA = WSP(bf16_t, WS_VA);
    float q[16];
    { const u32x4* qp = (const u32x4*)(WSP(bf16_t, WS_QA) + (size_t)row * 512 + h * 64 + 16 * sub); const u32x4 a = qp[0], c = qp[1];
      q[0] = bflo(a.x); q[1] = bfhi(a.x); q[2] = bflo(a.y); q[3] = bfhi(a.y); q[4] = bflo(a.z); q[5] = bfhi(a.z); q[6] = bflo(a.w); q[7] = bfhi(a.w);
      q[8] = bflo(c.x); q[9] = bfhi(c.x); q[10] = bflo(c.y); q[11] = bfhi(c.y); q[12] = bflo(c.z); q[13] = bfhi(c.z); q[14] = bflo(c.w); q[15] = bfhi(c.w); }
    float mrun = -1e30f, lrun = 0.f, acc[16];
#pragma unroll
    for (int e = 0; e < 16; ++e) acc[e] = 0.f;
    const int rd0 = half ? 5 : 0, rd1 = half ? 9 : 5;
#pragma nounroll
    for (int rd = rd0; rd < rd1; ++rd) {
        const int j = rd * 16 + grp; const bool valid = j <= 128;
        float kv[3][16], vv[3][16];
#pragma unroll
        for (int br = 0; br < 3; ++br) {
            const int dil = 1 << (2 * br);
            const int idx = WINB + t - (valid ? dil * j : 0);
            if (idx < WINB) {
                const f32x4* kp = (const f32x4*)(FIN(2) + (((size_t)b * WINB + idx) * 8 + h) * 64 + 16 * sub);
                const f32x4* vp = (const f32x4*)(FIN(3) + (((size_t)b * WINB + idx) * 8 + h) * 64 + 16 * sub);
#pragma unroll
                for (int c = 0; c < 4; ++c) { const f32x4 a = kp[c], d = vp[c];
#pragma unroll
                    for (int e = 0; e < 4; ++e) { kv[br][4 * c + e] = a[e]; vv[br][4 * c + e] = d[e]; } }
            } else {
                const size_t nrow = (size_t)MPROMPT + 4 * b + (idx - WINB);
                const u32x4* kp = (const u32x4*)(KA + nrow * 512 + h * 64 + 16 * sub); const u32x4* vp = (const u32x4*)(VA + nrow * 512 + h * 64 + 16 * sub);
#pragma unroll
                for (int c = 0; c < 2; ++c) { const u32x4 a = kp[c], d = vp[c];
                    kv[br][8 * c] = bflo(a.x); kv[br][8 * c + 1] = bfhi(a.x); kv[br][8 * c + 2] = bflo(a.y); kv[br][8 * c + 3] = bfhi(a.y); kv[br][8 * c + 4] = bflo(a.z); kv[br][8 * c + 5] = bfhi(a.z); kv[br][8 * c + 6] = bflo(a.w); kv[br][8 * c + 7] = bfhi(a.w);
                    vv[br][8 * c] = bflo(d.x); vv[br][8 * c + 1] = bfhi(d.x); vv[br][8 * c + 2] = bflo(d.y); vv[br][8 * c + 3] = bfhi(d.y); vv[br][8 * c + 4] = bflo(d.z); vv[br][8 * c + 5] = bfhi(d.z); vv[br][8 * c + 6] = bflo(d.w); vv[br][8 * c + 7] = bfhi(d.w); }
            }
        }
#pragma unroll
        for (int br = 0; br < 3; ++br) {
            float s = 0.f;
#pragma unroll
            for (int e = 0; e < 16; ++e) s += q[e] * kv[br][e];
            s += __shfl_xor(s, 1); s += __shfl_xor(s, 2);
            if (!valid) s = -INFINITY;
            const float mn = fmaxf(mrun, s), al = __builtin_amdgcn_exp2f(mrun - mn), p = __builtin_amdgcn_exp2f(s - mn);
            lrun = lrun * al + p; mrun = mn;
#pragma unroll
            for (int e = 0; e < 16; ++e) acc[e] = acc[e] * al + p * vv[br][e];
        }
    }
    float M = mrun;
#pragma unroll
    for (int o = 4; o < 64; o <<= 1) M = fmaxf(M, __shfl_xor(M, o));
    const float f = __builtin_amdgcn_exp2f(mrun - M);
    lrun *= f;
#pragma unroll
    for (int o = 4; o < 64; o <<= 1) lrun += __shfl_xor(lrun, o);
#pragma unroll
    for (int e = 0; e < 16; ++e) { float a = acc[e] * f;
#pragma unroll
        for (int o = 4; o < 64; o <<= 1) a += __shfl_xor(a, o);
        acc[e] = a; }
    LAS float* mrg = (LAS float*)(F.lds) + (F.wave & 3) * 80;
    if (half && grp == 0) {
#pragma unroll
        for (int e = 0; e < 16; ++e) mrg[sub * 16 + e] = acc[e];
        if (sub == 0) { mrg[64] = M; mrg[65] = lrun; }
    }
    LDS_WAIT(); __syncthreads();
    if (!half && grp == 0) {
        const float M2 = mrg[64], l2 = mrg[65], Mx = fmaxf(M, M2), f1 = __builtin_amdgcn_exp2f(M - Mx), f2 = __builtin_amdgcn_exp2f(M2 - Mx);
        const float inv = 1.f / (lrun * f1 + l2 * f2);
#pragma unroll
        for (int e = 0; e < 16; ++e) acc[e] = (acc[e] * f1 + mrg[sub * 16 + e] * f2) * inv;
        u32x4 w0, w1; w0.x = pk2(acc[0], acc[1]); w0.y = pk2(acc[2], acc[3]); w0.z = pk2(acc[4], acc[5]); w0.w = pk2(acc[6], acc[7]);
        w1.x = pk2(acc[8], acc[9]); w1.y = pk2(acc[10], acc[11]); w1.z = pk2(acc[12], acc[13]); w1.w = pk2(acc[14], acc[15]);
        u32x4* op = (u32x4*)(WSP(bf16_t, WS_A2) + (size_t)row * DM + h * 64 + 16 * sub); op[0] = w0; op[1] = w1;
    }
    LDS_WAIT(); __syncthreads();
}

constexpr int GL_A1 = 0  , GL_TOT = 4096  , GL_BT = GL_TOT + 2048  , GL_BC = GL_BT + 256  , GL_QA = GL_BC + 64 * 272  ,
              GL_KB = GL_QA + 64 * 144, GL_VR = GL_KB + 64 * 144  , GL_AM = GL_VR + 64 * 272  , GL_O = GL_AM + 64 * 144  , GL_END = GL_O + 64 * 132 * 4;
static_assert(GL_END <= RING_BYTES && GL_BC % 16 == 0 && GL_QA % 16 == 0 && GL_VR % 16 == 0 && GL_O % 16 == 0, "GLA LDS");
struct GlaIn { f32x4 a1; u32x4 kb, qb, vb0, vb1, gb0, gb1; bf16x8 sp[4]; };
template <bool P3> __device__ __forceinline__ void gla_fetch(Frame& F, GlaIn& I, int item, int hh, size_t row0) {
    const int tid = F.tid;
    I.a1 = (f32x4){0.f, 0.f, 0.f, 0.f};
    if (tid < 256) I.a1 = *(const f32x4*)(WSP(float, WS_A1) + (row0 + (tid >> 2)) * 16 + 4 * (tid & 3));
    I.kb = *(const u32x4*)(WSP(bf16_t, WS_KB) + (row0 + (tid >> 3)) * 256 + hh * 64 + 8 * (tid & 7));
    I.vb0 = *(const u32x4*)(WSP(bf16_t, WS_VB) + (row0 + (tid >> 4)) * 512 + hh * 128 + 8 * (tid & 15));
    I.vb1 = *(const u32x4*)(WSP(bf16_t, WS_VB) + (row0 + 32 + (tid >> 4)) * 512 + hh * 128 + 8 * (tid & 15));
    if (P3) {
        I.qb = *(const u32x4*)(WSP(bf16_t, WS_QB) + (row0 + (tid >> 3)) * 256 + hh * 64 + 8 * (tid & 7));
        const int i = tid >> 3, sub = tid & 7;
        const u32x4* gp = (const u32x4*)(WSP(bf16_t, WS_GB) + (row0 + i) * 512 + hh * 128 + 16 * sub); I.gb0 = gp[0]; I.gb1 = gp[1];
        const int lane = F.lane, vt = F.wave & 3, r32 = lane & 31, hi = lane >> 5;
        const bf16_t* sp = WSP(bf16_t, WS_SPT) + (size_t)item * 8192 + (size_t)(32 * vt + r32) * 64 + 8 * hi;
#pragma unroll
        for (int q = 0; q < 4; ++q) I.sp[q] = *(const bf16x8*)(sp + 16 * q);
    }
}
__device__ __forceinline__ void gla_decay(Frame& F, const f32x4 a1v, const float (&w2)[16], float bias, float& btot) {
    const int tid = F.tid, k = tid & 63, ig = tid >> 6;
    LAS float* a1s = (LAS float*)(F.lds + GL_A1); LAS float* tot = (LAS float*)(F.lds + GL_TOT); LAS float* BC = (LAS float*)(F.lds + GL_BC); LAS float* BT = (LAS float*)(F.lds + GL_BT);
    if (tid < 256) *(LAS f32x4*)(a1s + tid * 4) = a1v;
    LDS_WAIT(); __syncthreads();
    float run = 0.f, bcum[8];
#pragma unroll
    for (int e = 0; e < 8; ++e) { float pre = bias;
#pragma unroll
        for (int r = 0; r < 16; ++r) pre += a1s[(8 * ig + e) * 16 + r] * w2[r];
        run += logsigf_(pre) * (1.0f / 16.0f); bcum[e] = run; }
    tot[ig * 64 + k] = run;
    LDS_WAIT(); __syncthreads();
    float pre = 0.f, all = 0.f;
#pragma unroll
    for (int g = 0; g < 8; ++g) { const float tv = tot[g * 64 + k]; all += tv; if (g < ig) pre += tv; }
#pragma unroll
    for (int e = 0; e < 8; ++e) BC[(8 * ig + e) * 68 + k] = bcum[e] + pre;
    if (ig == 0) BT[k] = all;
    btot = all;
    LDS_WAIT(); __syncthreads();
}
__device__ __forceinline__ void unpack8(const u32x4 w, float (&x)[8]) { x[0] = bflo(w.x); x[1] = bfhi(w.x); x[2] = bflo(w.y); x[3] = bfhi(w.y); x[4] = bflo(w.z); x[5] = bfhi(w.z); x[6] = bflo(w.w); x[7] = bfhi(w.w); }
__device__ __forceinline__ u32x4 pack8(const float (&x)[8]) { u32x4 w; w.x = pk2(x[0], x[1]); w.y = pk2(x[2], x[3]); w.z = pk2(x[4], x[5]); w.w = pk2(x[6], x[7]); return w; }
__device__ __forceinline__ void gla_store_vr(Frame& F, const u32x4 vb0, const u32x4 vb1) {
    const int tid = F.tid;
    *(LAS u32x4*)(F.lds + GL_VR + (tid >> 4) * 272 + (tid & 15) * 16) = vb0;
    *(LAS u32x4*)(F.lds + GL_VR + (32 + (tid >> 4)) * 272 + (tid & 15) * 16) = vb1;
}
__device__ __forceinline__ bf16x8 tr_frag(LAS const unsigned char* img, int pitch, int col0, int s, int lane) {
    const int q4 = (lane & 15) >> 2, p4 = lane & 3, blk = (lane >> 4) & 1, hi = lane >> 5;
    LAS const unsigned char* p = img + (16 * s + 8 * hi + q4) * pitch + (col0 + 16 * blk + 4 * p4) * 2;
    const s16x4 lo = tr_read(p), hi4 = tr_read(p + 4 * pitch);
    return __builtin_shufflevector(lo, hi4, 0, 1, 2, 3, 4, 5, 6, 7);
}
template <int NIT> __device__ __forceinline__ void gla_p1_items(Frame& F, int item0) {
    const int bh = item0 >> 5, b = bh >> 2, hh = bh & 3;
    const int tid = F.tid, k = tid & 63, ig = tid >> 6, lane = F.lane;
    float w2[16];
#pragma unroll
    for (int r = 0; r < 16; ++r) w2[r] = FIN(12)[r * 256 + hh * 64 + k];
    const float bias = FIN(13)[hh * 64 + k];
    GlaIn nx; gla_fetch<false>(F, nx, item0, hh, (size_t)b * SEQ + 64 * (item0 & 31));
#pragma nounroll
    for (int it = 0; it < NIT; ++it) {
        const int item = item0 + it;
        const GlaIn cu = nx;
        if (it + 1 < NIT) gla_fetch<false>(F, nx, item + 1, hh, (size_t)b * SEQ + 64 * ((item + 1) & 31));
        float btot; gla_decay(F, cu.a1, w2, bias, btot);
        {
            const int i = tid >> 3, c = tid & 7;
            const f32x4 b0 = *(const LAS f32x4*)(F.lds + GL_BC + (i * 68 + 8 * c) * 4), b1 = *(const LAS f32x4*)(F.lds + GL_BC + (i * 68 + 8 * c + 4) * 4);
            const f32x4 t0 = *(const LAS f32x4*)(F.lds + GL_BT + 8 * c * 4), t1 = *(const LAS f32x4*)(F.lds + GL_BT + (8 * c + 4) * 4);
            float kx[8]; unpack8(cu.kb, kx);
#pragma unroll
            for (int e = 0; e < 4; ++e) { kx[e] *= fexp(t0[e] - b0[e]); kx[4 + e] *= fexp(t1[e] - b1[e]); }
            *(LAS u32x4*)(F.lds + GL_QA + i * 144 + c * 16) = pack8(kx);
        }
        gla_store_vr(F, cu.vb0, cu.vb1);
        if (ig == 0) WSP(float, WS_BTOT)[item * 64 + k] = btot;
        LDS_WAIT(); __syncthreads();
        const int kt = F.wave >> 2, vt = F.wave & 3, r32 = lane & 31, hi = lane >> 5;
        f32x16 acc;
#pragma unroll
        for (int i = 0; i < 16; ++i) acc[i] = 0.f;
#pragma unroll
        for (int q = 0; q < 4; ++q) {
            const bf16x8 a = tr_frag(F.lds + GL_QA, 144, 32 * kt, q, lane);
            const bf16x8 bb = tr_frag(F.lds + GL_VR, 272, 32 * vt, q, lane);
            acc = __builtin_amdgcn_mfma_f32_32x32x16_bf16(a, bb, acc, 0, 0, 0);
        }
        float* hct = WSP(float, WS_HCT) + (size_t)item * 8192 + (size_t)(32 * vt + r32) * 64 + 32 * kt + 4 * hi;
#pragma unroll
        for (int g = 0; g < 4; ++g) *(f32x4*)(hct + 8 * g) = (f32x4){acc[4 * g], acc[4 * g + 1], acc[4 * g + 2], acc[4 * g + 3]};
        LDS_WAIT(); __syncthreads();
    }
}
__device__ __forceinline__ void gla_scan(Frame& F) {
    const float* hct = WSP(float, WS_HCT); const float* bt = WSP(float, WS_BTOT); bf16_t* spt = WSP(bf16_t, WS_SPT);
    for (int e = F.vcu * 512 + F.tid; e < 32 * 2048; e += F.G * 512) {
        const int bh = e >> 11, vk4 = (e & 2047) * 4, k = vk4 & 63, v = vk4 >> 6;
        f32x4 S = (f32x4){0.f, 0.f, 0.f, 0.f};
#pragma nounroll
        for (int c0 = 0; c0 < 32; c0 += 8) {
            f32x4 hv[8], dv[8];
#pragma unroll
            for (int c = 0; c < 8; ++c) { hv[c] = *(const f32x4*)(hct + (size_t)(bh * 32 + c0 + c) * 8192 + vk4); dv[c] = *(const f32x4*)(bt + (bh * 32 + c0 + c) * 64 + k); }
#pragma unroll
            for (int c = 0; c < 8; ++c) {
                u32x2 w; w.x = pk2(S[0], S[1]); w.y = pk2(S[2], S[3]); *(u32x2*)(spt + (size_t)(bh * 32 + c0 + c) * 8192 + vk4) = w;
#pragma unroll
                for (int j = 0; j < 4; ++j) S[j] = fexp(dv[c][j]) * S[j] + hv[c][j];
            }
        }
#pragma unroll
        for (int j = 0; j < 4; ++j) F.out[OFF_SGP + ((size_t)bh * 64 + k + j) * 128 + v] = S[j];
    }
}
template <int NIT> __device__ __forceinline__ void gla_p3_items(Frame& F, int item0) {
    const int bh = item0 >> 5, b = bh >> 2, hh = bh & 3;
    const int tid = F.tid, k = tid & 63, lane = F.lane;
    float w2[16];
#pragma unroll
    for (int r = 0; r < 16; ++r) w2[r] = FIN(12)[r * 256 + hh * 64 + k];
    const float bias = FIN(13)[hh * 64 + k];
    GlaIn nx; gla_fetch<true>(F, nx, item0, hh, (size_t)b * SEQ + 64 * (item0 & 31));
#pragma nounroll
    for (int it = 0; it < NIT; ++it) {
        const int item = item0 + it, c = item & 31; const size_t row0 = (size_t)b * SEQ + 64 * c;
        const GlaIn cu = nx;
        if (it + 1 < NIT) gla_fetch<true>(F, nx, item + 1, hh, (size_t)b * SEQ + 64 * ((item + 1) & 31));
        float btot; gla_decay(F, cu.a1, w2, bias, btot);
        {
            const int i = tid >> 3, cc = tid & 7;
            const f32x4 b0 = *(const LAS f32x4*)(F.lds + GL_BC + (i * 68 + 8 * cc) * 4), b1 = *(const LAS f32x4*)(F.lds + GL_BC + (i * 68 + 8 * cc + 4) * 4);
            float qx[8], kx[8]; unpack8(cu.qb, qx); unpack8(cu.kb, kx);
#pragma unroll
            for (int e = 0; e < 4; ++e) { const float f0 = fexp(b0[e]), f1 = fexp(b1[e]); qx[e] *= f0; qx[4 + e] *= f1; kx[e] *= __builtin_amdgcn_rcpf(f0); kx[4 + e] *= __builtin_amdgcn_rcpf(f1); }
            *(LAS u32x4*)(F.lds + GL_QA + i * 144 + cc * 16) = pack8(qx);
            *(LAS u32x4*)(F.lds + GL_KB + i * 144 + cc * 16) = pack8(kx);
        }
        gla_store_vr(F, cu.vb0, cu.vb1);
        LDS_WAIT(); __syncthreads();
        const int r32 = lane & 31, hi = lane >> 5;
        if (F.wave < 4) {
            const int it2 = F.wave >> 1, jt = F.wave & 1;
            f32x16 acc;
#pragma unroll
            for (int i = 0; i < 16; ++i) acc[i] = 0.f;
            if (jt <= it2) {
#pragma unroll
                for (int q = 0; q < 4; ++q) {
                    const bf16x8 a = *(const LAS bf16x8*)(F.lds + GL_QA + (32 * it2 + r32) * 144 + (16 * q + 8 * hi) * 2);
                    const bf16x8 bb = *(const LAS bf16x8*)(F.lds + GL_KB + (32 * jt + r32) * 144 + (16 * q + 8 * hi) * 2);
                    acc = __builtin_amdgcn_mfma_f32_32x32x16_bf16(a, bb, acc, 0, 0, 0);
                }
            }
#pragma unroll
            for (int i = 0; i < 16; ++i) { const int ii = 32 * it2 + crow(i, hi), jj = 32 * jt + r32;
                *(LAS bf16_t*)(F.lds + GL_AM + ii * 144 + jj * 2) = (bf16_t)f2bf(jj <= ii ? acc[i] : 0.f); }
        }
        LDS_WAIT(); __syncthreads();
        {
            const int it2 = F.wave >> 2, vt = F.wave & 3;
            f32x16 acc;
#pragma unroll
            for (int i = 0; i < 16; ++i) acc[i] = 0.f;
            if (c > 0) {
#pragma unroll
                for (int q = 0; q < 4; ++q) {
                    const bf16x8 a = *(const LAS bf16x8*)(F.lds + GL_QA + (32 * it2 + r32) * 144 + (16 * q + 8 * hi) * 2);
                    acc = __builtin_amdgcn_mfma_f32_32x32x16_bf16(a, cu.sp[q], acc, 0, 0, 0);
                }
            }
#pragma unroll
            for (int q = 0; q < 4; ++q) {
                const bf16x8 a = *(const LAS bf16x8*)(F.lds + GL_AM + (32 * it2 + r32) * 144 + (16 * q + 8 * hi) * 2);
                const bf16x8 bb = tr_frag(F.lds + GL_VR, 272, 32 * vt, q, lane);
                acc = __builtin_amdgcn_mfma_f32_32x32x16_bf16(a, bb, acc, 0, 0, 0);
            }
#pragma unroll
            for (int i = 0; i < 16; ++i) *(LAS float*)(F.lds + GL_O + ((32 * it2 + crow(i, hi)) * 132 + 32 * vt + r32) * 4) = acc[i];
        }
        LDS_WAIT(); __syncthreads();
        {
            const int i = tid >> 3, sub = tid & 7; const size_t rr = row0 + i;
            float o[16]; float ss = 0.f;
#pragma unroll
            for (int q = 0; q < 4; ++q) { const f32x4 x = *(const LAS f32x4*)(F.lds + GL_O + (i * 132 + 16 * sub + 4 * q) * 4);
#pragma unroll
                for (int e = 0; e < 4; ++e) { o[4 * q + e] = x[e]; ss += x[e] * x[e]; } }
            ss += __shfl_xor(ss, 1); ss += __shfl_xor(ss, 2); ss += __shfl_xor(ss, 4);
            const float rn = rsqrtf(ss * (1.0f / 128.0f) + EPS);
            const unsigned gw[8] = {cu.gb0.x, cu.gb0.y, cu.gb0.z, cu.gb0.w, cu.gb1.x, cu.gb1.y, cu.gb1.z, cu.gb1.w};
            const float* go = FIN(14) + 16 * sub;
            unsigned w[8];
#pragma unroll
            for (int e = 0; e < 8; ++e) { const float a = o[2 * e] * rn * go[2 * e] * siluf_(bflo(gw[e])), bq = o[2 * e + 1] * rn * go[2 * e + 1] * siluf_(bfhi(gw[e])); w[e] = pk2(a, bq); }
            u32x4* op = (u32x4*)(WSP(bf16_t, WS_A2) + rr * DM + 512 + hh * 128 + 16 * sub);
            op[0] = (u32x4){w[0], w[1], w[2], w[3]}; op[1] = (u32x4){w[4], w[5], w[6], w[7]};
        }
        LDS_WAIT(); __syncthreads();
    }
}
__device__ __forceinline__ void gla_sample_item(Frame& F, int item) {
    const int b = item >> 2, hh = item & 3, tid = F.tid, v = tid & 127, kq = tid >> 7;
    LAS float* red = (LAS float*)(F.lds); LAS float* part = (LAS float*)(F.lds + 4096);
    LAS float* decs = (LAS float*)(F.lds + 8192); LAS float* qs = decs + 256; LAS float* ks = qs + 256;
    if (tid < 256) {
        const int t = tid >> 6, k = tid & 63; const size_t row = (size_t)MPROMPT + 4 * b + t;
        float pre = FIN(13)[hh * 64 + k];
#pragma unroll
        for (int r = 0; r < 16; ++r) pre += WSP(float, WS_A1)[row * 16 + r] * FIN(12)[r * 256 + hh * 64 + k];
        decs[tid] = fexp(logsigf_(pre) * (1.0f / 16.0f));
        qs[tid] = bf2f(WSP(bf16_t, WS_QB)[row * 256 + hh * 64 + k]);
        ks[tid] = bf2f(WSP(bf16_t, WS_KB)[row * 256 + hh * 64 + k]);
    }
    float S[16];
    const float* s0 = FIN(4) + ((size_t)item * 64 + 16 * kq) * 128 + v;
#pragma unroll
    for (int e = 0; e < 16; ++e) S[e] = s0[e * 128];
    float vv4[4], gg4[4];
#pragma unroll
    for (int t = 0; t < DEC_T; ++t) { const size_t row = (size_t)MPROMPT + 4 * b + t; vv4[t] = bf2f(WSP(bf16_t, WS_VB)[row * 512 + hh * 128 + v]); gg4[t] = bf2f(WSP(bf16_t, WS_GB)[row * 512 + hh * 128 + v]); }
    const float gout = FIN(14)[v];
    LDS_WAIT(); __syncthreads();
#pragma unroll
    for (int t = 0; t < DEC_T; ++t) {
        const size_t row = (size_t)MPROMPT + 4 * b + t;
        const float vv = vv4[t];
        float op = 0.f;
#pragma unroll
        for (int e = 0; e < 16; ++e) { const int k = t * 64 + 16 * kq + e;
            S[e] = decs[k] * S[e] + ks[k] * vv; op += qs[k] * S[e]; }
        red[kq * 128 + v] = op;
        LDS_WAIT(); __syncthreads();
        const float o = (red[v] + red[128 + v]) + (red[256 + v] + red[384 + v]);
        const float sq = wave_sum(o * o);
        if (F.lane == 0) part[F.wave] = sq;
        LDS_WAIT(); __syncthreads();
        const float rn = rsqrtf((part[0] + part[1]) * (1.0f / 128.0f) + EPS);
        if (tid < 128) WSP(bf16_t, WS_A2)[row * DM + 512 + hh * 128 + v] = (bf16_t)f2bf(o * rn * gout * siluf_(gg4[t]));
        LDS_WAIT(); __syncthreads();
    }
    float* so = F.out + OFF_SGS + ((size_t)item * 64 + 16 * kq) * 128 + v;
#pragma unroll
    for (int e = 0; e < 16; ++e) so[e * 128] = S[e];
    LDS_WAIT(); __syncthreads();
}

__device__ __forceinline__ void final_norm(Frame& F) {
    const int gw = F.vcu * NWAVES + F.wave, NGW = F.G * NWAVES;
    const bf16_t* H4 = WSP(bf16_t, WS_A2); const unsigned* tot4 = TOT(F.ws, 4);
    f32x4 g[4];
#pragma unroll
    for (int j = 0; j < 4; ++j) g[j] = *((const f32x4*)FIN(22) + F.lane + 64 * j);
    for (int m = MPROMPT + gw; m < MTOT; m += NGW) {
        const float rs = rs_from_tot(tot4[m]);
#pragma unroll
        for (int j = 0; j < 4; ++j) { const u32x2 w = *((const u32x2*)(H4 + (size_t)m * DM) + F.lane + 64 * j);
            const f32x4 x = (f32x4){bflo(w.x), bfhi(w.x), bflo(w.y), bfhi(w.y)};
            __builtin_nontemporal_store(x * rs * g[j], (f32x4*)(F.out + OFF_Y + (size_t)m * DM) + F.lane + 64 * j); }
    }
}

constexpr int NPHASES = 12;
constexpr int CW_BAR = 4096;
__global__ void __launch_bounds__(NWAVES * 64, 2) fwd_kernel(Args args) {
    extern __shared__ __attribute__((aligned(16))) unsigned char lds_raw[];
    Frame F;
    F.lds = (LAS unsigned char*)lds_raw;
    F.tid = threadIdx.x; F.lane = F.tid & 63; F.wave = __builtin_amdgcn_readfirstlane(F.tid >> 6);
    F.G = gridDim.x; { const int bx = blockIdx.x; F.vcu = (F.G % 8 == 0) ? (bx % 8) * (F.G / 8) + bx / 8 : bx; }
    F.a = &args; F.out = args.out; F.ws = args.ws;
    volatile LAS unsigned* MISC = (volatile LAS unsigned*)(F.lds + MISC_OFF);
    for (int u = F.tid; u < (LDS_BYTES - LDSCTL_OFF) / 4; u += NWAVES * 64) ((LAS unsigned*)(F.lds + LDSCTL_OFF))[u] = 0u;
    __syncthreads();
    const int lo = args.ph_lo, hi = args.ph_hi;
    XcdBarrier bar; bar.bar = (unsigned*)(F.ws + WS_CTL) + CW_BAR; bar.x = 0; bar.st = nullptr;
    if (hi - lo > 1) bar = xcd_barrier_post((unsigned*)(F.ws + WS_CTL) + CW_BAR, MISC + 8);
#ifndef REP_MASK
#define REP_MASK 0
#endif

#ifndef PH_MASK
#define PH_MASK 0xFFF
#endif
#define IN(k) ((((PH_MASK) >> (k)) & 1) && lo <= (k) && (k) < hi)
#define SEAM(k) do { if (IN(k) && IN((k) + 1)) xcd_barrier(bar); } while (0)
    LAS unsigned char* ring = F.lds;
    CopyCur cp = copy_cursor_init(args.in[2], args.in[3], args.out, (int)blockIdx.x);
#define DRY_K(k) ((int)((((REP_MASK) >> 12) & 1) && (((REP_MASK) >> (k)) & 1) && rep_ == 0))
#define PHASE_BEGIN() do { F.tid = launder_v(threadIdx.x); F.lane = F.tid & 63; F.wave = __builtin_amdgcn_readfirstlane(F.tid >> 6); } while (0)

    if (IN(0)) for (int rep_ = 0; rep_ <= (((REP_MASK) >> 0) & 1); ++rep_) { if (rep_) xcd_barrier(bar); PHASE_BEGIN(); p0_prologue(F); } SEAM(0);
    if (IN(1)) for (int rep_ = 0; rep_ <= (((REP_MASK) >> 1) & 1); ++rep_) { if (rep_) xcd_barrier(bar); PHASE_BEGIN();
#ifndef NO_G1
        { pg8::Gemm g{WSP(bf16_t, WS_HB), WSP(bf16_t, WS_WGU1), MPROMPT, NGU, DM}; pg8::StaticOrder S; S.init(MPROMPT, NGU, F.G, (int)blockIdx.x);
          pg8::EpiSwiGLU<0> E{F.ws, 0};
          pg8::gemm_phase<pg8::EpiSwiGLU<0>, pg8::StaticOrder, true>(ring, g, S, E, cp); }
#endif
#ifndef NO_G8
        if ((int)blockIdx.x >= 128 || F.G != 256) { pg8::Gemm g{WSP(bf16_t, WS_PB), WSP(bf16_t, WS_WPP), MPROMPT, DM, DPLE}; pg8::StaticOrder S; if (F.G == 256) S.init(MPROMPT, DM, 128, (int)blockIdx.x - 128); else S.init(MPROMPT, DM, F.G, (int)blockIdx.x);
          pg8::EpiPlainBf16 E{F.ws, 0};
          pg8::gemm_phase<pg8::EpiPlainBf16, pg8::StaticOrder, true>(ring, g, S, E, cp); }
#endif
        { const sk::EpiSwiGLU<0> E{F.ws, 0}; for (int t = F.G - 1 - (int)blockIdx.x; t < 2 * (DFF / 32); t += F.G) sk::tile(WSP(bf16_t, WS_HB) + (size_t)MPROMPT * DM, DM, WSP(bf16_t, WS_WGU1), E, t, F.lane, F.wave, ring); }
        { const sk::EpiPlain E{F.ws, 0}; for (int t = F.G - 1 - 2 * (DFF / 32) - (int)blockIdx.x; t < 2 * (DM / 64); t += F.G) if (t >= 0) sk::tile(WSP(bf16_t, WS_PB) + (size_t)MPROMPT * DPLE, DPLE, WSP(bf16_t, WS_WPP), E, t, F.lane, F.wave, ring); }
        if ((int)blockIdx.x >= 128) convert_weights<1>(F, ((int)blockIdx.x - 128) * NWAVES + F.wave, 128 * NWAVES);
    } SEAM(1);
    if (IN(2)) for (int rep_ = 0; rep_ <= (((REP_MASK) >> 2) & 1); ++rep_) { if (rep_) xcd_barrier(bar); PHASE_BEGIN();
        pg8::Gemm g{WSP(bf16_t, WS_ACT), WSP(bf16_t, WS_WD1), MPROMPT, DM, DFF}; pg8::StaticOrder S; S.init(MPROMPT, DM, F.G, (int)blockIdx.x);
        pg8::EpiResid<0, 1, false> E{nullptr, F.ws, 0.5f, DRY_K(2)};
        pg8::gemm_phase<pg8::EpiResid<0, 1, false>, pg8::StaticOrder, true>(ring, g, S, E, cp);
        { const sk::EpiResid<0, 1, false> E2{nullptr, F.ws, 0.5f, DRY_K(2)}; for (int t = F.G - 1 - (int)blockIdx.x; t < 2 * (DM / 64); t += F.G) sk::tile(WSP(bf16_t, WS_ACT) + (size_t)MPROMPT * DFF, DFF, WSP(bf16_t, WS_WD1), E2, t, F.lane, F.wave, ring); }
    } SEAM(2);
    if (IN(3)) for (int rep_ = 0; rep_ <= (((REP_MASK) >> 3) & 1); ++rep_) { if (rep_) xcd_barrier(bar); PHASE_BEGIN();
        pg8::Gemm g{WSP(bf16_t, WS_HB), WSP(bf16_t, WS_WIN), MPROMPT, NPROJ, DM}; pg8::StaticOrder S; S.init(MPROMPT, NPROJ, F.G, (int)blockIdx.x);
        pg8::EpiMix E{F.ws, F.out, 0};
        pg8::gemm_phase<pg8::EpiMix, pg8::StaticOrder, true>(ring, g, S, E, cp);
        { const sk::EpiMix E2{F.ws, F.out, 0}; for (int t = F.G - 1 - (int)blockIdx.x; t < 98; t += F.G) sk::tile(WSP(bf16_t, WS_HB) + (size_t)MPROMPT * DM, DM, WSP(bf16_t, WS_WIN), E2, t, F.lane, F.wave, ring); }
        if ((int)blockIdx.x >= 64) convert_weights<2>(F, ((int)blockIdx.x - 64) * NWAVES + F.wave, 192 * NWAVES);
    } SEAM(3);
    if (IN(4)) for (int rep_ = 0; rep_ <= (((REP_MASK) >> 4) & 1); ++rep_) { if (rep_) xcd_barrier(bar); PHASE_BEGIN();
        for (int it = F.vcu; it < 256; it += F.G) attn_prompt_item(F, it);
        for (int it = F.vcu; it < 256; it += F.G) gla_p1_items<4>(F, 4 * it);
    } SEAM(4);
    if (IN(5)) for (int rep_ = 0; rep_ <= (((REP_MASK) >> 5) & 1); ++rep_) { if (rep_) xcd_barrier(bar); PHASE_BEGIN(); gla_scan(F);
        for (int it = F.vcu; it < 128; it += F.G) gla_sample_item(F, it);
        for (int it = F.vcu; it < 256; it += F.G) attn_sample_task(F, (F.wave & 3) * 256 + it, F.wave >> 2);
    } SEAM(5);
    if (IN(6)) for (int rep_ = 0; rep_ <= (((REP_MASK) >> 6) & 1); ++rep_) { if (rep_) xcd_barrier(bar); PHASE_BEGIN(); for (int it = F.vcu; it < 256; it += F.G) gla_p3_items<4>(F, 4 * it); } SEAM(6);
    if (IN(7)) for (int rep_ = 0; rep_ <= (((REP_MASK) >> 7) & 1); ++rep_) { if (rep_) xcd_barrier(bar); PHASE_BEGIN();
        pg8::Gemm g{WSP(bf16_t, WS_A2), WSP(bf16_t, WS_WOUT), MPROMPT, DM, DM}; pg8::StaticOrder S; S.init(MPROMPT, DM, F.G, (int)blockIdx.x);
        pg8::EpiResid<0, 2, false> E{nullptr, F.ws, 1.0f, DRY_K(7)};
        pg8::gemm_phase<pg8::EpiResid<0, 2, false>, pg8::StaticOrder, true>(ring, g, S, E, cp);
        { const sk::EpiResid<0, 2, false> E2{nullptr, F.ws, 1.0f, DRY_K(7)}; for (int t = F.G - 1 - (int)blockIdx.x; t < 2 * (DM / 64); t += F.G) sk::tile(WSP(bf16_t, WS_A2) + (size_t)MPROMPT * DM, DM, WSP(bf16_t, WS_WOUT), E2, t, F.lane, F.wave, ring); }
    } SEAM(7);
    if (IN(8)) for (int rep_ = 0; rep_ <= (((REP_MASK) >> 8) & 1); ++rep_) { if (rep_) xcd_barrier(bar); PHASE_BEGIN();
        pg8::Gemm g{WSP(bf16_t, WS_HB), WSP(bf16_t, WS_WGU2), MPROMPT, NGU, DM}; pg8::StaticOrder S; S.init(MPROMPT, NGU, F.G, (int)blockIdx.x);
        pg8::EpiSwiGLU<2> E{F.ws, 0};
        pg8::gemm_phase<pg8::EpiSwiGLU<2>, pg8::StaticOrder, true>(ring, g, S, E, cp);
        { const sk::EpiSwiGLU<2> E2{F.ws, 0}; for (int t = F.G - 1 - (int)blockIdx.x; t < 2 * (DFF / 32); t += F.G) sk::tile(WSP(bf16_t, WS_HB) + (size_t)MPROMPT * DM, DM, WSP(bf16_t, WS_WGU2), E2, t, F.lane, F.wave, ring); }
    } SEAM(8);
    if (IN(9)) for (int rep_ = 0; rep_ <= (((REP_MASK) >> 9) & 1); ++rep_) { if (rep_) xcd_barrier(bar); PHASE_BEGIN();
        pg8::Gemm g{WSP(bf16_t, WS_ACT), WSP(bf16_t, WS_WD2), MPROMPT, DM, DFF}; pg8::StaticOrder S; S.init(MPROMPT, DM, F.G, (int)blockIdx.x);
        pg8::EpiResid<0, 3, false> E{nullptr, F.ws, 0.5f, DRY_K(9)};
        pg8::gemm_phase<pg8::EpiResid<0, 3, false>, pg8::StaticOrder, true>(ring, g, S, E, cp);
        { const sk::EpiResid<0, 3, false> E2{nullptr, F.ws, 0.5f, DRY_K(9)}; for (int t = F.G - 1 - (int)blockIdx.x; t < 2 * (DM / 64); t += F.G) sk::tile(WSP(bf16_t, WS_ACT) + (size_t)MPROMPT * DFF, DFF, WSP(bf16_t, WS_WD2), E2, t, F.lane, F.wave, ring); }
    } SEAM(9);
    if (IN(10)) for (int rep_ = 0; rep_ <= (((REP_MASK) >> 10) & 1); ++rep_) { if (rep_) xcd_barrier(bar); PHASE_BEGIN();
        pg8::Gemm g{WSP(bf16_t, WS_HB), WSP(bf16_t, WS_WPG), MPROMPT, DM, DM}; pg8::StaticOrder S; S.init(MPROMPT, DM, F.G, (int)blockIdx.x);
        pg8::EpiPleNorm E{F.ws, F.out, FIN(22), 32u * (unsigned)(rep_ + 1), DRY_K(10)};
        pg8::gemm_phase<pg8::EpiPleNorm, pg8::StaticOrder, true>(ring, g, S, E, cp);
        { const sk::EpiResid<1, 4, false> E2{nullptr, F.ws, 1.0f, DRY_K(10)}; for (int t = F.G - 1 - (int)blockIdx.x; t < 2 * (DM / 64); t += F.G) sk::tile(WSP(bf16_t, WS_HB) + (size_t)MPROMPT * DM, DM, WSP(bf16_t, WS_WPG), E2, t, F.lane, F.wave, ring); }
    } SEAM(10);
    if (IN(11)) for (int rep_ = 0; rep_ <= (((REP_MASK) >> 11) & 1); ++rep_) { if (rep_) xcd_barrier(bar); PHASE_BEGIN(); final_norm(F); copy_cleanup(cp, F.tid); }
#undef IN
#undef SEAM
}

extern "C" void kernel_launch(void* const* d_in, const int* in_sizes, int n_in, void* d_out, int out_size, void* d_ws, size_t ws_size, hipStream_t stream) {
    static int grid = 0;
    if (grid == 0) {
        if (n_in != 23 || (size_t)out_size != OUT_TOTAL || ws_size < WS_END) { fprintf(stderr, "kernel_launch: unexpected shapes: n_in %d out %d ws %zu (need %zu)\n", n_in, out_size, ws_size, (size_t)WS_END); grid = -1; return; }
        int dev = 0, cus = 0;
        if (hipGetDevice(&dev) != hipSuccess || hipDeviceGetAttribute(&cus, hipDeviceAttributeMultiprocessorCount, dev) != hipSuccess) { grid = -1; return; }
        if (hipFuncSetAttribute((const void*)fwd_kernel, hipFuncAttributeMaxDynamicSharedMemorySize, LDS_BYTES) != hipSuccess) { fprintf(stderr, "kernel_launch: hipFuncSetAttribute failed\n"); grid = -1; return; }
        int per_cu = 0;
        if (hipOccupancyMaxActiveBlocksPerMultiprocessor(&per_cu, (const void*)fwd_kernel, NWAVES * 64, LDS_BYTES) != hipSuccess || per_cu < 1) { fprintf(stderr, "kernel_launch: occupancy query says %d blocks per CU\n", per_cu); }
        (void)hipGetLastError();
        grid = cus;
        if (grid != 256) { fprintf(stderr, "kernel_launch: built for a 256-CU device (got %d CUs); nothing launched\n", cus); grid = -1; return; }
    }
    if (grid < 0) return;
    static_assert((CW_BAR + XCD_BAR_WORDS) * 4 <= 65536 && (pg8::CW_PANEL + 64 * 64) * 4 <= 65536, "control words inside the memset");
    (void)hipMemsetAsync((char*)d_ws + WS_CTL, 0, 65536, stream);
    Args a{};
    for (int i = 0; i < 23; ++i) a.in[i] = (const float*)d_in[i];
    a.out = (float*)d_out; a.ws = (unsigned char*)d_ws;
#if MK_PER_PHASE
    for (int p = 0; p < NPHASES; ++p) { a.ph_lo = p; a.ph_hi = p + 1; hipLaunchKernelGGL(fwd_kernel, dim3(grid), dim3(NWAVES * 64), LDS_BYTES, stream, a); }
#else
    a.ph_lo = 0; a.ph_hi = NPHASES;
    hipLaunchKernelGGL(fwd_kernel, dim3(grid), dim3(NWAVES * 64), LDS_BYTES, stream, a);
#endif
}
```

```cpp
#include <hip/hip_runtime.h>
#include <cstdio>
#include <cstdint>

#ifndef PROBE_EPI2
#define PROBE_EPI2 0
#endif
#ifndef PROBE_SK2
#define PROBE_SK2 0
#endif
#ifndef MK_PER_PHASE
#define MK_PER_PHASE 0
#endif

#define LAS __attribute__((address_space(3)))
#define GAS __attribute__((address_space(1)))
typedef unsigned short bf16_t;
typedef short bf16x8 __attribute__((ext_vector_type(8)));
typedef short s16x4 __attribute__((ext_vector_type(4)));
typedef float f32x4 __attribute__((ext_vector_type(4)));
typedef float f32x2 __attribute__((ext_vector_type(2)));
typedef float f32x16 __attribute__((ext_vector_type(16)));
typedef unsigned u32x4 __attribute__((ext_vector_type(4)));
typedef unsigned u32x2 __attribute__((ext_vector_type(2)));

constexpr int DM = 1024, NBATCH = 8, SEQ = 2048, MPROMPT = NBATCH * SEQ, DEC_B = 32, DEC_T = 4, MSAMP = DEC_B * DEC_T;
constexpr int MTOT = MPROMPT + MSAMP  , MPAD = 16640  ;
constexpr int DFF = 2816, NGU = 2 * DFF, NPROJ = 3328  , DPLE = 256, PAST = 8192, WINB = 2048;
constexpr int HA = 8, HDA = 64, HB_ = 4, DKB = 64, DVB = 128;
constexpr float EPS = 1e-6f;
constexpr float C2Q = 0.125f * 1.4426950408889634f;
constexpr size_t OFF_Y = 0, OFF_KWP = (size_t)MTOT * DM, OFF_VWP = OFF_KWP + (size_t)MPROMPT * 512, OFF_SGP = OFF_VWP + (size_t)MPROMPT * 512,
                 OFF_KWS = OFF_SGP + (size_t)NBATCH * 4 * 64 * 128, OFF_VWS = OFF_KWS + (size_t)DEC_B * WINB * 512, OFF_SGS = OFF_VWS + (size_t)DEC_B * WINB * 512,
                 OUT_TOTAL = OFF_SGS + (size_t)DEC_B * 4 * 64 * 128;

constexpr size_t al256(size_t x) { return (x + 255) & ~(size_t)255; }
constexpr size_t WS_CTL = 0, CTL_BYTES = 1u << 20;
constexpr size_t WS_WGU1 = CTL_BYTES,                                   SZ_WGU = (size_t)NGU * DM * 2;
constexpr size_t WS_WGU2 = WS_WGU1 + SZ_WGU;
constexpr size_t WS_WD1 = WS_WGU2 + SZ_WGU,                             SZ_WD = (size_t)DM * DFF * 2;
constexpr size_t WS_WD2 = WS_WD1 + SZ_WD;
constexpr size_t WS_WIN = WS_WD2 + SZ_WD,                               SZ_WIN = (size_t)NPROJ * DM * 2;
constexpr size_t WS_WOUT = WS_WIN + SZ_WIN,                             SZ_W1K = (size_t)DM * DM * 2;
constexpr size_t WS_WPG = WS_WOUT + SZ_W1K;
constexpr size_t WS_WPP = WS_WPG + SZ_W1K,                              SZ_WPP = (size_t)DM * DPLE * 2;
constexpr size_t WS_HB = WS_WPP + SZ_WPP,                               SZ_HB = (size_t)MPAD * DM * 2;
constexpr size_t WS_ACT = WS_HB + SZ_HB,                                SZ_ACT = (size_t)MPAD * DFF * 2;
constexpr size_t WS_H32 = WS_ACT + SZ_ACT,                              SZ_H32 = (size_t)MPAD * DM * 4;
constexpr size_t WS_PROJ = WS_H32 + SZ_H32;
constexpr size_t WS_QA = WS_PROJ + SZ_HB,                               SZ_512 = (size_t)MPAD * 512 * 2, SZ_256 = (size_t)MPAD * 256 * 2;
constexpr size_t WS_KA = WS_QA + SZ_512, WS_VA = WS_KA + SZ_512, WS_QB = WS_VA + SZ_512, WS_KB = WS_QB + SZ_256, WS_VB = WS_KB + SZ_256, WS_GB = WS_VB + SZ_512;
constexpr size_t WS_A1 = WS_GB + SZ_512,                                SZ_A1 = (size_t)MPAD * 16 * 4;
constexpr size_t WS_A2 = WS_A1 + SZ_A1;
constexpr size_t WS_PB = WS_A2 + SZ_HB;
constexpr size_t WS_SSQ = WS_PB + SZ_256,                               SZ_SSQ = (size_t)MPAD * 16 * 4;
constexpr size_t WS_ROPE = WS_SSQ + 5 * SZ_SSQ,                         SZ_ROPE = al256((size_t)2052 * 16 * 4);
constexpr size_t WS_BTOT = WS_ROPE + SZ_ROPE,                           SZ_BTOT = (size_t)1024 * 64 * 4;
constexpr size_t WS_END = WS_BTOT + SZ_BTOT;
constexpr size_t WS_HCT = WS_ACT, SZ_HCT = (size_t)1024 * 8192 * 4;
constexpr size_t WS_SPT = WS_HCT + SZ_HCT, SZ_SPT = (size_t)1024 * 8192 * 2;
static_assert(SZ_HCT + SZ_SPT <= SZ_ACT, "overlay fits");
static_assert(WS_END <= (size_t)500 * 1024 * 1024, "workspace budget");

constexpr int RING_BYTES = 131072, LDSCTL_OFF = RING_BYTES, MISC_OFF = LDSCTL_OFF + 320, LDS_BYTES = 147456;
constexpr int NWAVES = 8;

#define LDS_WAIT() asm volatile("s_waitcnt lgkmcnt(0)" ::: "memory")
#define VM_WAIT() asm volatile("s_waitcnt vmcnt(0)" ::: "memory")
__device__ __forceinline__ unsigned f2bf(float f) { unsigned u = __builtin_bit_cast(unsigned, f); return (u + 0x7fffu + ((u >> 16) & 1u)) >> 16; }
__device__ __forceinline__ unsigned pk2(float lo, float hi) { return f2bf(lo) | (f2bf(hi) << 16); }
typedef __bf16 bf16x2_t __attribute__((ext_vector_type(2)));
__device__ __forceinline__ unsigned cvt_pk_bf16(float lo, float hi) { const f32x2 v = {lo, hi}; return __builtin_bit_cast(unsigned, __builtin_convertvector(v, bf16x2_t)); }
__device__ __forceinline__ float bf2f(unsigned short b) { return __uint_as_float(((unsigned)b) << 16); }
__device__ __forceinline__ float bflo(unsigned w) { return __uint_as_float(w << 16); }
__device__ __forceinline__ float bfhi(unsigned w) { return __uint_as_float(w & 0xffff0000u); }
__device__ __forceinline__ float fexp(float x) { return __builtin_amdgcn_exp2f(x * 1.4426950408889634f); }
__device__ __forceinline__ float sigmoidf_(float x) { return __builtin_amdgcn_rcpf(1.f + fexp(-x)); }
__device__ __forceinline__ float siluf_(float x) { return x * sigmoidf_(x); }
__device__ __forceinline__ float logsigf_(float x) { return fminf(x, 0.f) - __logf(1.f + fexp(-fabsf(x))); }
__device__ __forceinline__ float wave_sum(float v) {
#pragma unroll
    for (int o = 1; o < 64; o <<= 1) v += __shfl_xor(v, o);
    return v;
}
__device__ __forceinline__ int launder_v(int x) { asm volatile("" : "+v"(x)); return x; }
template <class T> __device__ __forceinline__ T* launder_s(T* p) { asm volatile("" : "+s"(p)); return p; }
#define TOT(ws_, i) ((unsigned*)((ws_) + WS_SSQ + (size_t)(i) * SZ_SSQ))
constexpr float SSQ_SCALE = 16384.f, SSQ_INV = 1.0f / (16384.f * DM);
__device__ __forceinline__ float rs_from_tot(unsigned t) { return rsqrtf((float)t * SSQ_INV + EPS); }
__device__ __forceinline__ void ssq_add(unsigned* tot, int row, float ss) { __hip_atomic_fetch_add(tot + row, (unsigned)(ss * SSQ_SCALE + 0.5f), __ATOMIC_RELAXED, __HIP_MEMORY_SCOPE_AGENT); }
__device__ __forceinline__ float row_rs(const unsigned* tot, int row) { return rs_from_tot(tot[row]); }
__device__ __forceinline__ void row_tot8(const unsigned* tot, int row0, unsigned (&t)[2][4]) {
#pragma unroll
    for (int ai = 0; ai < 2; ++ai)
#pragma unroll
        for (int m = 0; m < 4; ++m) t[ai][m] = tot[row0 + ai * 128 + m * 16];
}

constexpr int CPQ_ELEMS = (WINB - DEC_T) * 128 / 4  , CP_STEPS = (CPQ_ELEMS + 511) / 512  ;
struct CopyCur { const f32x4* src; f32x4* dst; int it; };
__device__ __forceinline__ CopyCur copy_cursor_init(const float* ck, const float* cv, float* out, int w) {
    const int seg = w >> 2, q = w & 3, tensor = seg >> 5, b = seg & 31;
    CopyCur c; c.src = (const f32x4*)(tensor ? cv : ck) + (size_t)b * (WINB * 128) + DEC_T * 128 + (size_t)q * CPQ_ELEMS;
    c.dst = (f32x4*)(out + (tensor ? OFF_VWS : OFF_KWS)) + (size_t)b * (WINB * 128) + (size_t)q * CPQ_ELEMS; c.it = 0; return c;
}
__device__ __forceinline__ void copy_cleanup(CopyCur& c, int tid) {
    for (; c.it < CP_STEPS; ++c.it) { const int e = c.it * 512 + tid; if (e < CPQ_ELEMS) __builtin_nontemporal_store(__builtin_nontemporal_load(c.src + e), c.dst + e); }
}

namespace pg8 {
constexpr int BM = 256, BK = 64, HALF = 128, HTB = HALF * BK * 2, STAGE_BYTES = 8 * HTB, NXCD = 8, WGM = 8;
__host__ __device__ __forceinline__ int lds_byte(int r, int c) { const int st = (r >> 4) * 2 + (c >> 5), rr = r & 15, cc = c & 31, ob = rr * 64 + cc * 2; return st * 1024 + (ob ^ (((ob >> 9) & 1) << 5)); }
__host__ __device__ __forceinline__ void stage_rc(int b, int& R, int& C) { const int st = b / 1024, sb = b % 1024, swz = sb ^ (((sb >> 9) & 1) << 5); R = (st >> 1) * 16 + swz / 64; C = (st & 1) * 32 + (swz % 64) / 2; }
__host__ __device__ __forceinline__ int perm32(int rho) { const int n = rho >> 4, i = rho & 15; return 8 * (i >> 2) + 4 * n + (i & 3); }
struct Unit { int pm, pn; };
struct Gemm { const bf16_t* A; const bf16_t* Bt; int M, N, K; };
struct StaticOrder {
    int nM, nN, nwg, G, c;
    __host__ __device__ void init(int M, int N, int G_, int c_) { nM = M / BM; nN = N / BM; nwg = nM * nN; G = G_; c = c_; }
    __host__ __device__ bool next(int i, Unit& u) const {
        const long L = (long)i * G + c; if (L >= nwg) return false;
        int wgid = (int)L; { const int q = nwg / NXCD, r = nwg % NXCD, xcd = wgid % NXCD, off = wgid / NXCD; wgid = (xcd < r ? xcd * (q + 1) : r * (q + 1) + (xcd - r) * q) + off; }
        const int nig = WGM * nN, gid = wgid / nig, fm = gid * WGM, gsz = (nM - fm) < WGM ? (nM - fm) : WGM;
        u.pm = fm + ((wgid % nig) % gsz); u.pn = (wgid % nig) / gsz; return true;
    }
    __device__ __forceinline__ void a_ready(const Unit&) const {}
    __device__ __forceinline__ void done(const Unit&) const {}
};

template <class Epi, class Sched, bool ALIGN_EPI, bool LITE = false>
__device__ __forceinline__ void gemm_phase(LAS unsigned char* lds, const Gemm g, const Sched& S, const Epi& E, CopyCur& cp) {
    const int tid = launder_v(threadIdx.x), wid = __builtin_amdgcn_readfirstlane(tid >> 6), lane = tid & 63, wr = wid >> 2, wc = wid & 3, fr = lane & 15, fq = lane >> 4;
    const int K = g.K, nt = K / BK;
    unsigned voffA[2], voffB[2];
#pragma unroll
    for (int i = 0; i < 2; ++i) { int R, C; stage_rc(tid * 16 + i * 8192, R, C); const int Rb = Epi::PERM ? ((R & ~31) + perm32(R & 31)) : R;
        voffA[i] = (unsigned)(R * K + C) * 2u; voffB[i] = (unsigned)(Rb * K + C) * 2u; }
    const size_t kstep = (size_t)(BK * 2);
    const size_t hstep = (size_t)HALF * K * 2;
    const size_t tstep = 2 * hstep;
    const unsigned ldsw = (unsigned)wid * 1024u;
    const int aoff = lds_byte(wr * 64 + fr, fq * 8), boff = lds_byte(wc * 32 + fr, fq * 8);
#define PG8_SA(b, h) (((b) * 2 + (h)) * HTB)
#define PG8_SB(b, h) ((4 + (b) * 2 + (h)) * HTB)
#define PG8_STAGE(bufoff, gbase, voff) do { _Pragma("unroll") for (int _i = 0; _i < 2; ++_i) \
        __builtin_amdgcn_global_load_lds((const unsigned*)((const char*)(gbase) + (voff)[_i]), (LAS unsigned*)(lds + (bufoff) + ldsw + _i * 8192), 16, 0, 0); } while (0)
#define PG8_LDA(dst, b, h) do { _Pragma("unroll") for (int m = 0; m < 4; ++m) _Pragma("unroll") for (int k = 0; k < 2; ++k) dst[m][k] = *(const LAS bf16x8*)(lds + PG8_SA(b, h) + aoff + m * 2048 + k * 1024); } while (0)
#define PG8_LDB(dst, b, h) do { _Pragma("unroll") for (int n = 0; n < 2; ++n) _Pragma("unroll") for (int k = 0; k < 2; ++k) dst[n][k] = *(const LAS bf16x8*)(lds + PG8_SB(b, h) + boff + n * 2048 + k * 1024); } while (0)
#define PG8_MMA(ai, bj, At, Bt) do { if (LITE && ((bj) != 0 || wc != 0)) break; __builtin_amdgcn_s_setprio(1); _Pragma("unroll") for (int m = 0; m < 4; ++m) _Pragma("unroll") for (int n = 0; n < 2; ++n) _Pragma("unroll") for (int k = 0; k < 2; ++k) \
        acc[ai][bj][m][n] = __builtin_amdgcn_mfma_f32_16x16x32_bf16(Bt[n][k], At[m][k], acc[ai][bj][m][n], 0, 0, 0); __builtin_amdgcn_s_setprio(0); } while (0)
#define PG8_WAIT_V(n) asm volatile("s_waitcnt vmcnt(" #n ")" ::: "memory")
#define PG8_WAIT_VC() do { if (ncp == 0) PG8_WAIT_V(8); else if (ncp == 1) PG8_WAIT_V(9); else PG8_WAIT_V(10); } while (0)
#define PG8_WAIT_L(n) asm volatile("s_waitcnt lgkmcnt(" #n ")" ::: "memory")
#define PG8_BAR __builtin_amdgcn_s_barrier()
#define PG8_SCHED __builtin_amdgcn_sched_barrier(0)
    Unit cur, nxt; int ui = 0;
    if (!S.next(0, cur)) return;
    unsigned pre[2][4] = {{0u, 0u, 0u, 0u}, {0u, 0u, 0u, 0u}};
    if constexpr (Epi::PRE) E.prefetch(cur, wr, fr, pre);
    f32x4 acc[2][2][4][2];
#pragma unroll
    for (int a = 0; a < 2; ++a)
#pragma unroll
        for (int b = 0; b < 2; ++b)
#pragma unroll
            for (int m = 0; m < 4; ++m)
#pragma unroll
                for (int n = 0; n < 2; ++n) acc[a][b][m][n] = (f32x4){0.f, 0.f, 0.f, 0.f};
    bf16x8 At[4][2], B0[2][2], B1[2][2];
    f32x4 cp_data = (f32x4){0.f, 0.f, 0.f, 0.f}; int cp_e = 0; bool cp_pending = false;
    const char* cA = (const char*)g.A + (size_t)cur.pm * tstep; const char* cB = (const char*)g.Bt + (size_t)cur.pn * tstep;
    S.a_ready(cur);
    PG8_STAGE(PG8_SB(0, 0), cB, voffB); PG8_STAGE(PG8_SB(0, 1), cB + hstep, voffB); PG8_STAGE(PG8_SA(0, 0), cA, voffA); PG8_STAGE(PG8_SA(0, 1), cA + hstep, voffA);
    if (wr == 1) PG8_BAR;
    PG8_WAIT_V(2); PG8_BAR;
    PG8_STAGE(PG8_SB(1, 0), cB + kstep, voffB); PG8_STAGE(PG8_SA(1, 0), cA + kstep, voffA); PG8_STAGE(PG8_SB(1, 1), cB + hstep + kstep, voffB);
    PG8_WAIT_V(6); PG8_BAR;
    for (;;) {
        const bool has_next = S.next(ui + 1, nxt);
        const char* nA = has_next ? (const char*)g.A + (size_t)nxt.pm * tstep : cA; const char* nB = has_next ? (const char*)g.Bt + (size_t)nxt.pn * tstep : cB;
#pragma nounroll
        for (int t = 0; t < nt; t += 2) {
            const bool last = (t == nt - 2);
            const char* a1 = cA + (size_t)(t + 1) * kstep;
            const char* a2 = last ? nA : cA + (size_t)(t + 2) * kstep; const char* b2 = last ? nB : cB + (size_t)(t + 2) * kstep;
            const char* a3 = a2 + kstep; const char* b3 = b2 + kstep;
            if (last && has_next) S.a_ready(nxt);
            PG8_LDB(B0, 0, 0); PG8_LDB(B1, 0, 1); PG8_SCHED; PG8_LDA(At, 0, 0); PG8_STAGE(PG8_SA(1, 1), a1 + hstep, voffA);
            int ncp = 0;
            if (cp_pending) { asm volatile("global_store_dwordx4 %0, %1, off nt\n\ts_nop 1" :: "v"(cp.dst + cp_e), "v"(cp_data) : "memory"); ncp = 1; cp_pending = false; }
            if (cp.it < CP_STEPS && !last) {
                cp_e = cp.it * 512 + tid; ++cp.it;
                if (cp.it * 512 - 512 + wid * 64 < CPQ_ELEMS) { asm volatile("global_load_dwordx4 %0, %1, off nt" : "=v"(cp_data) : "v"(cp.src + cp_e) : "memory"); ++ncp; cp_pending = true; }
            }
            PG8_WAIT_VC(); PG8_WAIT_L(0); PG8_BAR; PG8_MMA(0, 0, At, B0); PG8_MMA(0, 1, At, B1); PG8_BAR; PG8_SCHED;
            PG8_LDA(At, 0, 1); PG8_STAGE(PG8_SB(0, 0), b2, voffB); PG8_STAGE(PG8_SB(0, 1), b2 + hstep, voffB); PG8_STAGE(PG8_SA(0, 0), a2, voffA);
            PG8_WAIT_VC(); PG8_WAIT_L(0); PG8_BAR; PG8_MMA(1, 0, At, B0); PG8_MMA(1, 1, At, B1); PG8_BAR; PG8_SCHED;
            PG8_LDB(B0, 1, 0); PG8_LDB(B1, 1, 1); PG8_SCHED; PG8_LDA(At, 1, 0); PG8_STAGE(PG8_SA(0, 1), a2 + hstep, voffA);
            PG8_WAIT_VC(); PG8_WAIT_L(0); PG8_BAR; PG8_MMA(0, 0, At, B0); PG8_MMA(0, 1, At, B1); PG8_BAR; PG8_SCHED;
            PG8_LDA(At, 1, 1); PG8_STAGE(PG8_SB(1, 0), b3, voffB); PG8_STAGE(PG8_SB(1, 1), b3 + hstep, voffB); PG8_STAGE(PG8_SA(1, 0), a3, voffA);
            PG8_WAIT_V(8); PG8_WAIT_L(0); PG8_BAR; PG8_MMA(1, 0, At, B0); PG8_MMA(1, 1, At, B1); PG8_BAR; PG8_SCHED;
        }
        if constexpr (ALIGN_EPI) { if (wr == 0) PG8_BAR; }
#if PROBE_EPI2
        if constexpr (Epi::PROBE2) { Epi Ed = E; Ed.dry = 1; Ed(acc, cur, wr, wc, fr, fq, pre); asm volatile("s_waitcnt vmcnt(0)" ::: "memory"); }
#endif
        E(acc, cur, wr, wc, fr, fq, pre); S.done(cur);
        if (!has_next) break;
        if constexpr (Epi::PRE) E.prefetch(nxt, wr, fr, pre);
#pragma unroll
        for (int a = 0; a < 2; ++a)
#pragma unroll
            for (int b = 0; b < 2; ++b)
#pragma unroll
                for (int m = 0; m < 4; ++m)
#pragma unroll
                    for (int n = 0; n < 2; ++n) acc[a][b][m][n] = (f32x4){0.f, 0.f, 0.f, 0.f};
        cur = nxt; cA = nA; cB = nB; ++ui;
        if constexpr (ALIGN_EPI) { if (wr == 1) PG8_BAR; }
    }
    PG8_WAIT_V(0);
    if constexpr (!ALIGN_EPI) { if (wr == 0) PG8_BAR; }
    PG8_BAR;
#undef PG8_SA
#undef PG8_SB
#undef PG8_STAGE
#undef PG8_LDA
#undef PG8_LDB
#undef PG8_MMA
#undef PG8_WAIT_V
#undef PG8_WAIT_VC
#undef PG8_WAIT_L
#undef PG8_BAR
#undef PG8_SCHED
}


template <int SSQI> struct EpiSwiGLU {
    static constexpr bool PERM = true, PROBE2 = true, PRE = true;
    unsigned char* ws; int dry;
    __device__ __forceinline__ void prefetch(const Unit& u, int wr, int fr, unsigned (&pre)[2][4]) const { row_tot8(TOT(ws, SSQI), u.pm * BM + wr * 64 + fr, pre); }
    __device__ __forceinline__ void operator()(const f32x4 (&acc)[2][2][4][2], const Unit& u, int wr, int wc, int fr, int fq, const unsigned (&pre)[2][4]) const {
        bf16_t* O = (bf16_t*)(ws + WS_ACT);
        const int row0 = u.pm * BM + wr * 64 + fr, col0 = u.pn * 128 + wc * 32 + 8 * fq;
#pragma unroll
        for (int ai = 0; ai < 2; ++ai)
#pragma unroll
            for (int m = 0; m < 4; ++m) {
                const int row = row0 + ai * HALF + m * 16; const float rs = rs_from_tot(pre[ai][m]);
                float o[8];
#pragma unroll
                for (int n = 0; n < 2; ++n)
#pragma unroll
                    for (int j = 0; j < 4; ++j) { const float gt = acc[ai][0][m][n][j] * rs, up = acc[ai][1][m][n][j] * rs; o[n * 4 + j] = siluf_(gt) * up; }
                u32x4 w; w.x = cvt_pk_bf16(o[0], o[1]); w.y = cvt_pk_bf16(o[2], o[3]); w.z = cvt_pk_bf16(o[4], o[5]); w.w = cvt_pk_bf16(o[6], o[7]);
                *(u32x4*)(O + (size_t)row * DFF + col0) = w;
            }
    }
};
struct EpiPlainBf16 {
    static constexpr bool PERM = true, PROBE2 = true, PRE = false;
    unsigned char* ws; int dry;
    __device__ __forceinline__ void operator()(const f32x4 (&acc)[2][2][4][2], const Unit& u, int wr, int wc, int fr, int fq, const unsigned (&)[2][4]) const {
        bf16_t* O = (bf16_t*)(ws + WS_PROJ); constexpr int ldc = DM;
        const int row0 = u.pm * BM + wr * 64 + fr, col0 = u.pn * BM + wc * 32 + 8 * fq;
#pragma unroll
        for (int ai = 0; ai < 2; ++ai)
#pragma unroll
            for (int m = 0; m < 4; ++m) { bf16_t* rowp = O + (size_t)(row0 + ai * HALF + m * 16) * ldc + col0;
#pragma unroll
                for (int bj = 0; bj < 2; ++bj) { const f32x4 v0 = acc[ai][bj][m][0], v1 = acc[ai][bj][m][1];
                    u32x4 w; w.x = cvt_pk_bf16(v0[0], v0[1]); w.y = cvt_pk_bf16(v0[2], v0[3]); w.z = cvt_pk_bf16(v1[0], v1[1]); w.w = cvt_pk_bf16(v1[2], v1[3]);
                    *(u32x4*)(rowp + bj * HALF) = w; } }
    }
};
template <int MODE  , int SSQO, bool FROM_X  > struct EpiResid {
    static constexpr bool PERM = true, PROBE2 = true, PRE = false;
    const float* xP; unsigned char* ws; float scale; int dry;
    __device__ __forceinline__ void operator()(const f32x4 (&acc)[2][2][4][2], const Unit& u, int wr, int wc, int fr, int fq, const unsigned (&)[2][4]) const {
        bf16_t* HBp = (bf16_t*)(ws + WS_HB); unsigned* ssq_out = TOT(ws, SSQO);
        const int col0 = u.pn * BM + wc * 32 + 8 * fq, row00 = u.pm * BM + wr * 64 + fr;
        u32x4 bn_[2];
#pragma unroll
        for (int bj = 0; bj < 2; ++bj) bn_[bj] = *(const u32x4*)(HBp + (size_t)row00 * DM + col0 + bj * HALF);
#pragma unroll
        for (int ai = 0; ai < 2; ++ai)
#pragma unroll
            for (int m = 0; m < 4; ++m) {
                const int row = row00 + ai * HALF + m * 16;
                u32x4 bc[2];
#pragma unroll
                for (int bj = 0; bj < 2; ++bj) bc[bj] = bn_[bj];
                if (ai * 4 + m < 7) { const int rown = row00 + ((ai * 4 + m + 1) >> 2) * HALF + ((ai * 4 + m + 1) & 3) * 16;
#pragma unroll
                    for (int bj = 0; bj < 2; ++bj) bn_[bj] = *(const u32x4*)(HBp + (size_t)rown * DM + col0 + bj * HALF); }
                float ss = 0.f;
#pragma unroll
                for (int bj = 0; bj < 2; ++bj) {
                    const u32x4 w0 = bc[bj];
                    const f32x4 v0 = (f32x4){bflo(w0.x), bfhi(w0.x), bflo(w0.y), bfhi(w0.y)} + acc[ai][bj][m][0] * scale;
                    const f32x4 v1 = (f32x4){bflo(w0.z), bfhi(w0.z), bflo(w0.w), bfhi(w0.w)} + acc[ai][bj][m][1] * scale;
                    if (!dry) { u32x4 w; w.x = cvt_pk_bf16(v0[0], v0[1]); w.y = cvt_pk_bf16(v0[2], v0[3]); w.z = cvt_pk_bf16(v1[0], v1[1]); w.w = cvt_pk_bf16(v1[2], v1[3]);
                        *(u32x4*)(HBp + (size_t)row * DM + col0 + bj * HALF) = w; }
                    ss += ((v0[0] * v0[0] + v0[1] * v0[1]) + (v0[2] * v0[2] + v0[3] * v0[3])) + ((v1[0] * v1[0] + v1[1] * v1[1]) + (v1[2] * v1[2] + v1[3] * v1[3])); }
                ss += __shfl_xor(ss, 16); ss += __shfl_xor(ss, 32);
                if (fq == 0 && !dry) ssq_add(ssq_out, row, ss);
            }
    }
};
constexpr int CW_PANEL = 8192;
struct EpiPleNorm {
    static constexpr bool PERM = true, PROBE2 = false, PRE = true;
    unsigned char* ws; float* out; const float* gfin; unsigned want; int dry;
    __device__ __forceinline__ void prefetch(const Unit& u, int wr, int fr, unsigned (&pre)[2][4]) const { row_tot8(TOT(ws, 3), u.pm * BM + wr * 64 + fr, pre); }
    __device__ __forceinline__ void operator()(f32x4 (&acc)[2][2][4][2], const Unit& u, int wr, int wc, int fr, int fq, const unsigned (&pre)[2][4]) const {
        const bf16_t* HBp = (const bf16_t*)(ws + WS_HB); const bf16_t* proj = (const bf16_t*)(ws + WS_PROJ);
        unsigned* ssq4 = TOT(ws, 4);
        const int col0 = u.pn * BM + wc * 32 + 8 * fq, row00 = u.pm * BM + wr * 64 + fr;
        u32x4 pn_[2], bn_[2];
#pragma unroll
        for (int bj = 0; bj < 2; ++bj) { pn_[bj] = *(const u32x4*)(proj + (size_t)row00 * DM + col0 + bj * HALF); bn_[bj] = *(const u32x4*)(HBp + (size_t)row00 * DM + col0 + bj * HALF); }
#pragma unroll
        for (int ai = 0; ai < 2; ++ai)
#pragma unroll
            for (int m = 0; m < 4; ++m) {
                const int row = row00 + ai * HALF + m * 16;
                const float rs = rs_from_tot(pre[ai][m]);
                u32x4 pc[2], bc[2];
#pragma unroll
                for (int bj = 0; bj < 2; ++bj) { pc[bj] = pn_[bj]; bc[bj] = bn_[bj]; }
                if (ai * 4 + m < 7) { const int rown = row00 + ((ai * 4 + m + 1) >> 2) * HALF + ((ai * 4 + m + 1) & 3) * 16;
#pragma unroll
                    for (int bj = 0; bj < 2; ++bj) { pn_[bj] = *(const u32x4*)(proj + (size_t)rown * DM + col0 + bj * HALF); bn_[bj] = *(const u32x4*)(HBp + (size_t)rown * DM + col0 + bj * HALF); } }
                float ss = 0.f;
#pragma unroll
                for (int bj = 0; bj < 2; ++bj) {
                    const u32x4 b0 = bc[bj], p0 = pc[bj];
                    const f32x4 a0 = acc[ai][bj][m][0] * rs, a1 = acc[ai][bj][m][1] * rs; f32x4 v0, v1;
                    v0[0] = bflo(b0.x) + sigmoidf_(a0[0]) * bflo(p0.x); v0[1] = bfhi(b0.x) + sigmoidf_(a0[1]) * bfhi(p0.x); v0[2] = bflo(b0.y) + sigmoidf_(a0[2]) * bflo(p0.y); v0[3] = bfhi(b0.y) + sigmoidf_(a0[3]) * bfhi(p0.y);
                    v1[0] = bflo(b0.z) + sigmoidf_(a1[0]) * bflo(p0.z); v1[1] = bfhi(b0.z) + sigmoidf_(a1[1]) * bfhi(p0.z); v1[2] = bflo(b0.w) + sigmoidf_(a1[2]) * bflo(p0.w); v1[3] = bfhi(b0.w) + sigmoidf_(a1[3]) * bfhi(p0.w);
                    acc[ai][bj][m][0] = v0; acc[ai][bj][m][1] = v1;
                    ss += ((v0[0] * v0[0] + v0[1] * v0[1]) + (v0[2] * v0[2] + v0[3] * v0[3])) + ((v1[0] * v1[0] + v1[1] * v1[1]) + (v1[2] * v1[2] + v1[3] * v1[3])); }
                ss += __shfl_xor(ss, 16); ss += __shfl_xor(ss, 32);
                if (fq == 0 && !dry) ssq_add(ssq4, row, ss);
            }
        asm volatile("s_waitcnt vmcnt(0)" ::: "memory");
        unsigned* cnt = (unsigned*)(ws + WS_CTL) + CW_PANEL + 64 * u.pm;
        if (fr == 0 && fq == 0) __hip_atomic_fetch_add(cnt, 1u, __ATOMIC_RELAXED, __HIP_MEMORY_SCOPE_AGENT);
        if (wr == 0 && wc == 0) {
            unsigned sp = 0;
            while ((unsigned)__builtin_amdgcn_readfirstlane(__hip_atomic_load(cnt, __ATOMIC_RELAXED, __HIP_MEMORY_SCOPE_AGENT)) < want) { __builtin_amdgcn_s_sleep(2); if (++sp > (1u << 20)) break; }
        }
        asm volatile("s_waitcnt vmcnt(0) lgkmcnt(0)" ::: "memory"); __builtin_amdgcn_s_barrier(); asm volatile("" ::: "memory");
        f32x4 g[2][2];
#pragma unroll
        for (int bj = 0; bj < 2; ++bj)
#pragma unroll
            for (int n = 0; n < 2; ++n) g[bj][n] = *(const f32x4*)(gfin + col0 + bj * HALF + n * 4);
#pragma unroll
        for (int ai = 0; ai < 2; ++ai)
#pragma unroll
            for (int m = 0; m < 4; ++m) {
                const int row = row00 + ai * HALF + m * 16;
                const float rs4 = rs_from_tot(__hip_atomic_load(ssq4 + row, __ATOMIC_RELAXED, __HIP_MEMORY_SCOPE_AGENT));
                if (!dry) {
#pragma unroll
                    for (int bj = 0; bj < 2; ++bj)
#pragma unroll
                        for (int n = 0; n < 2; ++n) __builtin_nontemporal_store(acc[ai][bj][m][n] * rs4 * g[bj][n], (f32x4*)(out + OFF_Y + (size_t)row * DM + col0 + bj * HALF + n * 4));
                }
            }
    }
};
struct EpiMix {
    static constexpr bool PERM = true, PROBE2 = true, PRE = true;
    unsigned char* ws; float* out; int dry; int pn_base;
    __device__ __forceinline__ void prefetch(const Unit& u, int wr, int fr, unsigned (&pre)[2][4]) const { row_tot8(TOT(ws, 1), u.pm * BM + wr * 64 + fr, pre); }
    __device__ __forceinline__ void operator()(const f32x4 (&acc)[2][2][4][2], const Unit& u, int wr, int wc, int fr, int fq, const unsigned (&pre)[2][4]) const {
        const float* rope = (const float*)(ws + WS_ROPE);
        bf16_t *QA = (bf16_t*)(ws + WS_QA), *KA = (bf16_t*)(ws + WS_KA), *VA = (bf16_t*)(ws + WS_VA), *QB = (bf16_t*)(ws + WS_QB), *KB = (bf16_t*)(ws + WS_KB), *VB = (bf16_t*)(ws + WS_VB), *GB = (bf16_t*)(ws + WS_GB);
        float* A1 = (float*)(ws + WS_A1);
        const int pn = u.pn + pn_base;
        if (pn == 12 && wc != 0) return;
        const bool do_rope = (pn < 4) && ((wc & 1) == 0);
        const int row00 = u.pm * BM + wr * 64 + fr, cb = wc * 32 + 8 * fq;
        f32x4 tn[4];
#pragma unroll
        for (int k = 0; k < 4; ++k) tn[k] = (f32x4){0.f, 0.f, 0.f, 0.f};
        if (do_rope) { const int posidx = row00 & (SEQ - 1);
#pragma unroll
            for (int k = 0; k < 4; ++k) tn[k] = *(const f32x4*)(rope + (size_t)posidx * 16 + 4 * k); }
#pragma unroll
        for (int ai = 0; ai < 2; ++ai)
#pragma unroll
            for (int m = 0; m < 4; ++m) {
                const int row = row00 + ai * HALF + m * 16;
                const float rs = rs_from_tot(pre[ai][m]);
                f32x4 v[2][2];
#pragma unroll
                for (int bj = 0; bj < 2; ++bj)
#pragma unroll
                    for (int n = 0; n < 2; ++n) v[bj][n] = acc[ai][bj][m][n] * rs;
                if (do_rope) {
                    f32x4 t[4];
#pragma unroll
                    for (int k = 0; k < 4; ++k) t[k] = tn[k];
                    if (ai * 4 + m < 7) { const int rown = row00 + ((ai * 4 + m + 1) >> 2) * HALF + ((ai * 4 + m + 1) & 3) * 16; const int posn = rown & (SEQ - 1);
#pragma unroll
                        for (int k = 0; k < 4; ++k) tn[k] = *(const f32x4*)(rope + (size_t)posn * 16 + 4 * k); }
#pragma unroll
                    for (int bj = 0; bj < 2; ++bj)
#pragma unroll
                        for (int n = 0; n < 2; ++n)
#pragma unroll
                            for (int j = 0; j < 4; ++j) { const float cs = t[2 * n + (j >> 1)][2 * (j & 1)], sn = t[2 * n + (j >> 1)][2 * (j & 1) + 1];
                                const float x = v[bj][n][j], w = __shfl_xor(x, 16);
                                if (fq < 2) v[bj][n][j] = (fq == 0) ? (x * cs - w * sn) : (x * cs + w * sn); }
                }
                if (pn < 6) {
                    const int kind = pn >> 1, c0 = (pn & 1) * 256 + cb;
                    bf16_t* dst = (kind == 0 ? QA : (kind == 1 ? KA : VA)) + (size_t)row * 512 + c0;
                    const float sc = kind == 0 ? C2Q : 1.f;
                    float* fo = kind == 0 ? nullptr : out + (kind == 1 ? OFF_KWP : OFF_VWP) + (size_t)row * 512 + c0;
#pragma unroll
                    for (int bj = 0; bj < 2; ++bj) { const f32x4 x0 = v[bj][0], x1 = v[bj][1];
                        u32x4 w; w.x = cvt_pk_bf16(x0[0] * sc, x0[1] * sc); w.y = cvt_pk_bf16(x0[2] * sc, x0[3] * sc); w.z = cvt_pk_bf16(x1[0] * sc, x1[1] * sc); w.w = cvt_pk_bf16(x1[2] * sc, x1[3] * sc);
                        *(u32x4*)(dst + bj * HALF) = w;
                        if (fo) { __builtin_nontemporal_store(x0, (f32x4*)(fo + bj * HALF)); __builtin_nontemporal_store(x1, (f32x4*)(fo + bj * HALF + 4)); } }
                } else if (pn < 12) {
                    bf16_t* dst; float sc = 1.f;
                    if (pn == 6) { dst = QB + (size_t)row * 256; sc = 0.125f; }
                    else if (pn == 7) dst = KB + (size_t)row * 256;
                    else if (pn < 10) dst = VB + (size_t)row * 512 + (pn - 8) * 256;
                    else dst = GB + (size_t)row * 512 + (pn - 10) * 256;
                    dst += cb;
#pragma unroll
                    for (int bj = 0; bj < 2; ++bj) { const f32x4 x0 = v[bj][0] * sc, x1 = v[bj][1] * sc;
                        u32x4 w; w.x = cvt_pk_bf16(x0[0], x0[1]); w.y = cvt_pk_bf16(x0[2], x0[3]); w.z = cvt_pk_bf16(x1[0], x1[1]); w.w = cvt_pk_bf16(x1[2], x1[3]);
                        *(u32x4*)(dst + bj * HALF) = w; }
                } else if (fq < 2) {
                    *(f32x4*)(A1 + (size_t)row * 16 + 8 * fq) = v[0][0]; *(f32x4*)(A1 + (size_t)row * 16 + 8 * fq + 4) = v[0][1];
                }
            }
    }
};
}


namespace sk {
template <class Epi> __device__ __forceinline__ void tile1(const bf16_t* A, int K, const bf16_t* Bt, const Epi& E, int task, int lane, int wave, LAS unsigned char* lds) {
    const int tn = task >> 1, rh = task & 1, fr = lane & 15, fq = lane >> 4;
    const int kw = K >> 3, nks = kw >> 5;
    const bf16_t* ap = A + (size_t)(64 * rh + fr) * K + wave * kw + 8 * fq;
    const bf16_t* bp[4];
#pragma unroll
    for (int f = 0; f < 4; ++f) bp[f] = Bt + (size_t)Epi::brow(tn, f, fr) * K + wave * kw + 8 * fq;
    f32x4 acc[4][4];
#pragma unroll
    for (int m = 0; m < 4; ++m)
#pragma unroll
        for (int f = 0; f < 4; ++f) acc[m][f] = (f32x4){0.f, 0.f, 0.f, 0.f};
#pragma nounroll
    for (int k0 = 0; k0 < nks; k0 += 4) {
        bf16x8 a[4][4], b[4][4];
#pragma unroll
        for (int q = 0; q < 4; ++q) {
            const int ks = (k0 + q < nks) ? k0 + q : nks - 1;
#pragma unroll
            for (int m = 0; m < 4; ++m) a[q][m] = *(const bf16x8*)(ap + (size_t)m * 16 * K + 32 * ks);
#pragma unroll
            for (int f = 0; f < 4; ++f) b[q][f] = *(const bf16x8*)(bp[f] + 32 * ks);
        }
#pragma unroll
        for (int q = 0; q < 4; ++q) {
            if (k0 + q < nks) {
#pragma unroll
                for (int m = 0; m < 4; ++m)
#pragma unroll
                    for (int f = 0; f < 4; ++f) acc[m][f] = __builtin_amdgcn_mfma_f32_16x16x32_bf16(b[q][f], a[q][m], acc[m][f], 0, 0, 0);
            }
        }
    }
    LAS f32x4* red = (LAS f32x4*)lds;
#pragma unroll
    for (int m = 0; m < 4; ++m)
#pragma unroll
        for (int f = 0; f < 4; ++f) red[(wave * 16 + m * 4 + f) * 64 + lane] = acc[m][f];
    LDS_WAIT(); __syncthreads();
    if (wave < 4) {
        f32x4 r[4];
#pragma unroll
        for (int f = 0; f < 4; ++f) { f32x4 sacc = red[(wave * 4 + f) * 64 + lane];
#pragma unroll
            for (int w = 1; w < 8; ++w) sacc += red[(w * 16 + wave * 4 + f) * 64 + lane];
            r[f] = sacc; }
        E(tn, 64 * rh + 16 * wave + fr, fq, r);
    }
    LDS_WAIT(); __syncthreads();
}
template <class Epi> __device__ __forceinline__ void tile(const bf16_t* A, int K, const bf16_t* Bt, const Epi& E, int task, int lane, int wave, LAS unsigned char* lds) {
#if PROBE_SK2
    { Epi Ed = E; Ed.dry = 1; tile1(A, K, Bt, Ed, task, lane, wave, lds); }
#endif
    tile1(A, K, Bt, E, task, lane, wave, lds);
}
__device__ __forceinline__ void st_bf4(bf16_t* p, const f32x4 v) { u32x2 w; w.x = cvt_pk_bf16(v[0], v[1]); w.y = cvt_pk_bf16(v[2], v[3]); *(u32x2*)p = w; }
template <int SSQI> struct EpiSwiGLU {
    unsigned char* ws; int dry;
    static __device__ __forceinline__ int brow(int tn, int f, int n) { const int gc = 32 * tn + 16 * (f & 1) + n; return 256 * (gc >> 7) + 128 * (f >> 1) + (gc & 127); }
    __device__ __forceinline__ void operator()(int tn, int srow, int fq, const f32x4 (&acc)[4]) const {
        const int row = MPROMPT + srow; const float rs = row_rs(TOT(ws, SSQI), row);
        bf16_t* O = (bf16_t*)(ws + WS_ACT) + (size_t)row * DFF + 32 * tn + 4 * fq;
#pragma unroll
        for (int f = 0; f < 2; ++f) { f32x4 o;
#pragma unroll
            for (int j = 0; j < 4; ++j) o[j] = siluf_(acc[f][j] * rs) * (acc[f + 2][j] * rs);
            st_bf4(O + 16 * f, o); }
    }
};
struct EpiPlain {
    unsigned char* ws; int dry;
    static __device__ __forceinline__ int brow(int tn, int f, int n) { return 64 * tn + 16 * f + n; }
    __device__ __forceinline__ void operator()(int tn, int srow, int fq, const f32x4 (&acc)[4]) const {
        bf16_t* O = (bf16_t*)(ws + WS_PROJ) + (size_t)(MPROMPT + srow) * DM + 64 * tn + 4 * fq;
#pragma unroll
        for (int f = 0; f < 4; ++f) st_bf4(O + 16 * f, acc[f]);
    }
};
template <int MODE, int SSQO, bool FROM_X> struct EpiResid {
    const float* xS; unsigned char* ws; float scale; int dry;
    static __device__ __forceinline__ int brow(int tn, int f, int n) { return 64 * tn + 16 * f + n; }
    __device__ __forceinline__ void operator()(int tn, int srow, int fq, const f32x4 (&acc)[4]) const {
        const int row = MPROMPT + srow;
        bf16_t* HBp = (bf16_t*)(ws + WS_HB) + (size_t)row * DM + 64 * tn + 4 * fq; bf16_t* Out = MODE == 0 ? HBp : (bf16_t*)(ws + WS_A2) + (size_t)row * DM + 64 * tn + 4 * fq;
        const float* xp = xS + (size_t)srow * DM + 64 * tn + 4 * fq;
        const bf16_t* pj = (const bf16_t*)(ws + WS_PROJ) + (size_t)row * DM + 64 * tn + 4 * fq;
        float rs = 1.f; if (MODE == 1) rs = row_rs(TOT(ws, SSQO - 1), row);
        float ss = 0.f;
#pragma unroll
        for (int f = 0; f < 4; ++f) { f32x4 bq;
            if (FROM_X) bq = *(const f32x4*)(xp + 16 * f);
            else { const u32x2 bw = *(const u32x2*)(HBp + 16 * f); bq = (f32x4){bflo(bw.x), bfhi(bw.x), bflo(bw.y), bfhi(bw.y)}; }
            f32x4 v;
            if (MODE == 0) v = bq + acc[f] * scale;
            else { const u32x2 pw = *(const u32x2*)(pj + 16 * f); const f32x4 a = acc[f] * rs;
                v[0] = bq[0] + sigmoidf_(a[0]) * bflo(pw.x); v[1] = bq[1] + sigmoidf_(a[1]) * bfhi(pw.x); v[2] = bq[2] + sigmoidf_(a[2]) * bflo(pw.y); v[3] = bq[3] + sigmoidf_(a[3]) * bfhi(pw.y); }
            if (!dry) st_bf4(Out + 16 * f, v);
            ss += (v[0] * v[0] + v[1] * v[1]) + (v[2] * v[2] + v[3] * v[3]); }
        ss += __shfl_xor(ss, 16); ss += __shfl_xor(ss, 32);
        if (fq == 0 && !dry) ssq_add(TOT(ws, SSQO), row, ss);
    }
};
struct EpiMix {
    unsigned char* ws; float* out; int dry;
    static __device__ __forceinline__ int brow(int tn, int f, int n) { return 64 * tn + 16 * f + n; }
    __device__ __forceinline__ void operator()(int tn, int srow, int fq, const f32x4 (&acc)[4]) const {
        const int row = MPROMPT + srow; const float rs = row_rs(TOT(ws, 1), row);
        f32x4 v[4];
#pragma unroll
        for (int f = 0; f < 4; ++f) v[f] = acc[f] * rs;
        if (tn < 16) {
            const float* rope = (const float*)(ws + WS_ROPE) + (size_t)(2048 + (srow & 3)) * 16 + 8 * (fq & 1);
            const f32x4 t0 = *(const f32x4*)rope, t1 = *(const f32x4*)(rope + 4);
            const float cs[4] = {t0[0], t0[2], t1[0], t1[2]}, sn[4] = {t0[1], t0[3], t1[1], t1[3]};
#pragma unroll
            for (int j = 0; j < 4; ++j) { const float x = v[0][j], w = __shfl_xor(x, 32); v[0][j] = (fq < 2) ? (x * cs[j] - w * sn[j]) : (x * cs[j] + w * sn[j]); }
        }
        if (tn < 24) {
            const int kind = tn >> 3, c0 = (tn & 7) * 64 + 4 * fq;
            bf16_t* dst = (bf16_t*)(ws + (kind == 0 ? WS_QA : (kind == 1 ? WS_KA : WS_VA))) + (size_t)row * 512 + c0;
            const float sc = kind == 0 ? C2Q : 1.f;
            float* fo = kind == 0 ? nullptr : out + (kind == 1 ? OFF_KWS : OFF_VWS) + ((size_t)(srow >> 2) * WINB + (WINB - DEC_T) + (srow & 3)) * 512 + c0;
#pragma unroll
            for (int f = 0; f < 4; ++f) { st_bf4(dst + 16 * f, v[f] * sc); if (fo) *(f32x4*)(fo + 16 * f) = v[f]; }
        } else if (tn < 48) {
            bf16_t* dst; float sc = 1.f;
            if (tn < 28) { dst = (bf16_t*)(ws + WS_QB) + (size_t)row * 256 + (tn - 24) * 64; sc = 0.125f; }
            else if (tn < 32) dst = (bf16_t*)(ws + WS_KB) + (size_t)row * 256 + (tn - 28) * 64;
            else if (tn < 40) dst = (bf16_t*)(ws + WS_VB) + (size_t)row * 512 + (tn - 32) * 64;
            else dst = (bf16_t*)(ws + WS_GB) + (size_t)row * 512 + (tn - 40) * 64;
            dst += 4 * fq;
#pragma unroll
            for (int f = 0; f < 4; ++f) st_bf4(dst + 16 * f, v[f] * sc);
        } else {
            *(f32x4*)((float*)(ws + WS_A1) + (size_t)row * 16 + 4 * fq) = v[0];
        }
    }
};
}

#define XB_TMO      128
#define XB_XCNT(j)  (256  + 64 * (j))
#define XB_XSUB(j)  (1280 + 64 * (j))
#define XB_XGEN(j)  (2304 + 64 * (j))
#define XB_TOP      3328
#define XB_TOPGEN   3392
#define XCD_BAR_WORDS 3456
#define XB_SPIN_CAP (1u << 18)
__device__ __forceinline__ unsigned xb_ld(unsigned* p)              { return __hip_atomic_load(p, __ATOMIC_RELAXED, __HIP_MEMORY_SCOPE_AGENT); }
__device__ __forceinline__ unsigned xb_add(unsigned* p, unsigned v) { return __hip_atomic_fetch_add(p, v, __ATOMIC_RELAXED, __HIP_MEMORY_SCOPE_AGENT); }
__device__ __forceinline__ unsigned xb_xcc_id() { return (unsigned)__builtin_amdgcn_s_getreg((3 << 11) | 20) & 0xFu; }
#define XB_SPIN(cond, bar) do { unsigned _sp = 0; while (cond) { __builtin_amdgcn_s_sleep(1); \
    if ((++_sp & 255u) == 0u) { if (xb_ld(&(bar)[XB_TMO])) break; if (_sp > XB_SPIN_CAP) { atomicAdd(&(bar)[XB_TMO], 1u); break; } } } } while (0)
struct XcdBarrier { unsigned* bar; unsigned x; volatile LAS unsigned* st; };
__device__ __forceinline__ XcdBarrier xcd_barrier_post(unsigned* bar, volatile LAS unsigned* st) {
    XcdBarrier b; b.bar = bar; b.x = xb_xcc_id(); b.st = st;
    if (threadIdx.x == 0) (void)xb_add(&bar[XB_XCNT(b.x)], 1u);
    return b;
}
__device__ __forceinline__ void xcd_barrier_complete(unsigned* bar, unsigned x, unsigned& nloc, unsigned& nx) {
    const unsigned G = gridDim.x * gridDim.y * gridDim.z;
    unsigned sum, cnt, mine, sp = 0u;
    for (;;) {
        sum = 0u; cnt = 0u; mine = 0u;
#pragma unroll
        for (unsigned j = 0; j < 16; ++j) { const unsigned c = xb_ld(&bar[XB_XCNT(j)]); sum += c; cnt += (c > 0u) ? 1u : 0u; mine = (j == x) ? c : mine; }
        if (sum == G) break;
        __builtin_amdgcn_s_sleep(1);
        if ((++sp & 255u) == 0u) { if (xb_ld(&bar[XB_TMO])) break; if (sp > XB_SPIN_CAP) { atomicAdd(&bar[XB_TMO], 1u); break; } }
    }
    nloc = mine > 0u ? mine : 1u; nx = cnt > 0u ? cnt : 1u;
}
__device__ __forceinline__ void xcd_barrier(const XcdBarrier& b) {
    asm volatile("s_waitcnt vmcnt(0)" ::: "memory");
    __syncthreads();
    if (threadIdx.x == 0) {
        unsigned* bar = b.bar;
        __builtin_amdgcn_s_waitcnt(0);
        unsigned nloc = b.st[0], nx = b.st[1];
        if (nloc == 0u) { xcd_barrier_complete(bar, b.x, nloc, nx); b.st[0] = nloc; b.st[1] = nx; }
        const unsigned old = xb_add(&bar[XB_XSUB(b.x)], 1u);
        const unsigned gen = old / nloc;
        if (old + 1u == (gen + 1u) * nloc) {
            __builtin_amdgcn_fence(__ATOMIC_RELEASE, "agent");
            asm volatile("s_waitcnt vmcnt(0)" ::: "memory");
            const unsigned og = xb_add(&bar[XB_TOP], 1u);
            const unsigned tg = og / nx;
            if (og + 1u == (tg + 1u) * nx) xb_add(&bar[XB_TOPGEN], 1u);
            else XB_SPIN(xb_ld(&bar[XB_TOPGEN]) == tg, bar);
            __builtin_amdgcn_fence(__ATOMIC_ACQUIRE, "agent");
            xb_add(&bar[XB_XGEN(b.x)], 1u);
            asm volatile("s_waitcnt vmcnt(0)" ::: "memory");
        } else {
            XB_SPIN(xb_ld(&bar[XB_XGEN(b.x)]) == gen, bar);
            __builtin_amdgcn_fence(__ATOMIC_ACQUIRE, "agent");
            asm volatile("s_waitcnt vmcnt(0)" ::: "memory");
        }
    }
    __syncthreads();
}

struct Args { const float* in[23]; float* out; unsigned char* ws; int ph_lo, ph_hi; };
struct Frame {
    LAS unsigned char* lds;
    int tid, lane, wave, vcu, G;
    const Args* a; float* out; unsigned char* ws;
};
#define FIN(i) (F.a->in[i])
#define WSP(T, off) ((T*)(F.ws + (off)))

__device__ __forceinline__ void tr_item(const float* W, int K, int Nsrc, const float* g, bf16_t* WT, int kind, LAS float* scr, int item, int nblk, int lane) {
    const int kb = item / nblk, nb = item % nblk, k0 = 64 * kb, n0 = 32 * nb;
    int src0 = n0, nval = 32;
    if (kind == 1) { const int pn = n0 >> 8, j = n0 & 255; src0 = (j < 128) ? 128 * pn + j : DFF + 128 * pn + (j - 128); }
    else if (kind == 2) { if (n0 < 2560) src0 = n0; else if (n0 < 3072) src0 = n0 + 16; else if (n0 == 3072) { src0 = 2560; nval = 16; } else { src0 = 0; nval = 0; } }
    const int r8 = lane >> 3, c4 = (lane & 7) * 4;
    f32x4 wv[8];
#pragma unroll
    for (int i = 0; i < 8; ++i) { const int kk = 8 * i + r8; wv[i] = (c4 < nval) ? *(const f32x4*)(W + (size_t)(k0 + kk) * Nsrc + src0 + c4) : (f32x4){0.f, 0.f, 0.f, 0.f}; }
    if (g) {
#pragma unroll
        for (int i = 0; i < 8; ++i) wv[i] = wv[i] * g[k0 + 8 * i + r8];
    }
#pragma unroll
    for (int i = 0; i < 8; ++i) { LAS float* d = scr + (8 * i + r8) * 33 + c4; d[0] = wv[i][0]; d[1] = wv[i][1]; d[2] = wv[i][2]; d[3] = wv[i][3]; }
    LDS_WAIT(); asm volatile("" ::: "memory");
    const int cc = lane & 7;
#pragma unroll
    for (int j = 0; j < 4; ++j) { const int n = (lane >> 3) + 8 * j; const LAS float* s = scr + (8 * cc) * 33 + n;
        u32x4 o; o.x = pk2(s[0 * 33], s[1 * 33]); o.y = pk2(s[2 * 33], s[3 * 33]); o.z = pk2(s[4 * 33], s[5 * 33]); o.w = pk2(s[6 * 33], s[7 * 33]);
        *(u32x4*)(WT + (size_t)(n0 + n) * K + k0 + 8 * cc) = o; }
    LDS_WAIT(); asm volatile("" ::: "memory");
}
__device__ __forceinline__ void sincos_red(double ang, float& c, float& s) {
    const double TWO_PI = 6.283185307179586476925, HALF_PI = 1.5707963267948966192;
    double r = ang - TWO_PI * __builtin_rint(ang / TWO_PI);
    const double q = __builtin_rint(r / HALF_PI); r -= q * HALF_PI;
    const int qi = ((int)q) & 3;
    const double y2 = r * r;
    const double sn = r * (1.0 + y2 * (-1.0 / 6 + y2 * (1.0 / 120 + y2 * (-1.0 / 5040 + y2 * (1.0 / 362880 - y2 * (1.0 / 39916800))))));
    const double cs = 1.0 + y2 * (-0.5 + y2 * (1.0 / 24 + y2 * (-1.0 / 720 + y2 * (1.0 / 40320 + y2 * (-1.0 / 3628800 + y2 * (1.0 / 479001600))))));
    double co, si;
    if (qi == 0) { co = cs; si = sn; } else if (qi == 1) { co = -sn; si = cs; } else if (qi == 2) { co = -cs; si = -sn; } else { co = sn; si = -cs; }
    c = (float)co; s = (float)si;
}
template <int SET> __device__ __forceinline__ void convert_weights(Frame& F, int gw, int NGW) {
    LAS float* scr = (LAS float*)(F.lds + F.wave * 16384);
    constexpr int I_GU = (DM / 64) * (NGU / 32), I_D = (DFF / 64) * (DM / 32), I_IN = (DM / 64) * (NPROJ / 32), I_1K = (DM / 64) * (DM / 32), I_PP = (DPLE / 64) * (DM / 32);
    if (SET == 0) {
        for (int it = gw; it < I_GU + I_PP; it += NGW) {
            if (it < I_GU) tr_item(FIN(8), DM, NGU, FIN(7), WSP(bf16_t, WS_WGU1), 1, scr, it, NGU / 32, F.lane);
            else tr_item(FIN(21), DPLE, DM, nullptr, WSP(bf16_t, WS_WPP), 0, scr, it - I_GU, DM / 32, F.lane);
        }
    } else if (SET == 1) {
        for (int it = gw; it < I_D + I_IN; it += NGW) {
            if (it < I_D) tr_item(FIN(9), DFF, DM, nullptr, WSP(bf16_t, WS_WD1), 0, scr, it, DM / 32, F.lane);
            else tr_item(FIN(11), DM, 3088, FIN(10), WSP(bf16_t, WS_WIN), 2, scr, it - I_D, NPROJ / 32, F.lane);
        }
    } else {
        for (int it = gw; it < I_GU + I_D + 2 * I_1K; it += NGW) {
            int r = it;
            if (r < I_GU) { tr_item(FIN(17), DM, NGU, FIN(16), WSP(bf16_t, WS_WGU2), 1, scr, r, NGU / 32, F.lane); continue; } r -= I_GU;
            if (r < I_D) { tr_item(FIN(18), DFF, DM, nullptr, WSP(bf16_t, WS_WD2), 0, scr, r, DM / 32, F.lane); continue; } r -= I_D;
            if (r < I_1K) { tr_item(FIN(15), DM, DM, nullptr, WSP(bf16_t, WS_WOUT), 0, scr, r, DM / 32, F.lane); continue; } r -= I_1K;
            tr_item(FIN(20), DM, DM, FIN(19), WSP(bf16_t, WS_WPG), 0, scr, r, DM / 32, F.lane);
        }
    }
}
__device__ __forceinline__ void p0_prologue(Frame& F) {
    const int gw = F.vcu * NWAVES + F.wave, NGW = F.G * NWAVES;
    convert_weights<0>(F, gw, NGW);
    bf16_t* HB = WSP(bf16_t, WS_HB); bf16_t* PB = WSP(bf16_t, WS_PB); unsigned* ssq0 = TOT(F.ws, 0);
    for (int e = F.vcu * 512 + F.tid; e < 4 * MPAD; e += F.G * 512) TOT(F.ws, 1 + e / MPAD)[e % MPAD] = 0u;
    for (int m0 = gw; m0 < MTOT; m0 += 4 * NGW) {
        f32x4 v[4][4], pv[4];
#pragma unroll
        for (int u = 0; u < 4; ++u) { const int m = m0 + u * NGW; const bool ok = m < MTOT;
            const float* xr = m < MPROMPT ? FIN(0) + (size_t)m * DM : FIN(1) + (size_t)(m - MPROMPT) * DM;
            const float* pr = m < MPROMPT ? FIN(5) + (size_t)m * DPLE : FIN(6) + (size_t)(m - MPROMPT) * DPLE;
#pragma unroll
            for (int j = 0; j < 4; ++j) v[u][j] = ok ? *((const f32x4*)xr + F.lane + 64 * j) : (f32x4){0.f, 0.f, 0.f, 0.f};
            pv[u] = ok ? *((const f32x4*)pr + F.lane) : (f32x4){0.f, 0.f, 0.f, 0.f}; }
#pragma unroll
        for (int u = 0; u < 4; ++u) { const int m = m0 + u * NGW; if (m >= MTOT) continue;
            float s = 0.f;
#pragma unroll
            for (int j = 0; j < 4; ++j) s += (v[u][j][0] * v[u][j][0] + v[u][j][1] * v[u][j][1]) + (v[u][j][2] * v[u][j][2] + v[u][j][3] * v[u][j][3]);
            s = wave_sum(s);
#pragma unroll
            for (int j = 0; j < 4; ++j) { u32x2 w; w.x = pk2(v[u][j][0], v[u][j][1]); w.y = pk2(v[u][j][2], v[u][j][3]); *((u32x2*)(HB + (size_t)m * DM) + F.lane + 64 * j) = w; }
            if (F.lane == 0) ssq0[m] = (unsigned)(s * SSQ_SCALE + 0.5f);
            u32x2 w; w.x = pk2(pv[u][0], pv[u][1]); w.y = pk2(pv[u][2], pv[u][3]); *((u32x2*)(PB + (size_t)m * DPLE) + F.lane) = w; }
    }
    float* rope = WSP(float, WS_ROPE);
    for (int e = F.vcu * 512 + F.tid; e < 2052 * 8; e += F.G * 512) {
        const int posidx = e >> 3, i = e & 7; const int pos = posidx < 2048 ? posidx : PAST + (posidx - 2048);
        const double inv = exp2(-(double)i * 0.125 * 18.931568569324174087);
        float c, s; sincos_red((double)pos * inv, c, s);
        rope[2 * e] = c; rope[2 * e + 1] = s;
    }
}


constexpr size_t CP_PER_B = (size_t)(WINB - DEC_T) * 512 / 4, CP_TOTAL = (size_t)DEC_B * CP_PER_B, CP_C1 = 0, CP_C3 = (CP_TOTAL * 6 / 10) & ~(size_t)511;
__device__ __forceinline__ void cache_copy_chunk(Frame& F, size_t e0, size_t e1, int rank, int nshare) {
    if (rank < 0) return;
    constexpr int U = 8;
    const size_t stride = (size_t)nshare * 512 * U;
    for (size_t eb = e0 + (size_t)rank * 512 * U + F.tid; eb < e1; eb += stride) {
        f32x4 kv[U], vv[U]; size_t dst[U];
#pragma unroll
        for (int u = 0; u < U; ++u) { const size_t e = eb + (size_t)u * 512; const size_t ec = e < e1 ? e : e1 - 1; const size_t b = ec / CP_PER_B, r = ec - b * CP_PER_B;
            const size_t src = b * ((size_t)WINB * 128) + DEC_T * 128 + r; dst[u] = b * ((size_t)WINB * 128) + r;
            kv[u] = __builtin_nontemporal_load((const f32x4*)FIN(2) + src); vv[u] = __builtin_nontemporal_load((const f32x4*)FIN(3) + src); }
#pragma unroll
        for (int u = 0; u < U; ++u) { __builtin_nontemporal_store(kv[u], (f32x4*)(F.out + OFF_KWS) + dst[u]); __builtin_nontemporal_store(vv[u], (f32x4*)(F.out + OFF_VWS) + dst[u]); }
    }
}

constexpr int AT_VW = 6144  , AT_VPITCH = 192, AT_STO = 8 * AT_VW, AT_SPITCH = 136, AT_SROWS = 528, AT_STM = AT_STO + AT_SROWS * AT_SPITCH, AT_STL = AT_STM + AT_SROWS * 4;
static_assert(AT_STL + AT_SROWS * 4 <= RING_BYTES, "attention LDS");
__device__ __forceinline__ int crow(int r, int hi) { return (r & 3) + 8 * (r >> 2) + 4 * hi; }
__device__ __forceinline__ float xhalf_max(float x) { const auto r = __builtin_amdgcn_permlane32_swap(__float_as_uint(x), __float_as_uint(x), false, false); return fmaxf(__uint_as_float(r[0]), __uint_as_float(r[1])); }
__device__ __forceinline__ float xhalf_sum(float x) { const auto r = __builtin_amdgcn_permlane32_swap(__float_as_uint(x), __float_as_uint(x), false, false); return __uint_as_float(r[0]) + __uint_as_float(r[1]); }
__device__ __forceinline__ s16x4 tr_read(LAS const unsigned char* p) { typedef short v4i16 __attribute__((ext_vector_type(4))); return __builtin_bit_cast(s16x4, __builtin_amdgcn_ds_read_tr16_b64_v4i16((LAS v4i16*)p)); }

template <int NQ> __device__ __forceinline__ void attn_task(Frame& F, int b, int h, int P0, int br, int dil, int r, int s0) {
    const int lane = F.lane, qi = lane & 31, hi = lane >> 5;
    const bf16_t* QA = WSP(bf16_t, WS_QA); const bf16_t* KA = WSP(bf16_t, WS_KA); const bf16_t* VA = WSP(bf16_t, WS_VA);
    LAS unsigned char* Vw = F.lds + F.wave * AT_VW;
    const size_t rowbase = (size_t)b * SEQ;
    const char* Qb = (const char*)(QA + rowbase * 512 + h * 64); const char* Kb = (const char*)(KA + rowbase * 512 + h * 64); const char* Vb = (const char*)(VA + rowbase * 512 + h * 64);
    bf16x8 qf[NQ][4]; f32x16 o0[NQ], o1[NQ]; float mrun[NQ], lrun[NQ];
#define POSQ(n) ((s0 + 32 * (n) + qi) * dil + r)
#define RHO(n) ((((POSQ(n) - P0) & 15) * 33) + ((POSQ(n) - P0) >> 4))
#pragma unroll
    for (int n = 0; n < NQ; ++n) {
        const unsigned qoff = (unsigned)POSQ(n) * 1024u + hi * 16u;
#pragma unroll
        for (int kk = 0; kk < 4; ++kk) qf[n][kk] = *(const bf16x8*)(Qb + qoff + 32 * kk);
        if (br == 0) {
#pragma unroll
            for (int i = 0; i < 16; ++i) { o0[n][i] = 0.f; o1[n][i] = 0.f; }
            mrun[n] = -1e30f; lrun[n] = 0.f;
        } else {
            const LAS unsigned char* sp = F.lds + AT_STO + RHO(n) * AT_SPITCH + 8 * hi;
#pragma unroll
            for (int g = 0; g < 4; ++g) {
                const u32x2 a = *(const LAS u32x2*)(sp + 16 * g), c = *(const LAS u32x2*)(sp + 64 + 16 * g);
                o0[n][4 * g] = bflo(a.x); o0[n][4 * g + 1] = bfhi(a.x); o0[n][4 * g + 2] = bflo(a.y); o0[n][4 * g + 3] = bfhi(a.y);
                o1[n][4 * g] = bflo(c.x); o1[n][4 * g + 1] = bfhi(c.x); o1[n][4 * g + 2] = bflo(c.y); o1[n][4 * g + 3] = bfhi(c.y);
            }
            mrun[n] = *(const LAS float*)(F.lds + AT_STM + RHO(n) * 4); lrun[n] = *(const LAS float*)(F.lds + AT_STL + RHO(n) * 4);
        }
    }
    const int kt0 = s0 >= 128 ? 0 : ((128 - s0) >> 5), ktend = 5 + (NQ - 1);
    const int q4 = (lane & 15) >> 2, p4 = lane & 3, blk = (lane >> 4) & 1;
    const LAS unsigned char* trb = Vw + (4 * hi + q4) * AT_VPITCH + (16 * blk + 4 * p4) * 2;
    bf16x8 kn[4]; u32x4 vr[4];
    {   const int sk0 = s0 - 128 + 32 * kt0;
        const unsigned koff = (unsigned)((sk0 + qi) * dil + r) * 1024u + hi * 16u;
#pragma unroll
        for (int kk = 0; kk < 4; ++kk) kn[kk] = *(const bf16x8*)(Kb + koff + 32 * kk);
#pragma unroll
        for (int c = 0; c < 4; ++c) { const int cid = lane + 64 * c, vrow = cid >> 3, ch = cid & 7;
            vr[c] = *(const u32x4*)(Vb + (unsigned)((sk0 + vrow) * dil + r) * 1024u + ch * 16u); } }
#define AT_STEP(KT, D0, D1) do { const int kt_ = (KT); \
        bf16x8 kf[4]; \
        _Pragma("unroll") for (int kk = 0; kk < 4; ++kk) kf[kk] = kn[kk]; \
        _Pragma("unroll") for (int c = 0; c < 4; ++c) { const int cid = lane + 64 * c, vrow = cid >> 3, ch = cid & 7; *(LAS u32x4*)(Vw + vrow * AT_VPITCH + ch * 16) = vr[c]; } \
        if (kt_ + 1 < ktend) { \
            const int sk1 = s0 - 128 + 32 * (kt_ + 1); \
            const unsigned koff = (unsigned)((sk1 + qi) * dil + r) * 1024u + hi * 16u; \
            _Pragma("unroll") for (int kk = 0; kk < 4; ++kk) kn[kk] = *(const bf16x8*)(Kb + koff + 32 * kk); \
            _Pragma("unroll") for (int c = 0; c < 4; ++c) { const int cid = lane + 64 * c, vrow = cid >> 3, ch = cid & 7; \
                vr[c] = *(const u32x4*)(Vb + (unsigned)((sk1 + vrow) * dil + r) * 1024u + ch * 16u); } \
        } \
        LDS_WAIT(); \
        bf16x8 va[2][2]; \
        _Pragma("unroll") for (int dt = 0; dt < 2; ++dt) { \
            const s16x4 lo0 = tr_read(trb + dt * 64), hi0 = tr_read(trb + dt * 64 + 8 * AT_VPITCH); \
            const s16x4 lo1 = tr_read(trb + dt * 64 + 16 * AT_VPITCH), hi1 = tr_read(trb + dt * 64 + 24 * AT_VPITCH); \
            va[dt][0] = __builtin_shufflevector(lo0, hi0, 0, 1, 2, 3, 4, 5, 6, 7); va[dt][1] = __builtin_shufflevector(lo1, hi1, 0, 1, 2, 3, 4, 5, 6, 7); } \
        f32x16 pp[NQ]; \
        _Pragma("unroll") for (int n = 0; n < NQ; ++n) _Pragma("unroll") for (int i = 0; i < 16; ++i) pp[n][i] = 0.f; \
        _Pragma("unroll") for (int kk = 0; kk < 4; ++kk) { \
            if (D0) pp[0] = __builtin_amdgcn_mfma_f32_32x32x16_bf16(kf[kk], qf[0][kk], pp[0], 0, 0, 0); \
            if (D1) pp[NQ - 1] = __builtin_amdgcn_mfma_f32_32x32x16_bf16(kf[kk], qf[NQ - 1][kk], pp[NQ - 1], 0, 0, 0); } \
        bf16x8 pb[NQ][2]; \
        _Pragma("unroll") for (int n = 0; n < NQ; ++n) { \
            if ((n == 0 && !(D0)) || (n == 1 && !(D1))) continue; \
            const int kr = kt_ - n; \
            if (kr == 0) { _Pragma("unroll") for (int i = 0; i < 16; ++i) if (crow(i, hi) < qi) pp[n][i] = -INFINITY; } \
            else if (kr == 4) { _Pragma("unroll") for (int i = 0; i < 16; ++i) if (crow(i, hi) > qi) pp[n][i] = -INFINITY; } } \
        _Pragma("unroll") for (int n = 0; n < NQ; ++n) { \
            if ((n == 0 && !(D0)) || (n == 1 && !(D1))) continue; \
            float mx = pp[n][0]; \
            _Pragma("unroll") for (int i = 1; i < 16; ++i) mx = fmaxf(mx, pp[n][i]); \
            mx = xhalf_max(mx); \
            if (__builtin_amdgcn_ballot_w64(mx > mrun[n] + 8.0f) != 0ull) {        \
                const float mn = fmaxf(mrun[n], mx), al = __builtin_amdgcn_exp2f(mrun[n] - mn); \
                lrun[n] *= al; mrun[n] = mn; \
                _Pragma("unroll") for (int i = 0; i < 16; ++i) { o0[n][i] *= al; o1[n][i] *= al; } \
            } \
            float rsum = 0.f; \
            _Pragma("unroll") for (int i = 0; i < 16; ++i) { pp[n][i] = __builtin_amdgcn_exp2f(pp[n][i] - mrun[n]); rsum += pp[n][i]; } \
            rsum = xhalf_sum(rsum); \
            lrun[n] += rsum; \
            u32x4 pw0, pw1; \
            pw0.x = cvt_pk_bf16(pp[n][0], pp[n][1]); pw0.y = cvt_pk_bf16(pp[n][2], pp[n][3]); pw0.z = cvt_pk_bf16(pp[n][4], pp[n][5]); pw0.w = cvt_pk_bf16(pp[n][6], pp[n][7]); \
            pw1.x = cvt_pk_bf16(pp[n][8], pp[n][9]); pw1.y = cvt_pk_bf16(pp[n][10], pp[n][11]); pw1.z = cvt_pk_bf16(pp[n][12], pp[n][13]); pw1.w = cvt_pk_bf16(pp[n][14], pp[n][15]); \
            pb[n][0] = __builtin_bit_cast(bf16x8, pw0); pb[n][1] = __builtin_bit_cast(bf16x8, pw1); } \
        _Pragma("unroll") for (int n = 0; n < NQ; ++n) { \
            if ((n == 0 && !(D0)) || (n == 1 && !(D1))) continue; \
            o0[n] = __builtin_amdgcn_mfma_f32_32x32x16_bf16(va[0][0], pb[n][0], o0[n], 0, 0, 0); o1[n] = __builtin_amdgcn_mfma_f32_32x32x16_bf16(va[1][0], pb[n][0], o1[n], 0, 0, 0); } \
        _Pragma("unroll") for (int n = 0; n < NQ; ++n) { \
            if ((n == 0 && !(D0)) || (n == 1 && !(D1))) continue; \
            o0[n] = __builtin_amdgcn_mfma_f32_32x32x16_bf16(va[0][1], pb[n][1], o0[n], 0, 0, 0); o1[n] = __builtin_amdgcn_mfma_f32_32x32x16_bf16(va[1][1], pb[n][1], o1[n], 0, 0, 0); } \
    } while (0)
    if (NQ == 1) {
#pragma nounroll
        for (int kt = kt0; kt < 5; ++kt) AT_STEP(kt, true, false);
    } else {
        int kt = kt0;
        if (kt == 0) { AT_STEP(0, true, false); kt = 1; }
#pragma nounroll
        for (; kt < 5; ++kt) AT_STEP(kt, true, true);
        AT_STEP(5, false, true);
    }
#undef AT_STEP
#pragma unroll
    for (int n = 0; n < NQ; ++n) {
        if (br < 2) {
            LAS unsigned char* sp = F.lds + AT_STO + RHO(n) * AT_SPITCH + 8 * hi;
#pragma unroll
            for (int g = 0; g < 4; ++g) {
                u32x2 a, c; a.x = cvt_pk_bf16(o0[n][4 * g], o0[n][4 * g + 1]); a.y = cvt_pk_bf16(o0[n][4 * g + 2], o0[n][4 * g + 3]); c.x = cvt_pk_bf16(o1[n][4 * g], o1[n][4 * g + 1]); c.y = cvt_pk_bf16(o1[n][4 * g + 2], o1[n][4 * g + 3]);
                *(LAS u32x2*)(sp + 16 * g) = a; *(LAS u32x2*)(sp + 64 + 16 * g) = c;
            }
            if (hi == 0) { *(LAS float*)(F.lds + AT_STM + RHO(n) * 4) = mrun[n]; *(LAS float*)(F.lds + AT_STL + RHO(n) * 4) = lrun[n]; }
        } else {
            const float inv = 1.f / lrun[n];
            bf16_t* op = WSP(bf16_t, WS_A2) + (rowbase + POSQ(n)) * DM + h * 64 + 4 * hi;
#pragma unroll
            for (int g = 0; g < 4; ++g) {
                u32x2 a, c; a.x = cvt_pk_bf16(o0[n][4 * g] * inv, o0[n][4 * g + 1] * inv); a.y = cvt_pk_bf16(o0[n][4 * g + 2] * inv, o0[n][4 * g + 3] * inv);
                c.x = cvt_pk_bf16(o1[n][4 * g] * inv, o1[n][4 * g + 1] * inv); c.y = cvt_pk_bf16(o1[n][4 * g + 2] * inv, o1[n][4 * g + 3] * inv);
                *(u32x2*)(op + 8 * g) = a; *(u32x2*)(op + 32 + 8 * g) = c;
            }
        }
    }
    LDS_WAIT();
#undef POSQ
#undef RHO
}
__device__ __forceinline__ void attn_prompt_item(Frame& F, int item) {
    const int b = item >> 5, h = (item >> 2) & 7, blk = item & 3, P0 = blk * 512;
    attn_task<2>(F, b, h, P0, 0, 1, 0, P0 + 64 * F.wave);
    LDS_WAIT(); __syncthreads();
    attn_task<2>(F, b, h, P0, 1, 4, F.wave & 3, P0 / 4 + 64 * (F.wave >> 2));
    LDS_WAIT(); __syncthreads();
    for (int u = 0; u < 2; ++u) attn_task<1>(F, b, h, P0, 2, 16, F.wave * 2 + u, P0 / 16);
    LDS_WAIT(); __syncthreads();
}

__device__ __forceinline__ void attn_sample_task(Frame& F, int task, int half) {
    const int h = task & 7, bt = task >> 3, b = bt >> 2, t = bt & 3, row = MPROMPT + bt;
    const int lane = F.lane, grp = lane >> 2, sub = lane & 3;
    const bf16_t* KA = WSP(bf16_t, WS_KA); const bf16_t* VA = WSP(bf16_t, WS_VA);
    float q[16];
    { const u32x4* qp = (const u32x4*)(WSP(bf16_t, WS_QA) + (size_t)row * 512 + h * 64 + 16 * sub); const u32x4 a = qp[0], c = qp[1];
      q[0] = bflo(a.x); q[1] = bfhi(a.x); q[2] = bflo(a.y); q[3] = bfhi(a.y); q[4] = bflo(a.z); q[5] = bfhi(a.z); q[6] = bflo(a.w); q[7] = bfhi(a.w);
      q[8] = bflo(c.x); q[9] = bfhi(c.x); q[10] = bflo(c.y); q[11] = bfhi(c.y); q[12] = bflo(c.z); q[13] = bfhi(c.z); q[14] = bflo(c.w); q[15] = bfhi(c.w); }
    float mrun = -1e30f, lrun = 0.f, acc[16];
#pragma unroll
    for (int e = 0; e < 16; ++e) acc[e] = 0.f;
    const int rd0 = half ? 5 : 0, rd1 = half ? 9 : 5;
#pragma nounroll
    for (int rd = rd0; rd < rd1; ++rd) {
        const int j = rd * 16 + grp; const bool valid = j <= 128;
        float kv[3][16], vv[3][16];
#pragma unroll
        for (int br = 0; br < 3; ++br) {
            const int dil = 1 << (2 * br);
            const int idx = WINB + t - (valid ? dil * j : 0);
            if (idx < WINB) {
                const f32x4* kp = (const f32x4*)(FIN(2) + (((size_t)b * WINB + idx) * 8 + h) * 64 + 16 * sub);
                const f32x4* vp = (const f32x4*)(FIN(3) + (((size_t)b * WINB + idx) * 8 + h) * 64 + 16 * sub);
#pragma unroll
                for (int c = 0; c < 4; ++c) { const f32x4 a = kp[c], d = vp[c];
#pragma unroll
                    for (int e = 0; e < 4; ++e) { kv[br][4 * c + e] = a[e]; vv[br][4 * c + e] = d[e]; } }
            } else {
                const size_t nrow = (size_t)MPROMPT + 4 * b + (idx - WINB);
                const u32x4* kp = (const u32x4*)(KA + nrow * 512 + h * 64 + 16 * sub); const u32x4* vp = (const u32x4*)(VA + nrow * 512 + h * 64 + 16 * sub);
#pragma unroll
                for (int c = 0; c < 2; ++c) { const u32x4 a = kp[c], d = vp[c];
                    kv[br][8 * c] = bflo(a.x); kv[br][8 * c + 1] = bfhi(a.x); kv[br][8 * c + 2] = bflo(a.y); kv[br][8 * c + 3] = bfhi(a.y); kv[br][8 * c + 4] = bflo(a.z); kv[br][8 * c + 5] = bfhi(a.z); kv[br][8 * c + 6] = bflo(a.w); kv[br][8 * c + 7] = bfhi(a.w);
                    vv[br][8 * c] = bflo(d.x); vv[br][8 * c + 1] = bfhi(d.x); vv[br][8 * c + 2] = bflo(d.y); vv[br][8 * c + 3] = bfhi(d.y); vv[br][8 * c + 4] = bflo(d.z); vv[br][8 * c + 5] = bfhi(d.z); vv[br][8 * c + 6] = bflo(d.w); vv[br][8 * c + 7] = bfhi(d.w); }
            }
        }
#pragma unroll
        for (int br = 0; br < 3; ++br) {
            float s = 0.f;
#pragma unroll
            for (int e = 0; e < 16; ++e) s += q[e] * kv[br][e];
            s += __shfl_xor(s, 1); s += __shfl_xor(s, 2);
            if (!valid) s = -INFINITY;
            const float mn = fmaxf(mrun, s), al = __builtin_amdgcn_exp2f(mrun - mn), p = __builtin_amdgcn_exp2f(s - mn);
            lrun = lrun * al + p; mrun = mn;
#pragma unroll
            for (int e = 0; e < 16; ++e) acc[e] = acc[e] * al + p * vv[br][e];
        }
    }
    float M = mrun;
#pragma unroll
    for (int o = 4; o < 64; o <<= 1) M = fmaxf(M, __shfl_xor(M, o));
    const float f = __builtin_amdgcn_exp2f(mrun - M);
    lrun *= f;
#pragma unroll
    for (int o = 4; o < 64; o <<= 1) lrun += __shfl_xor(lrun, o);
#pragma unroll
    for (int e = 0; e < 16; ++e) { float a = acc[e] * f;
#pragma unroll
        for (int o = 4; o < 64; o <<= 1) a += __shfl_xor(a, o);
        acc[e] = a; }
    LAS float* mrg = (LAS float*)(F.lds) + (F.wave & 3) * 80;
    if (half && grp == 0) {
#pragma unroll
        for (int e = 0; e < 16; ++e) mrg[sub * 16 + e] = acc[e];
        if (sub == 0) { mrg[64] = M; mrg[65] = lrun; }
    }
    LDS_WAIT(); __syncthreads();
    if (!half && grp == 0) {
        const float M2 = mrg[64], l2 = mrg[65], Mx = fmaxf(M, M2), f1 = __builtin_amdgcn_exp2f(M - Mx), f2 = __builtin_amdgcn_exp2f(M2 - Mx);
        const float inv = 1.f / (lrun * f1 + l2 * f2);
#pragma unroll
        for (int e = 0; e < 16; ++e) acc[e] = (acc[e] * f1 + mrg[sub * 16 + e] * f2) * inv;
        u32x4 w0, w1; w0.x = pk2(acc[0], acc[1]); w0.y = pk2(acc[2], acc[3]); w0.z = pk2(acc[4], acc[5]); w0.w = pk2(acc[6], acc[7]);
        w1.x = pk2(acc[8], acc[9]); w1.y = pk2(acc[10], acc[11]); w1.z = pk2(acc[12], acc[13]); w1.w = pk2(acc[14], acc[15]);
        u32x4* op = (u32x4*)(WSP(bf16_t, WS_A2) + (size_t)row * DM + h * 64 + 16 * sub); op[0] = w0; op[1] = w1;
    }
    LDS_WAIT(); __syncthreads();
}

constexpr int GL_A1 = 0  , GL_TOT = 4096  , GL_BT = GL_TOT + 2048  , GL_BC = GL_BT + 256  , GL_QA = GL_BC + 64 * 272  ,
              GL_KB = GL_QA + 64 * 144, GL_VR = GL_KB + 64 * 144  , GL_AM = GL_VR + 64 * 272  , GL_O = GL_AM + 64 * 144  , GL_END = GL_O + 64 * 132 * 4;
static_assert(GL_END <= RING_BYTES && GL_BC % 16 == 0 && GL_QA % 16 == 0 && GL_VR % 16 == 0 && GL_O % 16 == 0, "GLA LDS");
struct GlaIn { f32x4 a1; u32x4 kb, qb, vb0, vb1, gb0, gb1; bf16x8 sp[4]; };
template <bool P3> __device__ __forceinline__ void gla_fetch(Frame& F, GlaIn& I, int item, int hh, size_t row0) {
    const int tid = F.tid;
    I.a1 = (f32x4){0.f, 0.f, 0.f, 0.f};
    if (tid < 256) I.a1 = *(const f32x4*)(WSP(float, WS_A1) + (row0 + (tid >> 2)) * 16 + 4 * (tid & 3));
    I.kb = *(const u32x4*)(WSP(bf16_t, WS_KB) + (row0 + (tid >> 3)) * 256 + hh * 64 + 8 * (tid & 7));
    I.vb0 = *(const u32x4*)(WSP(bf16_t, WS_VB) + (row0 + (tid >> 4)) * 512 + hh * 128 + 8 * (tid & 15));
    I.vb1 = *(const u32x4*)(WSP(bf16_t, WS_VB) + (row0 + 32 + (tid >> 4)) * 512 + hh * 128 + 8 * (tid & 15));
    if (P3) {
        I.qb = *(const u32x4*)(WSP(bf16_t, WS_QB) + (row0 + (tid >> 3)) * 256 + hh * 64 + 8 * (tid & 7));
        const int i = tid >> 3, sub = tid & 7;
        const u32x4* gp = (const u32x4*)(WSP(bf16_t, WS_GB) + (row0 + i) * 512 + hh * 128 + 16 * sub); I.gb0 = gp[0]; I.gb1 = gp[1];
        const int lane = F.lane, vt = F.wave & 3, r32 = lane & 31, hi = lane >> 5;
        const bf16_t* sp = WSP(bf16_t, WS_SPT) + (size_t)item * 8192 + (size_t)(32 * vt + r32) * 64 + 8 * hi;
#pragma unroll
        for (int q = 0; q < 4; ++q) I.sp[q] = *(const bf16x8*)(sp + 16 * q);
    }
}
__device__ __forceinline__ void gla_decay(Frame& F, const f32x4 a1v, const float (&w2)[16], float bias, float& btot) {
    const int tid = F.tid, k = tid & 63, ig = tid >> 6;
    LAS float* a1s = (LAS float*)(F.lds + GL_A1); LAS float* tot = (LAS float*)(F.lds + GL_TOT); LAS float* BC = (LAS float*)(F.lds + GL_BC); LAS float* BT = (LAS float*)(F.lds + GL_BT);
    if (tid < 256) *(LAS f32x4*)(a1s + tid * 4) = a1v;
    LDS_WAIT(); __syncthreads();
    float run = 0.f, bcum[8];
#pragma unroll
    for (int e = 0; e < 8; ++e) { float pre = bias;
#pragma unroll
        for (int r = 0; r < 16; ++r) pre += a1s[(8 * ig + e) * 16 + r] * w2[r];
        run += logsigf_(pre) * (1.0f / 16.0f); bcum[e] = run; }
    tot[ig * 64 + k] = run;
    LDS_WAIT(); __syncthreads();
    float pre = 0.f, all = 0.f;
#pragma unroll
    for (int g = 0; g < 8; ++g) { const float tv = tot[g * 64 + k]; all += tv; if (g < ig) pre += tv; }
#pragma unroll
    for (int e = 0; e < 8; ++e) BC[(8 * ig + e) * 68 + k] = bcum[e] + pre;
    if (ig == 0) BT[k] = all;
    btot = all;
    LDS_WAIT(); __syncthreads();
}
__device__ __forceinline__ void unpack8(const u32x4 w, float (&x)[8]) { x[0] = bflo(w.x); x[1] = bfhi(w.x); x[2] = bflo(w.y); x[3] = bfhi(w.y); x[4] = bflo(w.z); x[5] = bfhi(w.z); x[6] = bflo(w.w); x[7] = bfhi(w.w); }
__device__ __forceinline__ u32x4 pack8(const float (&x)[8]) { u32x4 w; w.x = pk2(x[0], x[1]); w.y = pk2(x[2], x[3]); w.z = pk2(x[4], x[5]); w.w = pk2(x[6], x[7]); return w; }
__device__ __forceinline__ void gla_store_vr(Frame& F, const u32x4 vb0, const u32x4 vb1) {
    const int tid = F.tid;
    *(LAS u32x4*)(F.lds + GL_VR + (tid >> 4) * 272 + (tid & 15) * 16) = vb0;
    *(LAS u32x4*)(F.lds + GL_VR + (32 + (tid >> 4)) * 272 + (tid & 15) * 16) = vb1;
}
__device__ __forceinline__ bf16x8 tr_frag(LAS const unsigned char* img, int pitch, int col0, int s, int lane) {
    const int q4 = (lane & 15) >> 2, p4 = lane & 3, blk = (lane >> 4) & 1, hi = lane >> 5;
    LAS const unsigned char* p = img + (16 * s + 8 * hi + q4) * pitch + (col0 + 16 * blk + 4 * p4) * 2;
    const s16x4 lo = tr_read(p), hi4 = tr_read(p + 4 * pitch);
    return __builtin_shufflevector(lo, hi4, 0, 1, 2, 3, 4, 5, 6, 7);
}
template <int NIT> __device__ __forceinline__ void gla_p1_items(Frame& F, int item0) {
    const int bh = item0 >> 5, b = bh >> 2, hh = bh & 3;
    const int tid = F.tid, k = tid & 63, ig = tid >> 6, lane = F.lane;
    float w2[16];
#pragma unroll
    for (int r = 0; r < 16; ++r) w2[r] = FIN(12)[r * 256 + hh * 64 + k];
    const float bias = FIN(13)[hh * 64 + k];
    GlaIn nx; gla_fetch<false>(F, nx, item0, hh, (size_t)b * SEQ + 64 * (item0 & 31));
#pragma nounroll
    for (int it = 0; it < NIT; ++it) {
        const int item = item0 + it;
        const GlaIn cu = nx;
        if (it + 1 < NIT) gla_fetch<false>(F, nx, item + 1, hh, (size_t)b * SEQ + 64 * ((item + 1) & 31));
        float btot; gla_decay(F, cu.a1, w2, bias, btot);
        {
            const int i = tid >> 3, c = tid & 7;
            const f32x4 b0 = *(const LAS f32x4*)(F.lds + GL_BC + (i * 68 + 8 * c) * 4), b1 = *(const LAS f32x4*)(F.lds + GL_BC + (i * 68 + 8 * c + 4) * 4);
            const f32x4 t0 = *(const LAS f32x4*)(F.lds + GL_BT + 8 * c * 4), t1 = *(const LAS f32x4*)(F.lds + GL_BT + (8 * c + 4) * 4);
            float kx[8]; unpack8(cu.kb, kx);
#pragma unroll
            for (int e = 0; e < 4; ++e) { kx[e] *= fexp(t0[e] - b0[e]); kx[4 + e] *= fexp(t1[e] - b1[e]); }
            *(LAS u32x4*)(F.lds + GL_QA + i * 144 + c * 16) = pack8(kx);
        }
        gla_store_vr(F, cu.vb0, cu.vb1);
        if (ig == 0) WSP(float, WS_BTOT)[item * 64 + k] = btot;
        LDS_WAIT(); __syncthreads();
        const int kt = F.wave >> 2, vt = F.wave & 3, r32 = lane & 31, hi = lane >> 5;
        f32x16 acc;
#pragma unroll
        for (int i = 0; i < 16; ++i) acc[i] = 0.f;
#pragma unroll
        for (int q = 0; q < 4; ++q) {
            const bf16x8 a = tr_frag(F.lds + GL_QA, 144, 32 * kt, q, lane);
            const bf16x8 bb = tr_frag(F.lds + GL_VR, 272, 32 * vt, q, lane);
            acc = __builtin_amdgcn_mfma_f32_32x32x16_bf16(a, bb, acc, 0, 0, 0);
        }
        float* hct = WSP(float, WS_HCT) + (size_t)item * 8192 + (size_t)(32 * vt + r32) * 64 + 32 * kt + 4 * hi;
#pragma unroll
        for (int g = 0; g < 4; ++g) *(f32x4*)(hct + 8 * g) = (f32x4){acc[4 * g], acc[4 * g + 1], acc[4 * g + 2], acc[4 * g + 3]};
        LDS_WAIT(); __syncthreads();
    }
}
__device__ __forceinline__ void gla_scan(Frame& F) {
    const float* hct = WSP(float, WS_HCT); const float* bt = WSP(float, WS_BTOT); bf16_t* spt = WSP(bf16_t, WS_SPT);
    for (int e = F.vcu * 512 + F.tid; e < 32 * 2048; e += F.G * 512) {
        const int bh = e >> 11, vk4 = (e & 2047) * 4, k = vk4 & 63, v = vk4 >> 6;
        f32x4 S = (f32x4){0.f, 0.f, 0.f, 0.f};
#pragma nounroll
        for (int c0 = 0; c0 < 32; c0 += 8) {
            f32x4 hv[8], dv[8];
#pragma unroll
            for (int c = 0; c < 8; ++c) { hv[c] = *(const f32x4*)(hct + (size_t)(bh * 32 + c0 + c) * 8192 + vk4); dv[c] = *(const f32x4*)(bt + (bh * 32 + c0 + c) * 64 + k); }
#pragma unroll
            for (int c = 0; c < 8; ++c) {
                u32x2 w; w.x = pk2(S[0], S[1]); w.y = pk2(S[2], S[3]); *(u32x2*)(spt + (size_t)(bh * 32 + c0 + c) * 8192 + vk4) = w;
#pragma unroll
                for (int j = 0; j < 4; ++j) S[j] = fexp(dv[c][j]) * S[j] + hv[c][j];
            }
        }
#pragma unroll
        for (int j = 0; j < 4; ++j) F.out[OFF_SGP + ((size_t)bh * 64 + k + j) * 128 + v] = S[j];
    }
}
template <int NIT> __device__ __forceinline__ void gla_p3_items(Frame& F, int item0) {
    const int bh = item0 >> 5, b = bh >> 2, hh = bh & 3;
    const int tid = F.tid, k = tid & 63, lane = F.lane;
    float w2[16];
#pragma unroll
    for (int r = 0; r < 16; ++r) w2[r] = FIN(12)[r * 256 + hh * 64 + k];
    const float bias = FIN(13)[hh * 64 + k];
    GlaIn nx; gla_fetch<true>(F, nx, item0, hh, (size_t)b * SEQ + 64 * (item0 & 31));
#pragma nounroll
    for (int it = 0; it < NIT; ++it) {
        const int item = item0 + it, c = item & 31; const size_t row0 = (size_t)b * SEQ + 64 * c;
        const GlaIn cu = nx;
        if (it + 1 < NIT) gla_fetch<true>(F, nx, item + 1, hh, (size_t)b * SEQ + 64 * ((item + 1) & 31));
        float btot; gla_decay(F, cu.a1, w2, bias, btot);
        {
            const int i = tid >> 3, cc = tid & 7;
            const f32x4 b0 = *(const LAS f32x4*)(F.lds + GL_BC + (i * 68 + 8 * cc) * 4), b1 = *(const LAS f32x4*)(F.lds + GL_BC + (i * 68 + 8 * cc + 4) * 4);
            float qx[8], kx[8]; unpack8(cu.qb, qx); unpack8(cu.kb, kx);
#pragma unroll
            for (int e = 0; e < 4; ++e) { const float f0 = fexp(b0[e]), f1 = fexp(b1[e]); qx[e] *= f0; qx[4 + e] *= f1; kx[e] *= __builtin_amdgcn_rcpf(f0); kx[4 + e] *= __builtin_amdgcn_rcpf(f1); }
            *(LAS u32x4*)(F.lds + GL_QA + i * 144 + cc * 16) = pack8(qx);
            *(LAS u32x4*)(F.lds + GL_KB + i * 144 + cc * 16) = pack8(kx);
        }
        gla_store_vr(F, cu.vb0, cu.vb1);
        LDS_WAIT(); __syncthreads();
        const int r32 = lane & 31, hi = lane >> 5;
        if (F.wave < 4) {
            const int it2 = F.wave >> 1, jt = F.wave & 1;
            f32x16 acc;
#pragma unroll
            for (int i = 0; i < 16; ++i) acc[i] = 0.f;
            if (jt <= it2) {
#pragma unroll
                for (int q = 0; q < 4; ++q) {
                    const bf16x8 a = *(const LAS bf16x8*)(F.lds + GL_QA + (32 * it2 + r32) * 144 + (16 * q + 8 * hi) * 2);
                    const bf16x8 bb = *(const LAS bf16x8*)(F.lds + GL_KB + (32 * jt + r32) * 144 + (16 * q + 8 * hi) * 2);
                    acc = __builtin_amdgcn_mfma_f32_32x32x16_bf16(a, bb, acc, 0, 0, 0);
                }
            }
#pragma unroll
            for (int i = 0; i < 16; ++i) { const int ii = 32 * it2 + crow(i, hi), jj = 32 * jt + r32;
                *(LAS bf16_t*)(F.lds + GL_AM + ii * 144 + jj * 2) = (bf16_t)f2bf(jj <= ii ? acc[i] : 0.f); }
        }
        LDS_WAIT(); __syncthreads();
        {
            const int it2 = F.wave >> 2, vt = F.wave & 3;
            f32x16 acc;
#pragma unroll
            for (int i = 0; i < 16; ++i) acc[i] = 0.f;
            if (c > 0) {
#pragma unroll
                for (int q = 0; q < 4; ++q) {
                    const bf16x8 a = *(const LAS bf16x8*)(F.lds + GL_QA + (32 * it2 + r32) * 144 + (16 * q + 8 * hi) * 2);
                    acc = __builtin_amdgcn_mfma_f32_32x32x16_bf16(a, cu.sp[q], acc, 0, 0, 0);
                }
            }
#pragma unroll
            for (int q = 0; q < 4; ++q) {
                const bf16x8 a = *(const LAS bf16x8*)(F.lds + GL_AM + (32 * it2 + r32) * 144 + (16 * q + 8 * hi) * 2);
                const bf16x8 bb = tr_frag(F.lds + GL_VR, 272, 32 * vt, q, lane);
                acc = __builtin_amdgcn_mfma_f32_32x32x16_bf16(a, bb, acc, 0, 0, 0);
            }
#pragma unroll
            for (int i = 0; i < 16; ++i) *(LAS float*)(F.lds + GL_O + ((32 * it2 + crow(i, hi)) * 132 + 32 * vt + r32) * 4) = acc[i];
        }
        LDS_WAIT(); __syncthreads();
        {
            const int i = tid >> 3, sub = tid & 7; const size_t rr = row0 + i;
            float o[16]; float ss = 0.f;
#pragma unroll
            for (int q = 0; q < 4; ++q) { const f32x4 x = *(const LAS f32x4*)(F.lds + GL_O + (i * 132 + 16 * sub + 4 * q) * 4);
#pragma unroll
                for (int e = 0; e < 4; ++e) { o[4 * q + e] = x[e]; ss += x[e] * x[e]; } }
            ss += __shfl_xor(ss, 1); ss += __shfl_xor(ss, 2); ss += __shfl_xor(ss, 4);
            const float rn = rsqrtf(ss * (1.0f / 128.0f) + EPS);
            const unsigned gw[8] = {cu.gb0.x, cu.gb0.y, cu.gb0.z, cu.gb0.w, cu.gb1.x, cu.gb1.y, cu.gb1.z, cu.gb1.w};
            const float* go = FIN(14) + 16 * sub;
            unsigned w[8];
#pragma unroll
            for (int e = 0; e < 8; ++e) { const float a = o[2 * e] * rn * go[2 * e] * siluf_(bflo(gw[e])), bq = o[2 * e + 1] * rn * go[2 * e + 1] * siluf_(bfhi(gw[e])); w[e] = pk2(a, bq); }
            u32x4* op = (u32x4*)(WSP(bf16_t, WS_A2) + rr * DM + 512 + hh * 128 + 16 * sub);
            op[0] = (u32x4){w[0], w[1], w[2], w[3]}; op[1] = (u32x4){w[4], w[5], w[6], w[7]};
        }
        LDS_WAIT(); __syncthreads();
    }
}
__device__ __forceinline__ void gla_sample_item(Frame& F, int item) {
    const int b = item >> 2, hh = item & 3, tid = F.tid, v = tid & 127, kq = tid >> 7;
    LAS float* red = (LAS float*)(F.lds); LAS float* part = (LAS float*)(F.lds + 4096);
    LAS float* decs = (LAS float*)(F.lds + 8192); LAS float* qs = decs + 256; LAS float* ks = qs + 256;
    if (tid < 256) {
        const int t = tid >> 6, k = tid & 63; const size_t row = (size_t)MPROMPT + 4 * b + t;
        float pre = FIN(13)[hh * 64 + k];
#pragma unroll
        for (int r = 0; r < 16; ++r) pre += WSP(float, WS_A1)[row * 16 + r] * FIN(12)[r * 256 + hh * 64 + k];
        decs[tid] = fexp(logsigf_(pre) * (1.0f / 16.0f));
        qs[tid] = bf2f(WSP(bf16_t, WS_QB)[row * 256 + hh * 64 + k]);
        ks[tid] = bf2f(WSP(bf16_t, WS_KB)[row * 256 + hh * 64 + k]);
    }
    float S[16];
    const float* s0 = FIN(4) + ((size_t)item * 64 + 16 * kq) * 128 + v;
#pragma unroll
    for (int e = 0; e < 16; ++e) S[e] = s0[e * 128];
    float vv4[4], gg4[4];
#pragma unroll
    for (int t = 0; t < DEC_T; ++t) { const size_t row = (size_t)MPROMPT + 4 * b + t; vv4[t] = bf2f(WSP(bf16_t, WS_VB)[row * 512 + hh * 128 + v]); gg4[t] = bf2f(WSP(bf16_t, WS_GB)[row * 512 + hh * 128 + v]); }
    const float gout = FIN(14)[v];
    LDS_WAIT(); __syncthreads();
#pragma unroll
    for (int t = 0; t < DEC_T; ++t) {
        const size_t row = (size_t)MPROMPT + 4 * b + t;
        const float vv = vv4[t];
        float op = 0.f;
#pragma unroll
        for (int e = 0; e < 16; ++e) { const int k = t * 64 + 16 * kq + e;
            S[e] = decs[k] * S[e] + ks[k] * vv; op += qs[k] * S[e]; }
        red[kq * 128 + v] = op;
        LDS_WAIT(); __syncthreads();
        const float o = (red[v] + red[128 + v]) + (red[256 + v] + red[384 + v]);
        const float sq = wave_sum(o * o);
        if (F.lane == 0) part[F.wave] = sq;
        LDS_WAIT(); __syncthreads();
        const float rn = rsqrtf((part[0] + part[1]) * (1.0f / 128.0f) + EPS);
        if (tid < 128) WSP(bf16_t, WS_A2)[row * DM + 512 + hh * 128 + v] = (bf16_t)f2bf(o * rn * gout * siluf_(gg4[t]));
        LDS_WAIT(); __syncthreads();
    }
    float* so = F.out + OFF_SGS + ((size_t)item * 64 + 16 * kq) * 128 + v;
#pragma unroll
    for (int e = 0; e < 16; ++e) so[e * 128] = S[e];
    LDS_WAIT(); __syncthreads();
}

__device__ __forceinline__ void final_norm(Frame& F) {
    const int gw = F.vcu * NWAVES + F.wave, NGW = F.G * NWAVES;
    const bf16_t* H4 = WSP(bf16_t, WS_A2); const unsigned* tot4 = TOT(F.ws, 4);
    f32x4 g[4];
#pragma unroll
    for (int j = 0; j < 4; ++j) g[j] = *((const f32x4*)FIN(22) + F.lane + 64 * j);
    for (int m = MPROMPT + gw; m < MTOT; m += NGW) {
        const float rs = rs_from_tot(tot4[m]);
#pragma unroll
        for (int j = 0; j < 4; ++j) { const u32x2 w = *((const u32x2*)(H4 + (size_t)m * DM) + F.lane + 64 * j);
            const f32x4 x = (f32x4){bflo(w.x), bfhi(w.x), bflo(w.y), bfhi(w.y)};
            __builtin_nontemporal_store(x * rs * g[j], (f32x4*)(F.out + OFF_Y + (size_t)m * DM) + F.lane + 64 * j); }
    }
}

constexpr int NPHASES = 12;
constexpr int CW_BAR = 4096;
__global__ void __launch_bounds__(NWAVES * 64, 2) fwd_kernel(Args args) {
    extern __shared__ __attribute__((aligned(16))) unsigned char lds_raw[];
    Frame F;
    F.lds = (LAS unsigned char*)lds_raw;
    F.tid = threadIdx.x; F.lane = F.tid & 63; F.wave = __builtin_amdgcn_readfirstlane(F.tid >> 6);
    F.G = gridDim.x; { const int bx = blockIdx.x; F.vcu = (F.G % 8 == 0) ? (bx % 8) * (F.G / 8) + bx / 8 : bx; }
    F.a = &args; F.out = args.out; F.ws = args.ws;
    volatile LAS unsigned* MISC = (volatile LAS unsigned*)(F.lds + MISC_OFF);
    for (int u = F.tid; u < (LDS_BYTES - LDSCTL_OFF) / 4; u += NWAVES * 64) ((LAS unsigned*)(F.lds + LDSCTL_OFF))[u] = 0u;
    __syncthreads();
    const int lo = args.ph_lo, hi = args.ph_hi;
    XcdBarrier bar; bar.bar = (unsigned*)(F.ws + WS_CTL) + CW_BAR; bar.x = 0; bar.st = nullptr;
    if (hi - lo > 1) bar = xcd_barrier_post((unsigned*)(F.ws + WS_CTL) + CW_BAR, MISC + 8);
#ifndef REP_MASK
#define REP_MASK 0
#endif

#ifndef PH_MASK
#define PH_MASK 0xFFF
#endif
#define IN(k) ((((PH_MASK) >> (k)) & 1) && lo <= (k) && (k) < hi)
#define SEAM(k) do { if (IN(k) && IN((k) + 1)) xcd_barrier(bar); } while (0)
    LAS unsigned char* ring = F.lds;
    CopyCur cp = copy_cursor_init(args.in[2], args.in[3], args.out, (int)blockIdx.x);
#define DRY_K(k) ((int)((((REP_MASK) >> 12) & 1) && (((REP_MASK) >> (k)) & 1) && rep_ == 0))
#define PHASE_BEGIN() do { F.tid = launder_v(threadIdx.x); F.lane = F.tid & 63; F.wave = __builtin_amdgcn_readfirstlane(F.tid >> 6); } while (0)

    if (IN(0)) for (int rep_ = 0; rep_ <= (((REP_MASK) >> 0) & 1); ++rep_) { if (rep_) xcd_barrier(bar); PHASE_BEGIN(); p0_prologue(F); } SEAM(0);
    if (IN(1)) for (int rep_ = 0; rep_ <= (((REP_MASK) >> 1) & 1); ++rep_) { if (rep_) xcd_barrier(bar); PHASE_BEGIN();
#ifndef NO_G1
        { pg8::Gemm g{WSP(bf16_t, WS_HB), WSP(bf16_t, WS_WGU1), MPROMPT, NGU, DM}; pg8::StaticOrder S; S.init(MPROMPT, NGU, F.G, (int)blockIdx.x);
          pg8::EpiSwiGLU<0> E{F.ws, 0};
          pg8::gemm_phase<pg8::EpiSwiGLU<0>, pg8::StaticOrder, true>(ring, g, S, E, cp); }
#endif
#ifndef NO_G8
        if ((int)blockIdx.x >= 128 || F.G != 256) { pg8::Gemm g{WSP(bf16_t, WS_PB), WSP(bf16_t, WS_WPP), MPROMPT, DM, DPLE}; pg8::StaticOrder S; if (F.G == 256) S.init(MPROMPT, DM, 128, (int)blockIdx.x - 128); else S.init(MPROMPT, DM, F.G, (int)blockIdx.x);
          pg8::EpiPlainBf16 E{F.ws, 0};
          pg8::gemm_phase<pg8::EpiPlainBf16, pg8::StaticOrder, true>(ring, g, S, E, cp); }
#endif
        { const sk::EpiSwiGLU<0> E{F.ws, 0}; for (int t = F.G - 1 - (int)blockIdx.x; t < 2 * (DFF / 32); t += F.G) sk::tile(WSP(bf16_t, WS_HB) + (size_t)MPROMPT * DM, DM, WSP(bf16_t, WS_WGU1), E, t, F.lane, F.wave, ring); }
        { const sk::EpiPlain E{F.ws, 0}; for (int t = F.G - 1 - 2 * (DFF / 32) - (int)blockIdx.x; t < 2 * (DM / 64); t += F.G) if (t >= 0) sk::tile(WSP(bf16_t, WS_PB) + (size_t)MPROMPT * DPLE, DPLE, WSP(bf16_t, WS_WPP), E, t, F.lane, F.wave, ring); }
        if ((int)blockIdx.x >= 128) convert_weights<1>(F, ((int)blockIdx.x - 128) * NWAVES + F.wave, 128 * NWAVES);
    } SEAM(1);
    if (IN(2)) for (int rep_ = 0; rep_ <= (((REP_MASK) >> 2) & 1); ++rep_) { if (rep_) xcd_barrier(bar); PHASE_BEGIN();
        pg8::Gemm g{WSP(bf16_t, WS_ACT), WSP(bf16_t, WS_WD1), MPROMPT, DM, DFF}; pg8::StaticOrder S; S.init(MPROMPT, DM, F.G, (int)blockIdx.x);
        pg8::EpiResid<0, 1, false> E{nullptr, F.ws, 0.5f, DRY_K(2)};
        pg8::gemm_phase<pg8::EpiResid<0, 1, false>, pg8::StaticOrder, true>(ring, g, S, E, cp);
        { const sk::EpiResid<0, 1, false> E2{nullptr, F.ws, 0.5f, DRY_K(2)}; for (int t = F.G - 1 - (int)blockIdx.x; t < 2 * (DM / 64); t += F.G) sk::tile(WSP(bf16_t, WS_ACT) + (size_t)MPROMPT * DFF, DFF, WSP(bf16_t, WS_WD1), E2, t, F.lane, F.wave, ring); }
    } SEAM(2);
    if (IN(3)) for (int rep_ = 0; rep_ <= (((REP_MASK) >> 3) & 1); ++rep_) { if (rep_) xcd_barrier(bar); PHASE_BEGIN();
        { pg8::Gemm g{WSP(bf16_t, WS_HB), WSP(bf16_t, WS_WIN), MPROMPT, 3072, DM}; pg8::StaticOrder S; S.init(MPROMPT, 3072, F.G, (int)blockIdx.x);
          pg8::EpiMix E{F.ws, F.out, 0, 0};
          pg8::gemm_phase<pg8::EpiMix, pg8::StaticOrder, true>(ring, g, S, E, cp); }
        { pg8::Gemm g{WSP(bf16_t, WS_HB), WSP(bf16_t, WS_WIN) + (size_t)3072 * DM, MPROMPT, 256, DM}; pg8::StaticOrder S; S.init(MPROMPT, 256, F.G, (int)blockIdx.x);
          pg8::EpiMix E{F.ws, F.out, 0, 12};
          pg8::gemm_phase<pg8::EpiMix, pg8::StaticOrder, true, true>(ring, g, S, E, cp); }
        { const sk::EpiMix E2{F.ws, F.out, 0}; for (int t = F.G - 1 - (int)blockIdx.x; t < 98; t += F.G) sk::tile(WSP(bf16_t, WS_HB) + (size_t)MPROMPT * DM, DM, WSP(bf16_t, WS_WIN), E2, t, F.lane, F.wave, ring); }
        if ((int)blockIdx.x >= 64) convert_weights<2>(F, ((int)blockIdx.x - 64) * NWAVES + F.wave, 192 * NWAVES);
    } SEAM(3);
    if (IN(4)) for (int rep_ = 0; rep_ <= (((REP_MASK) >> 4) & 1); ++rep_) { if (rep_) xcd_barrier(bar); PHASE_BEGIN();
        for (int it = F.vcu; it < 256; it += F.G) attn_prompt_item(F, it);
        for (int it = F.vcu; it < 256; it += F.G) gla_p1_items<4>(F, 4 * it);
    } SEAM(4);
    if (IN(5)) for (int rep_ = 0; rep_ <= (((REP_MASK) >> 5) & 1); ++rep_) { if (rep_) xcd_barrier(bar); PHASE_BEGIN(); gla_scan(F);
        for (int it = F.vcu; it < 128; it += F.G) gla_sample_item(F, it);
        for (int it = F.vcu; it < 256; it += F.G) attn_sample_task(F, (F.wave & 3) * 256 + it, F.wave >> 2);
    } SEAM(5);
    if (IN(6)) for (int rep_ = 0; rep_ <= (((REP_MASK) >> 6) & 1); ++rep_) { if (rep_) xcd_barrier(bar); PHASE_BEGIN(); for (int it = F.vcu; it < 256; it += F.G) gla_p3_items<4>(F, 4 * it); } SEAM(6);
    if (IN(7)) for (int rep_ = 0; rep_ <= (((REP_MASK) >> 7) & 1); ++rep_) { if (rep_) xcd_barrier(bar); PHASE_BEGIN();
        pg8::Gemm g{WSP(bf16_t, WS_A2), WSP(bf16_t, WS_WOUT), MPROMPT, DM, DM}; pg8::StaticOrder S; S.init(MPROMPT, DM, F.G, (int)blockIdx.x);
        pg8::EpiResid<0, 2, false> E{nullptr, F.ws, 1.0f, DRY_K(7)};
        pg8::gemm_phase<pg8::EpiResid<0, 2, false>, pg8::StaticOrder, true>(ring, g, S, E, cp);
        { const sk::EpiResid<0, 2, false> E2{nullptr, F.ws, 1.0f, DRY_K(7)}; for (int t = F.G - 1 - (int)blockIdx.x; t < 2 * (DM / 64); t += F.G) sk::tile(WSP(bf16_t, WS_A2) + (size_t)MPROMPT * DM, DM, WSP(bf16_t, WS_WOUT), E2, t, F.lane, F.wave, ring); }
    } SEAM(7);
    if (IN(8)) for (int rep_ = 0; rep_ <= (((REP_MASK) >> 8) & 1); ++rep_) { if (rep_) xcd_barrier(bar); PHASE_BEGIN();
        pg8::Gemm g{WSP(bf16_t, WS_HB), WSP(bf16_t, WS_WGU2), MPROMPT, NGU, DM}; pg8::StaticOrder S; S.init(MPROMPT, NGU, F.G, (int)blockIdx.x);
        pg8::EpiSwiGLU<2> E{F.ws, 0};
        pg8::gemm_phase<pg8::EpiSwiGLU<2>, pg8::StaticOrder, true>(ring, g, S, E, cp);
        { const sk::EpiSwiGLU<2> E2{F.ws, 0}; for (int t = F.G - 1 - (int)blockIdx.x; t < 2 * (DFF / 32); t += F.G) sk::tile(WSP(bf16_t, WS_HB) + (size_t)MPROMPT * DM, DM, WSP(bf16_t, WS_WGU2), E2, t, F.lane, F.wave, ring); }
    } SEAM(8);
    if (IN(9)) for (int rep_ = 0; rep_ <= (((REP_MASK) >> 9) & 1); ++rep_) { if (rep_) xcd_barrier(bar); PHASE_BEGIN();
        pg8::Gemm g{WSP(bf16_t, WS_ACT), WSP(bf16_t, WS_WD2), MPROMPT, DM, DFF}; pg8::StaticOrder S; S.init(MPROMPT, DM, F.G, (int)blockIdx.x);
        pg8::EpiResid<0, 3, false> E{nullptr, F.ws, 0.5f, DRY_K(9)};
        pg8::gemm_phase<pg8::EpiResid<0, 3, false>, pg8::StaticOrder, true>(ring, g, S, E, cp);
        { const sk::EpiResid<0, 3, false> E2{nullptr, F.ws, 0.5f, DRY_K(9)}; for (int t = F.G - 1 - (int)blockIdx.x; t < 2 * (DM / 64); t += F.G) sk::tile(WSP(bf16_t, WS_ACT) + (size_t)MPROMPT * DFF, DFF, WSP(bf16_t, WS_WD2), E2, t, F.lane, F.wave, ring); }
    } SEAM(9);
    if (IN(10)) for (int rep_ = 0; rep_ <= (((REP_MASK) >> 10) & 1); ++rep_) { if (rep_) xcd_barrier(bar); PHASE_BEGIN();
        pg8::Gemm g{WSP(bf16_t, WS_HB), WSP(bf16_t, WS_WPG), MPROMPT, DM, DM}; pg8::StaticOrder S; S.init(MPROMPT, DM, F.G, (int)blockIdx.x);
        pg8::EpiPleNorm E{F.ws, F.out, FIN(22), 32u * (unsigned)(rep_ + 1), DRY_K(10)};
        pg8::gemm_phase<pg8::EpiPleNorm, pg8::StaticOrder, true>(ring, g, S, E, cp);
        { const sk::EpiResid<1, 4, false> E2{nullptr, F.ws, 1.0f, DRY_K(10)}; for (int t = F.G - 1 - (int)blockIdx.x; t < 2 * (DM / 64); t += F.G) sk::tile(WSP(bf16_t, WS_HB) + (size_t)MPROMPT * DM, DM, WSP(bf16_t, WS_WPG), E2, t, F.lane, F.wave, ring); }
    } SEAM(10);
    if (IN(11)) for (int rep_ = 0; rep_ <= (((REP_MASK) >> 11) & 1); ++rep_) { if (rep_) xcd_barrier(bar); PHASE_BEGIN(); final_norm(F); copy_cleanup(cp, F.tid); }
#undef IN
#undef SEAM
}

extern "C" void kernel_launch(void* const* d_in, const int* in_sizes, int n_in, void* d_out, int out_size, void* d_ws, size_t ws_size, hipStream_t stream) {
    static int grid = 0;
    if (grid == 0) {
        if (n_in != 23 || (size_t)out_size != OUT_TOTAL || ws_size < WS_END) { fprintf(stderr, "kernel_launch: unexpected shapes: n_in %d out %d ws %zu (need %zu)\n", n_in, out_size, ws_size, (size_t)WS_END); grid = -1; return; }
        int dev = 0, cus = 0;
        if (hipGetDevice(&dev) != hipSuccess || hipDeviceGetAttribute(&cus, hipDeviceAttributeMultiprocessorCount, dev) != hipSuccess) { grid = -1; return; }
        if (hipFuncSetAttribute((const void*)fwd_kernel, hipFuncAttributeMaxDynamicSharedMemorySize, LDS_BYTES) != hipSuccess) { fprintf(stderr, "kernel_launch: hipFuncSetAttribute failed\n"); grid = -1; return; }
        int per_cu = 0;
        if (hipOccupancyMaxActiveBlocksPerMultiprocessor(&per_cu, (const void*)fwd_kernel, NWAVES * 64, LDS_BYTES) != hipSuccess || per_cu < 1) { fprintf(stderr, "kernel_launch: occupancy query says %d blocks per CU\n", per_cu); }
        (void)hipGetLastError();
        grid = cus;
        if (grid != 256) { fprintf(stderr, "kernel_launch: built for a 256-CU device (got %d CUs); nothing launched\n", cus); grid = -1; return; }
    }
    if (grid < 0) return;
    static_assert((CW_BAR + XCD_BAR_WORDS) * 4 <= 65536 && (pg8::CW_PANEL + 64 * 64) * 4 <= 65536, "control words inside the memset");
    (void)hipMemsetAsync((char*)d_ws + WS_CTL, 0, 65536, stream);
    Args a{};
    for (int i = 0; i < 23; ++i) a.in[i] = (const float*)d_in[i];
    a.out = (float*)d_out; a.ws = (unsigned char*)d_ws;
#if MK_PER_PHASE
    for (int p = 0; p < NPHASES; ++p) { a.ph_lo = p; a.ph_hi = p + 1; hipLaunchKernelGGL(fwd_kernel, dim3(grid), dim3(NWAVES * 64), LDS_BYTES, stream, a); }
#else
    a.ph_lo = 0; a.ph_hi = NPHASES;
    hipLaunchKernelGGL(fwd_kernel, dim3(grid), dim3(NWAVES * 64), LDS_BYTES, stream, a);
#endif
}
```

```cpp
#include <hip/hip_runtime.h>
#include <cstdio>
#include <cstdint>

#ifndef PROBE_EPI2
#define PROBE_EPI2 0
#endif
#ifndef PROBE_SK2
#define PROBE_SK2 0
#endif
#ifndef MK_PER_PHASE
#define MK_PER_PHASE 0
#endif

#define LAS __attribute__((address_space(3)))
#define GAS __attribute__((address_space(1)))
typedef unsigned short bf16_t;
typedef short bf16x8 __attribute__((ext_vector_type(8)));
typedef short s16x4 __attribute__((ext_vector_type(4)));
typedef float f32x4 __attribute__((ext_vector_type(4)));
typedef float f32x2 __attribute__((ext_vector_type(2)));
typedef float f32x16 __attribute__((ext_vector_type(16)));
typedef unsigned u32x4 __attribute__((ext_vector_type(4)));
typedef unsigned u32x2 __attribute__((ext_vector_type(2)));

constexpr int DM = 1024, NBATCH = 8, SEQ = 2048, MPROMPT = NBATCH * SEQ, DEC_B = 32, DEC_T = 4, MSAMP = DEC_B * DEC_T;
constexpr int MTOT = MPROMPT + MSAMP  , MPAD = 16640  ;
constexpr int DFF = 2816, NGU = 2 * DFF, NPROJ = 3328  , DPLE = 256, PAST = 8192, WINB = 2048;
constexpr int HA = 8, HDA = 64, HB_ = 4, DKB = 64, DVB = 128;
constexpr float EPS = 1e-6f;
constexpr float C2Q = 0.125f * 1.4426950408889634f;
constexpr size_t OFF_Y = 0, OFF_KWP = (size_t)MTOT * DM, OFF_VWP = OFF_KWP + (size_t)MPROMPT * 512, OFF_SGP = OFF_VWP + (size_t)MPROMPT * 512,
                 OFF_KWS = OFF_SGP + (size_t)NBATCH * 4 * 64 * 128, OFF_VWS = OFF_KWS + (size_t)DEC_B * WINB * 512, OFF_SGS = OFF_VWS + (size_t)DEC_B * WINB * 512,
                 OUT_TOTAL = OFF_SGS + (size_t)DEC_B * 4 * 64 * 128;

constexpr size_t al256(size_t x) { return (x + 255) & ~(size_t)255; }
constexpr size_t WS_CTL = 0, CTL_BYTES = 1u << 20;
constexpr size_t WS_WGU1 = CTL_BYTES,                                   SZ_WGU = (size_t)NGU * DM * 2;
constexpr size_t WS_WGU2 = WS_WGU1 + SZ_WGU;
constexpr size_t WS_WD1 = WS_WGU2 + SZ_WGU,                             SZ_WD = (size_t)DM * DFF * 2;
constexpr size_t WS_WD2 = WS_WD1 + SZ_WD;
constexpr size_t WS_WIN = WS_WD2 + SZ_WD,                               SZ_WIN = (size_t)NPROJ * DM * 2;
constexpr size_t WS_WOUT = WS_WIN + SZ_WIN,                             SZ_W1K = (size_t)DM * DM * 2;
constexpr size_t WS_WPG = WS_WOUT + SZ_W1K;
constexpr size_t WS_WPP = WS_WPG + SZ_W1K,                              SZ_WPP = (size_t)DM * DPLE * 2;
constexpr size_t WS_HB = WS_WPP + SZ_WPP,                               SZ_HB = (size_t)MPAD * DM * 2;
constexpr size_t WS_ACT = WS_HB + SZ_HB,                                SZ_ACT = (size_t)MPAD * DFF * 2;
constexpr size_t WS_H32 = WS_ACT + SZ_ACT,                              SZ_H32 = (size_t)MPAD * DM * 4;
constexpr size_t WS_PROJ = WS_H32 + SZ_H32;
constexpr size_t WS_QA = WS_PROJ + SZ_HB,                               SZ_512 = (size_t)MPAD * 512 * 2, SZ_256 = (size_t)MPAD * 256 * 2;
constexpr size_t WS_KA = WS_QA + SZ_512, WS_VA = WS_KA + SZ_512, WS_QB = WS_VA + SZ_512, WS_KB = WS_QB + SZ_256, WS_VB = WS_KB + SZ_256, WS_GB = WS_VB + SZ_512;
constexpr size_t WS_A1 = WS_GB + SZ_512,                                SZ_A1 = (size_t)MPAD * 16 * 4;
constexpr size_t WS_A2 = WS_A1 + SZ_A1;
constexpr size_t WS_PB = WS_A2 + SZ_HB;
constexpr size_t WS_SSQ = WS_PB + SZ_256,                               SZ_SSQ = (size_t)MPAD * 16 * 4;
constexpr size_t WS_ROPE = WS_SSQ + 5 * SZ_SSQ,                         SZ_ROPE = al256((size_t)2052 * 16 * 4);
constexpr size_t WS_BTOT = WS_ROPE + SZ_ROPE,                           SZ_BTOT = (size_t)1024 * 64 * 4;
constexpr size_t WS_END = WS_BTOT + SZ_BTOT;
constexpr size_t WS_HCT = WS_ACT, SZ_HCT = (size_t)1024 * 8192 * 4;
constexpr size_t WS_SPT = WS_HCT + SZ_HCT, SZ_SPT = (size_t)1024 * 8192 * 2;
constexpr size_t WS_GAG = WS_SPT, WS_DSUM = WS_GAG + (size_t)256 * 8192 * 4;
static_assert(SZ_HCT + SZ_SPT <= SZ_ACT, "overlay fits");
static_assert(WS_END <= (size_t)500 * 1024 * 1024, "workspace budget");

constexpr int RING_BYTES = 131072, LDSCTL_OFF = RING_BYTES, MISC_OFF = LDSCTL_OFF + 320, LDS_BYTES = 147456;
constexpr int NWAVES = 8;

#define LDS_WAIT() asm volatile("s_waitcnt lgkmcnt(0)" ::: "memory")
#define VM_WAIT() asm volatile("s_waitcnt vmcnt(0)" ::: "memory")
__device__ __forceinline__ unsigned f2bf(float f) { unsigned u = __builtin_bit_cast(unsigned, f); return (u + 0x7fffu + ((u >> 16) & 1u)) >> 16; }
__device__ __forceinline__ unsigned pk2(float lo, float hi) { return f2bf(lo) | (f2bf(hi) << 16); }
typedef __bf16 bf16x2_t __attribute__((ext_vector_type(2)));
__device__ __forceinline__ unsigned cvt_pk_bf16(float lo, float hi) { const f32x2 v = {lo, hi}; return __builtin_bit_cast(unsigned, __builtin_convertvector(v, bf16x2_t)); }
__device__ __forceinline__ float bf2f(unsigned short b) { return __uint_as_float(((unsigned)b) << 16); }
__device__ __forceinline__ float bflo(unsigned w) { return __uint_as_float(w << 16); }
__device__ __forceinline__ float bfhi(unsigned w) { return __uint_as_float(w & 0xffff0000u); }
__device__ __forceinline__ float fexp(float x) { return __builtin_amdgcn_exp2f(x * 1.4426950408889634f); }
__device__ __forceinline__ float sigmoidf_(float x) { return __builtin_amdgcn_rcpf(1.f + fexp(-x)); }
__device__ __forceinline__ float siluf_(float x) { return x * sigmoidf_(x); }
__device__ __forceinline__ float logsigf_(float x) { return fminf(x, 0.f) - __logf(1.f + fexp(-fabsf(x))); }
__device__ __forceinline__ float wave_sum(float v) {
#pragma unroll
    for (int o = 1; o < 64; o <<= 1) v += __shfl_xor(v, o);
    return v;
}
__device__ __forceinline__ int launder_v(int x) { asm volatile("" : "+v"(x)); return x; }
template <class T> __device__ __forceinline__ T* launder_s(T* p) { asm volatile("" : "+s"(p)); return p; }
#define TOT(ws_, i) ((unsigned*)((ws_) + WS_SSQ + (size_t)(i) * SZ_SSQ))
constexpr float SSQ_SCALE = 16384.f, SSQ_INV = 1.0f / (16384.f * DM);
__device__ __forceinline__ float rs_from_tot(unsigned t) { return rsqrtf((float)t * SSQ_INV + EPS); }
__device__ __forceinline__ void ssq_add(unsigned* tot, int row, float ss) { __hip_atomic_fetch_add(tot + row, (unsigned)(ss * SSQ_SCALE + 0.5f), __ATOMIC_RELAXED, __HIP_MEMORY_SCOPE_AGENT); }
__device__ __forceinline__ float row_rs(const unsigned* tot, int row) { return rs_from_tot(tot[row]); }
__device__ __forceinline__ void row_tot8(const unsigned* tot, int row0, unsigned (&t)[2][4]) {
#pragma unroll
    for (int ai = 0; ai < 2; ++ai)
#pragma unroll
        for (int m = 0; m < 4; ++m) t[ai][m] = tot[row0 + ai * 128 + m * 16];
}

constexpr int CPQ_ELEMS = (WINB - DEC_T) * 128 / 4  , CP_STEPS = (CPQ_ELEMS + 511) / 512  ;
struct CopyCur { const f32x4* src; f32x4* dst; int it; };
__device__ __forceinline__ CopyCur copy_cursor_init(const float* ck, const float* cv, float* out, int w) {
    const int seg = w >> 2, q = w & 3, tensor = seg >> 5, b = seg & 31;
    CopyCur c; c.src = (const f32x4*)(tensor ? cv : ck) + (size_t)b * (WINB * 128) + DEC_T * 128 + (size_t)q * CPQ_ELEMS;
    c.dst = (f32x4*)(out + (tensor ? OFF_VWS : OFF_KWS)) + (size_t)b * (WINB * 128) + (size_t)q * CPQ_ELEMS; c.it = 0; return c;
}
__device__ __forceinline__ void copy_cleanup(CopyCur& c, int tid) {
    for (; c.it < CP_STEPS; ++c.it) { const int e = c.it * 512 + tid; if (e < CPQ_ELEMS) __builtin_nontemporal_store(__builtin_nontemporal_load(c.src + e), c.dst + e); }
}

namespace pg8 {
constexpr int BM = 256, BK = 64, HALF = 128, HTB = HALF * BK * 2, STAGE_BYTES = 8 * HTB, NXCD = 8, WGM = 8;
__host__ __device__ __forceinline__ int lds_byte(int r, int c) { const int st = (r >> 4) * 2 + (c >> 5), rr = r & 15, cc = c & 31, ob = rr * 64 + cc * 2; return st * 1024 + (ob ^ (((ob >> 9) & 1) << 5)); }
__host__ __device__ __forceinline__ void stage_rc(int b, int& R, int& C) { const int st = b / 1024, sb = b % 1024, swz = sb ^ (((sb >> 9) & 1) << 5); R = (st >> 1) * 16 + swz / 64; C = (st & 1) * 32 + (swz % 64) / 2; }
__host__ __device__ __forceinline__ int perm32(int rho) { const int n = rho >> 4, i = rho & 15; return 8 * (i >> 2) + 4 * n + (i & 3); }
struct Unit { int pm, pn; };
struct Gemm { const bf16_t* A; const bf16_t* Bt; int M, N, K; };
struct StaticOrder {
    int nM, nN, nwg, G, c;
    __host__ __device__ void init(int M, int N, int G_, int c_) { nM = M / BM; nN = N / BM; nwg = nM * nN; G = G_; c = c_; }
    __host__ __device__ bool next(int i, Unit& u) const {
        const long L = (long)i * G + c; if (L >= nwg) return false;
        int wgid = (int)L; { const int q = nwg / NXCD, r = nwg % NXCD, xcd = wgid % NXCD, off = wgid / NXCD; wgid = (xcd < r ? xcd * (q + 1) : r * (q + 1) + (xcd - r) * q) + off; }
        const int nig = WGM * nN, gid = wgid / nig, fm = gid * WGM, gsz = (nM - fm) < WGM ? (nM - fm) : WGM;
        u.pm = fm + ((wgid % nig) % gsz); u.pn = (wgid % nig) / gsz; return true;
    }
    __device__ __forceinline__ void a_ready(const Unit&) const {}
    __device__ __forceinline__ void done(const Unit&) const {}
};

template <class Epi, class Sched, bool ALIGN_EPI, bool LITE = false>
__device__ __forceinline__ void gemm_phase(LAS unsigned char* lds, const Gemm g, const Sched& S, const Epi& E, CopyCur& cp) {
    const int tid = launder_v(threadIdx.x), wid = __builtin_amdgcn_readfirstlane(tid >> 6), lane = tid & 63, wr = wid >> 2, wc = wid & 3, fr = lane & 15, fq = lane >> 4;
    const int K = g.K, nt = K / BK;
    unsigned voffA[2], voffB[2];
#pragma unroll
    for (int i = 0; i < 2; ++i) { int R, C; stage_rc(tid * 16 + i * 8192, R, C); const int Rb = Epi::PERM ? ((R & ~31) + perm32(R & 31)) : R;
        voffA[i] = (unsigned)(R * K + C) * 2u; voffB[i] = (unsigned)(Rb * K + C) * 2u; }
    const size_t kstep = (size_t)(BK * 2);
    const size_t hstep = (size_t)HALF * K * 2;
    const size_t tstep = 2 * hstep;
    const unsigned ldsw = (unsigned)wid * 1024u;
    const int aoff = lds_byte(wr * 64 + fr, fq * 8), boff = lds_byte(wc * 32 + fr, fq * 8);
#define PG8_SA(b, h) (((b) * 2 + (h)) * HTB)
#define PG8_SB(b, h) ((4 + (b) * 2 + (h)) * HTB)
#define PG8_STAGE(bufoff, gbase, voff) do { _Pragma("unroll") for (int _i = 0; _i < 2; ++_i) \
        __builtin_amdgcn_global_load_lds((const unsigned*)((const char*)(gbase) + (voff)[_i]), (LAS unsigned*)(lds + (bufoff) + ldsw + _i * 8192), 16, 0, 0); } while (0)
#define PG8_LDA(dst, b, h) do { _Pragma("unroll") for (int m = 0; m < 4; ++m) _Pragma("unroll") for (int k = 0; k < 2; ++k) dst[m][k] = *(const LAS bf16x8*)(lds + PG8_SA(b, h) + aoff + m * 2048 + k * 1024); } while (0)
#define PG8_LDB(dst, b, h) do { _Pragma("unroll") for (int n = 0; n < 2; ++n) _Pragma("unroll") for (int k = 0; k < 2; ++k) dst[n][k] = *(const LAS bf16x8*)(lds + PG8_SB(b, h) + boff + n * 2048 + k * 1024); } while (0)
#define PG8_MMA(ai, bj, At, Bt) do { if (LITE && ((bj) != 0 || wc != 0)) break; __builtin_amdgcn_s_setprio(1); _Pragma("unroll") for (int m = 0; m < 4; ++m) _Pragma("unroll") for (int n = 0; n < 2; ++n) _Pragma("unroll") for (int k = 0; k < 2; ++k) \
        acc[ai][bj][m][n] = __builtin_amdgcn_mfma_f32_16x16x32_bf16(Bt[n][k], At[m][k], acc[ai][bj][m][n], 0, 0, 0); __builtin_amdgcn_s_setprio(0); } while (0)
#define PG8_WAIT_V(n) asm volatile("s_waitcnt vmcnt(" #n ")" ::: "memory")
#define PG8_WAIT_VC() do { if (ncp == 0) PG8_WAIT_V(8); else if (ncp == 1) PG8_WAIT_V(9); else PG8_WAIT_V(10); } while (0)
#define PG8_WAIT_L(n) asm volatile("s_waitcnt lgkmcnt(" #n ")" ::: "memory")
#define PG8_BAR __builtin_amdgcn_s_barrier()
#define PG8_SCHED __builtin_amdgcn_sched_barrier(0)
    Unit cur, nxt; int ui = 0;
    if (!S.next(0, cur)) return;
    unsigned pre[2][4] = {{0u, 0u, 0u, 0u}, {0u, 0u, 0u, 0u}};
    if constexpr (Epi::PRE) E.prefetch(cur, wr, fr, pre);
    f32x4 acc[2][2][4][2];
#pragma unroll
    for (int a = 0; a < 2; ++a)
#pragma unroll
        for (int b = 0; b < 2; ++b)
#pragma unroll
            for (int m = 0; m < 4; ++m)
#pragma unroll
                for (int n = 0; n < 2; ++n) acc[a][b][m][n] = (f32x4){0.f, 0.f, 0.f, 0.f};
    bf16x8 At[4][2], B0[2][2], B1[2][2];
    f32x4 cp_data = (f32x4){0.f, 0.f, 0.f, 0.f}; int cp_e = 0; bool cp_pending = false;
    const char* cA = (const char*)g.A + (size_t)cur.pm * tstep; const char* cB = (const char*)g.Bt + (size_t)cur.pn * tstep;
    S.a_ready(cur);
    PG8_STAGE(PG8_SB(0, 0), cB, voffB); PG8_STAGE(PG8_SB(0, 1), cB + hstep, voffB); PG8_STAGE(PG8_SA(0, 0), cA, voffA); PG8_STAGE(PG8_SA(0, 1), cA + hstep, voffA);
    if (wr == 1) PG8_BAR;
    PG8_WAIT_V(2); PG8_BAR;
    PG8_STAGE(PG8_SB(1, 0), cB + kstep, voffB); PG8_STAGE(PG8_SA(1, 0), cA + kstep, voffA); PG8_STAGE(PG8_SB(1, 1), cB + hstep + kstep, voffB);
    PG8_WAIT_V(6); PG8_BAR;
    for (;;) {
        const bool has_next = S.next(ui + 1, nxt);
        const char* nA = has_next ? (const char*)g.A + (size_t)nxt.pm * tstep : cA; const char* nB = has_next ? (const char*)g.Bt + (size_t)nxt.pn * tstep : cB;
#pragma nounroll
        for (int t = 0; t < nt; t += 2) {
            const bool last = (t == nt - 2);
            const char* a1 = cA + (size_t)(t + 1) * kstep;
            const char* a2 = last ? nA : cA + (size_t)(t + 2) * kstep; const char* b2 = last ? nB : cB + (size_t)(t + 2) * kstep;
            const char* a3 = a2 + kstep; const char* b3 = b2 + kstep;
            if (last && has_next) S.a_ready(nxt);
            PG8_LDB(B0, 0, 0); PG8_LDB(B1, 0, 1); PG8_SCHED; PG8_LDA(At, 0, 0); PG8_STAGE(PG8_SA(1, 1), a1 + hstep, voffA);
            int ncp = 0;
            if (cp_pending) { asm volatile("global_store_dwordx4 %0, %1, off nt\n\ts_nop 1" :: "v"(cp.dst + cp_e), "v"(cp_data) : "memory"); ncp = 1; cp_pending = false; }
            if (cp.it < CP_STEPS && !last) {
                cp_e = cp.it * 512 + tid; ++cp.it;
                if (cp.it * 512 - 512 + wid * 64 < CPQ_ELEMS) { asm volatile("global_load_dwordx4 %0, %1, off nt" : "=v"(cp_data) : "v"(cp.src + cp_e) : "memory"); ++ncp; cp_pending = true; }
            }
            PG8_WAIT_VC(); PG8_WAIT_L(0); PG8_BAR; PG8_MMA(0, 0, At, B0); PG8_MMA(0, 1, At, B1); PG8_BAR; PG8_SCHED;
            PG8_LDA(At, 0, 1); PG8_STAGE(PG8_SB(0, 0), b2, voffB); PG8_STAGE(PG8_SB(0, 1), b2 + hstep, voffB); PG8_STAGE(PG8_SA(0, 0), a2, voffA);
            PG8_WAIT_VC(); PG8_WAIT_L(0); PG8_BAR; PG8_MMA(1, 0, At, B0); PG8_MMA(1, 1, At, B1); PG8_BAR; PG8_SCHED;
            PG8_LDB(B0, 1, 0); PG8_LDB(B1, 1, 1); PG8_SCHED; PG8_LDA(At, 1, 0); PG8_STAGE(PG8_SA(0, 1), a2 + hstep, voffA);
            PG8_WAIT_VC(); PG8_WAIT_L(0); PG8_BAR; PG8_MMA(0, 0, At, B0); PG8_MMA(0, 1, At, B1); PG8_BAR; PG8_SCHED;
            PG8_LDA(At, 1, 1); PG8_STAGE(PG8_SB(1, 0), b3, voffB); PG8_STAGE(PG8_SB(1, 1), b3 + hstep, voffB); PG8_STAGE(PG8_SA(1, 0), a3, voffA);
            PG8_WAIT_V(8); PG8_WAIT_L(0); PG8_BAR; PG8_MMA(1, 0, At, B0); PG8_MMA(1, 1, At, B1); PG8_BAR; PG8_SCHED;
        }
        if constexpr (ALIGN_EPI) { if (wr == 0) PG8_BAR; }
#if PROBE_EPI2
        if constexpr (Epi::PROBE2) { Epi Ed = E; Ed.dry = 1; Ed(acc, cur, wr, wc, fr, fq, pre); asm volatile("s_waitcnt vmcnt(0)" ::: "memory"); }
#endif
        E(acc, cur, wr, wc, fr, fq, pre); S.done(cur);
        if (!has_next) break;
        if constexpr (Epi::PRE) E.prefetch(nxt, wr, fr, pre);
#pragma unroll
        for (int a = 0; a < 2; ++a)
#pragma unroll
            for (int b = 0; b < 2; ++b)
#pragma unroll
                for (int m = 0; m < 4; ++m)
#pragma unroll
                    for (int n = 0; n < 2; ++n) acc[a][b][m][n] = (f32x4){0.f, 0.f, 0.f, 0.f};
        cur = nxt; cA = nA; cB = nB; ++ui;
        if constexpr (ALIGN_EPI) { if (wr == 1) PG8_BAR; }
    }
    PG8_WAIT_V(0);
    if constexpr (!ALIGN_EPI) { if (wr == 0) PG8_BAR; }
    PG8_BAR;
#undef PG8_SA
#undef PG8_SB
#undef PG8_STAGE
#undef PG8_LDA
#undef PG8_LDB
#undef PG8_MMA
#undef PG8_WAIT_V
#undef PG8_WAIT_VC
#undef PG8_WAIT_L
#undef PG8_BAR
#undef PG8_SCHED
}


template <int SSQI> struct EpiSwiGLU {
    static constexpr bool PERM = true, PROBE2 = true, PRE = true;
    unsigned char* ws; int dry;
    __device__ __forceinline__ void prefetch(const Unit& u, int wr, int fr, unsigned (&pre)[2][4]) const { row_tot8(TOT(ws, SSQI), u.pm * BM + wr * 64 + fr, pre); }
    __device__ __forceinline__ void operator()(const f32x4 (&acc)[2][2][4][2], const Unit& u, int wr, int wc, int fr, int fq, const unsigned (&pre)[2][4]) const {
        bf16_t* O = (bf16_t*)(ws + WS_ACT);
        const int row0 = u.pm * BM + wr * 64 + fr, col0 = u.pn * 128 + wc * 32 + 8 * fq;
#pragma unroll
        for (int ai = 0; ai < 2; ++ai)
#pragma unroll
            for (int m = 0; m < 4; ++m) {
                const int row = row0 + ai * HALF + m * 16; const float rs = rs_from_tot(pre[ai][m]);
                float o[8];
#pragma unroll
                for (int n = 0; n < 2; ++n)
#pragma unroll
                    for (int j = 0; j < 4; ++j) { const float gt = acc[ai][0][m][n][j] * rs, up = acc[ai][1][m][n][j] * rs; o[n * 4 + j] = siluf_(gt) * up; }
                u32x4 w; w.x = cvt_pk_bf16(o[0], o[1]); w.y = cvt_pk_bf16(o[2], o[3]); w.z = cvt_pk_bf16(o[4], o[5]); w.w = cvt_pk_bf16(o[6], o[7]);
                *(u32x4*)(O + (size_t)row * DFF + col0) = w;
            }
    }
};
struct EpiPlainBf16 {
    static constexpr bool PERM = true, PROBE2 = true, PRE = false;
    unsigned char* ws; int dry;
    __device__ __forceinline__ void operator()(const f32x4 (&acc)[2][2][4][2], const Unit& u, int wr, int wc, int fr, int fq, const unsigned (&)[2][4]) const {
        bf16_t* O = (bf16_t*)(ws + WS_PROJ); constexpr int ldc = DM;
        const int row0 = u.pm * BM + wr * 64 + fr, col0 = u.pn * BM + wc * 32 + 8 * fq;
#pragma unroll
        for (int ai = 0; ai < 2; ++ai)
#pragma unroll
            for (int m = 0; m < 4; ++m) { bf16_t* rowp = O + (size_t)(row0 + ai * HALF + m * 16) * ldc + col0;
#pragma unroll
                for (int bj = 0; bj < 2; ++bj) { const f32x4 v0 = acc[ai][bj][m][0], v1 = acc[ai][bj][m][1];
                    u32x4 w; w.x = cvt_pk_bf16(v0[0], v0[1]); w.y = cvt_pk_bf16(v0[2], v0[3]); w.z = cvt_pk_bf16(v1[0], v1[1]); w.w = cvt_pk_bf16(v1[2], v1[3]);
                    *(u32x4*)(rowp + bj * HALF) = w; } }
    }
};
template <int MODE  , int SSQO, bool FROM_X  > struct EpiResid {
    static constexpr bool PERM = true, PROBE2 = true, PRE = false;
    const float* xP; unsigned char* ws; float scale; int dry;
    __device__ __forceinline__ void operator()(const f32x4 (&acc)[2][2][4][2], const Unit& u, int wr, int wc, int fr, int fq, const unsigned (&)[2][4]) const {
        bf16_t* HBp = (bf16_t*)(ws + WS_HB); unsigned* ssq_out = TOT(ws, SSQO);
        const int col0 = u.pn * BM + wc * 32 + 8 * fq, row00 = u.pm * BM + wr * 64 + fr;
        u32x4 bn_[2];
#pragma unroll
        for (int bj = 0; bj < 2; ++bj) bn_[bj] = *(const u32x4*)(HBp + (size_t)row00 * DM + col0 + bj * HALF);
#pragma unroll
        for (int ai = 0; ai < 2; ++ai)
#pragma unroll
            for (int m = 0; m < 4; ++m) {
                const int row = row00 + ai * HALF + m * 16;
                u32x4 bc[2];
#pragma unroll
                for (int bj = 0; bj < 2; ++bj) bc[bj] = bn_[bj];
                if (ai * 4 + m < 7) { const int rown = row00 + ((ai * 4 + m + 1) >> 2) * HALF + ((ai * 4 + m + 1) & 3) * 16;
#pragma unroll
                    for (int bj = 0; bj < 2; ++bj) bn_[bj] = *(const u32x4*)(HBp + (size_t)rown * DM + col0 + bj * HALF); }
                float ss = 0.f;
#pragma unroll
                for (int bj = 0; bj < 2; ++bj) {
                    const u32x4 w0 = bc[bj];
                    const f32x4 v0 = (f32x4){bflo(w0.x), bfhi(w0.x), bflo(w0.y), bfhi(w0.y)} + acc[ai][bj][m][0] * scale;
                    const f32x4 v1 = (f32x4){bflo(w0.z), bfhi(w0.z), bflo(w0.w), bfhi(w0.w)} + acc[ai][bj][m][1] * scale;
                    if (!dry) { u32x4 w; w.x = cvt_pk_bf16(v0[0], v0[1]); w.y = cvt_pk_bf16(v0[2], v0[3]); w.z = cvt_pk_bf16(v1[0], v1[1]); w.w = cvt_pk_bf16(v1[2], v1[3]);
                        *(u32x4*)(HBp + (size_t)row * DM + col0 + bj * HALF) = w; }
                    ss += ((v0[0] * v0[0] + v0[1] * v0[1]) + (v0[2] * v0[2] + v0[3] * v0[3])) + ((v1[0] * v1[0] + v1[1] * v1[1]) + (v1[2] * v1[2] + v1[3] * v1[3])); }
                ss += __shfl_xor(ss, 16); ss += __shfl_xor(ss, 32);
                if (fq == 0 && !dry) ssq_add(ssq_out, row, ss);
            }
    }
};
constexpr int CW_PANEL = 8192;
struct EpiPleNorm {
    static constexpr bool PERM = true, PROBE2 = false, PRE = true;
    unsigned char* ws; float* out; const float* gfin; unsigned want; int dry;
    __device__ __forceinline__ void prefetch(const Unit& u, int wr, int fr, unsigned (&pre)[2][4]) const { row_tot8(TOT(ws, 3), u.pm * BM + wr * 64 + fr, pre); }
    __device__ __forceinline__ void operator()(f32x4 (&acc)[2][2][4][2], const Unit& u, int wr, int wc, int fr, int fq, const unsigned (&pre)[2][4]) const {
        const bf16_t* HBp = (const bf16_t*)(ws + WS_HB); const bf16_t* proj = (const bf16_t*)(ws + WS_PROJ);
        unsigned* ssq4 = TOT(ws, 4);
        const int col0 = u.pn * BM + wc * 32 + 8 * fq, row00 = u.pm * BM + wr * 64 + fr;
        u32x4 pn_[2], bn_[2];
#pragma unroll
        for (int bj = 0; bj < 2; ++bj) { pn_[bj] = *(const u32x4*)(proj + (size_t)row00 * DM + col0 + bj * HALF); bn_[bj] = *(const u32x4*)(HBp + (size_t)row00 * DM + col0 + bj * HALF); }
#pragma unroll
        for (int ai = 0; ai < 2; ++ai)
#pragma unroll
            for (int m = 0; m < 4; ++m) {
                const int row = row00 + ai * HALF + m * 16;
                const float rs = rs_from_tot(pre[ai][m]);
                u32x4 pc[2], bc[2];
#pragma unroll
                for (int bj = 0; bj < 2; ++bj) { pc[bj] = pn_[bj]; bc[bj] = bn_[bj]; }
                if (ai * 4 + m < 7) { const int rown = row00 + ((ai * 4 + m + 1) >> 2) * HALF + ((ai * 4 + m + 1) & 3) * 16;
#pragma unroll
                    for (int bj = 0; bj < 2; ++bj) { pn_[bj] = *(const u32x4*)(proj + (size_t)rown * DM + col0 + bj * HALF); bn_[bj] = *(const u32x4*)(HBp + (size_t)rown * DM + col0 + bj * HALF); } }
                float ss = 0.f;
#pragma unroll
                for (int bj = 0; bj < 2; ++bj) {
                    const u32x4 b0 = bc[bj], p0 = pc[bj];
                    const f32x4 a0 = acc[ai][bj][m][0] * rs, a1 = acc[ai][bj][m][1] * rs; f32x4 v0, v1;
                    v0[0] = bflo(b0.x) + sigmoidf_(a0[0]) * bflo(p0.x); v0[1] = bfhi(b0.x) + sigmoidf_(a0[1]) * bfhi(p0.x); v0[2] = bflo(b0.y) + sigmoidf_(a0[2]) * bflo(p0.y); v0[3] = bfhi(b0.y) + sigmoidf_(a0[3]) * bfhi(p0.y);
                    v1[0] = bflo(b0.z) + sigmoidf_(a1[0]) * bflo(p0.z); v1[1] = bfhi(b0.z) + sigmoidf_(a1[1]) * bfhi(p0.z); v1[2] = bflo(b0.w) + sigmoidf_(a1[2]) * bflo(p0.w); v1[3] = bfhi(b0.w) + sigmoidf_(a1[3]) * bfhi(p0.w);
                    acc[ai][bj][m][0] = v0; acc[ai][bj][m][1] = v1;
                    ss += ((v0[0] * v0[0] + v0[1] * v0[1]) + (v0[2] * v0[2] + v0[3] * v0[3])) + ((v1[0] * v1[0] + v1[1] * v1[1]) + (v1[2] * v1[2] + v1[3] * v1[3])); }
                ss += __shfl_xor(ss, 16); ss += __shfl_xor(ss, 32);
                if (fq == 0 && !dry) ssq_add(ssq4, row, ss);
            }
        asm volatile("s_waitcnt vmcnt(0)" ::: "memory");
        unsigned* cnt = (unsigned*)(ws + WS_CTL) + CW_PANEL + 64 * u.pm;
        if (fr == 0 && fq == 0) __hip_atomic_fetch_add(cnt, 1u, __ATOMIC_RELAXED, __HIP_MEMORY_SCOPE_AGENT);
        if (wr == 0 && wc == 0) {
            unsigned sp = 0;
            while ((unsigned)__builtin_amdgcn_readfirstlane(__hip_atomic_load(cnt, __ATOMIC_RELAXED, __HIP_MEMORY_SCOPE_AGENT)) < want) { __builtin_amdgcn_s_sleep(2); if (++sp > (1u << 20)) break; }
        }
        asm volatile("s_waitcnt vmcnt(0) lgkmcnt(0)" ::: "memory"); __builtin_amdgcn_s_barrier(); asm volatile("" ::: "memory");
        f32x4 g[2][2];
#pragma unroll
        for (int bj = 0; bj < 2; ++bj)
#pragma unroll
            for (int n = 0; n < 2; ++n) g[bj][n] = *(const f32x4*)(gfin + col0 + bj * HALF + n * 4);
#pragma unroll
        for (int ai = 0; ai < 2; ++ai)
#pragma unroll
            for (int m = 0; m < 4; ++m) {
                const int row = row00 + ai * HALF + m * 16;
                const float rs4 = rs_from_tot(__hip_atomic_load(ssq4 + row, __ATOMIC_RELAXED, __HIP_MEMORY_SCOPE_AGENT));
                if (!dry) {
#pragma unroll
                    for (int bj = 0; bj < 2; ++bj)
#pragma unroll
                        for (int n = 0; n < 2; ++n) __builtin_nontemporal_store(acc[ai][bj][m][n] * rs4 * g[bj][n], (f32x4*)(out + OFF_Y + (size_t)row * DM + col0 + bj * HALF + n * 4));
                }
            }
    }
};
struct EpiMix {
    static constexpr bool PERM = true, PROBE2 = true, PRE = true;
    unsigned char* ws; float* out; int dry; int pn_base;
    __device__ __forceinline__ void prefetch(const Unit& u, int wr, int fr, unsigned (&pre)[2][4]) const { row_tot8(TOT(ws, 1), u.pm * BM + wr * 64 + fr, pre); }
    __device__ __forceinline__ void operator()(const f32x4 (&acc)[2][2][4][2], const Unit& u, int wr, int wc, int fr, int fq, const unsigned (&pre)[2][4]) const {
        const float* rope = (const float*)(ws + WS_ROPE);
        bf16_t *QA = (bf16_t*)(ws + WS_QA), *KA = (bf16_t*)(ws + WS_KA), *VA = (bf16_t*)(ws + WS_VA), *QB = (bf16_t*)(ws + WS_QB), *KB = (bf16_t*)(ws + WS_KB), *VB = (bf16_t*)(ws + WS_VB), *GB = (bf16_t*)(ws + WS_GB);
        float* A1 = (float*)(ws + WS_A1);
        const int pn = u.pn + pn_base;
        if (pn == 12 && wc != 0) return;
        const bool do_rope = (pn < 4) && ((wc & 1) == 0);
        const int row00 = u.pm * BM + wr * 64 + fr, cb = wc * 32 + 8 * fq;
        f32x4 tn[4];
#pragma unroll
        for (int k = 0; k < 4; ++k) tn[k] = (f32x4){0.f, 0.f, 0.f, 0.f};
        if (do_rope) { const int posidx = row00 & (SEQ - 1);
#pragma unroll
            for (int k = 0; k < 4; ++k) tn[k] = *(const f32x4*)(rope + (size_t)posidx * 16 + 4 * k); }
#pragma unroll
        for (int ai = 0; ai < 2; ++ai)
#pragma unroll
            for (int m = 0; m < 4; ++m) {
                const int row = row00 + ai * HALF + m * 16;
                const float rs = rs_from_tot(pre[ai][m]);
                f32x4 v[2][2];
#pragma unroll
                for (int bj = 0; bj < 2; ++bj)
#pragma unroll
                    for (int n = 0; n < 2; ++n) v[bj][n] = acc[ai][bj][m][n] * rs;
                if (do_rope) {
                    f32x4 t[4];
#pragma unroll
                    for (int k = 0; k < 4; ++k) t[k] = tn[k];
                    if (ai * 4 + m < 7) { const int rown = row00 + ((ai * 4 + m + 1) >> 2) * HALF + ((ai * 4 + m + 1) & 3) * 16; const int posn = rown & (SEQ - 1);
#pragma unroll
                        for (int k = 0; k < 4; ++k) tn[k] = *(const f32x4*)(rope + (size_t)posn * 16 + 4 * k); }
#pragma unroll
                    for (int bj = 0; bj < 2; ++bj)
#pragma unroll
                        for (int n = 0; n < 2; ++n)
#pragma unroll
                            for (int j = 0; j < 4; ++j) { const float cs = t[2 * n + (j >> 1)][2 * (j & 1)], sn = t[2 * n + (j >> 1)][2 * (j & 1) + 1];
                                const float x = v[bj][n][j], w = __shfl_xor(x, 16);
                                if (fq < 2) v[bj][n][j] = (fq == 0) ? (x * cs - w * sn) : (x * cs + w * sn); }
                }
                if (pn < 6) {
                    const int kind = pn >> 1, c0 = (pn & 1) * 256 + cb;
                    bf16_t* dst = (kind == 0 ? QA : (kind == 1 ? KA : VA)) + (size_t)row * 512 + c0;
                    const float sc = kind == 0 ? C2Q : 1.f;
                    float* fo = kind == 0 ? nullptr : out + (kind == 1 ? OFF_KWP : OFF_VWP) + (size_t)row * 512 + c0;
#pragma unroll
                    for (int bj = 0; bj < 2; ++bj) { const f32x4 x0 = v[bj][0], x1 = v[bj][1];
                        u32x4 w; w.x = cvt_pk_bf16(x0[0] * sc, x0[1] * sc); w.y = cvt_pk_bf16(x0[2] * sc, x0[3] * sc); w.z = cvt_pk_bf16(x1[0] * sc, x1[1] * sc); w.w = cvt_pk_bf16(x1[2] * sc, x1[3] * sc);
                        *(u32x4*)(dst + bj * HALF) = w;
                        if (fo) { __builtin_nontemporal_store(x0, (f32x4*)(fo + bj * HALF)); __builtin_nontemporal_store(x1, (f32x4*)(fo + bj * HALF + 4)); } }
                } else if (pn < 12) {
                    bf16_t* dst; float sc = 1.f;
                    if (pn == 6) { dst = QB + (size_t)row * 256; sc = 0.125f; }
                    else if (pn == 7) dst = KB + (size_t)row * 256;
                    else if (pn < 10) dst = VB + (size_t)row * 512 + (pn - 8) * 256;
                    else dst = GB + (size_t)row * 512 + (pn - 10) * 256;
                    dst += cb;
#pragma unroll
                    for (int bj = 0; bj < 2; ++bj) { const f32x4 x0 = v[bj][0] * sc, x1 = v[bj][1] * sc;
                        u32x4 w; w.x = cvt_pk_bf16(x0[0], x0[1]); w.y = cvt_pk_bf16(x0[2], x0[3]); w.z = cvt_pk_bf16(x1[0], x1[1]); w.w = cvt_pk_bf16(x1[2], x1[3]);
                        *(u32x4*)(dst + bj * HALF) = w; }
                } else if (fq < 2) {
                    *(f32x4*)(A1 + (size_t)row * 16 + 8 * fq) = v[0][0]; *(f32x4*)(A1 + (size_t)row * 16 + 8 * fq + 4) = v[0][1];
                }
            }
    }
};
}


namespace sk {
template <class Epi> __device__ __forceinline__ void tile1(const bf16_t* A, int K, const bf16_t* Bt, const Epi& E, int task, int lane, int wave, LAS unsigned char* lds) {
    const int tn = task >> 1, rh = task & 1, fr = lane & 15, fq = lane >> 4;
    const int kw = K >> 3, nks = kw >> 5;
    const bf16_t* ap = A + (size_t)(64 * rh + fr) * K + wave * kw + 8 * fq;
    const bf16_t* bp[4];
#pragma unroll
    for (int f = 0; f < 4; ++f) bp[f] = Bt + (size_t)Epi::brow(tn, f, fr) * K + wave * kw + 8 * fq;
    f32x4 acc[4][4];
#pragma unroll
    for (int m = 0; m < 4; ++m)
#pragma unroll
        for (int f = 0; f < 4; ++f) acc[m][f] = (f32x4){0.f, 0.f, 0.f, 0.f};
#pragma nounroll
    for (int k0 = 0; k0 < nks; k0 += 4) {
        bf16x8 a[4][4], b[4][4];
#pragma unroll
        for (int q = 0; q < 4; ++q) {
            const int ks = (k0 + q < nks) ? k0 + q : nks - 1;
#pragma unroll
            for (int m = 0; m < 4; ++m) a[q][m] = *(const bf16x8*)(ap + (size_t)m * 16 * K + 32 * ks);
#pragma unroll
            for (int f = 0; f < 4; ++f) b[q][f] = *(const bf16x8*)(bp[f] + 32 * ks);
        }
#pragma unroll
        for (int q = 0; q < 4; ++q) {
            if (k0 + q < nks) {
#pragma unroll
                for (int m = 0; m < 4; ++m)
#pragma unroll
                    for (int f = 0; f < 4; ++f) acc[m][f] = __builtin_amdgcn_mfma_f32_16x16x32_bf16(b[q][f], a[q][m], acc[m][f], 0, 0, 0);
            }
        }
    }
    LAS f32x4* red = (LAS f32x4*)lds;
#pragma unroll
    for (int m = 0; m < 4; ++m)
#pragma unroll
        for (int f = 0; f < 4; ++f) red[(wave * 16 + m * 4 + f) * 64 + lane] = acc[m][f];
    LDS_WAIT(); __syncthreads();
    if (wave < 4) {
        f32x4 r[4];
#pragma unroll
        for (int f = 0; f < 4; ++f) { f32x4 sacc = red[(wave * 4 + f) * 64 + lane];
#pragma unroll
            for (int w = 1; w < 8; ++w) sacc += red[(w * 16 + wave * 4 + f) * 64 + lane];
            r[f] = sacc; }
        E(tn, 64 * rh + 16 * wave + fr, fq, r);
    }
    LDS_WAIT(); __syncthreads();
}
template <class Epi> __device__ __forceinline__ void tile(const bf16_t* A, int K, const bf16_t* Bt, const Epi& E, int task, int lane, int wave, LAS unsigned char* lds) {
#if PROBE_SK2
    { Epi Ed = E; Ed.dry = 1; tile1(A, K, Bt, Ed, task, lane, wave, lds); }
#endif
    tile1(A, K, Bt, E, task, lane, wave, lds);
}
__device__ __forceinline__ void st_bf4(bf16_t* p, const f32x4 v) { u32x2 w; w.x = cvt_pk_bf16(v[0], v[1]); w.y = cvt_pk_bf16(v[2], v[3]); *(u32x2*)p = w; }
template <int SSQI> struct EpiSwiGLU {
    unsigned char* ws; int dry;
    static __device__ __forceinline__ int brow(int tn, int f, int n) { const int gc = 32 * tn + 16 * (f & 1) + n; return 256 * (gc >> 7) + 128 * (f >> 1) + (gc & 127); }
    __device__ __forceinline__ void operator()(int tn, int srow, int fq, const f32x4 (&acc)[4]) const {
        const int row = MPROMPT + srow; const float rs = row_rs(TOT(ws, SSQI), row);
        bf16_t* O = (bf16_t*)(ws + WS_ACT) + (size_t)row * DFF + 32 * tn + 4 * fq;
#pragma unroll
        for (int f = 0; f < 2; ++f) { f32x4 o;
#pragma unroll
            for (int j = 0; j < 4; ++j) o[j] = siluf_(acc[f][j] * rs) * (acc[f + 2][j] * rs);
            st_bf4(O + 16 * f, o); }
    }
};
struct EpiPlain {
    unsigned char* ws; int dry;
    static __device__ __forceinline__ int brow(int tn, int f, int n) { return 64 * tn + 16 * f + n; }
    __device__ __forceinline__ void operator()(int tn, int srow, int fq, const f32x4 (&acc)[4]) const {
        bf16_t* O = (bf16_t*)(ws + WS_PROJ) + (size_t)(MPROMPT + srow) * DM + 64 * tn + 4 * fq;
#pragma unroll
        for (int f = 0; f < 4; ++f) st_bf4(O + 16 * f, acc[f]);
    }
};
template <int MODE, int SSQO, bool FROM_X> struct EpiResid {
    const float* xS; unsigned char* ws; float scale; int dry;
    static __device__ __forceinline__ int brow(int tn, int f, int n) { return 64 * tn + 16 * f + n; }
    __device__ __forceinline__ void operator()(int tn, int srow, int fq, const f32x4 (&acc)[4]) const {
        const int row = MPROMPT + srow;
        bf16_t* HBp = (bf16_t*)(ws + WS_HB) + (size_t)row * DM + 64 * tn + 4 * fq; bf16_t* Out = MODE == 0 ? HBp : (bf16_t*)(ws + WS_A2) + (size_t)row * DM + 64 * tn + 4 * fq;
        const float* xp = xS + (size_t)srow * DM + 64 * tn + 4 * fq;
        const bf16_t* pj = (const bf16_t*)(ws + WS_PROJ) + (size_t)row * DM + 64 * tn + 4 * fq;
        float rs = 1.f; if (MODE == 1) rs = row_rs(TOT(ws, SSQO - 1), row);
        float ss = 0.f;
#pragma unroll
        for (int f = 0; f < 4; ++f) { f32x4 bq;
            if (FROM_X) bq = *(const f32x4*)(xp + 16 * f);
            else { const u32x2 bw = *(const u32x2*)(HBp + 16 * f); bq = (f32x4){bflo(bw.x), bfhi(bw.x), bflo(bw.y), bfhi(bw.y)}; }
            f32x4 v;
            if (MODE == 0) v = bq + acc[f] * scale;
            else { const u32x2 pw = *(const u32x2*)(pj + 16 * f); const f32x4 a = acc[f] * rs;
                v[0] = bq[0] + sigmoidf_(a[0]) * bflo(pw.x); v[1] = bq[1] + sigmoidf_(a[1]) * bfhi(pw.x); v[2] = bq[2] + sigmoidf_(a[2]) * bflo(pw.y); v[3] = bq[3] + sigmoidf_(a[3]) * bfhi(pw.y); }
            if (!dry) st_bf4(Out + 16 * f, v);
            ss += (v[0] * v[0] + v[1] * v[1]) + (v[2] * v[2] + v[3] * v[3]); }
        ss += __shfl_xor(ss, 16); ss += __shfl_xor(ss, 32);
        if (fq == 0 && !dry) ssq_add(TOT(ws, SSQO), row, ss);
    }
};
struct EpiMix {
    unsigned char* ws; float* out; int dry;
    static __device__ __forceinline__ int brow(int tn, int f, int n) { return 64 * tn + 16 * f + n; }
    __device__ __forceinline__ void operator()(int tn, int srow, int fq, const f32x4 (&acc)[4]) const {
        const int row = MPROMPT + srow; const float rs = row_rs(TOT(ws, 1), row);
        f32x4 v[4];
#pragma unroll
        for (int f = 0; f < 4; ++f) v[f] = acc[f] * rs;
        if (tn < 16) {
            const float* rope = (const float*)(ws + WS_ROPE) + (size_t)(2048 + (srow & 3)) * 16 + 8 * (fq & 1);
            const f32x4 t0 = *(const f32x4*)rope, t1 = *(const f32x4*)(rope + 4);
            const float cs[4] = {t0[0], t0[2], t1[0], t1[2]}, sn[4] = {t0[1], t0[3], t1[1], t1[3]};
#pragma unroll
            for (int j = 0; j < 4; ++j) { const float x = v[0][j], w = __shfl_xor(x, 32); v[0][j] = (fq < 2) ? (x * cs[j] - w * sn[j]) : (x * cs[j] + w * sn[j]); }
        }
        if (tn < 24) {
            const int kind = tn >> 3, c0 = (tn & 7) * 64 + 4 * fq;
            bf16_t* dst = (bf16_t*)(ws + (kind == 0 ? WS_QA : (kind == 1 ? WS_KA : WS_VA))) + (size_t)row * 512 + c0;
            const float sc = kind == 0 ? C2Q : 1.f;
            float* fo = kind == 0 ? nullptr : out + (kind == 1 ? OFF_KWS : OFF_VWS) + ((size_t)(srow >> 2) * WINB + (WINB - DEC_T) + (srow & 3)) * 512 + c0;
#pragma unroll
            for (int f = 0; f < 4; ++f) { st_bf4(dst + 16 * f, v[f] * sc); if (fo) *(f32x4*)(fo + 16 * f) = v[f]; }
        } else if (tn < 48) {
            bf16_t* dst; float sc = 1.f;
            if (tn < 28) { dst = (bf16_t*)(ws + WS_QB) + (size_t)row * 256 + (tn - 24) * 64; sc = 0.125f; }
            else if (tn < 32) dst = (bf16_t*)(ws + WS_KB) + (size_t)row * 256 + (tn - 28) * 64;
            else if (tn < 40) dst = (bf16_t*)(ws + WS_VB) + (size_t)row * 512 + (tn - 32) * 64;
            else dst = (bf16_t*)(ws + WS_GB) + (size_t)row * 512 + (tn - 40) * 64;
            dst += 4 * fq;
#pragma unroll
            for (int f = 0; f < 4; ++f) st_bf4(dst + 16 * f, v[f] * sc);
        } else {
            *(f32x4*)((float*)(ws + WS_A1) + (size_t)row * 16 + 4 * fq) = v[0];
        }
    }
};
}

#define XB_TMO      128
#define XB_XCNT(j)  (256  + 64 * (j))
#define XB_XSUB(j)  (1280 + 64 * (j))
#define XB_XGEN(j)  (2304 + 64 * (j))
#define XB_TOP      3328
#define XB_TOPGEN   3392
#define XCD_BAR_WORDS 3456
#define XB_SPIN_CAP (1u << 18)
__device__ __forceinline__ unsigned xb_ld(unsigned* p)              { return __hip_atomic_load(p, __ATOMIC_RELAXED, __HIP_MEMORY_SCOPE_AGENT); }
__device__ __forceinline__ unsigned xb_add(unsigned* p, unsigned v) { return __hip_atomic_fetch_add(p, v, __ATOMIC_RELAXED, __HIP_MEMORY_SCOPE_AGENT); }
__device__ __forceinline__ unsigned xb_xcc_id() { return (unsigned)__builtin_amdgcn_s_getreg((3 << 11) | 20) & 0xFu; }
#define XB_SPIN(cond, bar) do { unsigned _sp = 0; while (cond) { __builtin_amdgcn_s_sleep(1); \
    if ((++_sp & 255u) == 0u) { if (xb_ld(&(bar)[XB_TMO])) break; if (_sp > XB_SPIN_CAP) { atomicAdd(&(bar)[XB_TMO], 1u); break; } } } } while (0)
struct XcdBarrier { unsigned* bar; unsigned x; volatile LAS unsigned* st; };
__device__ __forceinline__ XcdBarrier xcd_barrier_post(unsigned* bar, volatile LAS unsigned* st) {
    XcdBarrier b; b.bar = bar; b.x = xb_xcc_id(); b.st = st;
    if (threadIdx.x == 0) (void)xb_add(&bar[XB_XCNT(b.x)], 1u);
    return b;
}
__device__ __forceinline__ void xcd_barrier_complete(unsigned* bar, unsigned x, unsigned& nloc, unsigned& nx) {
    const unsigned G = gridDim.x * gridDim.y * gridDim.z;
    unsigned sum, cnt, mine, sp = 0u;
    for (;;) {
        sum = 0u; cnt = 0u; mine = 0u;
#pragma unroll
        for (unsigned j = 0; j < 16; ++j) { const unsigned c = xb_ld(&bar[XB_XCNT(j)]); sum += c; cnt += (c > 0u) ? 1u : 0u; mine = (j == x) ? c : mine; }
        if (sum == G) break;
        __builtin_amdgcn_s_sleep(1);
        if ((++sp & 255u) == 0u) { if (xb_ld(&bar[XB_TMO])) break; if (sp > XB_SPIN_CAP) { atomicAdd(&bar[XB_TMO], 1u); break; } }
    }
    nloc = mine > 0u ? mine : 1u; nx = cnt > 0u ? cnt : 1u;
}
__device__ __forceinline__ void xcd_barrier(const XcdBarrier& b) {
    asm volatile("s_waitcnt vmcnt(0)" ::: "memory");
    __syncthreads();
    if (threadIdx.x == 0) {
        unsigned* bar = b.bar;
        __builtin_amdgcn_s_waitcnt(0);
        unsigned nloc = b.st[0], nx = b.st[1];
        if (nloc == 0u) { xcd_barrier_complete(bar, b.x, nloc, nx); b.st[0] = nloc; b.st[1] = nx; }
        const unsigned old = xb_add(&bar[XB_XSUB(b.x)], 1u);
        const unsigned gen = old / nloc;
        if (old + 1u == (gen + 1u) * nloc) {
            __builtin_amdgcn_fence(__ATOMIC_RELEASE, "agent");
            asm volatile("s_waitcnt vmcnt(0)" ::: "memory");
            const unsigned og = xb_add(&bar[XB_TOP], 1u);
            const unsigned tg = og / nx;
            if (og + 1u == (tg + 1u) * nx) xb_add(&bar[XB_TOPGEN], 1u);
            else XB_SPIN(xb_ld(&bar[XB_TOPGEN]) == tg, bar);
            __builtin_amdgcn_fence(__ATOMIC_ACQUIRE, "agent");
            xb_add(&bar[XB_XGEN(b.x)], 1u);
            asm volatile("s_waitcnt vmcnt(0)" ::: "memory");
        } else {
            XB_SPIN(xb_ld(&bar[XB_XGEN(b.x)]) == gen, bar);
            __builtin_amdgcn_fence(__ATOMIC_ACQUIRE, "agent");
            asm volatile("s_waitcnt vmcnt(0)" ::: "memory");
        }
    }
    __syncthreads();
}

struct Args { const float* in[23]; float* out; unsigned char* ws; int ph_lo, ph_hi; };
struct Frame {
    LAS unsigned char* lds;
    int tid, lane, wave, vcu, G;
    const Args* a; float* out; unsigned char* ws;
};
#define FIN(i) (F.a->in[i])
#define WSP(T, off) ((T*)(F.ws + (off)))

__device__ __forceinline__ void tr_item(const float* W, int K, int Nsrc, const float* g, bf16_t* WT, int kind, LAS float* scr, int item, int nblk, int lane) {
    const int kb = item / nblk, nb = item % nblk, k0 = 64 * kb, n0 = 32 * nb;
    int src0 = n0, nval = 32;
    if (kind == 1) { const int pn = n0 >> 8, j = n0 & 255; src0 = (j < 128) ? 128 * pn + j : DFF + 128 * pn + (j - 128); }
    else if (kind == 2) { if (n0 < 2560) src0 = n0; else if (n0 < 3072) src0 = n0 + 16; else if (n0 == 3072) { src0 = 2560; nval = 16; } else { src0 = 0; nval = 0; } }
    const int r8 = lane >> 3, c4 = (lane & 7) * 4;
    f32x4 wv[8];
#pragma unroll
    for (int i = 0; i < 8; ++i) { const int kk = 8 * i + r8; wv[i] = (c4 < nval) ? *(const f32x4*)(W + (size_t)(k0 + kk) * Nsrc + src0 + c4) : (f32x4){0.f, 0.f, 0.f, 0.f}; }
    if (g) {
#pragma unroll
        for (int i = 0; i < 8; ++i) wv[i] = wv[i] * g[k0 + 8 * i + r8];
    }
#pragma unroll
    for (int i = 0; i < 8; ++i) { LAS float* d = scr + (8 * i + r8) * 33 + c4; d[0] = wv[i][0]; d[1] = wv[i][1]; d[2] = wv[i][2]; d[3] = wv[i][3]; }
    LDS_WAIT(); asm volatile("" ::: "memory");
    const int cc = lane & 7;
#pragma unroll
    for (int j = 0; j < 4; ++j) { const int n = (lane >> 3) + 8 * j; const LAS float* s = scr + (8 * cc) * 33 + n;
        u32x4 o; o.x = pk2(s[0 * 33], s[1 * 33]); o.y = pk2(s[2 * 33], s[3 * 33]); o.z = pk2(s[4 * 33], s[5 * 33]); o.w = pk2(s[6 * 33], s[7 * 33]);
        *(u32x4*)(WT + (size_t)(n0 + n) * K + k0 + 8 * cc) = o; }
    LDS_WAIT(); asm volatile("" ::: "memory");
}
__device__ __forceinline__ void sincos_red(double ang, float& c, float& s) {
    const double TWO_PI = 6.283185307179586476925, HALF_PI = 1.5707963267948966192;
    double r = ang - TWO_PI * __builtin_rint(ang / TWO_PI);
    const double q = __builtin_rint(r / HALF_PI); r -= q * HALF_PI;
    const int qi = ((int)q) & 3;
    const double y2 = r * r;
    const double sn = r * (1.0 + y2 * (-1.0 / 6 + y2 * (1.0 / 120 + y2 * (-1.0 / 5040 + y2 * (1.0 / 362880 - y2 * (1.0 / 39916800))))));
    const double cs = 1.0 + y2 * (-0.5 + y2 * (1.0 / 24 + y2 * (-1.0 / 720 + y2 * (1.0 / 40320 + y2 * (-1.0 / 3628800 + y2 * (1.0 / 479001600))))));
    double co, si;
    if (qi == 0) { co = cs; si = sn; } else if (qi == 1) { co = -sn; si = cs; } else if (qi == 2) { co = -cs; si = -sn; } else { co = sn; si = -cs; }
    c = (float)co; s = (float)si;
}
template <int SET> __device__ __forceinline__ void convert_weights(Frame& F, int gw, int NGW) {
    LAS float* scr = (LAS float*)(F.lds + F.wave * 16384);
    constexpr int I_GU = (DM / 64) * (NGU / 32), I_D = (DFF / 64) * (DM / 32), I_IN = (DM / 64) * (NPROJ / 32), I_1K = (DM / 64) * (DM / 32), I_PP = (DPLE / 64) * (DM / 32);
    if (SET == 0) {
        for (int it = gw; it < I_GU + I_PP; it += NGW) {
            if (it < I_GU) tr_item(FIN(8), DM, NGU, FIN(7), WSP(bf16_t, WS_WGU1), 1, scr, it, NGU / 32, F.lane);
            else tr_item(FIN(21), DPLE, DM, nullptr, WSP(bf16_t, WS_WPP), 0, scr, it - I_GU, DM / 32, F.lane);
        }
    } else if (SET == 1) {
        for (int it = gw; it < I_D + I_IN; it += NGW) {
            if (it < I_D) tr_item(FIN(9), DFF, DM, nullptr, WSP(bf16_t, WS_WD1), 0, scr, it, DM / 32, F.lane);
            else tr_item(FIN(11), DM, 3088, FIN(10), WSP(bf16_t, WS_WIN), 2, scr, it - I_D, NPROJ / 32, F.lane);
        }
    } else {
        for (int it = gw; it < I_GU + I_D + 2 * I_1K; it += NGW) {
            int r = it;
            if (r < I_GU) { tr_item(FIN(17), DM, NGU, FIN(16), WSP(bf16_t, WS_WGU2), 1, scr, r, NGU / 32, F.lane); continue; } r -= I_GU;
            if (r < I_D) { tr_item(FIN(18), DFF, DM, nullptr, WSP(bf16_t, WS_WD2), 0, scr, r, DM / 32, F.lane); continue; } r -= I_D;
            if (r < I_1K) { tr_item(FIN(15), DM, DM, nullptr, WSP(bf16_t, WS_WOUT), 0, scr, r, DM / 32, F.lane); continue; } r -= I_1K;
            tr_item(FIN(20), DM, DM, FIN(19), WSP(bf16_t, WS_WPG), 0, scr, r, DM / 32, F.lane);
        }
    }
}
__device__ __forceinline__ void p0_prologue(Frame& F) {
    const int gw = F.vcu * NWAVES + F.wave, NGW = F.G * NWAVES;
    convert_weights<0>(F, gw, NGW);
    bf16_t* HB = WSP(bf16_t, WS_HB); bf16_t* PB = WSP(bf16_t, WS_PB); unsigned* ssq0 = TOT(F.ws, 0);
    for (int e = F.vcu * 512 + F.tid; e < 4 * MPAD; e += F.G * 512) TOT(F.ws, 1 + e / MPAD)[e % MPAD] = 0u;
    for (int m0 = gw; m0 < MTOT; m0 += 4 * NGW) {
        f32x4 v[4][4], pv[4];
#pragma unroll
        for (int u = 0; u < 4; ++u) { const int m = m0 + u * NGW; const bool ok = m < MTOT;
            const float* xr = m < MPROMPT ? FIN(0) + (size_t)m * DM : FIN(1) + (size_t)(m - MPROMPT) * DM;
            const float* pr = m < MPROMPT ? FIN(5) + (size_t)m * DPLE : FIN(6) + (size_t)(m - MPROMPT) * DPLE;
#pragma unroll
            for (int j = 0; j < 4; ++j) v[u][j] = ok ? *((const f32x4*)xr + F.lane + 64 * j) : (f32x4){0.f, 0.f, 0.f, 0.f};
            pv[u] = ok ? *((const f32x4*)pr + F.lane) : (f32x4){0.f, 0.f, 0.f, 0.f}; }
#pragma unroll
        for (int u = 0; u < 4; ++u) { const int m = m0 + u * NGW; if (m >= MTOT) continue;
            float s = 0.f;
#pragma unroll
            for (int j = 0; j < 4; ++j) s += (v[u][j][0] * v[u][j][0] + v[u][j][1] * v[u][j][1]) + (v[u][j][2] * v[u][j][2] + v[u][j][3] * v[u][j][3]);
            s = wave_sum(s);
#pragma unroll
            for (int j = 0; j < 4; ++j) { u32x2 w; w.x = pk2(v[u][j][0], v[u][j][1]); w.y = pk2(v[u][j][2], v[u][j][3]); *((u32x2*)(HB + (size_t)m * DM) + F.lane + 64 * j) = w; }
            if (F.lane == 0) ssq0[m] = (unsigned)(s * SSQ_SCALE + 0.5f);
            u32x2 w; w.x = pk2(pv[u][0], pv[u][1]); w.y = pk2(pv[u][2], pv[u][3]); *((u32x2*)(PB + (size_t)m * DPLE) + F.lane) = w; }
    }
    float* rope = WSP(float, WS_ROPE);
    for (int e = F.vcu * 512 + F.tid; e < 2052 * 8; e += F.G * 512) {
        const int posidx = e >> 3, i = e & 7; const int pos = posidx < 2048 ? posidx : PAST + (posidx - 2048);
        const double inv = exp2(-(double)i * 0.125 * 18.931568569324174087);
        float c, s; sincos_red((double)pos * inv, c, s);
        rope[2 * e] = c; rope[2 * e + 1] = s;
    }
}


constexpr size_t CP_PER_B = (size_t)(WINB - DEC_T) * 512 / 4, CP_TOTAL = (size_t)DEC_B * CP_PER_B, CP_C1 = 0, CP_C3 = (CP_TOTAL * 6 / 10) & ~(size_t)511;
__device__ __forceinline__ void cache_copy_chunk(Frame& F, size_t e0, size_t e1, int rank, int nshare) {
    if (rank < 0) return;
    constexpr int U = 8;
    const size_t stride = (size_t)nshare * 512 * U;
    for (size_t eb = e0 + (size_t)rank * 512 * U + F.tid; eb < e1; eb += stride) {
        f32x4 kv[U], vv[U]; size_t dst[U];
#pragma unroll
        for (int u = 0; u < U; ++u) { const size_t e = eb + (size_t)u * 512; const size_t ec = e < e1 ? e : e1 - 1; const size_t b = ec / CP_PER_B, r = ec - b * CP_PER_B;
            const size_t src = b * ((size_t)WINB * 128) + DEC_T * 128 + r; dst[u] = b * ((size_t)WINB * 128) + r;
            kv[u] = __builtin_nontemporal_load((const f32x4*)FIN(2) + src); vv[u] = __builtin_nontemporal_load((const f32x4*)FIN(3) + src); }
#pragma unroll
        for (int u = 0; u < U; ++u) { __builtin_nontemporal_store(kv[u], (f32x4*)(F.out + OFF_KWS) + dst[u]); __builtin_nontemporal_store(vv[u], (f32x4*)(F.out + OFF_VWS) + dst[u]); }
    }
}

constexpr int AT_VW = 6144  , AT_VPITCH = 192, AT_STO = 8 * AT_VW, AT_SPITCH = 136, AT_SROWS = 528, AT_STM = AT_STO + AT_SROWS * AT_SPITCH, AT_STL = AT_STM + AT_SROWS * 4;
static_assert(AT_STL + AT_SROWS * 4 <= RING_BYTES, "attention LDS");
__device__ __forceinline__ int crow(int r, int hi) { return (r & 3) + 8 * (r >> 2) + 4 * hi; }
__device__ __forceinline__ float xhalf_max(float x) { const auto r = __builtin_amdgcn_permlane32_swap(__float_as_uint(x), __float_as_uint(x), false, false); return fmaxf(__uint_as_float(r[0]), __uint_as_float(r[1])); }
__device__ __forceinline__ float xhalf_sum(float x) { const auto r = __builtin_amdgcn_permlane32_swap(__float_as_uint(x), __float_as_uint(x), false, false); return __uint_as_float(r[0]) + __uint_as_float(r[1]); }
__device__ __forceinline__ s16x4 tr_read(LAS const unsigned char* p) { typedef short v4i16 __attribute__((ext_vector_type(4))); return __builtin_bit_cast(s16x4, __builtin_amdgcn_ds_read_tr16_b64_v4i16((LAS v4i16*)p)); }

template <int NQ> __device__ __forceinline__ void attn_task(Frame& F, int b, int h, int P0, int br, int dil, int r, int s0) {
    const int lane = F.lane, qi = lane & 31, hi = lane >> 5;
    const bf16_t* QA = WSP(bf16_t, WS_QA); const bf16_t* KA = WSP(bf16_t, WS_KA); const bf16_t* VA = WSP(bf16_t, WS_VA);
    LAS unsigned char* Vw = F.lds + F.wave * AT_VW;
    const size_t rowbase = (size_t)b * SEQ;
    const char* Qb = (const char*)(QA + rowbase * 512 + h * 64); const char* Kb = (const char*)(KA + rowbase * 512 + h * 64); const char* Vb = (const char*)(VA + rowbase * 512 + h * 64);
    bf16x8 qf[NQ][4]; f32x16 o0[NQ], o1[NQ]; float mrun[NQ], lrun[NQ];
#define POSQ(n) ((s0 + 32 * (n) + qi) * dil + r)
#define RHO(n) ((((POSQ(n) - P0) & 15) * 33) + ((POSQ(n) - P0) >> 4))
#pragma unroll
    for (int n = 0; n < NQ; ++n) {
        const unsigned qoff = (unsigned)POSQ(n) * 1024u + hi * 16u;
#pragma unroll
        for (int kk = 0; kk < 4; ++kk) qf[n][kk] = *(const bf16x8*)(Qb + qoff + 32 * kk);
        if (br == 0) {
#pragma unroll
            for (int i = 0; i < 16; ++i) { o0[n][i] = 0.f; o1[n][i] = 0.f; }
            mrun[n] = -1e30f; lrun[n] = 0.f;
        } else {
            const LAS unsigned char* sp = F.lds + AT_STO + RHO(n) * AT_SPITCH + 8 * hi;
#pragma unroll
            for (int g = 0; g < 4; ++g) {
                const u32x2 a = *(const LAS u32x2*)(sp + 16 * g), c = *(const LAS u32x2*)(sp + 64 + 16 * g);
                o0[n][4 * g] = bflo(a.x); o0[n][4 * g + 1] = bfhi(a.x); o0[n][4 * g + 2] = bflo(a.y); o0[n][4 * g + 3] = bfhi(a.y);
                o1[n][4 * g] = bflo(c.x); o1[n][4 * g + 1] = bfhi(c.x); o1[n][4 * g + 2] = bflo(c.y); o1[n][4 * g + 3] = bfhi(c.y);
            }
            mrun[n] = *(const LAS float*)(F.lds + AT_STM + RHO(n) * 4); lrun[n] = *(const LAS float*)(F.lds + AT_STL + RHO(n) * 4);
        }
    }
    const int kt0 = s0 >= 128 ? 0 : ((128 - s0) >> 5), ktend = 5 + (NQ - 1);
    const int q4 = (lane & 15) >> 2, p4 = lane & 3, blk = (lane >> 4) & 1;
    const LAS unsigned char* trb = Vw + (4 * hi + q4) * AT_VPITCH + (16 * blk + 4 * p4) * 2;
    bf16x8 kn[4]; u32x4 vr[4];
    {   const int sk0 = s0 - 128 + 32 * kt0;
        const unsigned koff = (unsigned)((sk0 + qi) * dil + r) * 1024u + hi * 16u;
#pragma unroll
        for (int kk = 0; kk < 4; ++kk) kn[kk] = *(const bf16x8*)(Kb + koff + 32 * kk);
#pragma unroll
        for (int c = 0; c < 4; ++c) { const int cid = lane + 64 * c, vrow = cid >> 3, ch = cid & 7;
            vr[c] = *(const u32x4*)(Vb + (unsigned)((sk0 + vrow) * dil + r) * 1024u + ch * 16u); } }
#define AT_STEP(KT, D0, D1) do { const int kt_ = (KT); \
        bf16x8 kf[4]; \
        _Pragma("unroll") for (int kk = 0; kk < 4; ++kk) kf[kk] = kn[kk]; \
        _Pragma("unroll") for (int c = 0; c < 4; ++c) { const int cid = lane + 64 * c, vrow = cid >> 3, ch = cid & 7; *(LAS u32x4*)(Vw + vrow * AT_VPITCH + ch * 16) = vr[c]; } \
        if (kt_ + 1 < ktend) { \
            const int sk1 = s0 - 128 + 32 * (kt_ + 1); \
            const unsigned koff = (unsigned)((sk1 + qi) * dil + r) * 1024u + hi * 16u; \
            _Pragma("unroll") for (int kk = 0; kk < 4; ++kk) kn[kk] = *(const bf16x8*)(Kb + koff + 32 * kk); \
            _Pragma("unroll") for (int c = 0; c < 4; ++c) { const int cid = lane + 64 * c, vrow = cid >> 3, ch = cid & 7; \
                vr[c] = *(const u32x4*)(Vb + (unsigned)((sk1 + vrow) * dil + r) * 1024u + ch * 16u); } \
        } \
        LDS_WAIT(); \
        bf16x8 va[2][2]; \
        _Pragma("unroll") for (int dt = 0; dt < 2; ++dt) { \
            const s16x4 lo0 = tr_read(trb + dt * 64), hi0 = tr_read(trb + dt * 64 + 8 * AT_VPITCH); \
            const s16x4 lo1 = tr_read(trb + dt * 64 + 16 * AT_VPITCH), hi1 = tr_read(trb + dt * 64 + 24 * AT_VPITCH); \
            va[dt][0] = __builtin_shufflevector(lo0, hi0, 0, 1, 2, 3, 4, 5, 6, 7); va[dt][1] = __builtin_shufflevector(lo1, hi1, 0, 1, 2, 3, 4, 5, 6, 7); } \
        f32x16 pp[NQ]; \
        _Pragma("unroll") for (int n = 0; n < NQ; ++n) _Pragma("unroll") for (int i = 0; i < 16; ++i) pp[n][i] = 0.f; \
        _Pragma("unroll") for (int kk = 0; kk < 4; ++kk) { \
            if (D0) pp[0] = __builtin_amdgcn_mfma_f32_32x32x16_bf16(kf[kk], qf[0][kk], pp[0], 0, 0, 0); \
            if (D1) pp[NQ - 1] = __builtin_amdgcn_mfma_f32_32x32x16_bf16(kf[kk], qf[NQ - 1][kk], pp[NQ - 1], 0, 0, 0); } \
        bf16x8 pb[NQ][2]; \
        _Pragma("unroll") for (int n = 0; n < NQ; ++n) { \
            if ((n == 0 && !(D0)) || (n == 1 && !(D1))) continue; \
            const int kr = kt_ - n; \
            if (kr == 0) { _Pragma("unroll") for (int i = 0; i < 16; ++i) if (crow(i, hi) < qi) pp[n][i] = -INFINITY; } \
            else if (kr == 4) { _Pragma("unroll") for (int i = 0; i < 16; ++i) if (crow(i, hi) > qi) pp[n][i] = -INFINITY; } } \
        _Pragma("unroll") for (int n = 0; n < NQ; ++n) { \
            if ((n == 0 && !(D0)) || (n == 1 && !(D1))) continue; \
            float mx = pp[n][0]; \
            _Pragma("unroll") for (int i = 1; i < 16; ++i) mx = fmaxf(mx, pp[n][i]); \
            mx = xhalf_max(mx); \
            if (__builtin_amdgcn_ballot_w64(mx > mrun[n] + 8.0f) != 0ull) {        \
                const float mn = fmaxf(mrun[n], mx), al = __builtin_amdgcn_exp2f(mrun[n] - mn); \
                lrun[n] *= al; mrun[n] = mn; \
                _Pragma("unroll") for (int i = 0; i < 16; ++i) { o0[n][i] *= al; o1[n][i] *= al; } \
            } \
            float rsum = 0.f; \
            _Pragma("unroll") for (int i = 0; i < 16; ++i) { pp[n][i] = __builtin_amdgcn_exp2f(pp[n][i] - mrun[n]); rsum += pp[n][i]; } \
            rsum = xhalf_sum(rsum); \
            lrun[n] += rsum; \
            u32x4 pw0, pw1; \
            pw0.x = cvt_pk_bf16(pp[n][0], pp[n][1]); pw0.y = cvt_pk_bf16(pp[n][2], pp[n][3]); pw0.z = cvt_pk_bf16(pp[n][4], pp[n][5]); pw0.w = cvt_pk_bf16(pp[n][6], pp[n][7]); \
            pw1.x = cvt_pk_bf16(pp[n][8], pp[n][9]); pw1.y = cvt_pk_bf16(pp[n][10], pp[n][11]); pw1.z = cvt_pk_bf16(pp[n][12], pp[n][13]); pw1.w = cvt_pk_bf16(pp[n][14], pp[n][15]); \
            pb[n][0] = __builtin_bit_cast(bf16x8, pw0); pb[n][1] = __builtin_bit_cast(bf16x8, pw1); } \
        _Pragma("unroll") for (int n = 0; n < NQ; ++n) { \
            if ((n == 0 && !(D0)) || (n == 1 && !(D1))) continue; \
            o0[n] = __builtin_amdgcn_mfma_f32_32x32x16_bf16(va[0][0], pb[n][0], o0[n], 0, 0, 0); o1[n] = __builtin_amdgcn_mfma_f32_32x32x16_bf16(va[1][0], pb[n][0], o1[n], 0, 0, 0); } \
        _Pragma("unroll") for (int n = 0; n < NQ; ++n) { \
            if ((n == 0 && !(D0)) || (n == 1 && !(D1))) continue; \
            o0[n] = __builtin_amdgcn_mfma_f32_32x32x16_bf16(va[0][1], pb[n][1], o0[n], 0, 0, 0); o1[n] = __builtin_amdgcn_mfma_f32_32x32x16_bf16(va[1][1], pb[n][1], o1[n], 0, 0, 0); } \
    } while (0)
    if (NQ == 1) {
#pragma nounroll
        for (int kt = kt0; kt < 5; ++kt) AT_STEP(kt, true, false);
    } else {
        int kt = kt0;
        if (kt == 0) { AT_STEP(0, true, false); kt = 1; }
#pragma nounroll
        for (; kt < 5; ++kt) AT_STEP(kt, true, true);
        AT_STEP(5, false, true);
    }
#undef AT_STEP
#pragma unroll
    for (int n = 0; n < NQ; ++n) {
        if (br < 2) {
            LAS unsigned char* sp = F.lds + AT_STO + RHO(n) * AT_SPITCH + 8 * hi;
#pragma unroll
            for (int g = 0; g < 4; ++g) {
                u32x2 a, c; a.x = cvt_pk_bf16(o0[n][4 * g], o0[n][4 * g + 1]); a.y = cvt_pk_bf16(o0[n][4 * g + 2], o0[n][4 * g + 3]); c.x = cvt_pk_bf16(o1[n][4 * g], o1[n][4 * g + 1]); c.y = cvt_pk_bf16(o1[n][4 * g + 2], o1[n][4 * g + 3]);
                *(LAS u32x2*)(sp + 16 * g) = a; *(LAS u32x2*)(sp + 64 + 16 * g) = c;
            }
            if (hi == 0) { *(LAS float*)(F.lds + AT_STM + RHO(n) * 4) = mrun[n]; *(LAS float*)(F.lds + AT_STL + RHO(n) * 4) = lrun[n]; }
        } else {
            const float inv = 1.f / lrun[n];
            bf16_t* op = WSP(bf16_t, WS_A2) + (rowbase + POSQ(n)) * DM + h * 64 + 4 * hi;
#pragma unroll
            for (int g = 0; g < 4; ++g) {
                u32x2 a, c; a.x = cvt_pk_bf16(o0[n][4 * g] * inv, o0[n][4 * g + 1] * inv); a.y = cvt_pk_bf16(o0[n][4 * g + 2] * inv, o0[n][4 * g + 3] * inv);
                c.x = cvt_pk_bf16(o1[n][4 * g] * inv, o1[n][4 * g + 1] * inv); c.y = cvt_pk_bf16(o1[n][4 * g + 2] * inv, o1[n][4 * g + 3] * inv);
                *(u32x2*)(op + 8 * g) = a; *(u32x2*)(op + 32 + 8 * g) = c;
            }
        }
    }
    LDS_WAIT();
#undef POSQ
#undef RHO
}
__device__ __forceinline__ void attn_prompt_item(Frame& F, int item) {
    const int b = item >> 5, h = (item >> 2) & 7, blk = item & 3, P0 = blk * 512;
    attn_task<2>(F, b, h, P0, 0, 1, 0, P0 + 64 * F.wave);
    LDS_WAIT(); __syncthreads();
    attn_task<2>(F, b, h, P0, 1, 4, F.wave & 3, P0 / 4 + 64 * (F.wave >> 2));
    LDS_WAIT(); __syncthreads();
    for (int u = 0; u < 2; ++u) attn_task<1>(F, b, h, P0, 2, 16, F.wave * 2 + u, P0 / 16);
    LDS_WAIT(); __syncthreads();
}

__device__ __forceinline__ void attn_sample_task(Frame& F, int task, int half) {
    const int h = task & 7, bt = task >> 3, b = bt >> 2, t = bt & 3, row = MPROMPT + bt;
    const int lane = F.lane, grp = lane >> 2, sub = lane & 3;
    const bf16_t* KA = WSP(bf16_t, WS_KA); const bf16_t* VA = WSP(bf16_t, WS_VA);
    float q[16];
    { const u32x4* qp = (const u32x4*)(WSP(bf16_t, WS_QA) + (size_t)row * 512 + h * 64 + 16 * sub); const u32x4 a = qp[0], c = qp[1];
      q[0] = bflo(a.x); q[1] = bfhi(a.x); q[2] = bflo(a.y); q[3] = bfhi(a.y); q[4] = bflo(a.z); q[5] = bfhi(a.z); q[6] = bflo(a.w); q[7] = bfhi(a.w);
      q[8] = bflo(c.x); q[9] = bfhi(c.x); q[10] = bflo(c.y); q[11] = bfhi(c.y); q[12] = bflo(c.z); q[13] = bfhi(c.z); q[14] = bflo(c.w); q[15] = bfhi(c.w); }
    float mrun = -1e30f, lrun = 0.f, acc[16];
#pragma unroll
    for (int e = 0; e < 16; ++e) acc[e] = 0.f;
    const int rd0 = half ? 5 : 0, rd1 = half ? 9 : 5;
#pragma nounroll
    for (int rd = rd0; rd < rd1; ++rd) {
        const int j = rd * 16 + grp; const bool valid = j <= 128;
        float kv[3][16], vv[3][16];
#pragma unroll
        for (int br = 0; br < 3; ++br) {
            const int dil = 1 << (2 * br);
            const int idx = WINB + t - (valid ? dil * j : 0);
            if (idx < WINB) {
                const f32x4* kp = (const f32x4*)(FIN(2) + (((size_t)b * WINB + idx) * 8 + h) * 64 + 16 * sub);
                const f32x4* vp = (const f32x4*)(FIN(3) + (((size_t)b * WINB + idx) * 8 + h) * 64 + 16 * sub);
#pragma unroll
                for (int c = 0; c < 4; ++c) { const f32x4 a = kp[c], d = vp[c];
#pragma unroll
                    for (int e = 0; e < 4; ++e) { kv[br][4 * c + e] = a[e]; vv[br][4 * c + e] = d[e]; } }
            } else {
                const size_t nrow = (size_t)MPROMPT + 4 * b + (idx - WINB);
                const u32x4* kp = (const u32x4*)(KA + nrow * 512 + h * 64 + 16 * sub); const u32x4* vp = (const u32x4*)(VA + nrow * 512 + h * 64 + 16 * sub);
#pragma unroll
                for (int c = 0; c < 2; ++c) { const u32x4 a = kp[c], d = vp[c];
                    kv[br][8 * c] = bflo(a.x); kv[br][8 * c + 1] = bfhi(a.x); kv[br][8 * c + 2] = bflo(a.y); kv[br][8 * c + 3] = bfhi(a.y); kv[br][8 * c + 4] = bflo(a.z); kv[br][8 * c + 5] = bfhi(a.z); kv[br][8 * c + 6] = bflo(a.w); kv[br][8 * c + 7] = bfhi(a.w);
                    vv[br][8 * c] = bflo(d.x); vv[br][8 * c + 1] = bfhi(d.x); vv[br][8 * c + 2] = bflo(d.y); vv[br][8 * c + 3] = bfhi(d.y); vv[br][8 * c + 4] = bflo(d.z); vv[br][8 * c + 5] = bfhi(d.z); vv[br][8 * c + 6] = bflo(d.w); vv[br][8 * c + 7] = bfhi(d.w); }
            }
        }
#pragma unroll
        for (int br = 0; br < 3; ++br) {
            float s = 0.f;
#pragma unroll
            for (int e = 0; e < 16; ++e) s += q[e] * kv[br][e];
            s += __shfl_xor(s, 1); s += __shfl_xor(s, 2);
            if (!valid) s = -INFINITY;
            const float mn = fmaxf(mrun, s), al = __builtin_amdgcn_exp2f(mrun - mn), p = __builtin_amdgcn_exp2f(s - mn);
            lrun = lrun * al + p; mrun = mn;
#pragma unroll
            for (int e = 0; e < 16; ++e) acc[e] = acc[e] * al + p * vv[br][e];
        }
    }
    float M = mrun;
#pragma unroll
    for (int o = 4; o < 64; o <<= 1) M = fmaxf(M, __shfl_xor(M, o));
    const float f = __builtin_amdgcn_exp2f(mrun - M);
    lrun *= f;
#pragma unroll
    for (int o = 4; o < 64; o <<= 1) lrun += __shfl_xor(lrun, o);
#pragma unroll
    for (int e = 0; e < 16; ++e) { float a = acc[e] * f;
#pragma unroll
        for (int o = 4; o < 64; o <<= 1) a += __shfl_xor(a, o);
        acc[e] = a; }
    LAS float* mrg = (LAS float*)(F.lds) + (F.wave & 3) * 80;
    if (half && grp == 0) {
#pragma unroll
        for (int e = 0; e < 16; ++e) mrg[sub * 16 + e] = acc[e];
        if (sub == 0) { mrg[64] = M; mrg[65] = lrun; }
    }
    LDS_WAIT(); __syncthreads();
    if (!half && grp == 0) {
        const float M2 = mrg[64], l2 = mrg[65], Mx = fmaxf(M, M2), f1 = __builtin_amdgcn_exp2f(M - Mx), f2 = __builtin_amdgcn_exp2f(M2 - Mx);
        const float inv = 1.f / (lrun * f1 + l2 * f2);
#pragma unroll
        for (int e = 0; e < 16; ++e) acc[e] = (acc[e] * f1 + mrg[sub * 16 + e] * f2) * inv;
        u32x4 w0, w1; w0.x = pk2(acc[0], acc[1]); w0.y = pk2(acc[2], acc[3]); w0.z = pk2(acc[4], acc[5]); w0.w = pk2(acc[6], acc[7]);
        w1.x = pk2(acc[8], acc[9]); w1.y = pk2(acc[10], acc[11]); w1.z = pk2(acc[12], acc[13]); w1.w = pk2(acc[14], acc[15]);
        u32x4* op = (u32x4*)(WSP(bf16_t, WS_A2) + (size_t)row * DM + h * 64 + 16 * sub); op[0] = w0; op[1] = w1;
    }
    LDS_WAIT(); __syncthreads();
}

constexpr int GL_A1 = 0  , GL_TOT = 4096  , GL_BT = GL_TOT + 2048  , GL_BC = GL_BT + 256  , GL_QA = GL_BC + 64 * 272  ,
              GL_KB = GL_QA + 64 * 144, GL_VR = GL_KB + 64 * 144  , GL_AM = GL_VR + 64 * 272  , GL_O = GL_AM + 64 * 144  , GL_SP = GL_O + 64 * 132 * 4  , GL_END = GL_SP + 128 * 144;
static_assert(GL_END <= RING_BYTES && GL_BC % 16 == 0 && GL_QA % 16 == 0 && GL_VR % 16 == 0 && GL_O % 16 == 0, "GLA LDS");
struct GlaIn { f32x4 a1; u32x4 kb, qb, vb0, vb1, gb0, gb1; f32x4 hc[4]; };
template <bool P3> __device__ __forceinline__ void gla_fetch(Frame& F, GlaIn& I, int item, int hh, size_t row0) {
    const int tid = F.tid;
    I.a1 = (f32x4){0.f, 0.f, 0.f, 0.f};
    if (tid < 256) I.a1 = *(const f32x4*)(WSP(float, WS_A1) + (row0 + (tid >> 2)) * 16 + 4 * (tid & 3));
    I.kb = *(const u32x4*)(WSP(bf16_t, WS_KB) + (row0 + (tid >> 3)) * 256 + hh * 64 + 8 * (tid & 7));
    I.vb0 = *(const u32x4*)(WSP(bf16_t, WS_VB) + (row0 + (tid >> 4)) * 512 + hh * 128 + 8 * (tid & 15));
    I.vb1 = *(const u32x4*)(WSP(bf16_t, WS_VB) + (row0 + 32 + (tid >> 4)) * 512 + hh * 128 + 8 * (tid & 15));
    if (P3) {
        I.qb = *(const u32x4*)(WSP(bf16_t, WS_QB) + (row0 + (tid >> 3)) * 256 + hh * 64 + 8 * (tid & 7));
        const int i = tid >> 3, sub = tid & 7;
        const u32x4* gp = (const u32x4*)(WSP(bf16_t, WS_GB) + (row0 + i) * 512 + hh * 128 + 16 * sub); I.gb0 = gp[0]; I.gb1 = gp[1];
        const float* hp = WSP(float, WS_HCT) + (size_t)item * 8192 + (size_t)(tid >> 4) * 64 + 4 * (tid & 15);
#pragma unroll
        for (int e = 0; e < 4; ++e) I.hc[e] = *(const f32x4*)(hp + (size_t)e * 32 * 64);
    }
}
__device__ __forceinline__ void gla_decay(Frame& F, const f32x4 a1v, const float (&w2)[16], float bias, float& btot) {
    const int tid = F.tid, k = tid & 63, ig = tid >> 6;
    LAS float* a1s = (LAS float*)(F.lds + GL_A1); LAS float* tot = (LAS float*)(F.lds + GL_TOT); LAS float* BC = (LAS float*)(F.lds + GL_BC); LAS float* BT = (LAS float*)(F.lds + GL_BT);
    if (tid < 256) *(LAS f32x4*)(a1s + tid * 4) = a1v;
    LDS_WAIT(); __syncthreads();
    float run = 0.f, bcum[8];
#pragma unroll
    for (int e = 0; e < 8; ++e) { float pre = bias;
#pragma unroll
        for (int r = 0; r < 16; ++r) pre += a1s[(8 * ig + e) * 16 + r] * w2[r];
        run += logsigf_(pre) * (1.0f / 16.0f); bcum[e] = run; }
    tot[ig * 64 + k] = run;
    LDS_WAIT(); __syncthreads();
    float pre = 0.f, all = 0.f;
#pragma unroll
    for (int g = 0; g < 8; ++g) { const float tv = tot[g * 64 + k]; all += tv; if (g < ig) pre += tv; }
#pragma unroll
    for (int e = 0; e < 8; ++e) BC[(8 * ig + e) * 68 + k] = bcum[e] + pre;
    if (ig == 0) BT[k] = all;
    btot = all;
    LDS_WAIT(); __syncthreads();
}
__device__ __forceinline__ void unpack8(const u32x4 w, float (&x)[8]) { x[0] = bflo(w.x); x[1] = bfhi(w.x); x[2] = bflo(w.y); x[3] = bfhi(w.y); x[4] = bflo(w.z); x[5] = bfhi(w.z); x[6] = bflo(w.w); x[7] = bfhi(w.w); }
__device__ __forceinline__ u32x4 pack8(const float (&x)[8]) { u32x4 w; w.x = pk2(x[0], x[1]); w.y = pk2(x[2], x[3]); w.z = pk2(x[4], x[5]); w.w = pk2(x[6], x[7]); return w; }
__device__ __forceinline__ void gla_store_vr(Frame& F, const u32x4 vb0, const u32x4 vb1) {
    const int tid = F.tid;
    *(LAS u32x4*)(F.lds + GL_VR + (tid >> 4) * 272 + (tid & 15) * 16) = vb0;
    *(LAS u32x4*)(F.lds + GL_VR + (32 + (tid >> 4)) * 272 + (tid & 15) * 16) = vb1;
}
__device__ __forceinline__ bf16x8 tr_frag(LAS const unsigned char* img, int pitch, int col0, int s, int lane) {
    const int q4 = (lane & 15) >> 2, p4 = lane & 3, blk = (lane >> 4) & 1, hi = lane >> 5;
    LAS const unsigned char* p = img + (16 * s + 8 * hi + q4) * pitch + (col0 + 16 * blk + 4 * p4) * 2;
    const s16x4 lo = tr_read(p), hi4 = tr_read(p + 4 * pitch);
    return __builtin_shufflevector(lo, hi4, 0, 1, 2, 3, 4, 5, 6, 7);
}
template <int NIT> __device__ __forceinline__ void gla_p1_items(Frame& F, int item0) {
    const int bh = item0 >> 5, b = bh >> 2, hh = bh & 3;
    const int tid = F.tid, k = tid & 63, ig = tid >> 6, lane = F.lane;
    float w2[16];
#pragma unroll
    for (int r = 0; r < 16; ++r) w2[r] = FIN(12)[r * 256 + hh * 64 + k];
    const float bias = FIN(13)[hh * 64 + k];
    GlaIn nx; gla_fetch<false>(F, nx, item0, hh, (size_t)b * SEQ + 64 * (item0 & 31));
    f32x16 ga; float dsum = 0.f;
#pragma unroll
    for (int i = 0; i < 16; ++i) ga[i] = 0.f;
#pragma nounroll
    for (int it = 0; it < NIT; ++it) {
        const int item = item0 + it;
        const GlaIn cu = nx;
        if (it + 1 < NIT) gla_fetch<false>(F, nx, item + 1, hh, (size_t)b * SEQ + 64 * ((item + 1) & 31));
        float btot; gla_decay(F, cu.a1, w2, bias, btot);
        dsum += btot;
        {
            const int i = tid >> 3, c = tid & 7;
            const f32x4 b0 = *(const LAS f32x4*)(F.lds + GL_BC + (i * 68 + 8 * c) * 4), b1 = *(const LAS f32x4*)(F.lds + GL_BC + (i * 68 + 8 * c + 4) * 4);
            const f32x4 t0 = *(const LAS f32x4*)(F.lds + GL_BT + 8 * c * 4), t1 = *(const LAS f32x4*)(F.lds + GL_BT + (8 * c + 4) * 4);
            float kx[8]; unpack8(cu.kb, kx);
#pragma unroll
            for (int e = 0; e < 4; ++e) { kx[e] *= fexp(t0[e] - b0[e]); kx[4 + e] *= fexp(t1[e] - b1[e]); }
            *(LAS u32x4*)(F.lds + GL_QA + i * 144 + c * 16) = pack8(kx);
        }
        gla_store_vr(F, cu.vb0, cu.vb1);
        if (ig == 0) WSP(float, WS_BTOT)[item * 64 + k] = btot;
        LDS_WAIT(); __syncthreads();
        const int kt = F.wave >> 2, vt = F.wave & 3, r32 = lane & 31, hi = lane >> 5;
        f32x16 acc;
#pragma unroll
        for (int i = 0; i < 16; ++i) acc[i] = 0.f;
#pragma unroll
        for (int q = 0; q < 4; ++q) {
            const bf16x8 a = tr_frag(F.lds + GL_QA, 144, 32 * kt, q, lane);
            const bf16x8 bb = tr_frag(F.lds + GL_VR, 272, 32 * vt, q, lane);
            acc = __builtin_amdgcn_mfma_f32_32x32x16_bf16(a, bb, acc, 0, 0, 0);
        }
        float* hct = WSP(float, WS_HCT) + (size_t)item * 8192 + (size_t)(32 * vt + r32) * 64 + 32 * kt + 4 * hi;
#pragma unroll
        for (int g = 0; g < 4; ++g) { *(f32x4*)(hct + 8 * g) = (f32x4){acc[4 * g], acc[4 * g + 1], acc[4 * g + 2], acc[4 * g + 3]};
            const f32x4 bt = *(const LAS f32x4*)(F.lds + GL_BT + (32 * kt + 8 * g + 4 * hi) * 4);
#pragma unroll
            for (int e = 0; e < 4; ++e) ga[4 * g + e] = fexp(bt[e]) * ga[4 * g + e] + acc[4 * g + e]; }
        LDS_WAIT(); __syncthreads();
    }
    {   const int grp = item0 >> 2, kt = F.wave >> 2, vt = F.wave & 3, r32 = lane & 31, hi = lane >> 5;
        float* gag = WSP(float, WS_GAG) + (size_t)grp * 8192 + (size_t)(32 * vt + r32) * 64 + 32 * kt + 4 * hi;
#pragma unroll
        for (int g = 0; g < 4; ++g) *(f32x4*)(gag + 8 * g) = (f32x4){ga[4 * g], ga[4 * g + 1], ga[4 * g + 2], ga[4 * g + 3]};
        if (ig == 0) WSP(float, WS_DSUM)[grp * 64 + k] = dsum; }
}
template <int NIT> __device__ __forceinline__ void gla_p3_items(Frame& F, int item0) {
    const int bh = item0 >> 5, b = bh >> 2, hh = bh & 3;
    const int tid = F.tid, k = tid & 63, lane = F.lane;
    float w2[16];
#pragma unroll
    for (int r = 0; r < 16; ++r) w2[r] = FIN(12)[r * 256 + hh * 64 + k];
    const float bias = FIN(13)[hh * 64 + k];
    GlaIn nx; gla_fetch<true>(F, nx, item0, hh, (size_t)b * SEQ + 64 * (item0 & 31));
    const int k4 = 4 * (tid & 15), v0 = tid >> 4;
    f32x4 S[4];
#pragma unroll
    for (int e = 0; e < 4; ++e) S[e] = (f32x4){0.f, 0.f, 0.f, 0.f};
    {   const int grp = item0 >> 2, j = grp & 7, grp0 = grp - j;
        const float* gag = WSP(float, WS_GAG) + (size_t)grp0 * 8192 + (size_t)v0 * 64 + k4; const float* dsp = WSP(float, WS_DSUM) + grp0 * 64 + k4;
        f32x4 dec = (f32x4){1.f, 1.f, 1.f, 1.f};
#pragma unroll
        for (int half = 1; half >= 0; --half) {
            f32x4 gv[4][4], dv[4];
#pragma unroll
            for (int q = 3; q >= 0; --q) { const int jp = 4 * half + q;
                if (jp < j && jp < 7) { dv[q] = *(const f32x4*)(dsp + jp * 64);
#pragma unroll
                    for (int e = 0; e < 4; ++e) gv[q][e] = *(const f32x4*)(gag + (size_t)jp * 8192 + (size_t)e * 32 * 64); } }
#pragma unroll
            for (int q = 3; q >= 0; --q) { const int jp = 4 * half + q;
                if (jp < j && jp < 7) {
#pragma unroll
                    for (int e = 0; e < 4; ++e) S[e] += dec * gv[q][e];
#pragma unroll
                    for (int x = 0; x < 4; ++x) dec[x] *= fexp(dv[q][x]); } }
        }
    }
#pragma nounroll
    for (int it = 0; it < NIT; ++it) {
        const int item = item0 + it, c = item & 31; const size_t row0 = (size_t)b * SEQ + 64 * c;
        const GlaIn cu = nx;
        if (it + 1 < NIT) gla_fetch<true>(F, nx, item + 1, hh, (size_t)b * SEQ + 64 * ((item + 1) & 31));
        float btot; gla_decay(F, cu.a1, w2, bias, btot);
        {
            const f32x4 bt = *(const LAS f32x4*)(F.lds + GL_BT + k4 * 4);
#pragma unroll
            for (int e = 0; e < 4; ++e) { u32x2 w; w.x = pk2(S[e][0], S[e][1]); w.y = pk2(S[e][2], S[e][3]); *(LAS u32x2*)(F.lds + GL_SP + (v0 + 32 * e) * 144 + k4 * 2) = w;
#pragma unroll
                for (int x = 0; x < 4; ++x) S[e][x] = fexp(bt[x]) * S[e][x] + cu.hc[e][x]; }
        }
        {
            const int i = tid >> 3, cc = tid & 7;
            const f32x4 b0 = *(const LAS f32x4*)(F.lds + GL_BC + (i * 68 + 8 * cc) * 4), b1 = *(const LAS f32x4*)(F.lds + GL_BC + (i * 68 + 8 * cc + 4) * 4);
            float qx[8], kx[8]; unpack8(cu.qb, qx); unpack8(cu.kb, kx);
#pragma unroll
            for (int e = 0; e < 4; ++e) { const float f0 = fexp(b0[e]), f1 = fexp(b1[e]); qx[e] *= f0; qx[4 + e] *= f1; kx[e] *= __builtin_amdgcn_rcpf(f0); kx[4 + e] *= __builtin_amdgcn_rcpf(f1); }
            *(LAS u32x4*)(F.lds + GL_QA + i * 144 + cc * 16) = pack8(qx);
            *(LAS u32x4*)(F.lds + GL_KB + i * 144 + cc * 16) = pack8(kx);
        }
        gla_store_vr(F, cu.vb0, cu.vb1);
        LDS_WAIT(); __syncthreads();
        const int r32 = lane & 31, hi = lane >> 5;
        if (F.wave < 4) {
            const int it2 = F.wave >> 1, jt = F.wave & 1;
            f32x16 acc;
#pragma unroll
            for (int i = 0; i < 16; ++i) acc[i] = 0.f;
            if (jt <= it2) {
#pragma unroll
                for (int q = 0; q < 4; ++q) {
                    const bf16x8 a = *(const LAS bf16x8*)(F.lds + GL_QA + (32 * it2 + r32) * 144 + (16 * q + 8 * hi) * 2);
                    const bf16x8 bb = *(const LAS bf16x8*)(F.lds + GL_KB + (32 * jt + r32) * 144 + (16 * q + 8 * hi) * 2);
                    acc = __builtin_amdgcn_mfma_f32_32x32x16_bf16(a, bb, acc, 0, 0, 0);
                }
            }
#pragma unroll
            for (int i = 0; i < 16; ++i) { const int ii = 32 * it2 + crow(i, hi), jj = 32 * jt + r32;
                *(LAS bf16_t*)(F.lds + GL_AM + ii * 144 + jj * 2) = (bf16_t)f2bf(jj <= ii ? acc[i] : 0.f); }
        }
        LDS_WAIT(); __syncthreads();
        {
            const int it2 = F.wave >> 2, vt = F.wave & 3;
            f32x16 acc;
#pragma unroll
            for (int i = 0; i < 16; ++i) acc[i] = 0.f;
            if (c > 0) {
#pragma unroll
                for (int q = 0; q < 4; ++q) {
                    const bf16x8 a = *(const LAS bf16x8*)(F.lds + GL_QA + (32 * it2 + r32) * 144 + (16 * q + 8 * hi) * 2);
                    const bf16x8 sb = *(const LAS bf16x8*)(F.lds + GL_SP + (32 * vt + r32) * 144 + (16 * q + 8 * hi) * 2);
                    acc = __builtin_amdgcn_mfma_f32_32x32x16_bf16(a, sb, acc, 0, 0, 0);
                }
            }
#pragma unroll
            for (int q = 0; q < 4; ++q) {
                const bf16x8 a = *(const LAS bf16x8*)(F.lds + GL_AM + (32 * it2 + r32) * 144 + (16 * q + 8 * hi) * 2);
                const bf16x8 bb = tr_frag(F.lds + GL_VR, 272, 32 * vt, q, lane);
                acc = __builtin_amdgcn_mfma_f32_32x32x16_bf16(a, bb, acc, 0, 0, 0);
            }
#pragma unroll
            for (int i = 0; i < 16; ++i) *(LAS float*)(F.lds + GL_O + ((32 * it2 + crow(i, hi)) * 132 + 32 * vt + r32) * 4) = acc[i];
        }
        LDS_WAIT(); __syncthreads();
        {
            const int i = tid >> 3, sub = tid & 7; const size_t rr = row0 + i;
            float o[16]; float ss = 0.f;
#pragma unroll
            for (int q = 0; q < 4; ++q) { const f32x4 x = *(const LAS f32x4*)(F.lds + GL_O + (i * 132 + 16 * sub + 4 * q) * 4);
#pragma unroll
                for (int e = 0; e < 4; ++e) { o[4 * q + e] = x[e]; ss += x[e] * x[e]; } }
            ss += __shfl_xor(ss, 1); ss += __shfl_xor(ss, 2); ss += __shfl_xor(ss, 4);
            const float rn = rsqrtf(ss * (1.0f / 128.0f) + EPS);
            const unsigned gw[8] = {cu.gb0.x, cu.gb0.y, cu.gb0.z, cu.gb0.w, cu.gb1.x, cu.gb1.y, cu.gb1.z, cu.gb1.w};
            const float* go = FIN(14) + 16 * sub;
            unsigned w[8];
#pragma unroll
            for (int e = 0; e < 8; ++e) { const float a = o[2 * e] * rn * go[2 * e] * siluf_(bflo(gw[e])), bq = o[2 * e + 1] * rn * go[2 * e + 1] * siluf_(bfhi(gw[e])); w[e] = pk2(a, bq); }
            u32x4* op = (u32x4*)(WSP(bf16_t, WS_A2) + rr * DM + 512 + hh * 128 + 16 * sub);
            op[0] = (u32x4){w[0], w[1], w[2], w[3]}; op[1] = (u32x4){w[4], w[5], w[6], w[7]};
        }
        LDS_WAIT(); __syncthreads();
    }
    if (((item0 >> 2) & 7) == 7) {
#pragma unroll
        for (int e = 0; e < 4; ++e)
#pragma unroll
            for (int x = 0; x < 4; ++x) F.out[OFF_SGP + ((size_t)bh * 64 + k4 + x) * 128 + v0 + 32 * e] = S[e][x];
    }
}
__device__ __forceinline__ void gla_sample_item(Frame& F, int item) {
    const int b = item >> 2, hh = item & 3, tid = F.tid, v = tid & 127, kq = tid >> 7;
    LAS float* red = (LAS float*)(F.lds); LAS float* part = (LAS float*)(F.lds + 4096);
    LAS float* decs = (LAS float*)(F.lds + 8192); LAS float* qs = decs + 256; LAS float* ks = qs + 256;
    if (tid < 256) {
        const int t = tid >> 6, k = tid & 63; const size_t row = (size_t)MPROMPT + 4 * b + t;
        float pre = FIN(13)[hh * 64 + k];
#pragma unroll
        for (int r = 0; r < 16; ++r) pre += WSP(float, WS_A1)[row * 16 + r] * FIN(12)[r * 256 + hh * 64 + k];
        decs[tid] = fexp(logsigf_(pre) * (1.0f / 16.0f));
        qs[tid] = bf2f(WSP(bf16_t, WS_QB)[row * 256 + hh * 64 + k]);
        ks[tid] = bf2f(WSP(bf16_t, WS_KB)[row * 256 + hh * 64 + k]);
    }
    float S[16];
    const float* s0 = FIN(4) + ((size_t)item * 64 + 16 * kq) * 128 + v;
#pragma unroll
    for (int e = 0; e < 16; ++e) S[e] = s0[e * 128];
    float vv4[4], gg4[4];
#pragma unroll
    for (int t = 0; t < DEC_T; ++t) { const size_t row = (size_t)MPROMPT + 4 * b + t; vv4[t] = bf2f(WSP(bf16_t, WS_VB)[row * 512 + hh * 128 + v]); gg4[t] = bf2f(WSP(bf16_t, WS_GB)[row * 512 + hh * 128 + v]); }
    const float gout = FIN(14)[v];
    LDS_WAIT(); __syncthreads();
#pragma unroll
    for (int t = 0; t < DEC_T; ++t) {
        const size_t row = (size_t)MPROMPT + 4 * b + t;
        const float vv = vv4[t];
        float op = 0.f;
#pragma unroll
        for (int e = 0; e < 16; ++e) { const int k = t * 64 + 16 * kq + e;
            S[e] = decs[k] * S[e] + ks[k] * vv; op += qs[k] * S[e]; }
        red[kq * 128 + v] = op;
        LDS_WAIT(); __syncthreads();
        const float o = (red[v] + red[128 + v]) + (red[256 + v] + red[384 + v]);
        const float sq = wave_sum(o * o);
        if (F.lane == 0) part[F.wave] = sq;
        LDS_WAIT(); __syncthreads();
        const float rn = rsqrtf((part[0] + part[1]) * (1.0f / 128.0f) + EPS);
        if (tid < 128) WSP(bf16_t, WS_A2)[row * DM + 512 + hh * 128 + v] = (bf16_t)f2bf(o * rn * gout * siluf_(gg4[t]));
        LDS_WAIT(); __syncthreads();
    }
    float* so = F.out + OFF_SGS + ((size_t)item * 64 + 16 * kq) * 128 + v;
#pragma unroll
    for (int e = 0; e < 16; ++e) so[e * 128] = S[e];
    LDS_WAIT(); __syncthreads();
}

__device__ __forceinline__ void final_norm(Frame& F) {
    const int gw = F.vcu * NWAVES + F.wave, NGW = F.G * NWAVES;
    const bf16_t* H4 = WSP(bf16_t, WS_A2); const unsigned* tot4 = TOT(F.ws, 4);
    f32x4 g[4];
#pragma unroll
    for (int j = 0; j < 4; ++j) g[j] = *((const f32x4*)FIN(22) + F.lane + 64 * j);
    for (int m = MPROMPT + gw; m < MTOT; m += NGW) {
        const float rs = rs_from_tot(tot4[m]);
#pragma unroll
        for (int j = 0; j < 4; ++j) { const u32x2 w = *((const u32x2*)(H4 + (size_t)m * DM) + F.lane + 64 * j);
            const f32x4 x = (f32x4){bflo(w.x), bfhi(w.x), bflo(w.y), bfhi(w.y)};
            __builtin_nontemporal_store(x * rs * g[j], (f32x4*)(F.out + OFF_Y + (size_t)m * DM) + F.lane + 64 * j); }
    }
}

constexpr int NPHASES = 12;
constexpr int CW_BAR = 4096;
__global__ void __launch_bounds__(NWAVES * 64, 2) fwd_kernel(Args args) {
    extern __shared__ __attribute__((aligned(16))) unsigned char lds_raw[];
    Frame F;
    F.lds = (LAS unsigned char*)lds_raw;
    F.tid = threadIdx.x; F.lane = F.tid & 63; F.wave = __builtin_amdgcn_readfirstlane(F.tid >> 6);
    F.G = gridDim.x; { const int bx = blockIdx.x; F.vcu = (F.G % 8 == 0) ? (bx % 8) * (F.G / 8) + bx / 8 : bx; }
    F.a = &args; F.out = args.out; F.ws = args.ws;
    volatile LAS unsigned* MISC = (volatile LAS unsigned*)(F.lds + MISC_OFF);
    for (int u = F.tid; u < (LDS_BYTES - LDSCTL_OFF) / 4; u += NWAVES * 64) ((LAS unsigned*)(F.lds + LDSCTL_OFF))[u] = 0u;
    __syncthreads();
    const int lo = args.ph_lo, hi = args.ph_hi;
    XcdBarrier bar; bar.bar = (unsigned*)(F.ws + WS_CTL) + CW_BAR; bar.x = 0; bar.st = nullptr;
    if (hi - lo > 1) bar = xcd_barrier_post((unsigned*)(F.ws + WS_CTL) + CW_BAR, MISC + 8);
#ifndef REP_MASK
#define REP_MASK 0
#endif

#ifndef PH_MASK
#define PH_MASK 0xFFF
#endif
#define IN(k) ((((PH_MASK) >> (k)) & 1) && lo <= (k) && (k) < hi)
#define SEAM(k) do { if (IN(k) && IN((k) + 1)) xcd_barrier(bar); } while (0)
    LAS unsigned char* ring = F.lds;
    CopyCur cp = copy_cursor_init(args.in[2], args.in[3], args.out, (int)blockIdx.x);
#define DRY_K(k) ((int)((((REP_MASK) >> 12) & 1) && (((REP_MASK) >> (k)) & 1) && rep_ == 0))
#define PHASE_BEGIN() do { F.tid = launder_v(threadIdx.x); F.lane = F.tid & 63; F.wave = __builtin_amdgcn_readfirstlane(F.tid >> 6); } while (0)

    if (IN(0)) for (int rep_ = 0; rep_ <= (((REP_MASK) >> 0) & 1); ++rep_) { if (rep_) xcd_barrier(bar); PHASE_BEGIN(); p0_prologue(F); } SEAM(0);
    if (IN(1)) for (int rep_ = 0; rep_ <= (((REP_MASK) >> 1) & 1); ++rep_) { if (rep_) xcd_barrier(bar); PHASE_BEGIN();
#ifndef NO_G1
        { pg8::Gemm g{WSP(bf16_t, WS_HB), WSP(bf16_t, WS_WGU1), MPROMPT, NGU, DM}; pg8::StaticOrder S; S.init(MPROMPT, NGU, F.G, (int)blockIdx.x);
          pg8::EpiSwiGLU<0> E{F.ws, 0};
          pg8::gemm_phase<pg8::EpiSwiGLU<0>, pg8::StaticOrder, true>(ring, g, S, E, cp); }
#endif
#ifndef NO_G8
        if ((int)blockIdx.x >= 128 || F.G != 256) { pg8::Gemm g{WSP(bf16_t, WS_PB), WSP(bf16_t, WS_WPP), MPROMPT, DM, DPLE}; pg8::StaticOrder S; if (F.G == 256) S.init(MPROMPT, DM, 128, (int)blockIdx.x - 128); else S.init(MPROMPT, DM, F.G, (int)blockIdx.x);
          pg8::EpiPlainBf16 E{F.ws, 0};
          pg8::gemm_phase<pg8::EpiPlainBf16, pg8::StaticOrder, true>(ring, g, S, E, cp); }
#endif
        { const sk::EpiSwiGLU<0> E{F.ws, 0}; for (int t = F.G - 1 - (int)blockIdx.x; t < 2 * (DFF / 32); t += F.G) sk::tile(WSP(bf16_t, WS_HB) + (size_t)MPROMPT * DM, DM, WSP(bf16_t, WS_WGU1), E, t, F.lane, F.wave, ring); }
        { const sk::EpiPlain E{F.ws, 0}; for (int t = F.G - 1 - 2 * (DFF / 32) - (int)blockIdx.x; t < 2 * (DM / 64); t += F.G) if (t >= 0) sk::tile(WSP(bf16_t, WS_PB) + (size_t)MPROMPT * DPLE, DPLE, WSP(bf16_t, WS_WPP), E, t, F.lane, F.wave, ring); }
        if ((int)blockIdx.x >= 128) convert_weights<1>(F, ((int)blockIdx.x - 128) * NWAVES + F.wave, 128 * NWAVES);
    } SEAM(1);
    if (IN(2)) for (int rep_ = 0; rep_ <= (((REP_MASK) >> 2) & 1); ++rep_) { if (rep_) xcd_barrier(bar); PHASE_BEGIN();
        pg8::Gemm g{WSP(bf16_t, WS_ACT), WSP(bf16_t, WS_WD1), MPROMPT, DM, DFF}; pg8::StaticOrder S; S.init(MPROMPT, DM, F.G, (int)blockIdx.x);
        pg8::EpiResid<0, 1, false> E{nullptr, F.ws, 0.5f, DRY_K(2)};
        pg8::gemm_phase<pg8::EpiResid<0, 1, false>, pg8::StaticOrder, true>(ring, g, S, E, cp);
        { const sk::EpiResid<0, 1, false> E2{nullptr, F.ws, 0.5f, DRY_K(2)}; for (int t = F.G - 1 - (int)blockIdx.x; t < 2 * (DM / 64); t += F.G) sk::tile(WSP(bf16_t, WS_ACT) + (size_t)MPROMPT * DFF, DFF, WSP(bf16_t, WS_WD1), E2, t, F.lane, F.wave, ring); }
    } SEAM(2);
    if (IN(3)) for (int rep_ = 0; rep_ <= (((REP_MASK) >> 3) & 1); ++rep_) { if (rep_) xcd_barrier(bar); PHASE_BEGIN();
        { pg8::Gemm g{WSP(bf16_t, WS_HB), WSP(bf16_t, WS_WIN), MPROMPT, 3072, DM}; pg8::StaticOrder S; S.init(MPROMPT, 3072, F.G, (int)blockIdx.x);
          pg8::EpiMix E{F.ws, F.out, 0, 0};
          pg8::gemm_phase<pg8::EpiMix, pg8::StaticOrder, true>(ring, g, S, E, cp); }
        { pg8::Gemm g{WSP(bf16_t, WS_HB), WSP(bf16_t, WS_WIN) + (size_t)3072 * DM, MPROMPT, 256, DM}; pg8::StaticOrder S; S.init(MPROMPT, 256, F.G, (int)blockIdx.x);
          pg8::EpiMix E{F.ws, F.out, 0, 12};
          pg8::gemm_phase<pg8::EpiMix, pg8::StaticOrder, true, true>(ring, g, S, E, cp); }
        { const sk::EpiMix E2{F.ws, F.out, 0}; for (int t = F.G - 1 - (int)blockIdx.x; t < 98; t += F.G) sk::tile(WSP(bf16_t, WS_HB) + (size_t)MPROMPT * DM, DM, WSP(bf16_t, WS_WIN), E2, t, F.lane, F.wave, ring); }
        if ((int)blockIdx.x >= 64) convert_weights<2>(F, ((int)blockIdx.x - 64) * NWAVES + F.wave, 192 * NWAVES);
    } SEAM(3);
    if (IN(4)) for (int rep_ = 0; rep_ <= (((REP_MASK) >> 4) & 1); ++rep_) { if (rep_) xcd_barrier(bar); PHASE_BEGIN();
        for (int it = F.vcu; it < 256; it += F.G) attn_prompt_item(F, it);
        for (int it = F.vcu; it < 256; it += F.G) gla_p1_items<4>(F, 4 * it);
    } if (IN(4) && IN(6)) xcd_barrier(bar);
    if (IN(6)) for (int rep_ = 0; rep_ <= (((REP_MASK) >> 6) & 1); ++rep_) { if (rep_) xcd_barrier(bar); PHASE_BEGIN();
        for (int it = F.vcu; it < 256; it += F.G) gla_p3_items<4>(F, 4 * it);
        for (int it = F.vcu; it < 128; it += F.G) gla_sample_item(F, it);
        for (int it = F.vcu; it < 256; it += F.G) attn_sample_task(F, (F.wave & 3) * 256 + it, F.wave >> 2);
    } if (IN(6) && IN(7)) xcd_barrier(bar);
    if (IN(7)) for (int rep_ = 0; rep_ <= (((REP_MASK) >> 7) & 1); ++rep_) { if (rep_) xcd_barrier(bar); PHASE_BEGIN();
        pg8::Gemm g{WSP(bf16_t, WS_A2), WSP(bf16_t, WS_WOUT), MPROMPT, DM, DM}; pg8::StaticOrder S; S.init(MPROMPT, DM, F.G, (int)blockIdx.x);
        pg8::EpiResid<0, 2, false> E{nullptr, F.ws, 1.0f, DRY_K(7)};
        pg8::gemm_phase<pg8::EpiResid<0, 2, false>, pg8::StaticOrder, true>(ring, g, S, E, cp);
        { const sk::EpiResid<0, 2, false> E2{nullptr, F.ws, 1.0f, DRY_K(7)}; for (int t = F.G - 1 - (int)blockIdx.x; t < 2 * (DM / 64); t += F.G) sk::tile(WSP(bf16_t, WS_A2) + (size_t)MPROMPT * DM, DM, WSP(bf16_t, WS_WOUT), E2, t, F.lane, F.wave, ring); }
    } SEAM(7);
    if (IN(8)) for (int rep_ = 0; rep_ <= (((REP_MASK) >> 8) & 1); ++rep_) { if (rep_) xcd_barrier(bar); PHASE_BEGIN();
        pg8::Gemm g{WSP(bf16_t, WS_HB), WSP(bf16_t, WS_WGU2), MPROMPT, NGU, DM}; pg8::StaticOrder S; S.init(MPROMPT, NGU, F.G, (int)blockIdx.x);
        pg8::EpiSwiGLU<2> E{F.ws, 0};
        pg8::gemm_phase<pg8::EpiSwiGLU<2>, pg8::StaticOrder, true>(ring, g, S, E, cp);
        { const sk::EpiSwiGLU<2> E2{F.ws, 0}; for (int t = F.G - 1 - (int)blockIdx.x; t < 2 * (DFF / 32); t += F.G) sk::tile(WSP(bf16_t, WS_HB) + (size_t)MPROMPT * DM, DM, WSP(bf16_t, WS_WGU2), E2, t, F.lane, F.wave, ring); }
    } SEAM(8);
    if (IN(9)) for (int rep_ = 0; rep_ <= (((REP_MASK) >> 9) & 1); ++rep_) { if (rep_) xcd_barrier(bar); PHASE_BEGIN();
        pg8::Gemm g{WSP(bf16_t, WS_ACT), WSP(bf16_t, WS_WD2), MPROMPT, DM, DFF}; pg8::StaticOrder S; S.init(MPROMPT, DM, F.G, (int)blockIdx.x);
        pg8::EpiResid<0, 3, false> E{nullptr, F.ws, 0.5f, DRY_K(9)};
        pg8::gemm_phase<pg8::EpiResid<0, 3, false>, pg8::StaticOrder, true>(ring, g, S, E, cp);
        { const sk::EpiResid<0, 3, false> E2{nullptr, F.ws, 0.5f, DRY_K(9)}; for (int t = F.G - 1 - (int)blockIdx.x; t < 2 * (DM / 64); t += F.G) sk::tile(WSP(bf16_t, WS_ACT) + (size_t)MPROMPT * DFF, DFF, WSP(bf16_t, WS_WD2), E2, t, F.lane, F.wave, ring); }
    } SEAM(9);
    if (IN(10)) for (int rep_ = 0; rep_ <= (((REP_MASK) >> 10) & 1); ++rep_) { if (rep_) xcd_barrier(bar); PHASE_BEGIN();
        pg8::Gemm g{WSP(bf16_t, WS_HB), WSP(bf16_t, WS_WPG), MPROMPT, DM, DM}; pg8::StaticOrder S; S.init(MPROMPT, DM, F.G, (int)blockIdx.x);
        pg8::EpiPleNorm E{F.ws, F.out, FIN(22), 32u * (unsigned)(rep_ + 1), DRY_K(10)};
        pg8::gemm_phase<pg8::EpiPleNorm, pg8::StaticOrder, true>(ring, g, S, E, cp);
        { const sk::EpiResid<1, 4, false> E2{nullptr, F.ws, 1.0f, DRY_K(10)}; for (int t = F.G - 1 - (int)blockIdx.x; t < 2 * (DM / 64); t += F.G) sk::tile(WSP(bf16_t, WS_HB) + (size_t)MPROMPT * DM, DM, WSP(bf16_t, WS_WPG), E2, t, F.lane, F.wave, ring); }
    } SEAM(10);
    if (IN(11)) for (int rep_ = 0; rep_ <= (((REP_MASK) >> 11) & 1); ++rep_) { if (rep_) xcd_barrier(bar); PHASE_BEGIN(); final_norm(F); copy_cleanup(cp, F.tid); }
#undef IN
#undef SEAM
}

extern "C" void kernel_launch(void* const* d_in, const int* in_sizes, int n_in, void* d_out, int out_size, void* d_ws, size_t ws_size, hipStream_t stream) {
    static int grid = 0;
    if (grid == 0) {
        if (n_in != 23 || (size_t)out_size != OUT_TOTAL || ws_size < WS_END) { fprintf(stderr, "kernel_launch: unexpected shapes: n_in %d out %d ws %zu (need %zu)\n", n_in, out_size, ws_size, (size_t)WS_END); grid = -1; return; }
        int dev = 0, cus = 0;
        if (hipGetDevice(&dev) != hipSuccess || hipDeviceGetAttribute(&cus, hipDeviceAttributeMultiprocessorCount, dev) != hipSuccess) { grid = -1; return; }
        if (hipFuncSetAttribute((const void*)fwd_kernel, hipFuncAttributeMaxDynamicSharedMemorySize, LDS_BYTES) != hipSuccess) { fprintf(stderr, "kernel_launch: hipFuncSetAttribute failed\n"); grid = -1; return; }
        int per_cu = 0;
        if (hipOccupancyMaxActiveBlocksPerMultiprocessor(&per_cu, (const void*)fwd_kernel, NWAVES * 64, LDS_BYTES) != hipSuccess || per_cu < 1) { fprintf(stderr, "kernel_launch: occupancy query says %d blocks per CU\n", per_cu); }
        (void)hipGetLastError();
        grid = cus;
        if (grid != 256) { fprintf(stderr, "kernel_launch: built for a 256-CU device (got %d CUs); nothing launched\n", cus); grid = -1; return; }
    }
    if (grid < 0) return;
    static_assert((CW_BAR + XCD_BAR_WORDS) * 4 <= 65536 && (pg8::CW_PANEL + 64 * 64) * 4 <= 65536, "control words inside the memset");
    (void)hipMemsetAsync((char*)d_ws + WS_CTL, 0, 65536, stream);
    Args a{};
    for (int i = 0; i < 23; ++i) a.in[i] = (const float*)d_in[i];
    a.out = (float*)d_out; a.ws = (unsigned char*)d_ws;
#if MK_PER_PHASE
    for (int p = 0; p < NPHASES; ++p) { a.ph_lo = p; a.ph_hi = p + 1; hipLaunchKernelGGL(fwd_kernel, dim3(grid), dim3(NWAVES * 64), LDS_BYTES, stream, a); }
#else
    a.ph_lo = 0; a.ph_hi = NPHASES;
    hipLaunchKernelGGL(fwd_kernel, dim3(grid), dim3(NWAVES * 64), LDS_BYTES, stream, a);
#endif
}
```

```cpp
#include <hip/hip_runtime.h>
#include <cstdio>
#include <cstdint>

#ifndef PROBE_EPI2
#define PROBE_EPI2 0
#endif
#ifndef PROBE_SK2
#define PROBE_SK2 0
#endif
#ifndef PROBE_VAR
#define PROBE_VAR 0
#endif
#ifndef MK_PER_PHASE
#define MK_PER_PHASE 0
#endif

#define LAS __attribute__((address_space(3)))
#define GAS __attribute__((address_space(1)))
typedef unsigned short bf16_t;
typedef short bf16x8 __attribute__((ext_vector_type(8)));
typedef short s16x4 __attribute__((ext_vector_type(4)));
typedef float f32x4 __attribute__((ext_vector_type(4)));
typedef float f32x2 __attribute__((ext_vector_type(2)));
typedef float f32x16 __attribute__((ext_vector_type(16)));
typedef unsigned u32x4 __attribute__((ext_vector_type(4)));
typedef unsigned u32x2 __attribute__((ext_vector_type(2)));

constexpr int DM = 1024, NBATCH = 8, SEQ = 2048, MPROMPT = NBATCH * SEQ, DEC_B = 32, DEC_T = 4, MSAMP = DEC_B * DEC_T;
constexpr int MTOT = MPROMPT + MSAMP  , MPAD = 16640  ;
constexpr int DFF = 2816, NGU = 2 * DFF, NPROJ = 3328  , DPLE = 256, PAST = 8192, WINB = 2048;
constexpr int HA = 8, HDA = 64, HB_ = 4, DKB = 64, DVB = 128;
constexpr float EPS = 1e-6f;
constexpr float C2Q = 0.125f * 1.4426950408889634f;
constexpr size_t OFF_Y = 0, OFF_KWP = (size_t)MTOT * DM, OFF_VWP = OFF_KWP + (size_t)MPROMPT * 512, OFF_SGP = OFF_VWP + (size_t)MPROMPT * 512,
                 OFF_KWS = OFF_SGP + (size_t)NBATCH * 4 * 64 * 128, OFF_VWS = OFF_KWS + (size_t)DEC_B * WINB * 512, OFF_SGS = OFF_VWS + (size_t)DEC_B * WINB * 512,
                 OUT_TOTAL = OFF_SGS + (size_t)DEC_B * 4 * 64 * 128;

constexpr size_t al256(size_t x) { return (x + 255) & ~(size_t)255; }
constexpr size_t WS_CTL = 0, CTL_BYTES = 1u << 20;
constexpr size_t WS_WGU1 = CTL_BYTES,                                   SZ_WGU = (size_t)NGU * DM * 2;
constexpr size_t WS_WGU2 = WS_WGU1 + SZ_WGU;
constexpr size_t WS_WD1 = WS_WGU2 + SZ_WGU,                             SZ_WD = (size_t)DM * DFF * 2;
constexpr size_t WS_WD2 = WS_WD1 + SZ_WD;
constexpr size_t WS_WIN = WS_WD2 + SZ_WD,                               SZ_WIN = (size_t)NPROJ * DM * 2;
constexpr size_t WS_WOUT = WS_WIN + SZ_WIN,                             SZ_W1K = (size_t)DM * DM * 2;
constexpr size_t WS_WPG = WS_WOUT + SZ_W1K;
constexpr size_t WS_WPP = WS_WPG + SZ_W1K,                              SZ_WPP = (size_t)DM * DPLE * 2;
constexpr size_t WS_HB = WS_WPP + SZ_WPP,                               SZ_HB = (size_t)MPAD * DM * 2;
constexpr size_t WS_ACT = WS_HB + SZ_HB,                                SZ_ACT = (size_t)MPAD * DFF * 2;
constexpr size_t WS_H32 = WS_ACT + SZ_ACT,                              SZ_H32 = (size_t)MPAD * DM * 4;
constexpr size_t WS_PROJ = WS_H32 + SZ_H32;
constexpr size_t WS_QA = WS_PROJ + SZ_HB,                               SZ_512 = (size_t)MPAD * 512 * 2, SZ_256 = (size_t)MPAD * 256 * 2;
constexpr size_t WS_KA = WS_QA + SZ_512, WS_VA = WS_KA + SZ_512, WS_QB = WS_VA + SZ_512, WS_KB = WS_QB + SZ_256, WS_VB = WS_KB + SZ_256, WS_GB = WS_VB + SZ_512;
constexpr size_t WS_A1 = WS_GB + SZ_512,                                SZ_A1 = (size_t)MPAD * 16 * 4;
constexpr size_t WS_A2 = WS_A1 + SZ_A1;
constexpr size_t WS_PB = WS_A2 + SZ_HB;
constexpr size_t WS_SSQ = WS_PB + SZ_256,                               SZ_SSQ = (size_t)MPAD * 16 * 4;
constexpr size_t WS_ROPE = WS_SSQ + 5 * SZ_SSQ,                         SZ_ROPE = al256((size_t)2052 * 16 * 4);
constexpr size_t WS_BTOT = WS_ROPE + SZ_ROPE,                           SZ_BTOT = (size_t)1024 * 64 * 4;
constexpr size_t WS_END = WS_BTOT + SZ_BTOT;
constexpr size_t WS_HCT = WS_ACT, SZ_HCT = (size_t)1024 * 8192 * 4;
constexpr size_t WS_SPT = WS_HCT + SZ_HCT, SZ_SPT = (size_t)1024 * 8192 * 2;
constexpr size_t WS_GAG = WS_SPT, WS_DSUM = WS_GAG + (size_t)256 * 8192 * 4;
static_assert(SZ_HCT + SZ_SPT <= SZ_ACT, "overlay fits");
static_assert(WS_END <= (size_t)500 * 1024 * 1024, "workspace budget");

constexpr int RING_BYTES = 131072, LDSCTL_OFF = RING_BYTES, MISC_OFF = LDSCTL_OFF + 320, LDS_BYTES = 147456;
constexpr int NWAVES = 8;

#define LDS_WAIT() asm volatile("s_waitcnt lgkmcnt(0)" ::: "memory")
#define VM_WAIT() asm volatile("s_waitcnt vmcnt(0)" ::: "memory")
__device__ __forceinline__ unsigned f2bf(float f) { unsigned u = __builtin_bit_cast(unsigned, f); return (u + 0x7fffu + ((u >> 16) & 1u)) >> 16; }
__device__ __forceinline__ unsigned pk2(float lo, float hi) { return f2bf(lo) | (f2bf(hi) << 16); }
typedef __bf16 bf16x2_t __attribute__((ext_vector_type(2)));
__device__ __forceinline__ unsigned cvt_pk_bf16(float lo, float hi) { const f32x2 v = {lo, hi}; return __builtin_bit_cast(unsigned, __builtin_convertvector(v, bf16x2_t)); }
__device__ __forceinline__ float bf2f(unsigned short b) { return __uint_as_float(((unsigned)b) << 16); }
__device__ __forceinline__ float bflo(unsigned w) { return __uint_as_float(w << 16); }
__device__ __forceinline__ float bfhi(unsigned w) { return __uint_as_float(w & 0xffff0000u); }
__device__ __forceinline__ float fexp(float x) { return __builtin_amdgcn_exp2f(x * 1.4426950408889634f); }
__device__ __forceinline__ float sigmoidf_(float x) { return __builtin_amdgcn_rcpf(1.f + fexp(-x)); }
__device__ __forceinline__ float siluf_(float x) { return x * sigmoidf_(x); }
__device__ __forceinline__ float logsigf_(float x) { return fminf(x, 0.f) - __logf(1.f + fexp(-fabsf(x))); }
__device__ __forceinline__ float wave_sum(float v) {
#pragma unroll
    for (int o = 1; o < 64; o <<= 1) v += __shfl_xor(v, o);
    return v;
}
__device__ __forceinline__ int launder_v(int x) { asm volatile("" : "+v"(x)); return x; }
template <class T> __device__ __forceinline__ T* launder_s(T* p) { asm volatile("" : "+s"(p)); return p; }
#define TOT(ws_, i) ((unsigned*)((ws_) + WS_SSQ + (size_t)(i) * SZ_SSQ))
constexpr float SSQ_SCALE = 16384.f, SSQ_INV = 1.0f / (16384.f * DM);
__device__ __forceinline__ float rs_from_tot(unsigned t) { return rsqrtf((float)t * SSQ_INV + EPS); }
__device__ __forceinline__ void ssq_add(unsigned* tot, int row, float ss) { __hip_atomic_fetch_add(tot + row, (unsigned)(ss * SSQ_SCALE + 0.5f), __ATOMIC_RELAXED, __HIP_MEMORY_SCOPE_AGENT); }
__device__ __forceinline__ float row_rs(const unsigned* tot, int row) { return rs_from_tot(tot[row]); }
__device__ __forceinline__ void row_tot8(const unsigned* tot, int row0, unsigned (&t)[2][4]) {
    const unsigned* p = tot + row0;
#pragma unroll
    for (int ai = 0; ai < 2; ++ai)
#pragma unroll
        for (int m = 0; m < 4; ++m) asm volatile("global_load_dword %0, %1, off offset:%2" : "=v"(t[ai][m]) : "v"(p), "n"((ai * 128 + m * 16) * 4) : "memory");
}

constexpr int CPQ_ELEMS = (WINB - DEC_T) * 128 / 4  , CP_STEPS = (CPQ_ELEMS + 511) / 512  ;
struct CopyCur { const f32x4* src; f32x4* dst; int it; };
__device__ __forceinline__ CopyCur copy_cursor_init(const float* ck, const float* cv, float* out, int w) {
    const int seg = w >> 2, q = w & 3, tensor = seg >> 5, b = seg & 31;
    CopyCur c; c.src = (const f32x4*)(tensor ? cv : ck) + (size_t)b * (WINB * 128) + DEC_T * 128 + (size_t)q * CPQ_ELEMS;
    c.dst = (f32x4*)(out + (tensor ? OFF_VWS : OFF_KWS)) + (size_t)b * (WINB * 128) + (size_t)q * CPQ_ELEMS; c.it = 0; return c;
}
__device__ __forceinline__ void copy_cleanup(CopyCur& c, int tid) {
    for (; c.it < CP_STEPS; ++c.it) { const int e = c.it * 512 + tid; if (e < CPQ_ELEMS) __builtin_nontemporal_store(__builtin_nontemporal_load(c.src + e), c.dst + e); }
}

namespace pg8 {
constexpr int BM = 256, BK = 64, HALF = 128, HTB = HALF * BK * 2, STAGE_BYTES = 8 * HTB, NXCD = 8, WGM = 8;
__host__ __device__ __forceinline__ int lds_byte(int r, int c) { const int st = (r >> 4) * 2 + (c >> 5), rr = r & 15, cc = c & 31, ob = rr * 64 + cc * 2; return st * 1024 + (ob ^ (((ob >> 9) & 1) << 5)); }
__host__ __device__ __forceinline__ void stage_rc(int b, int& R, int& C) { const int st = b / 1024, sb = b % 1024, swz = sb ^ (((sb >> 9) & 1) << 5); R = (st >> 1) * 16 + swz / 64; C = (st & 1) * 32 + (swz % 64) / 2; }
__host__ __device__ __forceinline__ int perm32(int rho) { const int n = rho >> 4, i = rho & 15; return 8 * (i >> 2) + 4 * n + (i & 3); }
struct Unit { int pm, pn; };
struct Gemm { const bf16_t* A; const bf16_t* Bt; int M, N, K; int ld = 0; };
struct StaticOrder {
    int nM, nN, nwg, G, c, same;
    __host__ __device__ void init(int M, int N, int G_, int c_) { nM = M / BM; nN = N / BM; nwg = nM * nN; G = G_; c = c_; same = 0; }
    __host__ __device__ bool next(int i, Unit& u) const {
        const long L = (long)i * G + c; if (L >= nwg) return false;
        int wgid = (int)L; { const int q = nwg / NXCD, r = nwg % NXCD, xcd = wgid % NXCD, off = wgid / NXCD; wgid = (xcd < r ? xcd * (q + 1) : r * (q + 1) + (xcd - r) * q) + off; }
        const int nig = WGM * nN, gid = wgid / nig, fm = gid * WGM, gsz = (nM - fm) < WGM ? (nM - fm) : WGM;
        u.pm = fm + ((wgid % nig) % gsz); u.pn = (wgid % nig) / gsz;
#if PROBE_VAR == 5
        if (same) { u.pm = c & 7; u.pn = 0; }
#endif
        return true;
    }
    __device__ __forceinline__ void a_ready(const Unit&) const {}
    __device__ __forceinline__ void done(const Unit&) const {}
};

template <class Epi, class Sched, bool ALIGN_EPI, bool LITE = false>
__device__ __forceinline__ void gemm_phase(LAS unsigned char* lds, const Gemm g, const Sched& S, const Epi& E, CopyCur& cp) {
    const int tid = launder_v(threadIdx.x), wid = __builtin_amdgcn_readfirstlane(tid >> 6), lane = tid & 63, wr = wid >> 2, wc = wid & 3, fr = lane & 15, fq = lane >> 4;
    const int nt = g.K / BK, K = g.ld ? g.ld : g.K;
    unsigned voffA[2], voffB[2];
#pragma unroll
    for (int i = 0; i < 2; ++i) { int R, C; stage_rc(tid * 16 + i * 8192, R, C); const int Rb = Epi::PERM ? ((R & ~31) + perm32(R & 31)) : R;
        voffA[i] = (unsigned)(R * K + C) * 2u; voffB[i] = (unsigned)(Rb * K + C) * 2u; }
    const size_t kstep = (size_t)(BK * 2);
    const size_t hstep = (size_t)HALF * K * 2;
    const size_t tstep = 2 * hstep;
    const unsigned ldsw = (unsigned)wid * 1024u;
    const int aoff = lds_byte(wr * 64 + fr, fq * 8), boff = lds_byte(wc * 32 + fr, fq * 8);
#define PG8_SA(b, h) (((b) * 2 + (h)) * HTB)
#define PG8_SB(b, h) ((4 + (b) * 2 + (h)) * HTB)
#define PG8_STAGE(bufoff, gbase, voff) do { _Pragma("unroll") for (int _i = 0; _i < 2; ++_i) \
        __builtin_amdgcn_global_load_lds((const unsigned*)((const char*)(gbase) + (voff)[_i]), (LAS unsigned*)(lds + (bufoff) + ldsw + _i * 8192), 16, 0, 0); } while (0)
#define PG8_LDA(dst, b, h) do { _Pragma("unroll") for (int m = 0; m < 4; ++m) _Pragma("unroll") for (int k = 0; k < 2; ++k) dst[m][k] = *(const LAS bf16x8*)(lds + PG8_SA(b, h) + aoff + m * 2048 + k * 1024); } while (0)
#define PG8_LDB(dst, b, h) do { _Pragma("unroll") for (int n = 0; n < 2; ++n) _Pragma("unroll") for (int k = 0; k < 2; ++k) dst[n][k] = *(const LAS bf16x8*)(lds + PG8_SB(b, h) + boff + n * 2048 + k * 1024); } while (0)
#define PG8_MMA(ai, bj, At, Bt) do { if (LITE && ((bj) != 0 || wc != 0)) break; __builtin_amdgcn_s_setprio(1); _Pragma("unroll") for (int m = 0; m < 4; ++m) _Pragma("unroll") for (int n = 0; n < 2; ++n) _Pragma("unroll") for (int k = 0; k < 2; ++k) \
        acc[ai][bj][m][n] = __builtin_amdgcn_mfma_f32_16x16x32_bf16(Bt[n][k], At[m][k], acc[ai][bj][m][n], 0, 0, 0); __builtin_amdgcn_s_setprio(0); } while (0)
#define PG8_WAIT_V(n) asm volatile("s_waitcnt vmcnt(" #n ")" ::: "memory")
#define PG8_WAIT_VC() do { if (ncp == 0) PG8_WAIT_V(8); else if (ncp == 1) PG8_WAIT_V(9); else PG8_WAIT_V(10); } while (0)
#define PG8_WAIT_L(n) asm volatile("s_waitcnt lgkmcnt(" #n ")" ::: "memory")
#define PG8_BAR __builtin_amdgcn_s_barrier()
#define PG8_SCHED __builtin_amdgcn_sched_barrier(0)
    Unit cur, nxt; int ui = 0;
    if (!S.next(0, cur)) return;
    unsigned pre[2][4] = {{0u, 0u, 0u, 0u}, {0u, 0u, 0u, 0u}};
    if constexpr (Epi::PRE) E.prefetch(cur, wr, fr, pre);
    f32x4 acc[2][2][4][2];
#pragma unroll
    for (int a = 0; a < 2; ++a)
#pragma unroll
        for (int b = 0; b < 2; ++b)
#pragma unroll
            for (int m = 0; m < 4; ++m)
#pragma unroll
                for (int n = 0; n < 2; ++n) acc[a][b][m][n] = (f32x4){0.f, 0.f, 0.f, 0.f};
    bf16x8 At[4][2], B0[2][2], B1[2][2];
    f32x4 cp_data = (f32x4){0.f, 0.f, 0.f, 0.f}; int cp_e = 0; bool cp_pending = false;
    const char* cA = (const char*)g.A + (size_t)cur.pm * tstep; const char* cB = (const char*)g.Bt + (size_t)cur.pn * tstep;
    S.a_ready(cur);
    PG8_STAGE(PG8_SB(0, 0), cB, voffB); PG8_STAGE(PG8_SB(0, 1), cB + hstep, voffB); PG8_STAGE(PG8_SA(0, 0), cA, voffA); PG8_STAGE(PG8_SA(0, 1), cA + hstep, voffA);
    if (wr == 1) PG8_BAR;
    PG8_WAIT_V(2); PG8_BAR;
    PG8_STAGE(PG8_SB(1, 0), cB + kstep, voffB); PG8_STAGE(PG8_SA(1, 0), cA + kstep, voffA); PG8_STAGE(PG8_SB(1, 1), cB + hstep + kstep, voffB);
    PG8_WAIT_V(6); PG8_BAR;
    for (;;) {
        const bool has_next = S.next(ui + 1, nxt);
        const char* nA = has_next ? (const char*)g.A + (size_t)nxt.pm * tstep : cA; const char* nB = has_next ? (const char*)g.Bt + (size_t)nxt.pn * tstep : cB;
#pragma nounroll
        for (int t = 0; t < nt; t += 2) {
            const bool last = (t == nt - 2);
            const char* a1 = cA + (size_t)(t + 1) * kstep;
            const char* a2 = last ? nA : cA + (size_t)(t + 2) * kstep; const char* b2 = last ? nB : cB + (size_t)(t + 2) * kstep;
            const char* a3 = a2 + kstep; const char* b3 = b2 + kstep;
            if (last && has_next) S.a_ready(nxt);
            PG8_LDB(B0, 0, 0); PG8_LDB(B1, 0, 1); PG8_SCHED; PG8_LDA(At, 0, 0); PG8_STAGE(PG8_SA(1, 1), a1 + hstep, voffA);
            int ncp = 0;
            if (cp_pending) { asm volatile("global_store_dwordx4 %0, %1, off nt\n\ts_nop 1" :: "v"(cp.dst + cp_e), "v"(cp_data) : "memory"); ncp = 1; cp_pending = false; }
            if (cp.it < CP_STEPS && !last) {
                cp_e = cp.it * 512 + tid; ++cp.it;
                if (cp.it * 512 - 512 + wid * 64 < CPQ_ELEMS) { asm volatile("global_load_dwordx4 %0, %1, off nt" : "=v"(cp_data) : "v"(cp.src + cp_e) : "memory"); ++ncp; cp_pending = true; }
            }
            PG8_WAIT_VC(); PG8_WAIT_L(0); PG8_BAR; PG8_MMA(0, 0, At, B0); PG8_MMA(0, 1, At, B1); PG8_BAR; PG8_SCHED;
            PG8_LDA(At, 0, 1); PG8_STAGE(PG8_SB(0, 0), b2, voffB); PG8_STAGE(PG8_SB(0, 1), b2 + hstep, voffB); PG8_STAGE(PG8_SA(0, 0), a2, voffA);
            PG8_WAIT_VC(); PG8_WAIT_L(0); PG8_BAR; PG8_MMA(1, 0, At, B0); PG8_MMA(1, 1, At, B1); PG8_BAR; PG8_SCHED;
            PG8_LDB(B0, 1, 0); PG8_LDB(B1, 1, 1); PG8_SCHED; PG8_LDA(At, 1, 0); PG8_STAGE(PG8_SA(0, 1), a2 + hstep, voffA);
            PG8_WAIT_VC(); PG8_WAIT_L(0); PG8_BAR; PG8_MMA(0, 0, At, B0); PG8_MMA(0, 1, At, B1); PG8_BAR; PG8_SCHED;
            PG8_LDA(At, 1, 1); PG8_STAGE(PG8_SB(1, 0), b3, voffB); PG8_STAGE(PG8_SB(1, 1), b3 + hstep, voffB); PG8_STAGE(PG8_SA(1, 0), a3, voffA);
            PG8_WAIT_V(8); PG8_WAIT_L(0); PG8_BAR; PG8_MMA(1, 0, At, B0); PG8_MMA(1, 1, At, B1); PG8_BAR; PG8_SCHED;
        }
        if constexpr (ALIGN_EPI) { if (wr == 0) PG8_BAR; }
#if PROBE_EPI2
        if constexpr (Epi::PROBE2) { Epi Ed = E; Ed.dry = 1; Ed(acc, cur, wr, wc, fr, fq, pre); asm volatile("s_waitcnt vmcnt(0)" ::: "memory"); }
#endif
        if constexpr (Epi::PRE) {
#pragma unroll
            for (int a = 0; a < 2; ++a)
#pragma unroll
                for (int m = 0; m < 4; ++m) asm volatile("" : "+v"(pre[a][m]));
        }
        E(acc, cur, wr, wc, fr, fq, pre); S.done(cur);
        if (!has_next) break;
        if constexpr (Epi::PRE) E.prefetch(nxt, wr, fr, pre);
#pragma unroll
        for (int a = 0; a < 2; ++a)
#pragma unroll
            for (int b = 0; b < 2; ++b)
#pragma unroll
                for (int m = 0; m < 4; ++m)
#pragma unroll
                    for (int n = 0; n < 2; ++n) acc[a][b][m][n] = (f32x4){0.f, 0.f, 0.f, 0.f};
        cur = nxt; cA = nA; cB = nB; ++ui;
        if constexpr (ALIGN_EPI) { if (wr == 1) PG8_BAR; }
    }
    PG8_WAIT_V(0);
    if constexpr (!ALIGN_EPI) { if (wr == 0) PG8_BAR; }
    PG8_BAR;
#undef PG8_SA
#undef PG8_SB
#undef PG8_STAGE
#undef PG8_LDA
#undef PG8_LDB
#undef PG8_MMA
#undef PG8_WAIT_V
#undef PG8_WAIT_VC
#undef PG8_WAIT_L
#undef PG8_BAR
#undef PG8_SCHED
}


template <int SSQI> struct EpiSwiGLU {
    static constexpr bool PERM = true, PROBE2 = true, PRE = true;
    unsigned char* ws; int dry;
    __device__ __forceinline__ void prefetch(const Unit& u, int wr, int fr, unsigned (&pre)[2][4]) const { row_tot8(TOT(ws, SSQI), u.pm * BM + wr * 64 + fr, pre); }
    __device__ __forceinline__ void operator()(const f32x4 (&acc)[2][2][4][2], const Unit& u, int wr, int wc, int fr, int fq, const unsigned (&pre)[2][4]) const {
        bf16_t* O = (bf16_t*)(ws + WS_ACT);
        const int row0 = u.pm * BM + wr * 64 + fr, col0 = u.pn * 128 + wc * 32 + 8 * fq;
#pragma unroll
        for (int ai = 0; ai < 2; ++ai)
#pragma unroll
            for (int m = 0; m < 4; ++m) {
                const int row = row0 + ai * HALF + m * 16; const float rs = rs_from_tot(pre[ai][m]);
                float o[8];
#pragma unroll
                for (int n = 0; n < 2; ++n)
#pragma unroll
                    for (int j = 0; j < 4; ++j) { const float gt = acc[ai][0][m][n][j] * rs, up = acc[ai][1][m][n][j] * rs; o[n * 4 + j] = siluf_(gt) * up; }
                u32x4 w; w.x = cvt_pk_bf16(o[0], o[1]); w.y = cvt_pk_bf16(o[2], o[3]); w.z = cvt_pk_bf16(o[4], o[5]); w.w = cvt_pk_bf16(o[6], o[7]);
                *(u32x4*)(O + (size_t)row * DFF + col0) = w;
            }
    }
};
struct EpiPlainBf16 {
    static constexpr bool PERM = true, PROBE2 = true, PRE = false;
    unsigned char* ws; int dry;
    __device__ __forceinline__ void operator()(const f32x4 (&acc)[2][2][4][2], const Unit& u, int wr, int wc, int fr, int fq, const unsigned (&)[2][4]) const {
        bf16_t* O = (bf16_t*)(ws + WS_PROJ); constexpr int ldc = DM;
        const int row0 = u.pm * BM + wr * 64 + fr, col0 = u.pn * BM + wc * 32 + 8 * fq;
#pragma unroll
        for (int ai = 0; ai < 2; ++ai)
#pragma unroll
            for (int m = 0; m < 4; ++m) { bf16_t* rowp = O + (size_t)(row0 + ai * HALF + m * 16) * ldc + col0;
#pragma unroll
                for (int bj = 0; bj < 2; ++bj) { const f32x4 v0 = acc[ai][bj][m][0], v1 = acc[ai][bj][m][1];
                    u32x4 w; w.x = cvt_pk_bf16(v0[0], v0[1]); w.y = cvt_pk_bf16(v0[2], v0[3]); w.z = cvt_pk_bf16(v1[0], v1[1]); w.w = cvt_pk_bf16(v1[2], v1[3]);
                    *(u32x4*)(rowp + bj * HALF) = w; } }
    }
};
template <int MODE  , int SSQO, bool FROM_X  > struct EpiResid {
    static constexpr bool PERM = true, PROBE2 = true, PRE = false;
    const float* xP; unsigned char* ws; float scale; int dry;
    __device__ __forceinline__ void operator()(const f32x4 (&acc)[2][2][4][2], const Unit& u, int wr, int wc, int fr, int fq, const unsigned (&)[2][4]) const {
        bf16_t* HBp = (bf16_t*)(ws + WS_HB); unsigned* ssq_out = TOT(ws, SSQO);
        const int col0 = u.pn * BM + wc * 32 + 8 * fq, row00 = u.pm * BM + wr * 64 + fr;
        u32x4 bn_[2];
#pragma unroll
        for (int bj = 0; bj < 2; ++bj) bn_[bj] = *(const u32x4*)(HBp + (size_t)row00 * DM + col0 + bj * HALF);
#pragma unroll
        for (int ai = 0; ai < 2; ++ai)
#pragma unroll
            for (int m = 0; m < 4; ++m) {
                const int row = row00 + ai * HALF + m * 16;
                u32x4 bc[2];
#pragma unroll
                for (int bj = 0; bj < 2; ++bj) bc[bj] = bn_[bj];
                if (ai * 4 + m < 7) { const int rown = row00 + ((ai * 4 + m + 1) >> 2) * HALF + ((ai * 4 + m + 1) & 3) * 16;
#pragma unroll
                    for (int bj = 0; bj < 2; ++bj) bn_[bj] = *(const u32x4*)(HBp + (size_t)rown * DM + col0 + bj * HALF); }
                float ss = 0.f;
#pragma unroll
                for (int bj = 0; bj < 2; ++bj) {
                    const u32x4 w0 = bc[bj];
                    const f32x4 v0 = (f32x4){bflo(w0.x), bfhi(w0.x), bflo(w0.y), bfhi(w0.y)} + acc[ai][bj][m][0] * scale;
                    const f32x4 v1 = (f32x4){bflo(w0.z), bfhi(w0.z), bflo(w0.w), bfhi(w0.w)} + acc[ai][bj][m][1] * scale;
                    if (!dry) { u32x4 w; w.x = cvt_pk_bf16(v0[0], v0[1]); w.y = cvt_pk_bf16(v0[2], v0[3]); w.z = cvt_pk_bf16(v1[0], v1[1]); w.w = cvt_pk_bf16(v1[2], v1[3]);
                        *(u32x4*)(HBp + (size_t)row * DM + col0 + bj * HALF) = w; }
                    ss += ((v0[0] * v0[0] + v0[1] * v0[1]) + (v0[2] * v0[2] + v0[3] * v0[3])) + ((v1[0] * v1[0] + v1[1] * v1[1]) + (v1[2] * v1[2] + v1[3] * v1[3])); }
                ss += __shfl_xor(ss, 16); ss += __shfl_xor(ss, 32);
                if (fq == 0 && !dry) ssq_add(ssq_out, row, ss);
            }
    }
};
constexpr int CW_PANEL = 8192;
struct EpiPleNorm {
    static constexpr bool PERM = true, PROBE2 = false, PRE = true;
    unsigned char* ws; float* out; const float* gfin; unsigned want; int dry;
    __device__ __forceinline__ void prefetch(const Unit& u, int wr, int fr, unsigned (&pre)[2][4]) const { row_tot8(TOT(ws, 3), u.pm * BM + wr * 64 + fr, pre); }
    __device__ __forceinline__ void operator()(f32x4 (&acc)[2][2][4][2], const Unit& u, int wr, int wc, int fr, int fq, const unsigned (&pre)[2][4]) const {
        const bf16_t* HBp = (const bf16_t*)(ws + WS_HB); const bf16_t* proj = (const bf16_t*)(ws + WS_PROJ);
        unsigned* ssq4 = TOT(ws, 4);
        const int col0 = u.pn * BM + wc * 32 + 8 * fq, row00 = u.pm * BM + wr * 64 + fr;
        u32x4 pn_[2], bn_[2];
#pragma unroll
        for (int bj = 0; bj < 2; ++bj) { pn_[bj] = *(const u32x4*)(proj + (size_t)row00 * DM + col0 + bj * HALF); bn_[bj] = *(const u32x4*)(HBp + (size_t)row00 * DM + col0 + bj * HALF); }
#pragma unroll
        for (int ai = 0; ai < 2; ++ai)
#pragma unroll
            for (int m = 0; m < 4; ++m) {
                const int row = row00 + ai * HALF + m * 16;
                const float rs = rs_from_tot(pre[ai][m]);
                u32x4 pc[2], bc[2];
#pragma unroll
                for (int bj = 0; bj < 2; ++bj) { pc[bj] = pn_[bj]; bc[bj] = bn_[bj]; }
                if (ai * 4 + m < 7) { const int rown = row00 + ((ai * 4 + m + 1) >> 2) * HALF + ((ai * 4 + m + 1) & 3) * 16;
#pragma unroll
                    for (int bj = 0; bj < 2; ++bj) { pn_[bj] = *(const u32x4*)(proj + (size_t)rown * DM + col0 + bj * HALF); bn_[bj] = *(const u32x4*)(HBp + (size_t)rown * DM + col0 + bj * HALF); } }
                float ss = 0.f;
#pragma unroll
                for (int bj = 0; bj < 2; ++bj) {
                    const u32x4 b0 = bc[bj], p0 = pc[bj];
                    const f32x4 a0 = acc[ai][bj][m][0] * rs, a1 = acc[ai][bj][m][1] * rs; f32x4 v0, v1;
                    v0[0] = bflo(b0.x) + sigmoidf_(a0[0]) * bflo(p0.x); v0[1] = bfhi(b0.x) + sigmoidf_(a0[1]) * bfhi(p0.x); v0[2] = bflo(b0.y) + sigmoidf_(a0[2]) * bflo(p0.y); v0[3] = bfhi(b0.y) + sigmoidf_(a0[3]) * bfhi(p0.y);
                    v1[0] = bflo(b0.z) + sigmoidf_(a1[0]) * bflo(p0.z); v1[1] = bfhi(b0.z) + sigmoidf_(a1[1]) * bfhi(p0.z); v1[2] = bflo(b0.w) + sigmoidf_(a1[2]) * bflo(p0.w); v1[3] = bfhi(b0.w) + sigmoidf_(a1[3]) * bfhi(p0.w);
                    acc[ai][bj][m][0] = v0; acc[ai][bj][m][1] = v1;
                    ss += ((v0[0] * v0[0] + v0[1] * v0[1]) + (v0[2] * v0[2] + v0[3] * v0[3])) + ((v1[0] * v1[0] + v1[1] * v1[1]) + (v1[2] * v1[2] + v1[3] * v1[3])); }
                ss += __shfl_xor(ss, 16); ss += __shfl_xor(ss, 32);
                if (fq == 0 && !dry) ssq_add(ssq4, row, ss);
            }
        asm volatile("s_waitcnt vmcnt(0)" ::: "memory");
        unsigned* cnt = (unsigned*)(ws + WS_CTL) + CW_PANEL + 64 * u.pm;
        if (fr == 0 && fq == 0) __hip_atomic_fetch_add(cnt, 1u, __ATOMIC_RELAXED, __HIP_MEMORY_SCOPE_AGENT);
        if (wr == 0 && wc == 0) {
            unsigned sp = 0;
            while ((unsigned)__builtin_amdgcn_readfirstlane(__hip_atomic_load(cnt, __ATOMIC_RELAXED, __HIP_MEMORY_SCOPE_AGENT)) < want) { __builtin_amdgcn_s_sleep(2); if (++sp > (1u << 20)) break; }
        }
        asm volatile("s_waitcnt vmcnt(0) lgkmcnt(0)" ::: "memory"); __builtin_amdgcn_s_barrier(); asm volatile("" ::: "memory");
        f32x4 g[2][2];
#pragma unroll
        for (int bj = 0; bj < 2; ++bj)
#pragma unroll
            for (int n = 0; n < 2; ++n) g[bj][n] = *(const f32x4*)(gfin + col0 + bj * HALF + n * 4);
#pragma unroll
        for (int ai = 0; ai < 2; ++ai)
#pragma unroll
            for (int m = 0; m < 4; ++m) {
                const int row = row00 + ai * HALF + m * 16;
                const float rs4 = rs_from_tot(__hip_atomic_load(ssq4 + row, __ATOMIC_RELAXED, __HIP_MEMORY_SCOPE_AGENT));
                if (!dry) {
#pragma unroll
                    for (int bj = 0; bj < 2; ++bj)
#pragma unroll
                        for (int n = 0; n < 2; ++n) __builtin_nontemporal_store(acc[ai][bj][m][n] * rs4 * g[bj][n], (f32x4*)(out + OFF_Y + (size_t)row * DM + col0 + bj * HALF + n * 4));
                }
            }
    }
};
struct EpiMix {
    static constexpr bool PERM = true, PROBE2 = true, PRE = true;
    unsigned char* ws; float* out; int dry; int pn_base;
    __device__ __forceinline__ void prefetch(const Unit& u, int wr, int fr, unsigned (&pre)[2][4]) const { row_tot8(TOT(ws, 1), u.pm * BM + wr * 64 + fr, pre); }
    __device__ __forceinline__ void operator()(const f32x4 (&acc)[2][2][4][2], const Unit& u, int wr, int wc, int fr, int fq, const unsigned (&pre)[2][4]) const {
        const float* rope = (const float*)(ws + WS_ROPE);
        bf16_t *QA = (bf16_t*)(ws + WS_QA), *KA = (bf16_t*)(ws + WS_KA), *VA = (bf16_t*)(ws + WS_VA), *QB = (bf16_t*)(ws + WS_QB), *KB = (bf16_t*)(ws + WS_KB), *VB = (bf16_t*)(ws + WS_VB), *GB = (bf16_t*)(ws + WS_GB);
        float* A1 = (float*)(ws + WS_A1);
        const int pn = u.pn + pn_base;
        if (pn == 12 && wc != 0) return;
        const bool do_rope = (pn < 4) && ((wc & 1) == 0);
        const int row00 = u.pm * BM + wr * 64 + fr, cb = wc * 32 + 8 * fq;
        f32x4 tn[4];
#pragma unroll
        for (int k = 0; k < 4; ++k) tn[k] = (f32x4){0.f, 0.f, 0.f, 0.f};
        if (do_rope) { const int posidx = row00 & (SEQ - 1);
#pragma unroll
            for (int k = 0; k < 4; ++k) tn[k] = *(const f32x4*)(rope + (size_t)posidx * 16 + 4 * k); }
#pragma unroll
        for (int ai = 0; ai < 2; ++ai)
#pragma unroll
            for (int m = 0; m < 4; ++m) {
                const int row = row00 + ai * HALF + m * 16;
                const float rs = rs_from_tot(pre[ai][m]);
                f32x4 v[2][2];
#pragma unroll
                for (int bj = 0; bj < 2; ++bj)
#pragma unroll
                    for (int n = 0; n < 2; ++n) v[bj][n] = acc[ai][bj][m][n] * rs;
                if (do_rope) {
                    f32x4 t[4];
#pragma unroll
                    for (int k = 0; k < 4; ++k) t[k] = tn[k];
                    if (ai * 4 + m < 7) { const int rown = row00 + ((ai * 4 + m + 1) >> 2) * HALF + ((ai * 4 + m + 1) & 3) * 16; const int posn = rown & (SEQ - 1);
#pragma unroll
                        for (int k = 0; k < 4; ++k) tn[k] = *(const f32x4*)(rope + (size_t)posn * 16 + 4 * k); }
#pragma unroll
                    for (int bj = 0; bj < 2; ++bj)
#pragma unroll
                        for (int n = 0; n < 2; ++n)
#pragma unroll
                            for (int j = 0; j < 4; ++j) { const float cs = t[2 * n + (j >> 1)][2 * (j & 1)], sn = t[2 * n + (j >> 1)][2 * (j & 1) + 1];
                                const float x = v[bj][n][j], w = __shfl_xor(x, 16);
                                if (fq < 2) v[bj][n][j] = (fq == 0) ? (x * cs - w * sn) : (x * cs + w * sn); }
                }
                if (pn < 6) {
                    const int kind = pn >> 1, c0 = (pn & 1) * 256 + cb;
                    bf16_t* dst = (kind == 0 ? QA : (kind == 1 ? KA : VA)) + (size_t)row * 512 + c0;
                    const float sc = kind == 0 ? C2Q : 1.f;
                    float* fo = kind == 0 ? nullptr : out + (kind == 1 ? OFF_KWP : OFF_VWP) + (size_t)row * 512 + c0;
#pragma unroll
                    for (int bj = 0; bj < 2; ++bj) { const f32x4 x0 = v[bj][0], x1 = v[bj][1];
                        u32x4 w; w.x = cvt_pk_bf16(x0[0] * sc, x0[1] * sc); w.y = cvt_pk_bf16(x0[2] * sc, x0[3] * sc); w.z = cvt_pk_bf16(x1[0] * sc, x1[1] * sc); w.w = cvt_pk_bf16(x1[2] * sc, x1[3] * sc);
                        *(u32x4*)(dst + bj * HALF) = w;
                        if (fo) { __builtin_nontemporal_store(x0, (f32x4*)(fo + bj * HALF)); __builtin_nontemporal_store(x1, (f32x4*)(fo + bj * HALF + 4)); } }
                } else if (pn < 12) {
                    bf16_t* dst; float sc = 1.f;
                    if (pn == 6) { dst = QB + (size_t)row * 256; sc = 0.125f; }
                    else if (pn == 7) dst = KB + (size_t)row * 256;
                    else if (pn < 10) dst = VB + (size_t)row * 512 + (pn - 8) * 256;
                    else dst = GB + (size_t)row * 512 + (pn - 10) * 256;
                    dst += cb;
#pragma unroll
                    for (int bj = 0; bj < 2; ++bj) { const f32x4 x0 = v[bj][0] * sc, x1 = v[bj][1] * sc;
                        u32x4 w; w.x = cvt_pk_bf16(x0[0], x0[1]); w.y = cvt_pk_bf16(x0[2], x0[3]); w.z = cvt_pk_bf16(x1[0], x1[1]); w.w = cvt_pk_bf16(x1[2], x1[3]);
                        *(u32x4*)(dst + bj * HALF) = w; }
                } else if (fq < 2) {
                    *(f32x4*)(A1 + (size_t)row * 16 + 8 * fq) = v[0][0]; *(f32x4*)(A1 + (size_t)row * 16 + 8 * fq + 4) = v[0][1];
                }
            }
    }
};
}


namespace sk {
template <class Epi> __device__ __forceinline__ void tile1(const bf16_t* A, int K, const bf16_t* Bt, const Epi& E, int task, int lane, int wave, LAS unsigned char* lds) {
    const int tn = task >> 1, rh = task & 1, fr = lane & 15, fq = lane >> 4;
    const int kw = K >> 3, nks = kw >> 5;
    const bf16_t* ap = A + (size_t)(64 * rh + fr) * K + wave * kw + 8 * fq;
    const bf16_t* bp[4];
#pragma unroll
    for (int f = 0; f < 4; ++f) bp[f] = Bt + (size_t)Epi::brow(tn, f, fr) * K + wave * kw + 8 * fq;
    f32x4 acc[4][4];
#pragma unroll
    for (int m = 0; m < 4; ++m)
#pragma unroll
        for (int f = 0; f < 4; ++f) acc[m][f] = (f32x4){0.f, 0.f, 0.f, 0.f};
#pragma nounroll
    for (int k0 = 0; k0 < nks; k0 += 4) {
        bf16x8 a[4][4], b[4][4];
#pragma unroll
        for (int q = 0; q < 4; ++q) {
            const int ks = (k0 + q < nks) ? k0 + q : nks - 1;
#pragma unroll
            for (int m = 0; m < 4; ++m) a[q][m] = *(const bf16x8*)(ap + (size_t)m * 16 * K + 32 * ks);
#pragma unroll
            for (int f = 0; f < 4; ++f) b[q][f] = *(const bf16x8*)(bp[f] + 32 * ks);
        }
#pragma unroll
        for (int q = 0; q < 4; ++q) {
            if (k0 + q < nks) {
#pragma unroll
                for (int m = 0; m < 4; ++m)
#pragma unroll
                    for (int f = 0; f < 4; ++f) acc[m][f] = __builtin_amdgcn_mfma_f32_16x16x32_bf16(b[q][f], a[q][m], acc[m][f], 0, 0, 0);
            }
        }
    }
    LAS f32x4* red = (LAS f32x4*)lds;
#pragma unroll
    for (int m = 0; m < 4; ++m)
#pragma unroll
        for (int f = 0; f < 4; ++f) red[(wave * 16 + m * 4 + f) * 64 + lane] = acc[m][f];
    LDS_WAIT(); __syncthreads();
    if (wave < 4) {
        f32x4 r[4];
#pragma unroll
        for (int f = 0; f < 4; ++f) { f32x4 sacc = red[(wave * 4 + f) * 64 + lane];
#pragma unroll
            for (int w = 1; w < 8; ++w) sacc += red[(w * 16 + wave * 4 + f) * 64 + lane];
            r[f] = sacc; }
        E(tn, 64 * rh + 16 * wave + fr, fq, r);
    }
    LDS_WAIT(); __syncthreads();
}
template <class Epi> __device__ __forceinline__ void tile(const bf16_t* A, int K, const bf16_t* Bt, const Epi& E, int task, int lane, int wave, LAS unsigned char* lds) {
#if PROBE_SK2
    { Epi Ed = E; Ed.dry = 1; tile1(A, K, Bt, Ed, task, lane, wave, lds); }
#endif
    tile1(A, K, Bt, E, task, lane, wave, lds);
}
__device__ __forceinline__ void st_bf4(bf16_t* p, const f32x4 v) { u32x2 w; w.x = cvt_pk_bf16(v[0], v[1]); w.y = cvt_pk_bf16(v[2], v[3]); *(u32x2*)p = w; }
template <int SSQI> struct EpiSwiGLU {
    unsigned char* ws; int dry;
    static __device__ __forceinline__ int brow(int tn, int f, int n) { const int gc = 32 * tn + 16 * (f & 1) + n; return 256 * (gc >> 7) + 128 * (f >> 1) + (gc & 127); }
    __device__ __forceinline__ void operator()(int tn, int srow, int fq, const f32x4 (&acc)[4]) const {
        const int row = MPROMPT + srow; const float rs = row_rs(TOT(ws, SSQI), row);
        bf16_t* O = (bf16_t*)(ws + WS_ACT) + (size_t)row * DFF + 32 * tn + 4 * fq;
#pragma unroll
        for (int f = 0; f < 2; ++f) { f32x4 o;
#pragma unroll
            for (int j = 0; j < 4; ++j) o[j] = siluf_(acc[f][j] * rs) * (acc[f + 2][j] * rs);
            st_bf4(O + 16 * f, o); }
    }
};
struct EpiPlain {
    unsigned char* ws; int dry;
    static __device__ __forceinline__ int brow(int tn, int f, int n) { return 64 * tn + 16 * f + n; }
    __device__ __forceinline__ void operator()(int tn, int srow, int fq, const f32x4 (&acc)[4]) const {
        bf16_t* O = (bf16_t*)(ws + WS_PROJ) + (size_t)(MPROMPT + srow) * DM + 64 * tn + 4 * fq;
#pragma unroll
        for (int f = 0; f < 4; ++f) st_bf4(O + 16 * f, acc[f]);
    }
};
template <int MODE, int SSQO, bool FROM_X> struct EpiResid {
    const float* xS; unsigned char* ws; float scale; int dry;
    static __device__ __forceinline__ int brow(int tn, int f, int n) { return 64 * tn + 16 * f + n; }
    __device__ __forceinline__ void operator()(int tn, int srow, int fq, const f32x4 (&acc)[4]) const {
        const int row = MPROMPT + srow;
        bf16_t* HBp = (bf16_t*)(ws + WS_HB) + (size_t)row * DM + 64 * tn + 4 * fq; bf16_t* Out = MODE == 0 ? HBp : (bf16_t*)(ws + WS_A2) + (size_t)row * DM + 64 * tn + 4 * fq;
        const float* xp = xS + (size_t)srow * DM + 64 * tn + 4 * fq;
        const bf16_t* pj = (const bf16_t*)(ws + WS_PROJ) + (size_t)row * DM + 64 * tn + 4 * fq;
        float rs = 1.f; if (MODE == 1) rs = row_rs(TOT(ws, SSQO - 1), row);
        float ss = 0.f;
#pragma unroll
        for (int f = 0; f < 4; ++f) { f32x4 bq;
            if (FROM_X) bq = *(const f32x4*)(xp + 16 * f);
            else { const u32x2 bw = *(const u32x2*)(HBp + 16 * f); bq = (f32x4){bflo(bw.x), bfhi(bw.x), bflo(bw.y), bfhi(bw.y)}; }
            f32x4 v;
            if (MODE == 0) v = bq + acc[f] * scale;
            else { const u32x2 pw = *(const u32x2*)(pj + 16 * f); const f32x4 a = acc[f] * rs;
                v[0] = bq[0] + sigmoidf_(a[0]) * bflo(pw.x); v[1] = bq[1] + sigmoidf_(a[1]) * bfhi(pw.x); v[2] = bq[2] + sigmoidf_(a[2]) * bflo(pw.y); v[3] = bq[3] + sigmoidf_(a[3]) * bfhi(pw.y); }
            if (!dry) st_bf4(Out + 16 * f, v);
            ss += (v[0] * v[0] + v[1] * v[1]) + (v[2] * v[2] + v[3] * v[3]); }
        ss += __shfl_xor(ss, 16); ss += __shfl_xor(ss, 32);
        if (fq == 0 && !dry) ssq_add(TOT(ws, SSQO), row, ss);
    }
};
struct EpiMix {
    unsigned char* ws; float* out; int dry;
    static __device__ __forceinline__ int brow(int tn, int f, int n) { return 64 * tn + 16 * f + n; }
    __device__ __forceinline__ void operator()(int tn, int srow, int fq, const f32x4 (&acc)[4]) const {
        const int row = MPROMPT + srow; const float rs = row_rs(TOT(ws, 1), row);
        f32x4 v[4];
#pragma unroll
        for (int f = 0; f < 4; ++f) v[f] = acc[f] * rs;
        if (tn < 16) {
            const float* rope = (const float*)(ws + WS_ROPE) + (size_t)(2048 + (srow & 3)) * 16 + 8 * (fq & 1);
            const f32x4 t0 = *(const f32x4*)rope, t1 = *(const f32x4*)(rope + 4);
            const float cs[4] = {t0[0], t0[2], t1[0], t1[2]}, sn[4] = {t0[1], t0[3], t1[1], t1[3]};
#pragma unroll
            for (int j = 0; j < 4; ++j) { const float x = v[0][j], w = __shfl_xor(x, 32); v[0][j] = (fq < 2) ? (x * cs[j] - w * sn[j]) : (x * cs[j] + w * sn[j]); }
        }
        if (tn < 24) {
            const int kind = tn >> 3, c0 = (tn & 7) * 64 + 4 * fq;
            bf16_t* dst = (bf16_t*)(ws + (kind == 0 ? WS_QA : (kind == 1 ? WS_KA : WS_VA))) + (size_t)row * 512 + c0;
            const float sc = kind == 0 ? C2Q : 1.f;
            float* fo = kind == 0 ? nullptr : out + (kind == 1 ? OFF_KWS : OFF_VWS) + ((size_t)(srow >> 2) * WINB + (WINB - DEC_T) + (srow & 3)) * 512 + c0;
#pragma unroll
            for (int f = 0; f < 4; ++f) { st_bf4(dst + 16 * f, v[f] * sc); if (fo) *(f32x4*)(fo + 16 * f) = v[f]; }
        } else if (tn < 48) {
            bf16_t* dst; float sc = 1.f;
            if (tn < 28) { dst = (bf16_t*)(ws + WS_QB) + (size_t)row * 256 + (tn - 24) * 64; sc = 0.125f; }
            else if (tn < 32) dst = (bf16_t*)(ws + WS_KB) + (size_t)row * 256 + (tn - 28) * 64;
            else if (tn < 40) dst = (bf16_t*)(ws + WS_VB) + (size_t)row * 512 + (tn - 32) * 64;
            else dst = (bf16_t*)(ws + WS_GB) + (size_t)row * 512 + (tn - 40) * 64;
            dst += 4 * fq;
#pragma unroll
            for (int f = 0; f < 4; ++f) st_bf4(dst + 16 * f, v[f] * sc);
        } else {
            *(f32x4*)((float*)(ws + WS_A1) + (size_t)row * 16 + 4 * fq) = v[0];
        }
    }
};
}

#define XB_TMO      128
#define XB_XCNT(j)  (256  + 64 * (j))
#define XB_XSUB(j)  (1280 + 64 * (j))
#define XB_XGEN(j)  (2304 + 64 * (j))
#define XB_TOP      3328
#define XB_TOPGEN   3392
#define XCD_BAR_WORDS 3456
#define XB_SPIN_CAP (1u << 18)
__device__ __forceinline__ unsigned xb_ld(unsigned* p)              { return __hip_atomic_load(p, __ATOMIC_RELAXED, __HIP_MEMORY_SCOPE_AGENT); }
__device__ __forceinline__ unsigned xb_add(unsigned* p, unsigned v) { return __hip_atomic_fetch_add(p, v, __ATOMIC_RELAXED, __HIP_MEMORY_SCOPE_AGENT); }
__device__ __forceinline__ unsigned xb_xcc_id() { return (unsigned)__builtin_amdgcn_s_getreg((3 << 11) | 20) & 0xFu; }
#define XB_SPIN(cond, bar) do { unsigned _sp = 0; while (cond) { __builtin_amdgcn_s_sleep(1); \
    if ((++_sp & 255u) == 0u) { if (xb_ld(&(bar)[XB_TMO])) break; if (_sp > XB_SPIN_CAP) { atomicAdd(&(bar)[XB_TMO], 1u); break; } } } } while (0)
struct XcdBarrier { unsigned* bar; unsigned x; volatile LAS unsigned* st; };
__device__ __forceinline__ XcdBarrier xcd_barrier_post(unsigned* bar, volatile LAS unsigned* st) {
    XcdBarrier b; b.bar = bar; b.x = xb_xcc_id(); b.st = st;
    if (threadIdx.x == 0) (void)xb_add(&bar[XB_XCNT(b.x)], 1u);
    return b;
}
__device__ __forceinline__ void xcd_barrier_complete(unsigned* bar, unsigned x, unsigned& nloc, unsigned& nx) {
    const unsigned G = gridDim.x * gridDim.y * gridDim.z;
    unsigned sum, cnt, mine, sp = 0u;
    for (;;) {
        sum = 0u; cnt = 0u; mine = 0u;
#pragma unroll
        for (unsigned j = 0; j < 16; ++j) { const unsigned c = xb_ld(&bar[XB_XCNT(j)]); sum += c; cnt += (c > 0u) ? 1u : 0u; mine = (j == x) ? c : mine; }
        if (sum == G) break;
        __builtin_amdgcn_s_sleep(1);
        if ((++sp & 255u) == 0u) { if (xb_ld(&bar[XB_TMO])) break; if (sp > XB_SPIN_CAP) { atomicAdd(&bar[XB_TMO], 1u); break; } }
    }
    nloc = mine > 0u ? mine : 1u; nx = cnt > 0u ? cnt : 1u;
}
__device__ __forceinline__ void xcd_barrier(const XcdBarrier& b) {
    asm volatile("s_waitcnt vmcnt(0)" ::: "memory");
    __syncthreads();
    if (threadIdx.x == 0) {
        unsigned* bar = b.bar;
        __builtin_amdgcn_s_waitcnt(0);
        unsigned nloc = b.st[0], nx = b.st[1];
        if (nloc == 0u) { xcd_barrier_complete(bar, b.x, nloc, nx); b.st[0] = nloc; b.st[1] = nx; }
        const unsigned old = xb_add(&bar[XB_XSUB(b.x)], 1u);
        const unsigned gen = old / nloc;
        if (old + 1u == (gen + 1u) * nloc) {
            __builtin_amdgcn_fence(__ATOMIC_RELEASE, "agent");
            asm volatile("s_waitcnt vmcnt(0)" ::: "memory");
            const unsigned og = xb_add(&bar[XB_TOP], 1u);
            const unsigned tg = og / nx;
            if (og + 1u == (tg + 1u) * nx) xb_add(&bar[XB_TOPGEN], 1u);
            else XB_SPIN(xb_ld(&bar[XB_TOPGEN]) == tg, bar);
            __builtin_amdgcn_fence(__ATOMIC_ACQUIRE, "agent");
            xb_add(&bar[XB_XGEN(b.x)], 1u);
            asm volatile("s_waitcnt vmcnt(0)" ::: "memory");
        } else {
            XB_SPIN(xb_ld(&bar[XB_XGEN(b.x)]) == gen, bar);
            __builtin_amdgcn_fence(__ATOMIC_ACQUIRE, "agent");
            asm volatile("s_waitcnt vmcnt(0)" ::: "memory");
        }
    }
    __syncthreads();
}

struct Args { const float* in[23]; float* out; unsigned char* ws; int ph_lo, ph_hi; };
struct Frame {
    LAS unsigned char* lds;
    int tid, lane, wave, vcu, G;
    const Args* a; float* out; unsigned char* ws;
};
#define FIN(i) (F.a->in[i])
#define WSP(T, off) ((T*)(F.ws + (off)))

__device__ __forceinline__ void tr_item(const float* W, int K, int Nsrc, const float* g, bf16_t* WT, int kind, LAS float* scr, int item, int nblk, int lane) {
    const int kb = item / nblk, nb = item % nblk, k0 = 64 * kb, n0 = 32 * nb;
    int src0 = n0, nval = 32;
    if (kind == 1) { const int pn = n0 >> 8, j = n0 & 255; src0 = (j < 128) ? 128 * pn + j : DFF + 128 * pn + (j - 128); }
    else if (kind == 2) { if (n0 < 2560) src0 = n0; else if (n0 < 3072) src0 = n0 + 16; else if (n0 == 3072) { src0 = 2560; nval = 16; } else { src0 = 0; nval = 0; } }
    const int r8 = lane >> 3, c4 = (lane & 7) * 4;
    f32x4 wv[8];
#pragma unroll
    for (int i = 0; i < 8; ++i) { const int kk = 8 * i + r8; wv[i] = (c4 < nval) ? *(const f32x4*)(W + (size_t)(k0 + kk) * Nsrc + src0 + c4) : (f32x4){0.f, 0.f, 0.f, 0.f}; }
    if (g) {
#pragma unroll
        for (int i = 0; i < 8; ++i) wv[i] = wv[i] * g[k0 + 8 * i + r8];
    }
#pragma unroll
    for (int i = 0; i < 8; ++i) { LAS float* d = scr + (8 * i + r8) * 33 + c4; d[0] = wv[i][0]; d[1] = wv[i][1]; d[2] = wv[i][2]; d[3] = wv[i][3]; }
    LDS_WAIT(); asm volatile("" ::: "memory");
    const int cc = lane & 7;
#pragma unroll
    for (int j = 0; j < 4; ++j) { const int n = (lane >> 3) + 8 * j; const LAS float* s = scr + (8 * cc) * 33 + n;
        u32x4 o; o.x = pk2(s[0 * 33], s[1 * 33]); o.y = pk2(s[2 * 33], s[3 * 33]); o.z = pk2(s[4 * 33], s[5 * 33]); o.w = pk2(s[6 * 33], s[7 * 33]);
        *(u32x4*)(WT + (size_t)(n0 + n) * K + k0 + 8 * cc) = o; }
    LDS_WAIT(); asm volatile("" ::: "memory");
}
__device__ __forceinline__ void sincos_red(double ang, float& c, float& s) {
    const double TWO_PI = 6.283185307179586476925, HALF_PI = 1.5707963267948966192;
    double r = ang - TWO_PI * __builtin_rint(ang / TWO_PI);
    const double q = __builtin_rint(r / HALF_PI); r -= q * HALF_PI;
    const int qi = ((int)q) & 3;
    const double y2 = r * r;
    const double sn = r * (1.0 + y2 * (-1.0 / 6 + y2 * (1.0 / 120 + y2 * (-1.0 / 5040 + y2 * (1.0 / 362880 - y2 * (1.0 / 39916800))))));
    const double cs = 1.0 + y2 * (-0.5 + y2 * (1.0 / 24 + y2 * (-1.0 / 720 + y2 * (1.0 / 40320 + y2 * (-1.0 / 3628800 + y2 * (1.0 / 479001600))))));
    double co, si;
    if (qi == 0) { co = cs; si = sn; } else if (qi == 1) { co = -sn; si = cs; } else if (qi == 2) { co = -cs; si = -sn; } else { co = sn; si = -cs; }
    c = (float)co; s = (float)si;
}
template <int SET> __device__ __forceinline__ void convert_weights(Frame& F, int gw, int NGW) {
    LAS float* scr = (LAS float*)(F.lds + F.wave * 16384);
    constexpr int I_GU = (DM / 64) * (NGU / 32), I_D = (DFF / 64) * (DM / 32), I_IN = (DM / 64) * (NPROJ / 32), I_1K = (DM / 64) * (DM / 32), I_PP = (DPLE / 64) * (DM / 32);
    if (SET == 0) {
        for (int it = gw; it < I_GU + I_PP; it += NGW) {
            if (it < I_GU) tr_item(FIN(8), DM, NGU, FIN(7), WSP(bf16_t, WS_WGU1), 1, scr, it, NGU / 32, F.lane);
            else tr_item(FIN(21), DPLE, DM, nullptr, WSP(bf16_t, WS_WPP), 0, scr, it - I_GU, DM / 32, F.lane);
        }
    } else if (SET == 1) {
        for (int it = gw; it < I_D + I_IN; it += NGW) {
            if (it < I_D) tr_item(FIN(9), DFF, DM, nullptr, WSP(bf16_t, WS_WD1), 0, scr, it, DM / 32, F.lane);
            else tr_item(FIN(11), DM, 3088, FIN(10), WSP(bf16_t, WS_WIN), 2, scr, it - I_D, NPROJ / 32, F.lane);
        }
    } else {
        for (int it = gw; it < I_GU + I_D + 2 * I_1K; it += NGW) {
            int r = it;
            if (r < I_GU) { tr_item(FIN(17), DM, NGU, FIN(16), WSP(bf16_t, WS_WGU2), 1, scr, r, NGU / 32, F.lane); continue; } r -= I_GU;
            if (r < I_D) { tr_item(FIN(18), DFF, DM, nullptr, WSP(bf16_t, WS_WD2), 0, scr, r, DM / 32, F.lane); continue; } r -= I_D;
            if (r < I_1K) { tr_item(FIN(15), DM, DM, nullptr, WSP(bf16_t, WS_WOUT), 0, scr, r, DM / 32, F.lane); continue; } r -= I_1K;
            tr_item(FIN(20), DM, DM, FIN(19), WSP(bf16_t, WS_WPG), 0, scr, r, DM / 32, F.lane);
        }
    }
}
__device__ __forceinline__ void p0_prologue(Frame& F) {
    const int gw = F.vcu * NWAVES + F.wave, NGW = F.G * NWAVES;
    convert_weights<0>(F, gw, NGW);
    bf16_t* HB = WSP(bf16_t, WS_HB); bf16_t* PB = WSP(bf16_t, WS_PB); unsigned* ssq0 = TOT(F.ws, 0);
    for (int e = F.vcu * 512 + F.tid; e < 4 * MPAD; e += F.G * 512) TOT(F.ws, 1 + e / MPAD)[e % MPAD] = 0u;
    for (int m0 = gw; m0 < MTOT; m0 += 4 * NGW) {
        f32x4 v[4][4], pv[4];
#pragma unroll
        for (int u = 0; u < 4; ++u) { const int m = m0 + u * NGW; const bool ok = m < MTOT;
            const float* xr = m < MPROMPT ? FIN(0) + (size_t)m * DM : FIN(1) + (size_t)(m - MPROMPT) * DM;
            const float* pr = m < MPROMPT ? FIN(5) + (size_t)m * DPLE : FIN(6) + (size_t)(m - MPROMPT) * DPLE;
#pragma unroll
            for (int j = 0; j < 4; ++j) v[u][j] = ok ? *((const f32x4*)xr + F.lane + 64 * j) : (f32x4){0.f, 0.f, 0.f, 0.f};
            pv[u] = ok ? *((const f32x4*)pr + F.lane) : (f32x4){0.f, 0.f, 0.f, 0.f}; }
#pragma unroll
        for (int u = 0; u < 4; ++u) { const int m = m0 + u * NGW; if (m >= MTOT) continue;
            float s = 0.f;
#pragma unroll
            for (int j = 0; j < 4; ++j) s += (v[u][j][0] * v[u][j][0] + v[u][j][1] * v[u][j][1]) + (v[u][j][2] * v[u][j][2] + v[u][j][3] * v[u][j][3]);
            s = wave_sum(s);
#pragma unroll
            for (int j = 0; j < 4; ++j) { u32x2 w; w.x = pk2(v[u][j][0], v[u][j][1]); w.y = pk2(v[u][j][2], v[u][j][3]); *((u32x2*)(HB + (size_t)m * DM) + F.lane + 64 * j) = w; }
            if (F.lane == 0) ssq0[m] = (unsigned)(s * SSQ_SCALE + 0.5f);
            u32x2 w; w.x = pk2(pv[u][0], pv[u][1]); w.y = pk2(pv[u][2], pv[u][3]); *((u32x2*)(PB + (size_t)m * DPLE) + F.lane) = w; }
    }
    float* rope = WSP(float, WS_ROPE);
    for (int e = F.vcu * 512 + F.tid; e < 2052 * 8; e += F.G * 512) {
        const int posidx = e >> 3, i = e & 7; const int pos = posidx < 2048 ? posidx : PAST + (posidx - 2048);
        const double inv = exp2(-(double)i * 0.125 * 18.931568569324174087);
        float c, s; sincos_red((double)pos * inv, c, s);
        rope[2 * e] = c; rope[2 * e + 1] = s;
    }
}


constexpr size_t CP_PER_B = (size_t)(WINB - DEC_T) * 512 / 4, CP_TOTAL = (size_t)DEC_B * CP_PER_B, CP_C1 = 0, CP_C3 = (CP_TOTAL * 6 / 10) & ~(size_t)511;
__device__ __forceinline__ void cache_copy_chunk(Frame& F, size_t e0, size_t e1, int rank, int nshare) {
    if (rank < 0) return;
    constexpr int U = 8;
    const size_t stride = (size_t)nshare * 512 * U;
    for (size_t eb = e0 + (size_t)rank * 512 * U + F.tid; eb < e1; eb += stride) {
        f32x4 kv[U], vv[U]; size_t dst[U];
#pragma unroll
        for (int u = 0; u < U; ++u) { const size_t e = eb + (size_t)u * 512; const size_t ec = e < e1 ? e : e1 - 1; const size_t b = ec / CP_PER_B, r = ec - b * CP_PER_B;
            const size_t src = b * ((size_t)WINB * 128) + DEC_T * 128 + r; dst[u] = b * ((size_t)WINB * 128) + r;
            kv[u] = __builtin_nontemporal_load((const f32x4*)FIN(2) + src); vv[u] = __builtin_nontemporal_load((const f32x4*)FIN(3) + src); }
#pragma unroll
        for (int u = 0; u < U; ++u) { __builtin_nontemporal_store(kv[u], (f32x4*)(F.out + OFF_KWS) + dst[u]); __builtin_nontemporal_store(vv[u], (f32x4*)(F.out + OFF_VWS) + dst[u]); }
    }
}

constexpr int AT_VW = 6144  , AT_VPITCH = 192, AT_STO = 8 * AT_VW, AT_SPITCH = 136, AT_SROWS = 528, AT_STM = AT_STO + AT_SROWS * AT_SPITCH, AT_STL = AT_STM + AT_SROWS * 4;
static_assert(AT_STL + AT_SROWS * 4 <= RING_BYTES, "attention LDS");
__device__ __forceinline__ int crow(int r, int hi) { return (r & 3) + 8 * (r >> 2) + 4 * hi; }
__device__ __forceinline__ float xhalf_max(float x) { const auto r = __builtin_amdgcn_permlane32_swap(__float_as_uint(x), __float_as_uint(x), false, false); return fmaxf(__uint_as_float(r[0]), __uint_as_float(r[1])); }
__device__ __forceinline__ float xhalf_sum(float x) { const auto r = __builtin_amdgcn_permlane32_swap(__float_as_uint(x), __float_as_uint(x), false, false); return __uint_as_float(r[0]) + __uint_as_float(r[1]); }
__device__ __forceinline__ s16x4 tr_read(LAS const unsigned char* p) { typedef short v4i16 __attribute__((ext_vector_type(4))); return __builtin_bit_cast(s16x4, __builtin_amdgcn_ds_read_tr16_b64_v4i16((LAS v4i16*)p)); }

template <int NQ> __device__ __forceinline__ void attn_task(Frame& F, int b, int h, int P0, int br, int dil, int r, int s0) {
    const int lane = F.lane, qi = lane & 31, hi = lane >> 5;
    const bf16_t* QA = WSP(bf16_t, WS_QA); const bf16_t* KA = WSP(bf16_t, WS_KA); const bf16_t* VA = WSP(bf16_t, WS_VA);
    LAS unsigned char* Vw = F.lds + F.wave * AT_VW;
    const size_t rowbase = (size_t)b * SEQ;
    const char* Qb = (const char*)(QA + rowbase * 512 + h * 64); const char* Kb = (const char*)(KA + rowbase * 512 + h * 64); const char* Vb = (const char*)(VA + rowbase * 512 + h * 64);
    bf16x8 qf[NQ][4]; f32x16 o0[NQ], o1[NQ]; float mrun[NQ], lrun[NQ];
#define POSQ(n) ((s0 + 32 * (n) + qi) * dil + r)
#define RHO(n) ((((POSQ(n) - P0) & 15) * 33) + ((POSQ(n) - P0) >> 4))
#pragma unroll
    for (int n = 0; n < NQ; ++n) {
        const unsigned qoff = (unsigned)POSQ(n) * 1024u + hi * 16u;
#pragma unroll
        for (int kk = 0; kk < 4; ++kk) qf[n][kk] = *(const bf16x8*)(Qb + qoff + 32 * kk);
        if (br == 0) {
#pragma unroll
            for (int i = 0; i < 16; ++i) { o0[n][i] = 0.f; o1[n][i] = 0.f; }
            mrun[n] = -1e30f; lrun[n] = 0.f;
        } else {
            const LAS unsigned char* sp = F.lds + AT_STO + RHO(n) * AT_SPITCH + 8 * hi;
#pragma unroll
            for (int g = 0; g < 4; ++g) {
                const u32x2 a = *(const LAS u32x2*)(sp + 16 * g), c = *(const LAS u32x2*)(sp + 64 + 16 * g);
                o0[n][4 * g] = bflo(a.x); o0[n][4 * g + 1] = bfhi(a.x); o0[n][4 * g + 2] = bflo(a.y); o0[n][4 * g + 3] = bfhi(a.y);
                o1[n][4 * g] = bflo(c.x); o1[n][4 * g + 1] = bfhi(c.x); o1[n][4 * g + 2] = bflo(c.y); o1[n][4 * g + 3] = bfhi(c.y);
            }
            mrun[n] = *(const LAS float*)(F.lds + AT_STM + RHO(n) * 4); lrun[n] = *(const LAS float*)(F.lds + AT_STL + RHO(n) * 4);
        }
    }
    const int kt0 = s0 >= 128 ? 0 : ((128 - s0) >> 5), ktend = 5 + (NQ - 1);
    const int q4 = (lane & 15) >> 2, p4 = lane & 3, blk = (lane >> 4) & 1;
    const LAS unsigned char* trb = Vw + (4 * hi + q4) * AT_VPITCH + (16 * blk + 4 * p4) * 2;
    bf16x8 kn[4]; u32x4 vr[4];
    {   const int sk0 = s0 - 128 + 32 * kt0;
        const unsigned koff = (unsigned)((sk0 + qi) * dil + r) * 1024u + hi * 16u;
#pragma unroll
        for (int kk = 0; kk < 4; ++kk) kn[kk] = *(const bf16x8*)(Kb + koff + 32 * kk);
#pragma unroll
        for (int c = 0; c < 4; ++c) { const int cid = lane + 64 * c, vrow = cid >> 3, ch = cid & 7;
            vr[c] = *(const u32x4*)(Vb + (unsigned)((sk0 + vrow) * dil + r) * 1024u + ch * 16u); } }
#define AT_STEP(KT, D0, D1) do { const int kt_ = (KT); \
        bf16x8 kf[4]; \
        _Pragma("unroll") for (int kk = 0; kk < 4; ++kk) kf[kk] = kn[kk]; \
        _Pragma("unroll") for (int c = 0; c < 4; ++c) { const int cid = lane + 64 * c, vrow = cid >> 3, ch = cid & 7; *(LAS u32x4*)(Vw + vrow * AT_VPITCH + ch * 16) = vr[c]; } \
        if (kt_ + 1 < ktend) { \
            const int sk1 = s0 - 128 + 32 * (kt_ + 1); \
            const unsigned koff = (unsigned)((sk1 + qi) * dil + r) * 1024u + hi * 16u; \
            _Pragma("unroll") for (int kk = 0; kk < 4; ++kk) kn[kk] = *(const bf16x8*)(Kb + koff + 32 * kk); \
            _Pragma("unroll") for (int c = 0; c < 4; ++c) { const int cid = lane + 64 * c, vrow = cid >> 3, ch = cid & 7; \
                vr[c] = *(const u32x4*)(Vb + (unsigned)((sk1 + vrow) * dil + r) * 1024u + ch * 16u); } \
        } \
        LDS_WAIT(); \
        bf16x8 va[2][2]; \
        _Pragma("unroll") for (int dt = 0; dt < 2; ++dt) { \
            const s16x4 lo0 = tr_read(trb + dt * 64), hi0 = tr_read(trb + dt * 64 + 8 * AT_VPITCH); \
            const s16x4 lo1 = tr_read(trb + dt * 64 + 16 * AT_VPITCH), hi1 = tr_read(trb + dt * 64 + 24 * AT_VPITCH); \
            va[dt][0] = __builtin_shufflevector(lo0, hi0, 0, 1, 2, 3, 4, 5, 6, 7); va[dt][1] = __builtin_shufflevector(lo1, hi1, 0, 1, 2, 3, 4, 5, 6, 7); } \
        f32x16 pp[NQ]; \
        _Pragma("unroll") for (int n = 0; n < NQ; ++n) _Pragma("unroll") for (int i = 0; i < 16; ++i) pp[n][i] = 0.f; \
        _Pragma("unroll") for (int kk = 0; kk < 4; ++kk) { \
            if (D0) pp[0] = __builtin_amdgcn_mfma_f32_32x32x16_bf16(kf[kk], qf[0][kk], pp[0], 0, 0, 0); \
            if (D1) pp[NQ - 1] = __builtin_amdgcn_mfma_f32_32x32x16_bf16(kf[kk], qf[NQ - 1][kk], pp[NQ - 1], 0, 0, 0); } \
        bf16x8 pb[NQ][2]; \
        _Pragma("unroll") for (int n = 0; n < NQ; ++n) { \
            if ((n == 0 && !(D0)) || (n == 1 && !(D1))) continue; \
            const int kr = kt_ - n; \
            if (kr == 0) { _Pragma("unroll") for (int i = 0; i < 16; ++i) if (crow(i, hi) < qi) pp[n][i] = -INFINITY; } \
            else if (kr == 4) { _Pragma("unroll") for (int i = 0; i < 16; ++i) if (crow(i, hi) > qi) pp[n][i] = -INFINITY; } } \
        _Pragma("unroll") for (int n = 0; n < NQ; ++n) { \
            if ((n == 0 && !(D0)) || (n == 1 && !(D1))) continue; \
            float mx = pp[n][0]; \
            _Pragma("unroll") for (int i = 1; i < 16; ++i) mx = fmaxf(mx, pp[n][i]); \
            mx = xhalf_max(mx); \
            if (__builtin_amdgcn_ballot_w64(mx > mrun[n] + 8.0f) != 0ull) {        \
                const float mn = fmaxf(mrun[n], mx), al = __builtin_amdgcn_exp2f(mrun[n] - mn); \
                lrun[n] *= al; mrun[n] = mn; \
                _Pragma("unroll") for (int i = 0; i < 16; ++i) { o0[n][i] *= al; o1[n][i] *= al; } \
            } \
            float rsum = 0.f; \
            _Pragma("unroll") for (int i = 0; i < 16; ++i) { pp[n][i] = __builtin_amdgcn_exp2f(pp[n][i] - mrun[n]); rsum += pp[n][i]; } \
            rsum = xhalf_sum(rsum); \
            lrun[n] += rsum; \
            u32x4 pw0, pw1; \
            pw0.x = cvt_pk_bf16(pp[n][0], pp[n][1]); pw0.y = cvt_pk_bf16(pp[n][2], pp[n][3]); pw0.z = cvt_pk_bf16(pp[n][4], pp[n][5]); pw0.w = cvt_pk_bf16(pp[n][6], pp[n][7]); \
            pw1.x = cvt_pk_bf16(pp[n][8], pp[n][9]); pw1.y = cvt_pk_bf16(pp[n][10], pp[n][11]); pw1.z = cvt_pk_bf16(pp[n][12], pp[n][13]); pw1.w = cvt_pk_bf16(pp[n][14], pp[n][15]); \
            pb[n][0] = __builtin_bit_cast(bf16x8, pw0); pb[n][1] = __builtin_bit_cast(bf16x8, pw1); } \
        _Pragma("unroll") for (int n = 0; n < NQ; ++n) { \
            if ((n == 0 && !(D0)) || (n == 1 && !(D1))) continue; \
            o0[n] = __builtin_amdgcn_mfma_f32_32x32x16_bf16(va[0][0], pb[n][0], o0[n], 0, 0, 0); o1[n] = __builtin_amdgcn_mfma_f32_32x32x16_bf16(va[1][0], pb[n][0], o1[n], 0, 0, 0); } \
        _Pragma("unroll") for (int n = 0; n < NQ; ++n) { \
            if ((n == 0 && !(D0)) || (n == 1 && !(D1))) continue; \
            o0[n] = __builtin_amdgcn_mfma_f32_32x32x16_bf16(va[0][1], pb[n][1], o0[n], 0, 0, 0); o1[n] = __builtin_amdgcn_mfma_f32_32x32x16_bf16(va[1][1], pb[n][1], o1[n], 0, 0, 0); } \
    } while (0)
    if (NQ == 1) {
#pragma nounroll
        for (int kt = kt0; kt < 5; ++kt) AT_STEP(kt, true, false);
    } else {
        int kt = kt0;
        if (kt == 0) { AT_STEP(0, true, false); kt = 1; }
#pragma nounroll
        for (; kt < 5; ++kt) AT_STEP(kt, true, true);
        AT_STEP(5, false, true);
    }
#undef AT_STEP
#pragma unroll
    for (int n = 0; n < NQ; ++n) {
        if (br < 2) {
            LAS unsigned char* sp = F.lds + AT_STO + RHO(n) * AT_SPITCH + 8 * hi;
#pragma unroll
            for (int g = 0; g < 4; ++g) {
                u32x2 a, c; a.x = cvt_pk_bf16(o0[n][4 * g], o0[n][4 * g + 1]); a.y = cvt_pk_bf16(o0[n][4 * g + 2], o0[n][4 * g + 3]); c.x = cvt_pk_bf16(o1[n][4 * g], o1[n][4 * g + 1]); c.y = cvt_pk_bf16(o1[n][4 * g + 2], o1[n][4 * g + 3]);
                *(LAS u32x2*)(sp + 16 * g) = a; *(LAS u32x2*)(sp + 64 + 16 * g) = c;
            }
            if (hi == 0) { *(LAS float*)(F.lds + AT_STM + RHO(n) * 4) = mrun[n]; *(LAS float*)(F.lds + AT_STL + RHO(n) * 4) = lrun[n]; }
        } else {
            const float inv = 1.f / lrun[n];
            bf16_t* op = WSP(bf16_t, WS_A2) + (rowbase + POSQ(n)) * DM + h * 64 + 4 * hi;
#pragma unroll
            for (int g = 0; g < 4; ++g) {
                u32x2 a, c; a.x = cvt_pk_bf16(o0[n][4 * g] * inv, o0[n][4 * g + 1] * inv); a.y = cvt_pk_bf16(o0[n][4 * g + 2] * inv, o0[n][4 * g + 3] * inv);
                c.x = cvt_pk_bf16(o1[n][4 * g] * inv, o1[n][4 * g + 1] * inv); c.y = cvt_pk_bf16(o1[n][4 * g + 2] * inv, o1[n][4 * g + 3] * inv);
                *(u32x2*)(op + 8 * g) = a; *(u32x2*)(op + 32 + 8 * g) = c;
            }
        }
    }
    LDS_WAIT();
#undef POSQ
#undef RHO
}
__device__ __forceinline__ void attn_prompt_item(Frame& F, int item) {
    const int b = item >> 5, h = (item >> 2) & 7, blk = item & 3, P0 = blk * 512;
    attn_task<2>(F, b, h, P0, 0, 1, 0, P0 + 64 * F.wave);
    LDS_WAIT(); __syncthreads();
    attn_task<2>(F, b, h, P0, 1, 4, F.wave & 3, P0 / 4 + 64 * (F.wave >> 2));
    LDS_WAIT(); __syncthreads();
    for (int u = 0; u < 2; ++u) attn_task<1>(F, b, h, P0, 2, 16, F.wave * 2 + u, P0 / 16);
    LDS_WAIT(); __syncthreads();
}

__device__ __forceinline__ void attn_sample_task(Frame& F, int task, int half) {
    const int h = task & 7, bt = task >> 3, b = bt >> 2, t = bt & 3, row = MPROMPT + bt;
    const int lane = F.lane, grp = lane >> 2, sub = lane & 3;
    const bf16_t* KA = WSP(bf16_t, WS_KA); const bf16_t* VA = WSP(bf16_t, WS_VA);
    float q[16];
    { const u32x4* qp = (const u32x4*)(WSP(bf16_t, WS_QA) + (size_t)row * 512 + h * 64 + 16 * sub); const u32x4 a = qp[0], c = qp[1];
      q[0] = bflo(a.x); q[1] = bfhi(a.x); q[2] = bflo(a.y); q[3] = bfhi(a.y); q[4] = bflo(a.z); q[5] = bfhi(a.z); q[6] = bflo(a.w); q[7] = bfhi(a.w);
      q[8] = bflo(c.x); q[9] = bfhi(c.x); q[10] = bflo(c.y); q[11] = bfhi(c.y); q[12] = bflo(c.z); q[13] = bfhi(c.z); q[14] = bflo(c.w); q[15] = bfhi(c.w); }
    float mrun = -1e30f, lrun = 0.f, acc[16];
#pragma unroll
    for (int e = 0; e < 16; ++e) acc[e] = 0.f;
    const int rd0 = half ? 5 : 0, rd1 = half ? 9 : 5;
#pragma nounroll
    for (int rd = rd0; rd < rd1; ++rd) {
        const int j = rd * 16 + grp; const bool valid = j <= 128;
        float kv[3][16], vv[3][16];
#pragma unroll
        for (int br = 0; br < 3; ++br) {
            const int dil = 1 << (2 * br);
            const int idx = WINB + t - (valid ? dil * j : 0);
            if (idx < WINB) {
                const f32x4* kp = (const f32x4*)(FIN(2) + (((size_t)b * WINB + idx) * 8 + h) * 64 + 16 * sub);
                const f32x4* vp = (const f32x4*)(FIN(3) + (((size_t)b * WINB + idx) * 8 + h) * 64 + 16 * sub);
#pragma unroll
                for (int c = 0; c < 4; ++c) { const f32x4 a = kp[c], d = vp[c];
#pragma unroll
                    for (int e = 0; e < 4; ++e) { kv[br][4 * c + e] = a[e]; vv[br][4 * c + e] = d[e]; } }
            } else {
                const size_t nrow = (size_t)MPROMPT + 4 * b + (idx - WINB);
                const u32x4* kp = (const u32x4*)(KA + nrow * 512 + h * 64 + 16 * sub); const u32x4* vp = (const u32x4*)(VA + nrow * 512 + h * 64 + 16 * sub);
#pragma unroll
                for (int c = 0; c < 2; ++c) { const u32x4 a = kp[c], d = vp[c];
                    kv[br][8 * c] = bflo(a.x); kv[br][8 * c + 1] = bfhi(a.x); kv[br][8 * c + 2] = bflo(a.y); kv[br][8 * c + 3] = bfhi(a.y); kv[br][8 * c + 4] = bflo(a.z); kv[br][8 * c + 5] = bfhi(a.z); kv[br][8 * c + 6] = bflo(a.w); kv[br][8 * c + 7] = bfhi(a.w);
                    vv[br][8 * c] = bflo(d.x); vv[br][8 * c + 1] = bfhi(d.x); vv[br][8 * c + 2] = bflo(d.y); vv[br][8 * c + 3] = bfhi(d.y); vv[br][8 * c + 4] = bflo(d.z); vv[br][8 * c + 5] = bfhi(d.z); vv[br][8 * c + 6] = bflo(d.w); vv[br][8 * c + 7] = bfhi(d.w); }
            }
        }
#pragma unroll
        for (int br = 0; br < 3; ++br) {
            float s = 0.f;
#pragma unroll
            for (int e = 0; e < 16; ++e) s += q[e] * kv[br][e];
            s += __shfl_xor(s, 1); s += __shfl_xor(s, 2);
            if (!valid) s = -INFINITY;
            const float mn = fmaxf(mrun, s), al = __builtin_amdgcn_exp2f(mrun - mn), p = __builtin_amdgcn_exp2f(s - mn);
            lrun = lrun * al + p; mrun = mn;
#pragma unroll
            for (int e = 0; e < 16; ++e) acc[e] = acc[e] * al + p * vv[br][e];
        }
    }
    float M = mrun;
#pragma unroll
    for (int o = 4; o < 64; o <<= 1) M = fmaxf(M, __shfl_xor(M, o));
    const float f = __builtin_amdgcn_exp2f(mrun - M);
    lrun *= f;
#pragma unroll
    for (int o = 4; o < 64; o <<= 1) lrun += __shfl_xor(lrun, o);
#pragma unroll
    for (int e = 0; e < 16; ++e) { float a = acc[e] * f;
#pragma unroll
        for (int o = 4; o < 64; o <<= 1) a += __shfl_xor(a, o);
        acc[e] = a; }
    LAS float* mrg = (LAS float*)(F.lds) + (F.wave & 3) * 80;
    if (half && grp == 0) {
#pragma unroll
        for (int e = 0; e < 16; ++e) mrg[sub * 16 + e] = acc[e];
        if (sub == 0) { mrg[64] = M; mrg[65] = lrun; }
    }
    LDS_WAIT(); __syncthreads();
    if (!half && grp == 0) {
        const float M2 = mrg[64], l2 = mrg[65], Mx = fmaxf(M, M2), f1 = __builtin_amdgcn_exp2f(M - Mx), f2 = __builtin_amdgcn_exp2f(M2 - Mx);
        const float inv = 1.f / (lrun * f1 + l2 * f2);
#pragma unroll
        for (int e = 0; e < 16; ++e) acc[e] = (acc[e] * f1 + mrg[sub * 16 + e] * f2) * inv;
        u32x4 w0, w1; w0.x = pk2(acc[0], acc[1]); w0.y = pk2(acc[2], acc[3]); w0.z = pk2(acc[4], acc[5]); w0.w = pk2(acc[6], acc[7]);
        w1.x = pk2(acc[8], acc[9]); w1.y = pk2(acc[10], acc[11]); w1.z = pk2(acc[12], acc[13]); w1.w = pk2(acc[14], acc[15]);
        u32x4* op = (u32x4*)(WSP(bf16_t, WS_A2) + (size_t)row * DM + h * 64 + 16 * sub); op[0] = w0; op[1] = w1;
    }
    LDS_WAIT(); __syncthreads();
}

constexpr int GL_A1 = 0  , GL_TOT = 4096  , GL_BT = GL_TOT + 2048  , GL_BC = GL_BT + 256  , GL_QA = GL_BC + 64 * 272  ,
              GL_KB = GL_QA + 64 * 144, GL_VR = GL_KB + 64 * 144  , GL_AM = GL_VR + 64 * 272  , GL_O = GL_AM + 64 * 144  , GL_SP = GL_O + 64 * 132 * 4  , GL_END = GL_SP + 128 * 144;
static_assert(GL_END <= RING_BYTES && GL_BC % 16 == 0 && GL_QA % 16 == 0 && GL_VR % 16 == 0 && GL_O % 16 == 0, "GLA LDS");
struct GlaIn { f32x4 a1; u32x4 kb, qb, vb0, vb1, gb0, gb1; f32x4 hc[4]; };
template <bool P3> __device__ __forceinline__ void gla_fetch(Frame& F, GlaIn& I, int item, int hh, size_t row0) {
    const int tid = F.tid;
    I.a1 = (f32x4){0.f, 0.f, 0.f, 0.f};
    if (tid < 256) I.a1 = *(const f32x4*)(WSP(float, WS_A1) + (row0 + (tid >> 2)) * 16 + 4 * (tid & 3));
    I.kb = *(const u32x4*)(WSP(bf16_t, WS_KB) + (row0 + (tid >> 3)) * 256 + hh * 64 + 8 * (tid & 7));
    I.vb0 = *(const u32x4*)(WSP(bf16_t, WS_VB) + (row0 + (tid >> 4)) * 512 + hh * 128 + 8 * (tid & 15));
    I.vb1 = *(const u32x4*)(WSP(bf16_t, WS_VB) + (row0 + 32 + (tid >> 4)) * 512 + hh * 128 + 8 * (tid & 15));
    if (P3) {
        I.qb = *(const u32x4*)(WSP(bf16_t, WS_QB) + (row0 + (tid >> 3)) * 256 + hh * 64 + 8 * (tid & 7));
        const int i = tid >> 3, sub = tid & 7;
        const u32x4* gp = (const u32x4*)(WSP(bf16_t, WS_GB) + (row0 + i) * 512 + hh * 128 + 16 * sub); I.gb0 = gp[0]; I.gb1 = gp[1];
        const float* hp = WSP(float, WS_HCT) + (size_t)item * 8192 + (size_t)(tid >> 4) * 64 + 4 * (tid & 15);
#pragma unroll
        for (int e = 0; e < 4; ++e) I.hc[e] = *(const f32x4*)(hp + (size_t)e * 32 * 64);
    }
}
__device__ __forceinline__ void gla_decay(Frame& F, const f32x4 a1v, const float (&w2)[16], float bias, float& btot) {
    const int tid = F.tid, k = tid & 63, ig = tid >> 6;
    LAS float* a1s = (LAS float*)(F.lds + GL_A1); LAS float* tot = (LAS float*)(F.lds + GL_TOT); LAS float* BC = (LAS float*)(F.lds + GL_BC); LAS float* BT = (LAS float*)(F.lds + GL_BT);
    if (tid < 256) *(LAS f32x4*)(a1s + tid * 4) = a1v;
    LDS_WAIT(); __syncthreads();
    float run = 0.f, bcum[8];
#pragma unroll
    for (int e = 0; e < 8; ++e) { float pre = bias;
#pragma unroll
        for (int r = 0; r < 16; ++r) pre += a1s[(8 * ig + e) * 16 + r] * w2[r];
        run += logsigf_(pre) * (1.0f / 16.0f); bcum[e] = run; }
    tot[ig * 64 + k] = run;
    LDS_WAIT(); __syncthreads();
    float pre = 0.f, all = 0.f;
#pragma unroll
    for (int g = 0; g < 8; ++g) { const float tv = tot[g * 64 + k]; all += tv; if (g < ig) pre += tv; }
#pragma unroll
    for (int e = 0; e < 8; ++e) BC[(8 * ig + e) * 68 + k] = bcum[e] + pre;
    if (ig == 0) BT[k] = all;
    btot = all;
    LDS_WAIT(); __syncthreads();
}
__device__ __forceinline__ void unpack8(const u32x4 w, float (&x)[8]) { x[0] = bflo(w.x); x[1] = bfhi(w.x); x[2] = bflo(w.y); x[3] = bfhi(w.y); x[4] = bflo(w.z); x[5] = bfhi(w.z); x[6] = bflo(w.w); x[7] = bfhi(w.w); }
__device__ __forceinline__ u32x4 pack8(const float (&x)[8]) { u32x4 w; w.x = pk2(x[0], x[1]); w.y = pk2(x[2], x[3]); w.z = pk2(x[4], x[5]); w.w = pk2(x[6], x[7]); return w; }
__device__ __forceinline__ void gla_store_vr(Frame& F, const u32x4 vb0, const u32x4 vb1) {
    const int tid = F.tid;
    *(LAS u32x4*)(F.lds + GL_VR + (tid >> 4) * 272 + (tid & 15) * 16) = vb0;
    *(LAS u32x4*)(F.lds + GL_VR + (32 + (tid >> 4)) * 272 + (tid & 15) * 16) = vb1;
}
__device__ __forceinline__ bf16x8 tr_frag(LAS const unsigned char* img, int pitch, int col0, int s, int lane) {
    const int q4 = (lane & 15) >> 2, p4 = lane & 3, blk = (lane >> 4) & 1, hi = lane >> 5;
    LAS const unsigned char* p = img + (16 * s + 8 * hi + q4) * pitch + (col0 + 16 * blk + 4 * p4) * 2;
    const s16x4 lo = tr_read(p), hi4 = tr_read(p + 4 * pitch);
    return __builtin_shufflevector(lo, hi4, 0, 1, 2, 3, 4, 5, 6, 7);
}
template <int NIT> __device__ __forceinline__ void gla_p1_items(Frame& F, int item0) {
    const int bh = item0 >> 5, b = bh >> 2, hh = bh & 3;
    const int tid = F.tid, k = tid & 63, ig = tid >> 6, lane = F.lane;
    float w2[16];
#pragma unroll
    for (int r = 0; r < 16; ++r) w2[r] = FIN(12)[r * 256 + hh * 64 + k];
    const float bias = FIN(13)[hh * 64 + k];
    GlaIn nx; gla_fetch<false>(F, nx, item0, hh, (size_t)b * SEQ + 64 * (item0 & 31));
    f32x16 ga; float dsum = 0.f;
#pragma unroll
    for (int i = 0; i < 16; ++i) ga[i] = 0.f;
#pragma nounroll
    for (int it = 0; it < NIT; ++it) {
        const int item = item0 + it;
        const GlaIn cu = nx;
        if (it + 1 < NIT) gla_fetch<false>(F, nx, item + 1, hh, (size_t)b * SEQ + 64 * ((item + 1) & 31));
        float btot; gla_decay(F, cu.a1, w2, bias, btot);
        dsum += btot;
        {
            const int i = tid >> 3, c = tid & 7;
            const f32x4 b0 = *(const LAS f32x4*)(F.lds + GL_BC + (i * 68 + 8 * c) * 4), b1 = *(const LAS f32x4*)(F.lds + GL_BC + (i * 68 + 8 * c + 4) * 4);
            const f32x4 t0 = *(const LAS f32x4*)(F.lds + GL_BT + 8 * c * 4), t1 = *(const LAS f32x4*)(F.lds + GL_BT + (8 * c + 4) * 4);
            float kx[8]; unpack8(cu.kb, kx);
#pragma unroll
            for (int e = 0; e < 4; ++e) { kx[e] *= fexp(t0[e] - b0[e]); kx[4 + e] *= fexp(t1[e] - b1[e]); }
            *(LAS u32x4*)(F.lds + GL_QA + i * 144 + c * 16) = pack8(kx);
        }
        gla_store_vr(F, cu.vb0, cu.vb1);
        if (ig == 0) WSP(float, WS_BTOT)[item * 64 + k] = btot;
        LDS_WAIT(); __syncthreads();
        const int kt = F.wave >> 2, vt = F.wave & 3, r32 = lane & 31, hi = lane >> 5;
        f32x16 acc;
#pragma unroll
        for (int i = 0; i < 16; ++i) acc[i] = 0.f;
#pragma unroll
        for (int q = 0; q < 4; ++q) {
            const bf16x8 a = tr_frag(F.lds + GL_QA, 144, 32 * kt, q, lane);
            const bf16x8 bb = tr_frag(F.lds + GL_VR, 272, 32 * vt, q, lane);
            acc = __builtin_amdgcn_mfma_f32_32x32x16_bf16(a, bb, acc, 0, 0, 0);
        }
        float* hct = WSP(float, WS_HCT) + (size_t)item * 8192 + (size_t)(32 * vt + r32) * 64 + 32 * kt + 4 * hi;
#pragma unroll
        for (int g = 0; g < 4; ++g) { *(f32x4*)(hct + 8 * g) = (f32x4){acc[4 * g], acc[4 * g + 1], acc[4 * g + 2], acc[4 * g + 3]};
            const f32x4 bt = *(const LAS f32x4*)(F.lds + GL_BT + (32 * kt + 8 * g + 4 * hi) * 4);
#pragma unroll
            for (int e = 0; e < 4; ++e) ga[4 * g + e] = fexp(bt[e]) * ga[4 * g + e] + acc[4 * g + e]; }
        LDS_WAIT(); __syncthreads();
    }
    {   const int grp = item0 >> 2, kt = F.wave >> 2, vt = F.wave & 3, r32 = lane & 31, hi = lane >> 5;
        float* gag = WSP(float, WS_GAG) + (size_t)grp * 8192 + (size_t)(32 * vt + r32) * 64 + 32 * kt + 4 * hi;
#pragma unroll
        for (int g = 0; g < 4; ++g) *(f32x4*)(gag + 8 * g) = (f32x4){ga[4 * g], ga[4 * g + 1], ga[4 * g + 2], ga[4 * g + 3]};
        if (ig == 0) WSP(float, WS_DSUM)[grp * 64 + k] = dsum; }
}
template <int NIT> __device__ __forceinline__ void gla_p3_items(Frame& F, int item0) {
    const int bh = item0 >> 5, b = bh >> 2, hh = bh & 3;
    const int tid = F.tid, k = tid & 63, lane = F.lane;
    float w2[16];
#pragma unroll
    for (int r = 0; r < 16; ++r) w2[r] = FIN(12)[r * 256 + hh * 64 + k];
    const float bias = FIN(13)[hh * 64 + k];
    GlaIn nx; gla_fetch<true>(F, nx, item0, hh, (size_t)b * SEQ + 64 * (item0 & 31));
    const int k4 = 4 * (tid & 15), v0 = tid >> 4;
    f32x4 S[4];
#pragma unroll
    for (int e = 0; e < 4; ++e) S[e] = (f32x4){0.f, 0.f, 0.f, 0.f};
    {   const int grp = item0 >> 2, j = grp & 7, grp0 = grp - j;
        const float* gag = WSP(float, WS_GAG) + (size_t)grp0 * 8192 + (size_t)v0 * 64 + k4; const float* dsp = WSP(float, WS_DSUM) + grp0 * 64 + k4;
        f32x4 dec = (f32x4){1.f, 1.f, 1.f, 1.f};
#pragma unroll
        for (int half = 1; half >= 0; --half) {
            f32x4 gv[4][4], dv[4];
#pragma unroll
            for (int q = 3; q >= 0; --q) { const int jp = 4 * half + q;
                if (jp < j && jp < 7) { dv[q] = *(const f32x4*)(dsp + jp * 64);
#pragma unroll
                    for (int e = 0; e < 4; ++e) gv[q][e] = *(const f32x4*)(gag + (size_t)jp * 8192 + (size_t)e * 32 * 64); } }
#pragma unroll
            for (int q = 3; q >= 0; --q) { const int jp = 4 * half + q;
                if (jp < j && jp < 7) {
#pragma unroll
                    for (int e = 0; e < 4; ++e) S[e] += dec * gv[q][e];
#pragma unroll
                    for (int x = 0; x < 4; ++x) dec[x] *= fexp(dv[q][x]); } }
        }
    }
#pragma nounroll
    for (int it = 0; it < NIT; ++it) {
        const int item = item0 + it, c = item & 31; const size_t row0 = (size_t)b * SEQ + 64 * c;
        const GlaIn cu = nx;
        if (it + 1 < NIT) gla_fetch<true>(F, nx, item + 1, hh, (size_t)b * SEQ + 64 * ((item + 1) & 31));
        float btot; gla_decay(F, cu.a1, w2, bias, btot);
        {
            const f32x4 bt = *(const LAS f32x4*)(F.lds + GL_BT + k4 * 4);
#pragma unroll
            for (int e = 0; e < 4; ++e) { u32x2 w; w.x = pk2(S[e][0], S[e][1]); w.y = pk2(S[e][2], S[e][3]); *(LAS u32x2*)(F.lds + GL_SP + (v0 + 32 * e) * 144 + k4 * 2) = w;
#pragma unroll
                for (int x = 0; x < 4; ++x) S[e][x] = fexp(bt[x]) * S[e][x] + cu.hc[e][x]; }
        }
        {
            const int i = tid >> 3, cc = tid & 7;
            const f32x4 b0 = *(const LAS f32x4*)(F.lds + GL_BC + (i * 68 + 8 * cc) * 4), b1 = *(const LAS f32x4*)(F.lds + GL_BC + (i * 68 + 8 * cc + 4) * 4);
            float qx[8], kx[8]; unpack8(cu.qb, qx); unpack8(cu.kb, kx);
#pragma unroll
            for (int e = 0; e < 4; ++e) { const float f0 = fexp(b0[e]), f1 = fexp(b1[e]); qx[e] *= f0; qx[4 + e] *= f1; kx[e] *= __builtin_amdgcn_rcpf(f0); kx[4 + e] *= __builtin_amdgcn_rcpf(f1); }
            *(LAS u32x4*)(F.lds + GL_QA + i * 144 + cc * 16) = pack8(qx);
            *(LAS u32x4*)(F.lds + GL_KB + i * 144 + cc * 16) = pack8(kx);
        }
        gla_store_vr(F, cu.vb0, cu.vb1);
        LDS_WAIT(); __syncthreads();
        const int r32 = lane & 31, hi = lane >> 5;
        if (F.wave < 4) {
            const int it2 = F.wave >> 1, jt = F.wave & 1;
            f32x16 acc;
#pragma unroll
            for (int i = 0; i < 16; ++i) acc[i] = 0.f;
            if (jt <= it2) {
#pragma unroll
                for (int q = 0; q < 4; ++q) {
                    const bf16x8 a = *(const LAS bf16x8*)(F.lds + GL_QA + (32 * it2 + r32) * 144 + (16 * q + 8 * hi) * 2);
                    const bf16x8 bb = *(const LAS bf16x8*)(F.lds + GL_KB + (32 * jt + r32) * 144 + (16 * q + 8 * hi) * 2);
                    acc = __builtin_amdgcn_mfma_f32_32x32x16_bf16(a, bb, acc, 0, 0, 0);
                }
            }
#pragma unroll
            for (int i = 0; i < 16; ++i) { const int ii = 32 * it2 + crow(i, hi), jj = 32 * jt + r32;
                *(LAS bf16_t*)(F.lds + GL_AM + ii * 144 + jj * 2) = (bf16_t)f2bf(jj <= ii ? acc[i] : 0.f); }
        }
        LDS_WAIT(); __syncthreads();
        {
            const int it2 = F.wave >> 2, vt = F.wave & 3;
            f32x16 acc;
#pragma unroll
            for (int i = 0; i < 16; ++i) acc[i] = 0.f;
            if (c > 0) {
#pragma unroll
                for (int q = 0; q < 4; ++q) {
                    const bf16x8 a = *(const LAS bf16x8*)(F.lds + GL_QA + (32 * it2 + r32) * 144 + (16 * q + 8 * hi) * 2);
                    const bf16x8 sb = *(const LAS bf16x8*)(F.lds + GL_SP + (32 * vt + r32) * 144 + (16 * q + 8 * hi) * 2);
                    acc = __builtin_amdgcn_mfma_f32_32x32x16_bf16(a, sb, acc, 0, 0, 0);
                }
            }
#pragma unroll
            for (int q = 0; q < 4; ++q) {
                const bf16x8 a = *(const LAS bf16x8*)(F.lds + GL_AM + (32 * it2 + r32) * 144 + (16 * q + 8 * hi) * 2);
                const bf16x8 bb = tr_frag(F.lds + GL_VR, 272, 32 * vt, q, lane);
                acc = __builtin_amdgcn_mfma_f32_32x32x16_bf16(a, bb, acc, 0, 0, 0);
            }
#pragma unroll
            for (int i = 0; i < 16; ++i) *(LAS float*)(F.lds + GL_O + ((32 * it2 + crow(i, hi)) * 132 + 32 * vt + r32) * 4) = acc[i];
        }
        LDS_WAIT(); __syncthreads();
        {
            const int i = tid >> 3, sub = tid & 7; const size_t rr = row0 + i;
            float o[16]; float ss = 0.f;
#pragma unroll
            for (int q = 0; q < 4; ++q) { const f32x4 x = *(const LAS f32x4*)(F.lds + GL_O + (i * 132 + 16 * sub + 4 * q) * 4);
#pragma unroll
                for (int e = 0; e < 4; ++e) { o[4 * q + e] = x[e]; ss += x[e] * x[e]; } }
            ss += __shfl_xor(ss, 1); ss += __shfl_xor(ss, 2); ss += __shfl_xor(ss, 4);
            const float rn = rsqrtf(ss * (1.0f / 128.0f) + EPS);
            const unsigned gw[8] = {cu.gb0.x, cu.gb0.y, cu.gb0.z, cu.gb0.w, cu.gb1.x, cu.gb1.y, cu.gb1.z, cu.gb1.w};
            const float* go = FIN(14) + 16 * sub;
            unsigned w[8];
#pragma unroll
            for (int e = 0; e < 8; ++e) { const float a = o[2 * e] * rn * go[2 * e] * siluf_(bflo(gw[e])), bq = o[2 * e + 1] * rn * go[2 * e + 1] * siluf_(bfhi(gw[e])); w[e] = pk2(a, bq); }
            u32x4* op = (u32x4*)(WSP(bf16_t, WS_A2) + rr * DM + 512 + hh * 128 + 16 * sub);
            op[0] = (u32x4){w[0], w[1], w[2], w[3]}; op[1] = (u32x4){w[4], w[5], w[6], w[7]};
        }
        LDS_WAIT(); __syncthreads();
    }
    if (((item0 >> 2) & 7) == 7) {
#pragma unroll
        for (int e = 0; e < 4; ++e)
#pragma unroll
            for (int x = 0; x < 4; ++x) F.out[OFF_SGP + ((size_t)bh * 64 + k4 + x) * 128 + v0 + 32 * e] = S[e][x];
    }
}
__device__ __forceinline__ void gla_sample_item(Frame& F, int item) {
    const int b = item >> 2, hh = item & 3, tid = F.tid, v = tid & 127, kq = tid >> 7;
    LAS float* red = (LAS float*)(F.lds); LAS float* part = (LAS float*)(F.lds + 4096);
    LAS float* decs = (LAS float*)(F.lds + 8192); LAS float* qs = decs + 256; LAS float* ks = qs + 256;
    if (tid < 256) {
        const int t = tid >> 6, k = tid & 63; const size_t row = (size_t)MPROMPT + 4 * b + t;
        float pre = FIN(13)[hh * 64 + k];
#pragma unroll
        for (int r = 0; r < 16; ++r) pre += WSP(float, WS_A1)[row * 16 + r] * FIN(12)[r * 256 + hh * 64 + k];
        decs[tid] = fexp(logsigf_(pre) * (1.0f / 16.0f));
        qs[tid] = bf2f(WSP(bf16_t, WS_QB)[row * 256 + hh * 64 + k]);
        ks[tid] = bf2f(WSP(bf16_t, WS_KB)[row * 256 + hh * 64 + k]);
    }
    float S[16];
    const float* s0 = FIN(4) + ((size_t)item * 64 + 16 * kq) * 128 + v;
#pragma unroll
    for (int e = 0; e < 16; ++e) S[e] = s0[e * 128];
    float vv4[4], gg4[4];
#pragma unroll
    for (int t = 0; t < DEC_T; ++t) { const size_t row = (size_t)MPROMPT + 4 * b + t; vv4[t] = bf2f(WSP(bf16_t, WS_VB)[row * 512 + hh * 128 + v]); gg4[t] = bf2f(WSP(bf16_t, WS_GB)[row * 512 + hh * 128 + v]); }
    const float gout = FIN(14)[v];
    LDS_WAIT(); __syncthreads();
#pragma unroll
    for (int t = 0; t < DEC_T; ++t) {
        const size_t row = (size_t)MPROMPT + 4 * b + t;
        const float vv = vv4[t];
        float op = 0.f;
#pragma unroll
        for (int e = 0; e < 16; ++e) { const int k = t * 64 + 16 * kq + e;
            S[e] = decs[k] * S[e] + ks[k] * vv; op += qs[k] * S[e]; }
        red[kq * 128 + v] = op;
        LDS_WAIT(); __syncthreads();
        const float o = (red[v] + red[128 + v]) + (red[256 + v] + red[384 + v]);
        const float sq = wave_sum(o * o);
        if (F.lane == 0) part[F.wave] = sq;
        LDS_WAIT(); __syncthreads();
        const float rn = rsqrtf((part[0] + part[1]) * (1.0f / 128.0f) + EPS);
        if (tid < 128) WSP(bf16_t, WS_A2)[row * DM + 512 + hh * 128 + v] = (bf16_t)f2bf(o * rn * gout * siluf_(gg4[t]));
        LDS_WAIT(); __syncthreads();
    }
    float* so = F.out + OFF_SGS + ((size_t)item * 64 + 16 * kq) * 128 + v;
#pragma unroll
    for (int e = 0; e < 16; ++e) so[e * 128] = S[e];
    LDS_WAIT(); __syncthreads();
}

__device__ __forceinline__ void final_norm(Frame& F) {
    const int gw = F.vcu * NWAVES + F.wave, NGW = F.G * NWAVES;
    const bf16_t* H4 = WSP(bf16_t, WS_A2); const unsigned* tot4 = TOT(F.ws, 4);
    f32x4 g[4];
#pragma unroll
    for (int j = 0; j < 4; ++j) g[j] = *((const f32x4*)FIN(22) + F.lane + 64 * j);
    for (int m = MPROMPT + gw; m < MTOT; m += NGW) {
        const float rs = rs_from_tot(tot4[m]);
#pragma unroll
        for (int j = 0; j < 4; ++j) { const u32x2 w = *((const u32x2*)(H4 + (size_t)m * DM) + F.lane + 64 * j);
            const f32x4 x = (f32x4){bflo(w.x), bfhi(w.x), bflo(w.y), bfhi(w.y)};
            __builtin_nontemporal_store(x * rs * g[j], (f32x4*)(F.out + OFF_Y + (size_t)m * DM) + F.lane + 64 * j); }
    }
}

constexpr int NPHASES = 12;
constexpr int CW_BAR = 4096;
__global__ void __launch_bounds__(NWAVES * 64, 2) fwd_kernel(Args args) {
    extern __shared__ __attribute__((aligned(16))) unsigned char lds_raw[];
    Frame F;
    F.lds = (LAS unsigned char*)lds_raw;
    F.tid = threadIdx.x; F.lane = F.tid & 63; F.wave = __builtin_amdgcn_readfirstlane(F.tid >> 6);
    F.G = gridDim.x; { const int bx = blockIdx.x; F.vcu = (F.G % 8 == 0) ? (bx % 8) * (F.G / 8) + bx / 8 : bx; }
    F.a = &args; F.out = args.out; F.ws = args.ws;
    volatile LAS unsigned* MISC = (volatile LAS unsigned*)(F.lds + MISC_OFF);
    for (int u = F.tid; u < (LDS_BYTES - LDSCTL_OFF) / 4; u += NWAVES * 64) ((LAS unsigned*)(F.lds + LDSCTL_OFF))[u] = 0u;
    __syncthreads();
    const int lo = args.ph_lo, hi = args.ph_hi;
    XcdBarrier bar; bar.bar = (unsigned*)(F.ws + WS_CTL) + CW_BAR; bar.x = 0; bar.st = nullptr;
    if (hi - lo > 1) bar = xcd_barrier_post((unsigned*)(F.ws + WS_CTL) + CW_BAR, MISC + 8);
#ifndef REP_MASK
#define REP_MASK 0
#endif

#ifndef PH_MASK
#define PH_MASK 0xFFF
#endif
#define IN(k) ((((PH_MASK) >> (k)) & 1) && lo <= (k) && (k) < hi)
#define SEAM(k) do { if (IN(k) && IN((k) + 1)) xcd_barrier(bar); } while (0)
    LAS unsigned char* ring = F.lds;
    CopyCur cp = copy_cursor_init(args.in[2], args.in[3], args.out, (int)blockIdx.x);
#define DRY_K(k) ((int)((((REP_MASK) >> 12) & 1) && (((REP_MASK) >> (k)) & 1) && rep_ == 0))
#define PHASE_BEGIN() do { F.tid = launder_v(threadIdx.x); F.lane = F.tid & 63; F.wave = __builtin_amdgcn_readfirstlane(F.tid >> 6); } while (0)

    if (IN(0)) for (int rep_ = 0; rep_ <= (((REP_MASK) >> 0) & 1); ++rep_) { if (rep_) xcd_barrier(bar); PHASE_BEGIN(); p0_prologue(F); } SEAM(0);
    if (IN(1)) for (int rep_ = 0; rep_ <= (((REP_MASK) >> 1) & 1); ++rep_) { if (rep_) xcd_barrier(bar); PHASE_BEGIN();
#ifndef NO_G1
        { pg8::Gemm g{WSP(bf16_t, WS_HB), WSP(bf16_t, WS_WGU1), MPROMPT, NGU, DM}; pg8::StaticOrder S; S.init(MPROMPT, NGU, F.G, (int)blockIdx.x);
          pg8::EpiSwiGLU<0> E{F.ws, 0};
          pg8::gemm_phase<pg8::EpiSwiGLU<0>, pg8::StaticOrder, true>(ring, g, S, E, cp); }
#endif
#ifndef NO_G8
        if ((int)blockIdx.x >= 128 || F.G != 256) { pg8::Gemm g{WSP(bf16_t, WS_PB), WSP(bf16_t, WS_WPP), MPROMPT, DM, DPLE}; pg8::StaticOrder S; if (F.G == 256) S.init(MPROMPT, DM, 128, (int)blockIdx.x - 128); else S.init(MPROMPT, DM, F.G, (int)blockIdx.x);
          pg8::EpiPlainBf16 E{F.ws, 0};
          pg8::gemm_phase<pg8::EpiPlainBf16, pg8::StaticOrder, true>(ring, g, S, E, cp); }
#endif
        { const sk::EpiSwiGLU<0> E{F.ws, 0}; for (int t = F.G - 1 - (int)blockIdx.x; t < 2 * (DFF / 32); t += F.G) sk::tile(WSP(bf16_t, WS_HB) + (size_t)MPROMPT * DM, DM, WSP(bf16_t, WS_WGU1), E, t, F.lane, F.wave, ring); }
        { const sk::EpiPlain E{F.ws, 0}; for (int t = F.G - 1 - 2 * (DFF / 32) - (int)blockIdx.x; t < 2 * (DM / 64); t += F.G) if (t >= 0) sk::tile(WSP(bf16_t, WS_PB) + (size_t)MPROMPT * DPLE, DPLE, WSP(bf16_t, WS_WPP), E, t, F.lane, F.wave, ring); }
        if ((int)blockIdx.x >= 128) convert_weights<1>(F, ((int)blockIdx.x - 128) * NWAVES + F.wave, 128 * NWAVES);
    } SEAM(1);
    if (IN(2)) for (int rep_ = 0; rep_ <= (((REP_MASK) >> 2) & 1); ++rep_) { if (rep_) xcd_barrier(bar); PHASE_BEGIN();
        pg8::Gemm g{WSP(bf16_t, WS_ACT), WSP(bf16_t, WS_WD1), MPROMPT, DM, DFF}; pg8::StaticOrder S; S.init(MPROMPT, DM, F.G, (int)blockIdx.x);
        pg8::EpiResid<0, 1, false> E{nullptr, F.ws, 0.5f, DRY_K(2)};
        pg8::gemm_phase<pg8::EpiResid<0, 1, false>, pg8::StaticOrder, true>(ring, g, S, E, cp);
        { const sk::EpiResid<0, 1, false> E2{nullptr, F.ws, 0.5f, DRY_K(2)}; for (int t = F.G - 1 - (int)blockIdx.x; t < 2 * (DM / 64); t += F.G) sk::tile(WSP(bf16_t, WS_ACT) + (size_t)MPROMPT * DFF, DFF, WSP(bf16_t, WS_WD1), E2, t, F.lane, F.wave, ring); }
    } SEAM(2);
    if (IN(3)) for (int rep_ = 0; rep_ <= (((REP_MASK) >> 3) & 1); ++rep_) { if (rep_) xcd_barrier(bar); PHASE_BEGIN();
        { pg8::Gemm g{WSP(bf16_t, WS_HB), WSP(bf16_t, WS_WIN), MPROMPT, 3072, DM}; pg8::StaticOrder S; S.init(MPROMPT, 3072, F.G, (int)blockIdx.x);
          pg8::EpiMix E{F.ws, F.out, 0, 0};
          pg8::gemm_phase<pg8::EpiMix, pg8::StaticOrder, true>(ring, g, S, E, cp); }
        { pg8::Gemm g{WSP(bf16_t, WS_HB), WSP(bf16_t, WS_WIN) + (size_t)3072 * DM, MPROMPT, 256, DM}; pg8::StaticOrder S; S.init(MPROMPT, 256, F.G, (int)blockIdx.x);
          pg8::EpiMix E{F.ws, F.out, 0, 12};
          pg8::gemm_phase<pg8::EpiMix, pg8::StaticOrder, true, true>(ring, g, S, E, cp); }
        { const sk::EpiMix E2{F.ws, F.out, 0}; for (int t = F.G - 1 - (int)blockIdx.x; t < 98; t += F.G) sk::tile(WSP(bf16_t, WS_HB) + (size_t)MPROMPT * DM, DM, WSP(bf16_t, WS_WIN), E2, t, F.lane, F.wave, ring); }
        if ((int)blockIdx.x >= 64) convert_weights<2>(F, ((int)blockIdx.x - 64) * NWAVES + F.wave, 192 * NWAVES);
    } SEAM(3);
    if (IN(4)) for (int rep_ = 0; rep_ <= (((REP_MASK) >> 4) & 1); ++rep_) { if (rep_) xcd_barrier(bar); PHASE_BEGIN();
        for (int it = F.vcu; it < 256; it += F.G) attn_prompt_item(F, it);
        for (int it = F.vcu; it < 256; it += F.G) gla_p1_items<4>(F, 4 * it);
    } if (IN(4) && IN(6)) xcd_barrier(bar);
    if (IN(6)) for (int rep_ = 0; rep_ <= (((REP_MASK) >> 6) & 1); ++rep_) { if (rep_) xcd_barrier(bar); PHASE_BEGIN();
        for (int it = F.vcu; it < 256; it += F.G) gla_p3_items<4>(F, 4 * it);
        for (int it = F.vcu; it < 128; it += F.G) gla_sample_item(F, it);
        for (int it = F.vcu; it < 256; it += F.G) attn_sample_task(F, (F.wave & 3) * 256 + it, F.wave >> 2);
    } if (IN(6) && IN(7)) xcd_barrier(bar);
    if (IN(7)) for (int rep_ = 0; rep_ <= (((REP_MASK) >> 7) & 1); ++rep_) { if (rep_) xcd_barrier(bar); PHASE_BEGIN();
        pg8::Gemm g{WSP(bf16_t, WS_A2), WSP(bf16_t, WS_WOUT), MPROMPT, DM, DM}; pg8::StaticOrder S; S.init(MPROMPT, DM, F.G, (int)blockIdx.x);
        pg8::EpiResid<0, 2, false> E{nullptr, F.ws, 1.0f, DRY_K(7)};
        pg8::gemm_phase<pg8::EpiResid<0, 2, false>, pg8::StaticOrder, true>(ring, g, S, E, cp);
        { const sk::EpiResid<0, 2, false> E2{nullptr, F.ws, 1.0f, DRY_K(7)}; for (int t = F.G - 1 - (int)blockIdx.x; t < 2 * (DM / 64); t += F.G) sk::tile(WSP(bf16_t, WS_A2) + (size_t)MPROMPT * DM, DM, WSP(bf16_t, WS_WOUT), E2, t, F.lane, F.wave, ring); }
    } SEAM(7);
    if (IN(8)) for (int rep_ = 0; rep_ <= (((REP_MASK) >> 8) & 1); ++rep_) { if (rep_) xcd_barrier(bar); PHASE_BEGIN();
        pg8::Gemm g{WSP(bf16_t, WS_HB), WSP(bf16_t, WS_WGU2), MPROMPT, NGU, (PROBE_VAR == 4 && !rep_) ? DM / 2 : DM}; if (PROBE_VAR == 7 && !rep_) g.ld = DM + 64; pg8::StaticOrder S; S.init(MPROMPT, (PROBE_VAR == 2 && rep_) ? NGU / 2 : NGU, F.G, (int)blockIdx.x);
        pg8::EpiSwiGLU<2> E{F.ws, 0};
        if (PROBE_VAR == 5 && !rep_) S.same = 1;
        if (PROBE_VAR == 6 && !rep_) { CopyCur cpd = cp; cpd.it = CP_STEPS; pg8::gemm_phase<pg8::EpiSwiGLU<2>, pg8::StaticOrder, true>(ring, g, S, E, cpd); }
        else if (!(PROBE_VAR == 3 && rep_)) pg8::gemm_phase<pg8::EpiSwiGLU<2>, pg8::StaticOrder, true>(ring, g, S, E, cp);
        if (!((PROBE_VAR == 1 || PROBE_VAR == 2) && rep_) && !((PROBE_VAR == 4 || PROBE_VAR == 5 || PROBE_VAR == 6 || PROBE_VAR == 7) && !rep_)) { const sk::EpiSwiGLU<2> E2{F.ws, 0}; for (int t = F.G - 1 - (int)blockIdx.x; t < 2 * (DFF / 32); t += F.G) sk::tile(WSP(bf16_t, WS_HB) + (size_t)MPROMPT * DM, DM, WSP(bf16_t, WS_WGU2), E2, t, F.lane, F.wave, ring); }
    } SEAM(8);
    if (IN(9)) for (int rep_ = 0; rep_ <= (((REP_MASK) >> 9) & 1); ++rep_) { if (rep_) xcd_barrier(bar); PHASE_BEGIN();
        pg8::Gemm g{WSP(bf16_t, WS_ACT), WSP(bf16_t, WS_WD2), MPROMPT, DM, DFF}; pg8::StaticOrder S; S.init(MPROMPT, DM, F.G, (int)blockIdx.x);
        pg8::EpiResid<0, 3, false> E{nullptr, F.ws, 0.5f, DRY_K(9)};
        pg8::gemm_phase<pg8::EpiResid<0, 3, false>, pg8::StaticOrder, true>(ring, g, S, E, cp);
        { const sk::EpiResid<0, 3, false> E2{nullptr, F.ws, 0.5f, DRY_K(9)}; for (int t = F.G - 1 - (int)blockIdx.x; t < 2 * (DM / 64); t += F.G) sk::tile(WSP(bf16_t, WS_ACT) + (size_t)MPROMPT * DFF, DFF, WSP(bf16_t, WS_WD2), E2, t, F.lane, F.wave, ring); }
    } SEAM(9);
    if (IN(10)) for (int rep_ = 0; rep_ <= (((REP_MASK) >> 10) & 1); ++rep_) { if (rep_) xcd_barrier(bar); PHASE_BEGIN();
        pg8::Gemm g{WSP(bf16_t, WS_HB), WSP(bf16_t, WS_WPG), MPROMPT, DM, DM}; pg8::StaticOrder S; S.init(MPROMPT, DM, F.G, (int)blockIdx.x);
        pg8::EpiPleNorm E{F.ws, F.out, FIN(22), 32u * (unsigned)(rep_ + 1), DRY_K(10)};
        pg8::gemm_phase<pg8::EpiPleNorm, pg8::StaticOrder, true>(ring, g, S, E, cp);
        { const sk::EpiResid<1, 4, false> E2{nullptr, F.ws, 1.0f, DRY_K(10)}; for (int t = F.G - 1 - (int)blockIdx.x; t < 2 * (DM / 64); t += F.G) sk::tile(WSP(bf16_t, WS_HB) + (size_t)MPROMPT * DM, DM, WSP(bf16_t, WS_WPG), E2, t, F.lane, F.wave, ring); }
    } SEAM(10);
    if (IN(11)) for (int rep_ = 0; rep_ <= (((REP_MASK) >> 11) & 1); ++rep_) { if (rep_) xcd_barrier(bar); PHASE_BEGIN(); final_norm(F); copy_cleanup(cp, F.tid); }
#undef IN
#undef SEAM
}

extern "C" void kernel_launch(void* const* d_in, const int* in_sizes, int n_in, void* d_out, int out_size, void* d_ws, size_t ws_size, hipStream_t stream) {
    static int grid = 0;
    if (grid == 0) {
        if (n_in != 23 || (size_t)out_size != OUT_TOTAL || ws_size < WS_END) { fprintf(stderr, "kernel_launch: unexpected shapes: n_in %d out %d ws %zu (need %zu)\n", n_in, out_size, ws_size, (size_t)WS_END); grid = -1; return; }
        int dev = 0, cus = 0;
        if (hipGetDevice(&dev) != hipSuccess || hipDeviceGetAttribute(&cus, hipDeviceAttributeMultiprocessorCount, dev) != hipSuccess) { grid = -1; return; }
        if (hipFuncSetAttribute((const void*)fwd_kernel, hipFuncAttributeMaxDynamicSharedMemorySize, LDS_BYTES) != hipSuccess) { fprintf(stderr, "kernel_launch: hipFuncSetAttribute failed\n"); grid = -1; return; }
        int per_cu = 0;
        if (hipOccupancyMaxActiveBlocksPerMultiprocessor(&per_cu, (const void*)fwd_kernel, NWAVES * 64, LDS_BYTES) != hipSuccess || per_cu < 1) { fprintf(stderr, "kernel_launch: occupancy query says %d blocks per CU\n", per_cu); }
        (void)hipGetLastError();
        grid = cus;
        if (grid != 256) { fprintf(stderr, "kernel_launch: built for a 256-CU device (got %d CUs); nothing launched\n", cus); grid = -1; return; }
    }
    if (grid < 0) return;
    static_assert((CW_BAR + XCD_BAR_WORDS) * 4 <= 65536 && (pg8::CW_PANEL + 64 * 64) * 4 <= 65536, "control words inside the memset");
    (void)hipMemsetAsync((char*)d_ws + WS_CTL, 0, 65536, stream);
    Args a{};
    for (int i = 0; i < 23; ++i) a.in[i] = (const float*)d_in[i];
    a.out = (float*)d_out; a.ws = (unsigned char*)d_ws;
#if MK_PER_PHASE
    for (int p = 0; p < NPHASES; ++p) { a.ph_lo = p; a.ph_hi = p + 1; hipLaunchKernelGGL(fwd_kernel, dim3(grid), dim3(NWAVES * 64), LDS_BYTES, stream, a); }
#else
    a.ph_lo = 0; a.ph_hi = NPHASES;
    hipLaunchKernelGGL(fwd_kernel, dim3(grid), dim3(NWAVES * 64), LDS_BYTES, stream, a);
#endif
}
```

```cpp
#include <hip/hip_runtime.h>
#include <cstdio>
#include <cstdint>

#ifndef PROBE_EPI2
#define PROBE_EPI2 0
#endif
#ifndef PROBE_SK2
#define PROBE_SK2 0
#endif
#ifndef PROBE_VAR
#define PROBE_VAR 0
#endif
#ifndef MK_PER_PHASE
#define MK_PER_PHASE 0
#endif

#define LAS __attribute__((address_space(3)))
#define GAS __attribute__((address_space(1)))
typedef unsigned short bf16_t;
typedef short bf16x8 __attribute__((ext_vector_type(8)));
typedef short s16x4 __attribute__((ext_vector_type(4)));
typedef float f32x4 __attribute__((ext_vector_type(4)));
typedef float f32x2 __attribute__((ext_vector_type(2)));
typedef float f32x16 __attribute__((ext_vector_type(16)));
typedef unsigned u32x4 __attribute__((ext_vector_type(4)));
typedef unsigned u32x2 __attribute__((ext_vector_type(2)));

constexpr int DM = 1024, NBATCH = 8, SEQ = 2048, MPROMPT = NBATCH * SEQ, DEC_B = 32, DEC_T = 4, MSAMP = DEC_B * DEC_T;
constexpr int MTOT = MPROMPT + MSAMP  , MPAD = 16640  ;
constexpr int DFF = 2816, NGU = 2 * DFF, NPROJ = 3328  , DPLE = 256, PAST = 8192, WINB = 2048;
constexpr int HA = 8, HDA = 64, HB_ = 4, DKB = 64, DVB = 128;
constexpr float EPS = 1e-6f;
constexpr float C2Q = 0.125f * 1.4426950408889634f;
constexpr size_t OFF_Y = 0, OFF_KWP = (size_t)MTOT * DM, OFF_VWP = OFF_KWP + (size_t)MPROMPT * 512, OFF_SGP = OFF_VWP + (size_t)MPROMPT * 512,
                 OFF_KWS = OFF_SGP + (size_t)NBATCH * 4 * 64 * 128, OFF_VWS = OFF_KWS + (size_t)DEC_B * WINB * 512, OFF_SGS = OFF_VWS + (size_t)DEC_B * WINB * 512,
                 OUT_TOTAL = OFF_SGS + (size_t)DEC_B * 4 * 64 * 128;

constexpr size_t al256(size_t x) { return (x + 255) & ~(size_t)255; }
constexpr size_t WS_CTL = 0, CTL_BYTES = 1u << 20;
constexpr size_t WS_WGU1 = CTL_BYTES,                                   SZ_WGU = (size_t)NGU * DM * 2;
constexpr size_t WS_WGU2 = WS_WGU1 + SZ_WGU;
constexpr size_t WS_WD1 = WS_WGU2 + SZ_WGU,                             SZ_WD = (size_t)DM * DFF * 2;
constexpr size_t WS_WD2 = WS_WD1 + SZ_WD;
constexpr size_t WS_WIN = WS_WD2 + SZ_WD,                               SZ_WIN = (size_t)NPROJ * DM * 2;
constexpr size_t WS_WOUT = WS_WIN + SZ_WIN,                             SZ_W1K = (size_t)DM * DM * 2;
constexpr size_t WS_WPG = WS_WOUT + SZ_W1K;
constexpr size_t WS_WPP = WS_WPG + SZ_W1K,                              SZ_WPP = (size_t)DM * DPLE * 2;
constexpr size_t WS_HB = WS_WPP + SZ_WPP,                               SZ_HB = (size_t)MPAD * DM * 2;
constexpr size_t WS_ACT = WS_HB + SZ_HB,                                SZ_ACT = (size_t)MPAD * DFF * 2;
constexpr size_t WS_H32 = WS_ACT + SZ_ACT,                              SZ_H32 = (size_t)MPAD * DM * 4;
constexpr size_t WS_PROJ = WS_H32 + SZ_H32;
constexpr size_t WS_QA = WS_PROJ + SZ_HB,                               SZ_512 = (size_t)MPAD * 512 * 2, SZ_256 = (size_t)MPAD * 256 * 2;
constexpr size_t WS_KA = WS_QA + SZ_512, WS_VA = WS_KA + SZ_512, WS_QB = WS_VA + SZ_512, WS_KB = WS_QB + SZ_256, WS_VB = WS_KB + SZ_256, WS_GB = WS_VB + SZ_512;
constexpr size_t WS_A1 = WS_GB + SZ_512,                                SZ_A1 = (size_t)MPAD * 16 * 4;
constexpr size_t WS_A2 = WS_A1 + SZ_A1;
constexpr size_t WS_PB = WS_A2 + SZ_HB;
constexpr size_t WS_SSQ = WS_PB + SZ_256,                               SZ_SSQ = (size_t)MPAD * 16 * 4;
constexpr size_t WS_ROPE = WS_SSQ + 5 * SZ_SSQ,                         SZ_ROPE = al256((size_t)2052 * 16 * 4);
constexpr size_t WS_BTOT = WS_ROPE + SZ_ROPE,                           SZ_BTOT = (size_t)1024 * 64 * 4;
constexpr size_t WS_END = WS_BTOT + SZ_BTOT;
constexpr size_t WS_HCT = WS_ACT, SZ_HCT = (size_t)1024 * 8192 * 4;
constexpr size_t WS_SPT = WS_HCT + SZ_HCT, SZ_SPT = (size_t)1024 * 8192 * 2;
constexpr size_t WS_GAG = WS_SPT, WS_DSUM = WS_GAG + (size_t)256 * 8192 * 4;
static_assert(SZ_HCT + SZ_SPT <= SZ_ACT, "overlay fits");
static_assert(WS_END <= (size_t)500 * 1024 * 1024, "workspace budget");

constexpr int RING_BYTES = 131072, LDSCTL_OFF = RING_BYTES, MISC_OFF = LDSCTL_OFF + 320, LDS_BYTES = 147456;
constexpr int NWAVES = 8;

#define LDS_WAIT() asm volatile("s_waitcnt lgkmcnt(0)" ::: "memory")
#define VM_WAIT() asm volatile("s_waitcnt vmcnt(0)" ::: "memory")
__device__ __forceinline__ unsigned f2bf(float f) { unsigned u = __builtin_bit_cast(unsigned, f); return (u + 0x7fffu + ((u >> 16) & 1u)) >> 16; }
__device__ __forceinline__ unsigned pk2(float lo, float hi) { return f2bf(lo) | (f2bf(hi) << 16); }
typedef __bf16 bf16x2_t __attribute__((ext_vector_type(2)));
__device__ __forceinline__ unsigned cvt_pk_bf16(float lo, float hi) { const f32x2 v = {lo, hi}; return __builtin_bit_cast(unsigned, __builtin_convertvector(v, bf16x2_t)); }
__device__ __forceinline__ float bf2f(unsigned short b) { return __uint_as_float(((unsigned)b) << 16); }
__device__ __forceinline__ float bflo(unsigned w) { return __uint_as_float(w << 16); }
__device__ __forceinline__ float bfhi(unsigned w) { return __uint_as_float(w & 0xffff0000u); }
__device__ __forceinline__ float fexp(float x) { return __builtin_amdgcn_exp2f(x * 1.4426950408889634f); }
__device__ __forceinline__ float sigmoidf_(float x) { return __builtin_amdgcn_rcpf(1.f + fexp(-x)); }
__device__ __forceinline__ float siluf_(float x) { return x * sigmoidf_(x); }
__device__ __forceinline__ float logsigf_(float x) { return fminf(x, 0.f) - __logf(1.f + fexp(-fabsf(x))); }
__device__ __forceinline__ float wave_sum(float v) {
#pragma unroll
    for (int o = 1; o < 64; o <<= 1) v += __shfl_xor(v, o);
    return v;
}
__device__ __forceinline__ int launder_v(int x) { asm volatile("" : "+v"(x)); return x; }
template <class T> __device__ __forceinline__ T* launder_s(T* p) { asm volatile("" : "+s"(p)); return p; }
#define TOT(ws_, i) ((unsigned*)((ws_) + WS_SSQ + (size_t)(i) * SZ_SSQ))
constexpr float SSQ_SCALE = 16384.f, SSQ_INV = 1.0f / (16384.f * DM);
__device__ __forceinline__ float rs_from_tot(unsigned t) { return rsqrtf((float)t * SSQ_INV + EPS); }
__device__ __forceinline__ void ssq_add(unsigned* tot, int row, float ss) { __hip_atomic_fetch_add(tot + row, (unsigned)(ss * SSQ_SCALE + 0.5f), __ATOMIC_RELAXED, __HIP_MEMORY_SCOPE_AGENT); }
__device__ __forceinline__ float row_rs(const unsigned* tot, int row) { return rs_from_tot(tot[row]); }
__device__ __forceinline__ void row_tot8(const unsigned* tot, int row0, unsigned (&t)[2][4]) {
    const unsigned* p = tot + row0;
#pragma unroll
    for (int ai = 0; ai < 2; ++ai)
#pragma unroll
        for (int m = 0; m < 4; ++m) asm volatile("global_load_dword %0, %1, off offset:%2" : "=v"(t[ai][m]) : "v"(p), "n"((ai * 128 + m * 16) * 4) : "memory");
}

constexpr int CPQ_ELEMS = (WINB - DEC_T) * 128 / 4  , CP_STEPS = (CPQ_ELEMS + 511) / 512  ;
struct CopyCur { const f32x4* src; f32x4* dst; int it; };
__device__ __forceinline__ CopyCur copy_cursor_init(const float* ck, const float* cv, float* out, int w) {
    const int seg = w >> 2, q = w & 3, tensor = seg >> 5, b = seg & 31;
    CopyCur c; c.src = (const f32x4*)(tensor ? cv : ck) + (size_t)b * (WINB * 128) + DEC_T * 128 + (size_t)q * CPQ_ELEMS;
    c.dst = (f32x4*)(out + (tensor ? OFF_VWS : OFF_KWS)) + (size_t)b * (WINB * 128) + (size_t)q * CPQ_ELEMS; c.it = 0; return c;
}
__device__ __forceinline__ void copy_cleanup(CopyCur& c, int tid) {
    for (; c.it < CP_STEPS; ++c.it) { const int e = c.it * 512 + tid; if (e < CPQ_ELEMS) __builtin_nontemporal_store(__builtin_nontemporal_load(c.src + e), c.dst + e); }
}

namespace pg8 {
constexpr int BM = 256, BK = 64, HALF = 128, HTB = HALF * BK * 2, STAGE_BYTES = 8 * HTB, NXCD = 8, WGM = 8;
__host__ __device__ __forceinline__ int lds_byte(int r, int c) { const int st = (r >> 4) * 2 + (c >> 5), rr = r & 15, cc = c & 31, ob = rr * 64 + cc * 2; return st * 1024 + (ob ^ (((ob >> 9) & 1) << 5)); }
__host__ __device__ __forceinline__ void stage_rc(int b, int& R, int& C) { const int st = b / 1024, sb = b % 1024, swz = sb ^ (((sb >> 9) & 1) << 5); R = (st >> 1) * 16 + swz / 64; C = (st & 1) * 32 + (swz % 64) / 2; }
__host__ __device__ __forceinline__ int perm32(int rho) { const int n = rho >> 4, i = rho & 15; return 8 * (i >> 2) + 4 * n + (i & 3); }
struct Unit { int pm, pn; };
struct Gemm { const bf16_t* A; const bf16_t* Bt; int M, N, K; int ld = 0; };
struct StaticOrder {
    int nM, nN, nwg, G, c, same;
    __host__ __device__ void init(int M, int N, int G_, int c_) { nM = M / BM; nN = N / BM; nwg = nM * nN; G = G_; c = c_; same = 0; }
    __host__ __device__ bool next(int i, Unit& u) const {
        const long L = (long)i * G + c; if (L >= nwg) return false;
        int wgid = (int)L; { const int q = nwg / NXCD, r = nwg % NXCD, xcd = wgid % NXCD, off = wgid / NXCD; wgid = (xcd < r ? xcd * (q + 1) : r * (q + 1) + (xcd - r) * q) + off; }
        const int nig = WGM * nN, gid = wgid / nig, fm = gid * WGM, gsz = (nM - fm) < WGM ? (nM - fm) : WGM;
        u.pm = fm + ((wgid % nig) % gsz); u.pn = (wgid % nig) / gsz;
#if PROBE_VAR == 5
        if (same) { u.pm = c & 7; u.pn = 0; }
#endif
        return true;
    }
    __device__ __forceinline__ void a_ready(const Unit&) const {}
    __device__ __forceinline__ void done(const Unit&) const {}
};

template <class Epi, class Sched, bool ALIGN_EPI, bool LITE = false>
__device__ __forceinline__ void gemm_phase(LAS unsigned char* lds, const Gemm g, const Sched& S, const Epi& E, CopyCur& cp) {
    const int tid = launder_v(threadIdx.x), wid = __builtin_amdgcn_readfirstlane(tid >> 6), lane = tid & 63, wr = wid >> 2, wc = wid & 3, fr = lane & 15, fq = lane >> 4;
    const int nt = g.K / BK, K = g.ld ? g.ld : g.K;
    unsigned voffA[2], voffB[2];
#pragma unroll
    for (int i = 0; i < 2; ++i) { int R, C; stage_rc(tid * 16 + i * 8192, R, C); const int Rb = Epi::PERM ? ((R & ~31) + perm32(R & 31)) : R;
        voffA[i] = (unsigned)(R * K + C) * 2u; voffB[i] = (unsigned)(Rb * K + C) * 2u; }
    const size_t kstep = (size_t)(BK * 2);
    const size_t hstep = (size_t)HALF * K * 2;
    const size_t tstep = 2 * hstep;
    const unsigned ldsw = (unsigned)wid * 1024u;
    const int aoff = lds_byte(wr * 64 + fr, fq * 8), boff = lds_byte(wc * 32 + fr, fq * 8);
#define PG8_SA(b, h) (((b) * 2 + (h)) * HTB)
#define PG8_SB(b, h) ((4 + (b) * 2 + (h)) * HTB)
#define PG8_STAGE(bufoff, gbase, voff) do { _Pragma("unroll") for (int _i = 0; _i < 2; ++_i) \
        __builtin_amdgcn_global_load_lds((const unsigned*)((const char*)(gbase) + (voff)[_i]), (LAS unsigned*)(lds + (bufoff) + ldsw + _i * 8192), 16, 0, 0); } while (0)
#define PG8_LDA(dst, b, h) do { _Pragma("unroll") for (int m = 0; m < 4; ++m) _Pragma("unroll") for (int k = 0; k < 2; ++k) dst[m][k] = *(const LAS bf16x8*)(lds + PG8_SA(b, h) + aoff + m * 2048 + k * 1024); } while (0)
#define PG8_LDB(dst, b, h) do { _Pragma("unroll") for (int n = 0; n < 2; ++n) _Pragma("unroll") for (int k = 0; k < 2; ++k) dst[n][k] = *(const LAS bf16x8*)(lds + PG8_SB(b, h) + boff + n * 2048 + k * 1024); } while (0)
#define PG8_MMA(ai, bj, At, Bt) do { if (LITE && ((bj) != 0 || wc != 0)) break; __builtin_amdgcn_s_setprio(1); _Pragma("unroll") for (int m = 0; m < 4; ++m) _Pragma("unroll") for (int n = 0; n < 2; ++n) _Pragma("unroll") for (int k = 0; k < 2; ++k) \
        acc[ai][bj][m][n] = __builtin_amdgcn_mfma_f32_16x16x32_bf16(Bt[n][k], At[m][k], acc[ai][bj][m][n], 0, 0, 0); __builtin_amdgcn_s_setprio(0); } while (0)
#define PG8_WAIT_V(n) asm volatile("s_waitcnt vmcnt(" #n ")" ::: "memory")
#define PG8_WAIT_VC() do { if (ncp == 0) PG8_WAIT_V(8); else if (ncp == 1) PG8_WAIT_V(9); else PG8_WAIT_V(10); } while (0)
#define PG8_WAIT_L(n) asm volatile("s_waitcnt lgkmcnt(" #n ")" ::: "memory")
#define PG8_BAR __builtin_amdgcn_s_barrier()
#define PG8_SCHED __builtin_amdgcn_sched_barrier(0)
    Unit cur, nxt; int ui = 0;
    if (!S.next(0, cur)) return;
    unsigned pre[2][4] = {{0u, 0u, 0u, 0u}, {0u, 0u, 0u, 0u}};
    if constexpr (Epi::PRE) E.prefetch(cur, wr, fr, pre);
    f32x4 acc[2][2][4][2];
#pragma unroll
    for (int a = 0; a < 2; ++a)
#pragma unroll
        for (int b = 0; b < 2; ++b)
#pragma unroll
            for (int m = 0; m < 4; ++m)
#pragma unroll
                for (int n = 0; n < 2; ++n) acc[a][b][m][n] = (f32x4){0.f, 0.f, 0.f, 0.f};
    bf16x8 At[4][2], B0[2][2], B1[2][2];
    f32x4 cp_data = (f32x4){0.f, 0.f, 0.f, 0.f}; int cp_e = 0; bool cp_pending = false;
    const char* cA = (const char*)g.A + (size_t)cur.pm * tstep; const char* cB = (const char*)g.Bt + (size_t)cur.pn * tstep;
    S.a_ready(cur);
    PG8_STAGE(PG8_SB(0, 0), cB, voffB); PG8_STAGE(PG8_SB(0, 1), cB + hstep, voffB); PG8_STAGE(PG8_SA(0, 0), cA, voffA); PG8_STAGE(PG8_SA(0, 1), cA + hstep, voffA);
    if (wr == 1) PG8_BAR;
    PG8_WAIT_V(2); PG8_BAR;
    PG8_STAGE(PG8_SB(1, 0), cB + kstep, voffB); PG8_STAGE(PG8_SA(1, 0), cA + kstep, voffA); PG8_STAGE(PG8_SB(1, 1), cB + hstep + kstep, voffB);
    PG8_WAIT_V(6); PG8_BAR;
    for (;;) {
        const bool has_next = S.next(ui + 1, nxt);
        const char* nA = has_next ? (const char*)g.A + (size_t)nxt.pm * tstep : cA; const char* nB = has_next ? (const char*)g.Bt + (size_t)nxt.pn * tstep : cB;
#pragma nounroll
        for (int t = 0; t < nt; t += 2) {
            const bool last = (t == nt - 2);
            const char* a1 = cA + (size_t)(t + 1) * kstep;
            const char* a2 = last ? nA : cA + (size_t)(t + 2) * kstep; const char* b2 = last ? nB : cB + (size_t)(t + 2) * kstep;
            const char* a3 = a2 + kstep; const char* b3 = b2 + kstep;
            if (last && has_next) S.a_ready(nxt);
            PG8_LDB(B0, 0, 0); PG8_LDB(B1, 0, 1); PG8_SCHED; PG8_LDA(At, 0, 0); PG8_STAGE(PG8_SA(1, 1), a1 + hstep, voffA);
            int ncp = 0;
            if (cp_pending) { asm volatile("global_store_dwordx4 %0, %1, off nt\n\ts_nop 1" :: "v"(cp.dst + cp_e), "v"(cp_data) : "memory"); ncp = 1; cp_pending = false; }
            if (cp.it < CP_STEPS && !last) {
                cp_e = cp.it * 512 + tid; ++cp.it;
                if (cp.it * 512 - 512 + wid * 64 < CPQ_ELEMS) { asm volatile("global_load_dwordx4 %0, %1, off nt" : "=v"(cp_data) : "v"(cp.src + cp_e) : "memory"); ++ncp; cp_pending = true; }
            }
            PG8_WAIT_VC(); PG8_WAIT_L(0); PG8_BAR; PG8_MMA(0, 0, At, B0); PG8_MMA(0, 1, At, B1); PG8_BAR; PG8_SCHED;
            PG8_LDA(At, 0, 1); PG8_STAGE(PG8_SB(0, 0), b2, voffB); PG8_STAGE(PG8_SB(0, 1), b2 + hstep, voffB); PG8_STAGE(PG8_SA(0, 0), a2, voffA);
            PG8_WAIT_VC(); PG8_WAIT_L(0); PG8_BAR; PG8_MMA(1, 0, At, B0); PG8_MMA(1, 1, At, B1); PG8_BAR; PG8_SCHED;
            PG8_LDB(B0, 1, 0); PG8_LDB(B1, 1, 1); PG8_SCHED; PG8_LDA(At, 1, 0); PG8_STAGE(PG8_SA(0, 1), a2 + hstep, voffA);
            PG8_WAIT_VC(); PG8_WAIT_L(0); PG8_BAR; PG8_MMA(0, 0, At, B0); PG8_MMA(0, 1, At, B1); PG8_BAR; PG8_SCHED;
            PG8_LDA(At, 1, 1); PG8_STAGE(PG8_SB(1, 0), b3, voffB); PG8_STAGE(PG8_SB(1, 1), b3 + hstep, voffB); PG8_STAGE(PG8_SA(1, 0), a3, voffA);
            PG8_WAIT_V(8); PG8_WAIT_L(0); PG8_BAR; PG8_MMA(1, 0, At, B0); PG8_MMA(1, 1, At, B1); PG8_BAR; PG8_SCHED;
        }
        if constexpr (ALIGN_EPI) { if (wr == 0) PG8_BAR; }
#if PROBE_EPI2
        if constexpr (Epi::PROBE2) { Epi Ed = E; Ed.dry = 1; Ed(acc, cur, wr, wc, fr, fq, pre); asm volatile("s_waitcnt vmcnt(0)" ::: "memory"); }
#endif
        if constexpr (Epi::PRE) {
#pragma unroll
            for (int a = 0; a < 2; ++a)
#pragma unroll
                for (int m = 0; m < 4; ++m) asm volatile("" : "+v"(pre[a][m]));
        }
        E(acc, cur, wr, wc, fr, fq, pre); S.done(cur);
        if (!has_next) break;
        if constexpr (Epi::PRE) E.prefetch(nxt, wr, fr, pre);
#pragma unroll
        for (int a = 0; a < 2; ++a)
#pragma unroll
            for (int b = 0; b < 2; ++b)
#pragma unroll
                for (int m = 0; m < 4; ++m)
#pragma unroll
                    for (int n = 0; n < 2; ++n) acc[a][b][m][n] = (f32x4){0.f, 0.f, 0.f, 0.f};
        cur = nxt; cA = nA; cB = nB; ++ui;
        if constexpr (ALIGN_EPI) { if (wr == 1) PG8_BAR; }
    }
    PG8_WAIT_V(0);
    if constexpr (!ALIGN_EPI) { if (wr == 0) PG8_BAR; }
    PG8_BAR;
#undef PG8_SA
#undef PG8_SB
#undef PG8_STAGE
#undef PG8_LDA
#undef PG8_LDB
#undef PG8_MMA
#undef PG8_WAIT_V
#undef PG8_WAIT_VC
#undef PG8_WAIT_L
#undef PG8_BAR
#undef PG8_SCHED
}


template <int SSQI> struct EpiSwiGLU {
    static constexpr bool PERM = true, PROBE2 = true, PRE = true;
    unsigned char* ws; int dry;
    __device__ __forceinline__ void prefetch(const Unit& u, int wr, int fr, unsigned (&pre)[2][4]) const { row_tot8(TOT(ws, SSQI), u.pm * BM + wr * 64 + fr, pre); }
    __device__ __forceinline__ void operator()(const f32x4 (&acc)[2][2][4][2], const Unit& u, int wr, int wc, int fr, int fq, const unsigned (&pre)[2][4]) const {
        bf16_t* O = (bf16_t*)(ws + WS_ACT);
        const int row0 = u.pm * BM + wr * 64 + fr, col0 = u.pn * 128 + wc * 32 + 8 * fq;
#pragma unroll
        for (int ai = 0; ai < 2; ++ai)
#pragma unroll
            for (int m = 0; m < 4; ++m) {
                const int row = row0 + ai * HALF + m * 16; const float rs = rs_from_tot(pre[ai][m]);
                float o[8];
#pragma unroll
                for (int n = 0; n < 2; ++n)
#pragma unroll
                    for (int j = 0; j < 4; ++j) { const float gt = acc[ai][0][m][n][j] * rs, up = acc[ai][1][m][n][j] * rs; o[n * 4 + j] = siluf_(gt) * up; }
                u32x4 w; w.x = cvt_pk_bf16(o[0], o[1]); w.y = cvt_pk_bf16(o[2], o[3]); w.z = cvt_pk_bf16(o[4], o[5]); w.w = cvt_pk_bf16(o[6], o[7]);
                *(u32x4*)(O + (size_t)row * DFF + col0) = w;
            }
    }
};
struct EpiPlainBf16 {
    static constexpr bool PERM = true, PROBE2 = true, PRE = false;
    unsigned char* ws; int dry;
    __device__ __forceinline__ void operator()(const f32x4 (&acc)[2][2][4][2], const Unit& u, int wr, int wc, int fr, int fq, const unsigned (&)[2][4]) const {
        bf16_t* O = (bf16_t*)(ws + WS_PROJ); constexpr int ldc = DM;
        const int row0 = u.pm * BM + wr * 64 + fr, col0 = u.pn * BM + wc * 32 + 8 * fq;
#pragma unroll
        for (int ai = 0; ai < 2; ++ai)
#pragma unroll
            for (int m = 0; m < 4; ++m) { bf16_t* rowp = O + (size_t)(row0 + ai * HALF + m * 16) * ldc + col0;
#pragma unroll
                for (int bj = 0; bj < 2; ++bj) { const f32x4 v0 = acc[ai][bj][m][0], v1 = acc[ai][bj][m][1];
                    u32x4 w; w.x = cvt_pk_bf16(v0[0], v0[1]); w.y = cvt_pk_bf16(v0[2], v0[3]); w.z = cvt_pk_bf16(v1[0], v1[1]); w.w = cvt_pk_bf16(v1[2], v1[3]);
                    *(u32x4*)(rowp + bj * HALF) = w; } }
    }
};
template <int MODE  , int SSQO, bool FROM_X  > struct EpiResid {
    static constexpr bool PERM = true, PROBE2 = true, PRE = false;
    const float* xP; unsigned char* ws; float scale; int dry;
    __device__ __forceinline__ void operator()(const f32x4 (&acc)[2][2][4][2], const Unit& u, int wr, int wc, int fr, int fq, const unsigned (&)[2][4]) const {
        bf16_t* HBp = (bf16_t*)(ws + WS_HB); unsigned* ssq_out = TOT(ws, SSQO);
        const int col0 = u.pn * BM + wc * 32 + 8 * fq, row00 = u.pm * BM + wr * 64 + fr;
        u32x4 bn_[2];
#pragma unroll
        for (int bj = 0; bj < 2; ++bj) bn_[bj] = *(const u32x4*)(HBp + (size_t)row00 * DM + col0 + bj * HALF);
#pragma unroll
        for (int ai = 0; ai < 2; ++ai)
#pragma unroll
            for (int m = 0; m < 4; ++m) {
                const int row = row00 + ai * HALF + m * 16;
                u32x4 bc[2];
#pragma unroll
                for (int bj = 0; bj < 2; ++bj) bc[bj] = bn_[bj];
                if (ai * 4 + m < 7) { const int rown = row00 + ((ai * 4 + m + 1) >> 2) * HALF + ((ai * 4 + m + 1) & 3) * 16;
#pragma unroll
                    for (int bj = 0; bj < 2; ++bj) bn_[bj] = *(const u32x4*)(HBp + (size_t)rown * DM + col0 + bj * HALF); }
                float ss = 0.f;
#pragma unroll
                for (int bj = 0; bj < 2; ++bj) {
                    const u32x4 w0 = bc[bj];
                    const f32x4 v0 = (f32x4){bflo(w0.x), bfhi(w0.x), bflo(w0.y), bfhi(w0.y)} + acc[ai][bj][m][0] * scale;
                    const f32x4 v1 = (f32x4){bflo(w0.z), bfhi(w0.z), bflo(w0.w), bfhi(w0.w)} + acc[ai][bj][m][1] * scale;
                    if (!dry) { u32x4 w; w.x = cvt_pk_bf16(v0[0], v0[1]); w.y = cvt_pk_bf16(v0[2], v0[3]); w.z = cvt_pk_bf16(v1[0], v1[1]); w.w = cvt_pk_bf16(v1[2], v1[3]);
                        *(u32x4*)(HBp + (size_t)row * DM + col0 + bj * HALF) = w; }
                    ss += ((v0[0] * v0[0] + v0[1] * v0[1]) + (v0[2] * v0[2] + v0[3] * v0[3])) + ((v1[0] * v1[0] + v1[1] * v1[1]) + (v1[2] * v1[2] + v1[3] * v1[3])); }
                ss += __shfl_xor(ss, 16); ss += __shfl_xor(ss, 32);
                if (fq == 0 && !dry) ssq_add(ssq_out, row, ss);
            }
    }
};
constexpr int CW_PANEL = 8192;
struct EpiPleNorm {
    static constexpr bool PERM = true, PROBE2 = false, PRE = true;
    unsigned char* ws; float* out; const float* gfin; unsigned want; int dry;
    __device__ __forceinline__ void prefetch(const Unit& u, int wr, int fr, unsigned (&pre)[2][4]) const { row_tot8(TOT(ws, 3), u.pm * BM + wr * 64 + fr, pre); }
    __device__ __forceinline__ void operator()(f32x4 (&acc)[2][2][4][2], const Unit& u, int wr, int wc, int fr, int fq, const unsigned (&pre)[2][4]) const {
        const bf16_t* HBp = (const bf16_t*)(ws + WS_HB); const bf16_t* proj = (const bf16_t*)(ws + WS_PROJ);
        unsigned* ssq4 = TOT(ws, 4);
        const int col0 = u.pn * BM + wc * 32 + 8 * fq, row00 = u.pm * BM + wr * 64 + fr;
        u32x4 pn_[2], bn_[2];
#pragma unroll
        for (int bj = 0; bj < 2; ++bj) { pn_[bj] = *(const u32x4*)(proj + (size_t)row00 * DM + col0 + bj * HALF); bn_[bj] = *(const u32x4*)(HBp + (size_t)row00 * DM + col0 + bj * HALF); }
#pragma unroll
        for (int ai = 0; ai < 2; ++ai)
#pragma unroll
            for (int m = 0; m < 4; ++m) {
                const int row = row00 + ai * HALF + m * 16;
                const float rs = rs_from_tot(pre[ai][m]);
                u32x4 pc[2], bc[2];
#pragma unroll
                for (int bj = 0; bj < 2; ++bj) { pc[bj] = pn_[bj]; bc[bj] = bn_[bj]; }
                if (ai * 4 + m < 7) { const int rown = row00 + ((ai * 4 + m + 1) >> 2) * HALF + ((ai * 4 + m + 1) & 3) * 16;
#pragma unroll
                    for (int bj = 0; bj < 2; ++bj) { pn_[bj] = *(const u32x4*)(proj + (size_t)rown * DM + col0 + bj * HALF); bn_[bj] = *(const u32x4*)(HBp + (size_t)rown * DM + col0 + bj * HALF); } }
                float ss = 0.f;
#pragma unroll
                for (int bj = 0; bj < 2; ++bj) {
                    const u32x4 b0 = bc[bj], p0 = pc[bj];
                    const f32x4 a0 = acc[ai][bj][m][0] * rs, a1 = acc[ai][bj][m][1] * rs; f32x4 v0, v1;
                    v0[0] = bflo(b0.x) + sigmoidf_(a0[0]) * bflo(p0.x); v0[1] = bfhi(b0.x) + sigmoidf_(a0[1]) * bfhi(p0.x); v0[2] = bflo(b0.y) + sigmoidf_(a0[2]) * bflo(p0.y); v0[3] = bfhi(b0.y) + sigmoidf_(a0[3]) * bfhi(p0.y);
                    v1[0] = bflo(b0.z) + sigmoidf_(a1[0]) * bflo(p0.z); v1[1] = bfhi(b0.z) + sigmoidf_(a1[1]) * bfhi(p0.z); v1[2] = bflo(b0.w) + sigmoidf_(a1[2]) * bflo(p0.w); v1[3] = bfhi(b0.w) + sigmoidf_(a1[3]) * bfhi(p0.w);
                    acc[ai][bj][m][0] = v0; acc[ai][bj][m][1] = v1;
                    ss += ((v0[0] * v0[0] + v0[1] * v0[1]) + (v0[2] * v0[2] + v0[3] * v0[3])) + ((v1[0] * v1[0] + v1[1] * v1[1]) + (v1[2] * v1[2] + v1[3] * v1[3])); }
                ss += __shfl_xor(ss, 16); ss += __shfl_xor(ss, 32);
                if (fq == 0 && !dry) ssq_add(ssq4, row, ss);
            }
        asm volatile("s_waitcnt vmcnt(0)" ::: "memory");
        unsigned* cnt = (unsigned*)(ws + WS_CTL) + CW_PANEL + 64 * u.pm;
        if (fr == 0 && fq == 0) __hip_atomic_fetch_add(cnt, 1u, __ATOMIC_RELAXED, __HIP_MEMORY_SCOPE_AGENT);
        if (wr == 0 && wc == 0) {
            unsigned sp = 0;
            while ((unsigned)__builtin_amdgcn_readfirstlane(__hip_atomic_load(cnt, __ATOMIC_RELAXED, __HIP_MEMORY_SCOPE_AGENT)) < want) { __builtin_amdgcn_s_sleep(2); if (++sp > (1u << 20)) break; }
        }
        asm volatile("s_waitcnt vmcnt(0) lgkmcnt(0)" ::: "memory"); __builtin_amdgcn_s_barrier(); asm volatile("" ::: "memory");
        f32x4 g[2][2];
#pragma unroll
        for (int bj = 0; bj < 2; ++bj)
#pragma unroll
            for (int n = 0; n < 2; ++n) g[bj][n] = *(const f32x4*)(gfin + col0 + bj * HALF + n * 4);
#pragma unroll
        for (int ai = 0; ai < 2; ++ai)
#pragma unroll
            for (int m = 0; m < 4; ++m) {
                const int row = row00 + ai * HALF + m * 16;
                const float rs4 = rs_from_tot(__hip_atomic_load(ssq4 + row, __ATOMIC_RELAXED, __HIP_MEMORY_SCOPE_AGENT));
                if (!dry) {
#pragma unroll
                    for (int bj = 0; bj < 2; ++bj)
#pragma unroll
                        for (int n = 0; n < 2; ++n) __builtin_nontemporal_store(acc[ai][bj][m][n] * rs4 * g[bj][n], (f32x4*)(out + OFF_Y + (size_t)row * DM + col0 + bj * HALF + n * 4));
                }
            }
    }
};
struct EpiMix {
    static constexpr bool PERM = true, PROBE2 = true, PRE = true;
    unsigned char* ws; float* out; int dry; int pn_base;
    __device__ __forceinline__ void prefetch(const Unit& u, int wr, int fr, unsigned (&pre)[2][4]) const { row_tot8(TOT(ws, 1), u.pm * BM + wr * 64 + fr, pre); }
    __device__ __forceinline__ void operator()(const f32x4 (&acc)[2][2][4][2], const Unit& u, int wr, int wc, int fr, int fq, const unsigned (&pre)[2][4]) const {
        const float* rope = (const float*)(ws + WS_ROPE);
        bf16_t *QA = (bf16_t*)(ws + WS_QA), *KA = (bf16_t*)(ws + WS_KA), *VA = (bf16_t*)(ws + WS_VA), *QB = (bf16_t*)(ws + WS_QB), *KB = (bf16_t*)(ws + WS_KB), *VB = (bf16_t*)(ws + WS_VB), *GB = (bf16_t*)(ws + WS_GB);
        float* A1 = (float*)(ws + WS_A1);
        const int pn = u.pn + pn_base;
        if (pn == 12 && wc != 0) return;
        const bool do_rope = (pn < 4) && ((wc & 1) == 0);
        const int row00 = u.pm * BM + wr * 64 + fr, cb = wc * 32 + 8 * fq;
        f32x4 tn[4];
#pragma unroll
        for (int k = 0; k < 4; ++k) tn[k] = (f32x4){0.f, 0.f, 0.f, 0.f};
        if (do_rope) { const int posidx = row00 & (SEQ - 1);
#pragma unroll
            for (int k = 0; k < 4; ++k) tn[k] = *(const f32x4*)(rope + (size_t)posidx * 16 + 4 * k); }
#pragma unroll
        for (int ai = 0; ai < 2; ++ai)
#pragma unroll
            for (int m = 0; m < 4; ++m) {
                const int row = row00 + ai * HALF + m * 16;
                const float rs = rs_from_tot(pre[ai][m]);
                f32x4 v[2][2];
#pragma unroll
                for (int bj = 0; bj < 2; ++bj)
#pragma unroll
                    for (int n = 0; n < 2; ++n) v[bj][n] = acc[ai][bj][m][n] * rs;
                if (do_rope) {
                    f32x4 t[4];
#pragma unroll
                    for (int k = 0; k < 4; ++k) t[k] = tn[k];
                    if (ai * 4 + m < 7) { const int rown = row00 + ((ai * 4 + m + 1) >> 2) * HALF + ((ai * 4 + m + 1) & 3) * 16; const int posn = rown & (SEQ - 1);
#pragma unroll
                        for (int k = 0; k < 4; ++k) tn[k] = *(const f32x4*)(rope + (size_t)posn * 16 + 4 * k); }
#pragma unroll
                    for (int bj = 0; bj < 2; ++bj)
#pragma unroll
                        for (int n = 0; n < 2; ++n)
#pragma unroll
                            for (int j = 0; j < 4; ++j) { const float cs = t[2 * n + (j >> 1)][2 * (j & 1)], sn = t[2 * n + (j >> 1)][2 * (j & 1) + 1];
                                const float x = v[bj][n][j], w = __shfl_xor(x, 16);
                                if (fq < 2) v[bj][n][j] = (fq == 0) ? (x * cs - w * sn) : (x * cs + w * sn); }
                }
                if (pn < 6) {
                    const int kind = pn >> 1, c0 = (pn & 1) * 256 + cb;
                    bf16_t* dst = (kind == 0 ? QA : (kind == 1 ? KA : VA)) + (size_t)row * 512 + c0;
                    const float sc = kind == 0 ? C2Q : 1.f;
                    float* fo = kind == 0 ? nullptr : out + (kind == 1 ? OFF_KWP : OFF_VWP) + (size_t)row * 512 + c0;
#pragma unroll
                    for (int bj = 0; bj < 2; ++bj) { const f32x4 x0 = v[bj][0], x1 = v[bj][1];
                        u32x4 w; w.x = cvt_pk_bf16(x0[0] * sc, x0[1] * sc); w.y = cvt_pk_bf16(x0[2] * sc, x0[3] * sc); w.z = cvt_pk_bf16(x1[0] * sc, x1[1] * sc); w.w = cvt_pk_bf16(x1[2] * sc, x1[3] * sc);
                        *(u32x4*)(dst + bj * HALF) = w;
                        if (fo) { __builtin_nontemporal_store(x0, (f32x4*)(fo + bj * HALF)); __builtin_nontemporal_store(x1, (f32x4*)(fo + bj * HALF + 4)); } }
                } else if (pn < 12) {
                    bf16_t* dst; float sc = 1.f;
                    if (pn == 6) { dst = QB + (size_t)row * 256; sc = 0.125f; }
                    else if (pn == 7) dst = KB + (size_t)row * 256;
                    else if (pn < 10) dst = VB + (size_t)row * 512 + (pn - 8) * 256;
                    else dst = GB + (size_t)row * 512 + (pn - 10) * 256;
                    dst += cb;
#pragma unroll
                    for (int bj = 0; bj < 2; ++bj) { const f32x4 x0 = v[bj][0] * sc, x1 = v[bj][1] * sc;
                        u32x4 w; w.x = cvt_pk_bf16(x0[0], x0[1]); w.y = cvt_pk_bf16(x0[2], x0[3]); w.z = cvt_pk_bf16(x1[0], x1[1]); w.w = cvt_pk_bf16(x1[2], x1[3]);
                        *(u32x4*)(dst + bj * HALF) = w; }
                } else if (fq < 2) {
                    *(f32x4*)(A1 + (size_t)row * 16 + 8 * fq) = v[0][0]; *(f32x4*)(A1 + (size_t)row * 16 + 8 * fq + 4) = v[0][1];
                }
            }
    }
};
}


namespace sk {
template <class Epi> __device__ __forceinline__ void tile1(const bf16_t* A, int K, const bf16_t* Bt, const Epi& E, int task, int lane, int wave, LAS unsigned char* lds) {
    const int tn = task >> 1, rh = task & 1, fr = lane & 15, fq = lane >> 4;
    const int kw = K >> 3, nks = kw >> 5;
    const bf16_t* ap = A + (size_t)(64 * rh + fr) * K + wave * kw + 8 * fq;
    const bf16_t* bp[4];
#pragma unroll
    for (int f = 0; f < 4; ++f) bp[f] = Bt + (size_t)Epi::brow(tn, f, fr) * K + wave * kw + 8 * fq;
    f32x4 acc[4][4];
#pragma unroll
    for (int m = 0; m < 4; ++m)
#pragma unroll
        for (int f = 0; f < 4; ++f) acc[m][f] = (f32x4){0.f, 0.f, 0.f, 0.f};
#pragma nounroll
    for (int k0 = 0; k0 < nks; k0 += 4) {
        bf16x8 a[4][4], b[4][4];
#pragma unroll
        for (int q = 0; q < 4; ++q) {
            const int ks = (k0 + q < nks) ? k0 + q : nks - 1;
#pragma unroll
            for (int m = 0; m < 4; ++m) a[q][m] = *(const bf16x8*)(ap + (size_t)m * 16 * K + 32 * ks);
#pragma unroll
            for (int f = 0; f < 4; ++f) b[q][f] = *(const bf16x8*)(bp[f] + 32 * ks);
        }
#pragma unroll
        for (int q = 0; q < 4; ++q) {
            if (k0 + q < nks) {
#pragma unroll
                for (int m = 0; m < 4; ++m)
#pragma unroll
                    for (int f = 0; f < 4; ++f) acc[m][f] = __builtin_amdgcn_mfma_f32_16x16x32_bf16(b[q][f], a[q][m], acc[m][f], 0, 0, 0);
            }
        }
    }
    LAS f32x4* red = (LAS f32x4*)lds;
#pragma unroll
    for (int m = 0; m < 4; ++m)
#pragma unroll
        for (int f = 0; f < 4; ++f) red[(wave * 16 + m * 4 + f) * 64 + lane] = acc[m][f];
    LDS_WAIT(); __syncthreads();
    if (wave < 4) {
        f32x4 r[4];
#pragma unroll
        for (int f = 0; f < 4; ++f) { f32x4 sacc = red[(wave * 4 + f) * 64 + lane];
#pragma unroll
            for (int w = 1; w < 8; ++w) sacc += red[(w * 16 + wave * 4 + f) * 64 + lane];
            r[f] = sacc; }
        E(tn, 64 * rh + 16 * wave + fr, fq, r);
    }
    LDS_WAIT(); __syncthreads();
}
template <class Epi> __device__ __forceinline__ void tile(const bf16_t* A, int K, const bf16_t* Bt, const Epi& E, int task, int lane, int wave, LAS unsigned char* lds) {
#if PROBE_SK2
    { Epi Ed = E; Ed.dry = 1; tile1(A, K, Bt, Ed, task, lane, wave, lds); }
#endif
    tile1(A, K, Bt, E, task, lane, wave, lds);
}
__device__ __forceinline__ void st_bf4(bf16_t* p, const f32x4 v) { u32x2 w; w.x = cvt_pk_bf16(v[0], v[1]); w.y = cvt_pk_bf16(v[2], v[3]); *(u32x2*)p = w; }
template <int SSQI> struct EpiSwiGLU {
    unsigned char* ws; int dry;
    static __device__ __forceinline__ int brow(int tn, int f, int n) { const int gc = 32 * tn + 16 * (f & 1) + n; return 256 * (gc >> 7) + 128 * (f >> 1) + (gc & 127); }
    __device__ __forceinline__ void operator()(int tn, int srow, int fq, const f32x4 (&acc)[4]) const {
        const int row = MPROMPT + srow; const float rs = row_rs(TOT(ws, SSQI), row);
        bf16_t* O = (bf16_t*)(ws + WS_ACT) + (size_t)row * DFF + 32 * tn + 4 * fq;
#pragma unroll
        for (int f = 0; f < 2; ++f) { f32x4 o;
#pragma unroll
            for (int j = 0; j < 4; ++j) o[j] = siluf_(acc[f][j] * rs) * (acc[f + 2][j] * rs);
            st_bf4(O + 16 * f, o); }
    }
};
struct EpiPlain {
    unsigned char* ws; int dry;
    static __device__ __forceinline__ int brow(int tn, int f, int n) { return 64 * tn + 16 * f + n; }
    __device__ __forceinline__ void operator()(int tn, int srow, int fq, const f32x4 (&acc)[4]) const {
        bf16_t* O = (bf16_t*)(ws + WS_PROJ) + (size_t)(MPROMPT + srow) * DM + 64 * tn + 4 * fq;
#pragma unroll
        for (int f = 0; f < 4; ++f) st_bf4(O + 16 * f, acc[f]);
    }
};
template <int MODE, int SSQO, bool FROM_X> struct EpiResid {
    const float* xS; unsigned char* ws; float scale; int dry;
    static __device__ __forceinline__ int brow(int tn, int f, int n) { return 64 * tn + 16 * f + n; }
    __device__ __forceinline__ void operator()(int tn, int srow, int fq, const f32x4 (&acc)[4]) const {
        const int row = MPROMPT + srow;
        bf16_t* HBp = (bf16_t*)(ws + WS_HB) + (size_t)row * DM + 64 * tn + 4 * fq; bf16_t* Out = MODE == 0 ? HBp : (bf16_t*)(ws + WS_A2) + (size_t)row * DM + 64 * tn + 4 * fq;
        const float* xp = xS + (size_t)srow * DM + 64 * tn + 4 * fq;
        const bf16_t* pj = (const bf16_t*)(ws + WS_PROJ) + (size_t)row * DM + 64 * tn + 4 * fq;
        float rs = 1.f; if (MODE == 1) rs = row_rs(TOT(ws, SSQO - 1), row);
        float ss = 0.f;
#pragma unroll
        for (int f = 0; f < 4; ++f) { f32x4 bq;
            if (FROM_X) bq = *(const f32x4*)(xp + 16 * f);
            else { const u32x2 bw = *(const u32x2*)(HBp + 16 * f); bq = (f32x4){bflo(bw.x), bfhi(bw.x), bflo(bw.y), bfhi(bw.y)}; }
            f32x4 v;
            if (MODE == 0) v = bq + acc[f] * scale;
            else { const u32x2 pw = *(const u32x2*)(pj + 16 * f); const f32x4 a = acc[f] * rs;
                v[0] = bq[0] + sigmoidf_(a[0]) * bflo(pw.x); v[1] = bq[1] + sigmoidf_(a[1]) * bfhi(pw.x); v[2] = bq[2] + sigmoidf_(a[2]) * bflo(pw.y); v[3] = bq[3] + sigmoidf_(a[3]) * bfhi(pw.y); }
            if (!dry) st_bf4(Out + 16 * f, v);
            ss += (v[0] * v[0] + v[1] * v[1]) + (v[2] * v[2] + v[3] * v[3]); }
        ss += __shfl_xor(ss, 16); ss += __shfl_xor(ss, 32);
        if (fq == 0 && !dry) ssq_add(TOT(ws, SSQO), row, ss);
    }
};
struct EpiMix {
    unsigned char* ws; float* out; int dry;
    static __device__ __forceinline__ int brow(int tn, int f, int n) { return 64 * tn + 16 * f + n; }
    __device__ __forceinline__ void operator()(int tn, int srow, int fq, const f32x4 (&acc)[4]) const {
        const int row = MPROMPT + srow; const float rs = row_rs(TOT(ws, 1), row);
        f32x4 v[4];
#pragma unroll
        for (int f = 0; f < 4; ++f) v[f] = acc[f] * rs;
        if (tn < 16) {
            const float* rope = (const float*)(ws + WS_ROPE) + (size_t)(2048 + (srow & 3)) * 16 + 8 * (fq & 1);
            const f32x4 t0 = *(const f32x4*)rope, t1 = *(const f32x4*)(rope + 4);
            const float cs[4] = {t0[0], t0[2], t1[0], t1[2]}, sn[4] = {t0[1], t0[3], t1[1], t1[3]};
#pragma unroll
            for (int j = 0; j < 4; ++j) { const float x = v[0][j], w = __shfl_xor(x, 32); v[0][j] = (fq < 2) ? (x * cs[j] - w * sn[j]) : (x * cs[j] + w * sn[j]); }
        }
        if (tn < 24) {
            const int kind = tn >> 3, c0 = (tn & 7) * 64 + 4 * fq;
            bf16_t* dst = (bf16_t*)(ws + (kind == 0 ? WS_QA : (kind == 1 ? WS_KA : WS_VA))) + (size_t)row * 512 + c0;
            const float sc = kind == 0 ? C2Q : 1.f;
            float* fo = kind == 0 ? nullptr : out + (kind == 1 ? OFF_KWS : OFF_VWS) + ((size_t)(srow >> 2) * WINB + (WINB - DEC_T) + (srow & 3)) * 512 + c0;
#pragma unroll
            for (int f = 0; f < 4; ++f) { st_bf4(dst + 16 * f, v[f] * sc); if (fo) *(f32x4*)(fo + 16 * f) = v[f]; }
        } else if (tn < 48) {
            bf16_t* dst; float sc = 1.f;
            if (tn < 28) { dst = (bf16_t*)(ws + WS_QB) + (size_t)row * 256 + (tn - 24) * 64; sc = 0.125f; }
            else if (tn < 32) dst = (bf16_t*)(ws + WS_KB) + (size_t)row * 256 + (tn - 28) * 64;
            else if (tn < 40) dst = (bf16_t*)(ws + WS_VB) + (size_t)row * 512 + (tn - 32) * 64;
            else dst = (bf16_t*)(ws + WS_GB) + (size_t)row * 512 + (tn - 40) * 64;
            dst += 4 * fq;
#pragma unroll
            for (int f = 0; f < 4; ++f) st_bf4(dst + 16 * f, v[f] * sc);
        } else {
            *(f32x4*)((float*)(ws + WS_A1) + (size_t)row * 16 + 4 * fq) = v[0];
        }
    }
};
}

#define XB_TMO      128
#define XB_XCNT(j)  (256  + 64 * (j))
#define XB_XSUB(j)  (1280 + 64 * (j))
#define XB_XGEN(j)  (2304 + 64 * (j))
#define XB_TOP      3328
#define XB_TOPGEN   3392
#define XCD_BAR_WORDS 3456
#define XB_SPIN_CAP (1u << 18)
__device__ __forceinline__ unsigned xb_ld(unsigned* p)              { return __hip_atomic_load(p, __ATOMIC_RELAXED, __HIP_MEMORY_SCOPE_AGENT); }
__device__ __forceinline__ unsigned xb_add(unsigned* p, unsigned v) { return __hip_atomic_fetch_add(p, v, __ATOMIC_RELAXED, __HIP_MEMORY_SCOPE_AGENT); }
__device__ __forceinline__ unsigned xb_xcc_id() { return (unsigned)__builtin_amdgcn_s_getreg((3 << 11) | 20) & 0xFu; }
#define XB_SPIN(cond, bar) do { unsigned _sp = 0; while (cond) { __builtin_amdgcn_s_sleep(1); \
    if ((++_sp & 255u) == 0u) { if (xb_ld(&(bar)[XB_TMO])) break; if (_sp > XB_SPIN_CAP) { atomicAdd(&(bar)[XB_TMO], 1u); break; } } } } while (0)
struct XcdBarrier { unsigned* bar; unsigned x; volatile LAS unsigned* st; };
__device__ __forceinline__ XcdBarrier xcd_barrier_post(unsigned* bar, volatile LAS unsigned* st) {
    XcdBarrier b; b.bar = bar; b.x = xb_xcc_id(); b.st = st;
    if (threadIdx.x == 0) (void)xb_add(&bar[XB_XCNT(b.x)], 1u);
    return b;
}
__device__ __forceinline__ void xcd_barrier_complete(unsigned* bar, unsigned x, unsigned& nloc, unsigned& nx) {
    const unsigned G = gridDim.x * gridDim.y * gridDim.z;
    unsigned sum, cnt, mine, sp = 0u;
    for (;;) {
        sum = 0u; cnt = 0u; mine = 0u;
#pragma unroll
        for (unsigned j = 0; j < 16; ++j) { const unsigned c = xb_ld(&bar[XB_XCNT(j)]); sum += c; cnt += (c > 0u) ? 1u : 0u; mine = (j == x) ? c : mine; }
        if (sum == G) break;
        __builtin_amdgcn_s_sleep(1);
        if ((++sp & 255u) == 0u) { if (xb_ld(&bar[XB_TMO])) break; if (sp > XB_SPIN_CAP) { atomicAdd(&bar[XB_TMO], 1u); break; } }
    }
    nloc = mine > 0u ? mine : 1u; nx = cnt > 0u ? cnt : 1u;
}
__device__ __forceinline__ void xcd_barrier(const XcdBarrier& b) {
    asm volatile("s_waitcnt vmcnt(0)" ::: "memory");
    __syncthreads();
    if (threadIdx.x == 0) {
        unsigned* bar = b.bar;
        __builtin_amdgcn_s_waitcnt(0);
        unsigned nloc = b.st[0], nx = b.st[1];
        if (nloc == 0u) { xcd_barrier_complete(bar, b.x, nloc, nx); b.st[0] = nloc; b.st[1] = nx; }
        const unsigned old = xb_add(&bar[XB_XSUB(b.x)], 1u);
        const unsigned gen = old / nloc;
        if (old + 1u == (gen + 1u) * nloc) {
            __builtin_amdgcn_fence(__ATOMIC_RELEASE, "agent");
            asm volatile("s_waitcnt vmcnt(0)" ::: "memory");
            const unsigned og = xb_add(&bar[XB_TOP], 1u);
            const unsigned tg = og / nx;
            if (og + 1u == (tg + 1u) * nx) xb_add(&bar[XB_TOPGEN], 1u);
            else XB_SPIN(xb_ld(&bar[XB_TOPGEN]) == tg, bar);
            __builtin_amdgcn_fence(__ATOMIC_ACQUIRE, "agent");
            xb_add(&bar[XB_XGEN(b.x)], 1u);
            asm volatile("s_waitcnt vmcnt(0)" ::: "memory");
        } else {
            XB_SPIN(xb_ld(&bar[XB_XGEN(b.x)]) == gen, bar);
            __builtin_amdgcn_fence(__ATOMIC_ACQUIRE, "agent");
            asm volatile("s_waitcnt vmcnt(0)" ::: "memory");
        }
    }
    __syncthreads();
}

struct Args { const float* in[23]; float* out; unsigned char* ws; int ph_lo, ph_hi; };
struct Frame {
    LAS unsigned char* lds;
    int tid, lane, wave, vcu, G;
    const Args* a; float* out; unsigned char* ws;
};
#define FIN(i) (F.a->in[i])
#define WSP(T, off) ((T*)(F.ws + (off)))

__device__ __forceinline__ void tr_item(const float* W, int K, int Nsrc, const float* g, bf16_t* WT, int kind, LAS float* scr, int item, int nblk, int lane) {
    const int kb = item / nblk, nb = item % nblk, k0 = 64 * kb, n0 = 32 * nb;
    int src0 = n0, nval = 32;
    if (kind == 1) { const int pn = n0 >> 8, j = n0 & 255; src0 = (j < 128) ? 128 * pn + j : DFF + 128 * pn + (j - 128); }
    else if (kind == 2) { if (n0 < 2560) src0 = n0; else if (n0 < 3072) src0 = n0 + 16; else if (n0 == 3072) { src0 = 2560; nval = 16; } else { src0 = 0; nval = 0; } }
    const int r8 = lane >> 3, c4 = (lane & 7) * 4;
    f32x4 wv[8];
#pragma unroll
    for (int i = 0; i < 8; ++i) { const int kk = 8 * i + r8; wv[i] = (c4 < nval) ? *(const f32x4*)(W + (size_t)(k0 + kk) * Nsrc + src0 + c4) : (f32x4){0.f, 0.f, 0.f, 0.f}; }
    if (g) {
#pragma unroll
        for (int i = 0; i < 8; ++i) wv[i] = wv[i] * g[k0 + 8 * i + r8];
    }
#pragma unroll
    for (int i = 0; i < 8; ++i) { LAS float* d = scr + (8 * i + r8) * 33 + c4; d[0] = wv[i][0]; d[1] = wv[i][1]; d[2] = wv[i][2]; d[3] = wv[i][3]; }
    LDS_WAIT(); asm volatile("" ::: "memory");
    const int cc = lane & 7;
#pragma unroll
    for (int j = 0; j < 4; ++j) { const int n = (lane >> 3) + 8 * j; const LAS float* s = scr + (8 * cc) * 33 + n;
        u32x4 o; o.x = pk2(s[0 * 33], s[1 * 33]); o.y = pk2(s[2 * 33], s[3 * 33]); o.z = pk2(s[4 * 33], s[5 * 33]); o.w = pk2(s[6 * 33], s[7 * 33]);
        *(u32x4*)(WT + (size_t)(n0 + n) * K + k0 + 8 * cc) = o; }
    LDS_WAIT(); asm volatile("" ::: "memory");
}
__device__ __forceinline__ void sincos_red(double ang, float& c, float& s) {
    const double TWO_PI = 6.283185307179586476925, HALF_PI = 1.5707963267948966192;
    double r = ang - TWO_PI * __builtin_rint(ang / TWO_PI);
    const double q = __builtin_rint(r / HALF_PI); r -= q * HALF_PI;
    const int qi = ((int)q) & 3;
    const double y2 = r * r;
    const double sn = r * (1.0 + y2 * (-1.0 / 6 + y2 * (1.0 / 120 + y2 * (-1.0 / 5040 + y2 * (1.0 / 362880 - y2 * (1.0 / 39916800))))));
    const double cs = 1.0 + y2 * (-0.5 + y2 * (1.0 / 24 + y2 * (-1.0 / 720 + y2 * (1.0 / 40320 + y2 * (-1.0 / 3628800 + y2 * (1.0 / 479001600))))));
    double co, si;
    if (qi == 0) { co = cs; si = sn; } else if (qi == 1) { co = -sn; si = cs; } else if (qi == 2) { co = -cs; si = -sn; } else { co = sn; si = -cs; }
    c = (float)co; s = (float)si;
}
template <int SET> __device__ __forceinline__ void convert_weights(Frame& F, int gw, int NGW) {
    LAS float* scr = (LAS float*)(F.lds + F.wave * 16384);
    constexpr int I_GU = (DM / 64) * (NGU / 32), I_D = (DFF / 64) * (DM / 32), I_IN = (DM / 64) * (NPROJ / 32), I_1K = (DM / 64) * (DM / 32), I_PP = (DPLE / 64) * (DM / 32);
    if (SET == 0) {
        for (int it = gw; it < I_GU + I_PP; it += NGW) {
            if (it < I_GU) tr_item(FIN(8), DM, NGU, FIN(7), WSP(bf16_t, WS_WGU1), 1, scr, it, NGU / 32, F.lane);
            else tr_item(FIN(21), DPLE, DM, nullptr, WSP(bf16_t, WS_WPP), 0, scr, it - I_GU, DM / 32, F.lane);
        }
    } else if (SET == 1) {
        for (int it = gw; it < I_D + I_IN; it += NGW) {
            if (it < I_D) tr_item(FIN(9), DFF, DM, nullptr, WSP(bf16_t, WS_WD1), 0, scr, it, DM / 32, F.lane);
            else tr_item(FIN(11), DM, 3088, FIN(10), WSP(bf16_t, WS_WIN), 2, scr, it - I_D, NPROJ / 32, F.lane);
        }
    } else {
        for (int it = gw; it < I_GU + I_D + 2 * I_1K; it += NGW) {
            int r = it;
            if (r < I_GU) { tr_item(FIN(17), DM, NGU, FIN(16), WSP(bf16_t, WS_WGU2), 1, scr, r, NGU / 32, F.lane); continue; } r -= I_GU;
            if (r < I_D) { tr_item(FIN(18), DFF, DM, nullptr, WSP(bf16_t, WS_WD2), 0, scr, r, DM / 32, F.lane); continue; } r -= I_D;
            if (r < I_1K) { tr_item(FIN(15), DM, DM, nullptr, WSP(bf16_t, WS_WOUT), 0, scr, r, DM / 32, F.lane); continue; } r -= I_1K;
            tr_item(FIN(20), DM, DM, FIN(19), WSP(bf16_t, WS_WPG), 0, scr, r, DM / 32, F.lane);
        }
    }
}
__device__ __forceinline__ void p0_prologue(Frame& F) {
    const int gw = F.vcu * NWAVES + F.wave, NGW = F.G * NWAVES;
    convert_weights<0>(F, gw, NGW);
    bf16_t* HB = WSP(bf16_t, WS_HB); bf16_t* PB = WSP(bf16_t, WS_PB); unsigned* ssq0 = TOT(F.ws, 0);
    for (int e = F.vcu * 512 + F.tid; e < 4 * MPAD; e += F.G * 512) TOT(F.ws, 1 + e / MPAD)[e % MPAD] = 0u;
    for (int m0 = gw; m0 < MTOT; m0 += 4 * NGW) {
        f32x4 v[4][4], pv[4];
#pragma unroll
        for (int u = 0; u < 4; ++u) { const int m = m0 + u * NGW; const bool ok = m < MTOT;
            const float* xr = m < MPROMPT ? FIN(0) + (size_t)m * DM : FIN(1) + (size_t)(m - MPROMPT) * DM;
            const float* pr = m < MPROMPT ? FIN(5) + (size_t)m * DPLE : FIN(6) + (size_t)(m - MPROMPT) * DPLE;
#pragma unroll
            for (int j = 0; j < 4; ++j) v[u][j] = ok ? *((const f32x4*)xr + F.lane + 64 * j) : (f32x4){0.f, 0.f, 0.f, 0.f};
            pv[u] = ok ? *((const f32x4*)pr + F.lane) : (f32x4){0.f, 0.f, 0.f, 0.f}; }
#pragma unroll
        for (int u = 0; u < 4; ++u) { const int m = m0 + u * NGW; if (m >= MTOT) continue;
            float s = 0.f;
#pragma unroll
            for (int j = 0; j < 4; ++j) s += (v[u][j][0] * v[u][j][0] + v[u][j][1] * v[u][j][1]) + (v[u][j][2] * v[u][j][2] + v[u][j][3] * v[u][j][3]);
            s = wave_sum(s);
#pragma unroll
            for (int j = 0; j < 4; ++j) { u32x2 w; w.x = pk2(v[u][j][0], v[u][j][1]); w.y = pk2(v[u][j][2], v[u][j][3]); *((u32x2*)(HB + (size_t)m * DM) + F.lane + 64 * j) = w; }
            if (F.lane == 0) ssq0[m] = (unsigned)(s * SSQ_SCALE + 0.5f);
            u32x2 w; w.x = pk2(pv[u][0], pv[u][1]); w.y = pk2(pv[u][2], pv[u][3]); *((u32x2*)(PB + (size_t)m * DPLE) + F.lane) = w; }
    }
    float* rope = WSP(float, WS_ROPE);
    for (int e = F.vcu * 512 + F.tid; e < 2052 * 8; e += F.G * 512) {
        const int posidx = e >> 3, i = e & 7; const int pos = posidx < 2048 ? posidx : PAST + (posidx - 2048);
        const double inv = exp2(-(double)i * 0.125 * 18.931568569324174087);
        float c, s; sincos_red((double)pos * inv, c, s);
        rope[2 * e] = c; rope[2 * e + 1] = s;
    }
}


constexpr size_t CP_PER_B = (size_t)(WINB - DEC_T) * 512 / 4, CP_TOTAL = (size_t)DEC_B * CP_PER_B, CP_C1 = 0, CP_C3 = (CP_TOTAL * 6 / 10) & ~(size_t)511;
__device__ __forceinline__ void cache_copy_chunk(Frame& F, size_t e0, size_t e1, int rank, int nshare) {
    if (rank < 0) return;
    constexpr int U = 8;
    const size_t stride = (size_t)nshare * 512 * U;
    for (size_t eb = e0 + (size_t)rank * 512 * U + F.tid; eb < e1; eb += stride) {
        f32x4 kv[U], vv[U]; size_t dst[U];
#pragma unroll
        for (int u = 0; u < U; ++u) { const size_t e = eb + (size_t)u * 512; const size_t ec = e < e1 ? e : e1 - 1; const size_t b = ec / CP_PER_B, r = ec - b * CP_PER_B;
            const size_t src = b * ((size_t)WINB * 128) + DEC_T * 128 + r; dst[u] = b * ((size_t)WINB * 128) + r;
            kv[u] = __builtin_nontemporal_load((const f32x4*)FIN(2) + src); vv[u] = __builtin_nontemporal_load((const f32x4*)FIN(3) + src); }
#pragma unroll
        for (int u = 0; u < U; ++u) { __builtin_nontemporal_store(kv[u], (f32x4*)(F.out + OFF_KWS) + dst[u]); __builtin_nontemporal_store(vv[u], (f32x4*)(F.out + OFF_VWS) + dst[u]); }
    }
}

constexpr int AT_VW = 6144  , AT_VPITCH = 192, AT_STO = 8 * AT_VW, AT_SPITCH = 136, AT_SROWS = 528, AT_STM = AT_STO + AT_SROWS * AT_SPITCH, AT_STL = AT_STM + AT_SROWS * 4;
static_assert(AT_STL + AT_SROWS * 4 <= RING_BYTES, "attention LDS");
__device__ __forceinline__ int crow(int r, int hi) { return (r & 3) + 8 * (r >> 2) + 4 * hi; }
__device__ __forceinline__ float xhalf_max(float x) { const auto r = __builtin_amdgcn_permlane32_swap(__float_as_uint(x), __float_as_uint(x), false, false); return fmaxf(__uint_as_float(r[0]), __uint_as_float(r[1])); }
__device__ __forceinline__ float xhalf_sum(float x) { const auto r = __builtin_amdgcn_permlane32_swap(__float_as_uint(x), __float_as_uint(x), false, false); return __uint_as_float(r[0]) + __uint_as_float(r[1]); }
__device__ __forceinline__ s16x4 tr_read(LAS const unsigned char* p) { typedef short v4i16 __attribute__((ext_vector_type(4))); return __builtin_bit_cast(s16x4, __builtin_amdgcn_ds_read_tr16_b64_v4i16((LAS v4i16*)p)); }

template <int NQ> __device__ __forceinline__ void attn_task(Frame& F, int b, int h, int P0, int br, int dil, int r, int s0) {
    const int lane = F.lane, qi = lane & 31, hi = lane >> 5;
    const bf16_t* QA = WSP(bf16_t, WS_QA); const bf16_t* KA = WSP(bf16_t, WS_KA); const bf16_t* VA = WSP(bf16_t, WS_VA);
    LAS unsigned char* Vw = F.lds + F.wave * AT_VW;
    const size_t rowbase = (size_t)b * SEQ;
    const char* Qb = (const char*)(QA + rowbase * 512 + h * 64); const char* Kb = (const char*)(KA + rowbase * 512 + h * 64); const char* Vb = (const char*)(VA + rowbase * 512 + h * 64);
    bf16x8 qf[NQ][4]; f32x16 o0[NQ], o1[NQ]; float mrun[NQ], lrun[NQ];
#define POSQ(n) ((s0 + 32 * (n) + qi) * dil + r)
#define RHO(n) ((((POSQ(n) - P0) & 15) * 33) + ((POSQ(n) - P0) >> 4))
#pragma unroll
    for (int n = 0; n < NQ; ++n) {
        const unsigned qoff = (unsigned)POSQ(n) * 1024u + hi * 16u;
#pragma unroll
        for (int kk = 0; kk < 4; ++kk) qf[n][kk] = *(const bf16x8*)(Qb + qoff + 32 * kk);
        if (br == 0) {
#pragma unroll
            for (int i = 0; i < 16; ++i) { o0[n][i] = 0.f; o1[n][i] = 0.f; }
            mrun[n] = -1e30f; lrun[n] = 0.f;
        } else {
            const LAS unsigned char* sp = F.lds + AT_STO + RHO(n) * AT_SPITCH + 8 * hi;
#pragma unroll
            for (int g = 0; g < 4; ++g) {
                const u32x2 a = *(const LAS u32x2*)(sp + 16 * g), c = *(const LAS u32x2*)(sp + 64 + 16 * g);
                o0[n][4 * g] = bflo(a.x); o0[n][4 * g + 1] = bfhi(a.x); o0[n][4 * g + 2] = bflo(a.y); o0[n][4 * g + 3] = bfhi(a.y);
                o1[n][4 * g] = bflo(c.x); o1[n][4 * g + 1] = bfhi(c.x); o1[n][4 * g + 2] = bflo(c.y); o1[n][4 * g + 3] = bfhi(c.y);
            }
            mrun[n] = *(const LAS float*)(F.lds + AT_STM + RHO(n) * 4); lrun[n] = *(const LAS float*)(F.lds + AT_STL + RHO(n) * 4);
        }
    }
    const int kt0 = s0 >= 128 ? 0 : ((128 - s0) >> 5), ktend = 5 + (NQ - 1);
    const int q4 = (lane & 15) >> 2, p4 = lane & 3, blk = (lane >> 4) & 1;
    const LAS unsigned char* trb = Vw + (4 * hi + q4) * AT_VPITCH + (16 * blk + 4 * p4) * 2;
    bf16x8 kn[4]; u32x4 vr[4];
    {   const int sk0 = s0 - 128 + 32 * kt0;
        const unsigned koff = (unsigned)((sk0 + qi) * dil + r) * 1024u + hi * 16u;
#pragma unroll
        for (int kk = 0; kk < 4; ++kk) kn[kk] = *(const bf16x8*)(Kb + koff + 32 * kk);
#pragma unroll
        for (int c = 0; c < 4; ++c) { const int cid = lane + 64 * c, vrow = cid >> 3, ch = cid & 7;
            vr[c] = *(const u32x4*)(Vb + (unsigned)((sk0 + vrow) * dil + r) * 1024u + ch * 16u); } }
#define AT_STEP(KT, D0, D1) do { const int kt_ = (KT); \
        bf16x8 kf[4]; \
        _Pragma("unroll") for (int kk = 0; kk < 4; ++kk) kf[kk] = kn[kk]; \
        _Pragma("unroll") for (int c = 0; c < 4; ++c) { const int cid = lane + 64 * c, vrow = cid >> 3, ch = cid & 7; *(LAS u32x4*)(Vw + vrow * AT_VPITCH + ch * 16) = vr[c]; } \
        if (kt_ + 1 < ktend) { \
            const int sk1 = s0 - 128 + 32 * (kt_ + 1); \
            const unsigned koff = (unsigned)((sk1 + qi) * dil + r) * 1024u + hi * 16u; \
            _Pragma("unroll") for (int kk = 0; kk < 4; ++kk) kn[kk] = *(const bf16x8*)(Kb + koff + 32 * kk); \
            _Pragma("unroll") for (int c = 0; c < 4; ++c) { const int cid = lane + 64 * c, vrow = cid >> 3, ch = cid & 7; \
                vr[c] = *(const u32x4*)(Vb + (unsigned)((sk1 + vrow) * dil + r) * 1024u + ch * 16u); } \
        } \
        LDS_WAIT(); \
        bf16x8 va[2][2]; \
        _Pragma("unroll") for (int dt = 0; dt < 2; ++dt) { \
            const s16x4 lo0 = tr_read(trb + dt * 64), hi0 = tr_read(trb + dt * 64 + 8 * AT_VPITCH); \
            const s16x4 lo1 = tr_read(trb + dt * 64 + 16 * AT_VPITCH), hi1 = tr_read(trb + dt * 64 + 24 * AT_VPITCH); \
            va[dt][0] = __builtin_shufflevector(lo0, hi0, 0, 1, 2, 3, 4, 5, 6, 7); va[dt][1] = __builtin_shufflevector(lo1, hi1, 0, 1, 2, 3, 4, 5, 6, 7); } \
        f32x16 pp[NQ]; \
        _Pragma("unroll") for (int n = 0; n < NQ; ++n) _Pragma("unroll") for (int i = 0; i < 16; ++i) pp[n][i] = 0.f; \
        _Pragma("unroll") for (int kk = 0; kk < 4; ++kk) { \
            if (D0) pp[0] = __builtin_amdgcn_mfma_f32_32x32x16_bf16(kf[kk], qf[0][kk], pp[0], 0, 0, 0); \
            if (D1) pp[NQ - 1] = __builtin_amdgcn_mfma_f32_32x32x16_bf16(kf[kk], qf[NQ - 1][kk], pp[NQ - 1], 0, 0, 0); } \
        bf16x8 pb[NQ][2]; \
        _Pragma("unroll") for (int n = 0; n < NQ; ++n) { \
            if ((n == 0 && !(D0)) || (n == 1 && !(D1))) continue; \
            const int kr = kt_ - n; \
            if (kr == 0) { _Pragma("unroll") for (int i = 0; i < 16; ++i) if (crow(i, hi) < qi) pp[n][i] = -INFINITY; } \
            else if (kr == 4) { _Pragma("unroll") for (int i = 0; i < 16; ++i) if (crow(i, hi) > qi) pp[n][i] = -INFINITY; } } \
        _Pragma("unroll") for (int n = 0; n < NQ; ++n) { \
            if ((n == 0 && !(D0)) || (n == 1 && !(D1))) continue; \
            float mx = pp[n][0]; \
            _Pragma("unroll") for (int i = 1; i < 16; ++i) mx = fmaxf(mx, pp[n][i]); \
            mx = xhalf_max(mx); \
            if (__builtin_amdgcn_ballot_w64(mx > mrun[n] + 8.0f) != 0ull) {        \
                const float mn = fmaxf(mrun[n], mx), al = __builtin_amdgcn_exp2f(mrun[n] - mn); \
                lrun[n] *= al; mrun[n] = mn; \
                _Pragma("unroll") for (int i = 0; i < 16; ++i) { o0[n][i] *= al; o1[n][i] *= al; } \
            } \
            float rsum = 0.f; \
            _Pragma("unroll") for (int i = 0; i < 16; ++i) { pp[n][i] = __builtin_amdgcn_exp2f(pp[n][i] - mrun[n]); rsum += pp[n][i]; } \
            rsum = xhalf_sum(rsum); \
            lrun[n] += rsum; \
            u32x4 pw0, pw1; \
            pw0.x = cvt_pk_bf16(pp[n][0], pp[n][1]); pw0.y = cvt_pk_bf16(pp[n][2], pp[n][3]); pw0.z = cvt_pk_bf16(pp[n][4], pp[n][5]); pw0.w = cvt_pk_bf16(pp[n][6], pp[n][7]); \
            pw1.x = cvt_pk_bf16(pp[n][8], pp[n][9]); pw1.y = cvt_pk_bf16(pp[n][10], pp[n][11]); pw1.z = cvt_pk_bf16(pp[n][12], pp[n][13]); pw1.w = cvt_pk_bf16(pp[n][14], pp[n][15]); \
            pb[n][0] = __builtin_bit_cast(bf16x8, pw0); pb[n][1] = __builtin_bit_cast(bf16x8, pw1); } \
        _Pragma("unroll") for (int n = 0; n < NQ; ++n) { \
            if ((n == 0 && !(D0)) || (n == 1 && !(D1))) continue; \
            o0[n] = __builtin_amdgcn_mfma_f32_32x32x16_bf16(va[0][0], pb[n][0], o0[n], 0, 0, 0); o1[n] = __builtin_amdgcn_mfma_f32_32x32x16_bf16(va[1][0], pb[n][0], o1[n], 0, 0, 0); } \
        _Pragma("unroll") for (int n = 0; n < NQ; ++n) { \
            if ((n == 0 && !(D0)) || (n == 1 && !(D1))) continue; \
            o0[n] = __builtin_amdgcn_mfma_f32_32x32x16_bf16(va[0][1], pb[n][1], o0[n], 0, 0, 0); o1[n] = __builtin_amdgcn_mfma_f32_32x32x16_bf16(va[1][1], pb[n][1], o1[n], 0, 0, 0); } \
    } while (0)
    if (NQ == 1) {
#pragma nounroll
        for (int kt = kt0; kt < 5; ++kt) AT_STEP(kt, true, false);
    } else {
        int kt = kt0;
        if (kt == 0) { AT_STEP(0, true, false); kt = 1; }
#pragma nounroll
        for (; kt < 5; ++kt) AT_STEP(kt, true, true);
        AT_STEP(5, false, true);
    }
#undef AT_STEP
#pragma unroll
    for (int n = 0; n < NQ; ++n) {
        if (br < 2) {
            LAS unsigned char* sp = F.lds + AT_STO + RHO(n) * AT_SPITCH + 8 * hi;
#pragma unroll
            for (int g = 0; g < 4; ++g) {
                u32x2 a, c; a.x = cvt_pk_bf16(o0[n][4 * g], o0[n][4 * g + 1]); a.y = cvt_pk_bf16(o0[n][4 * g + 2], o0[n][4 * g + 3]); c.x = cvt_pk_bf16(o1[n][4 * g], o1[n][4 * g + 1]); c.y = cvt_pk_bf16(o1[n][4 * g + 2], o1[n][4 * g + 3]);
                *(LAS u32x2*)(sp + 16 * g) = a; *(LAS u32x2*)(sp + 64 + 16 * g) = c;
            }
            if (hi == 0) { *(LAS float*)(F.lds + AT_STM + RHO(n) * 4) = mrun[n]; *(LAS float*)(F.lds + AT_STL + RHO(n) * 4) = lrun[n]; }
        } else {
            const float inv = 1.f / lrun[n];
            bf16_t* op = WSP(bf16_t, WS_A2) + (rowbase + POSQ(n)) * DM + h * 64 + 4 * hi;
#pragma unroll
            for (int g = 0; g < 4; ++g) {
                u32x2 a, c; a.x = cvt_pk_bf16(o0[n][4 * g] * inv, o0[n][4 * g + 1] * inv); a.y = cvt_pk_bf16(o0[n][4 * g + 2] * inv, o0[n][4 * g + 3] * inv);
                c.x = cvt_pk_bf16(o1[n][4 * g] * inv, o1[n][4 * g + 1] * inv); c.y = cvt_pk_bf16(o1[n][4 * g + 2] * inv, o1[n][4 * g + 3] * inv);
                *(u32x2*)(op + 8 * g) = a; *(u32x2*)(op + 32 + 8 * g) = c;
            }
        }
    }
    LDS_WAIT();
#undef POSQ
#undef RHO
}
__device__ __forceinline__ void attn_prompt_item(Frame& F, int item) {
    const int b = item >> 5, h = (item >> 2) & 7, blk = item & 3, P0 = blk * 512;
    attn_task<2>(F, b, h, P0, 0, 1, 0, P0 + 64 * F.wave);
    LDS_WAIT(); __syncthreads();
    attn_task<2>(F, b, h, P0, 1, 4, F.wave & 3, P0 / 4 + 64 * (F.wave >> 2));
    LDS_WAIT(); __syncthreads();
    for (int u = 0; u < 2; ++u) attn_task<1>(F, b, h, P0, 2, 16, F.wave * 2 + u, P0 / 16);
    LDS_WAIT(); __syncthreads();
}

__device__ __forceinline__ void attn_sample_task(Frame& F, int task, int half) {
    const int h = task & 7, bt = task >> 3, b = bt >> 2, t = bt & 3, row = MPROMPT + bt;
    const int lane = F.lane, grp = lane >> 2, sub = lane & 3;
    const bf16_t* KA = WSP(bf16_t, WS_KA); const bf16_t* VA = WSP(bf16_t, WS_VA);
    float q[16];
    { const u32x4* qp = (const u32x4*)(WSP(bf16_t, WS_QA) + (size_t)row * 512 + h * 64 + 16 * sub); const u32x4 a = qp[0], c = qp[1];
      q[0] = bflo(a.x); q[1] = bfhi(a.x); q[2] = bflo(a.y); q[3] = bfhi(a.y); q[4] = bflo(a.z); q[5] = bfhi(a.z); q[6] = bflo(a.w); q[7] = bfhi(a.w);
      q[8] = bflo(c.x); q[9] = bfhi(c.x); q[10] = bflo(c.y); q[11] = bfhi(c.y); q[12] = bflo(c.z); q[13] = bfhi(c.z); q[14] = bflo(c.w); q[15] = bfhi(c.w); }
    float mrun = -1e30f, lrun = 0.f, acc[16];
#pragma unroll
    for (int e = 0; e < 16; ++e) acc[e] = 0.f;
    const int rd0 = half ? 5 : 0, rd1 = half ? 9 : 5;
#pragma nounroll
    for (int rd = rd0; rd < rd1; ++rd) {
        const int j = rd * 16 + grp; const bool valid = j <= 128;
        float kv[3][16], vv[3][16];
#pragma unroll
        for (int br = 0; br < 3; ++br) {
            const int dil = 1 << (2 * br);
            const int idx = WINB + t - (valid ? dil * j : 0);
            if (idx < WINB) {
                const f32x4* kp = (const f32x4*)(FIN(2) + (((size_t)b * WINB + idx) * 8 + h) * 64 + 16 * sub);
                const f32x4* vp = (const f32x4*)(FIN(3) + (((size_t)b * WINB + idx) * 8 + h) * 64 + 16 * sub);
#pragma unroll
                for (int c = 0; c < 4; ++c) { const f32x4 a = kp[c], d = vp[c];
#pragma unroll
                    for (int e = 0; e < 4; ++e) { kv[br][4 * c + e] = a[e]; vv[br][4 * c + e] = d[e]; } }
            } else {
                const size_t nrow = (size_t)MPROMPT + 4 * b + (idx - WINB);
                const u32x4* kp = (const u32x4*)(KA + nrow * 512 + h * 64 + 16 * sub); const u32x4* vp = (const u32x4*)(VA + nrow * 512 + h * 64 + 16 * sub);
#pragma unroll
                for (int c = 0; c < 2; ++c) { const u32x4 a = kp[c], d = vp[c];
                    kv[br][8 * c] = bflo(a.x); kv[br][8 * c + 1] = bfhi(a.x); kv[br][8 * c + 2] = bflo(a.y); kv[br][8 * c + 3] = bfhi(a.y); kv[br][8 * c + 4] = bflo(a.z); kv[br][8 * c + 5] = bfhi(a.z); kv[br][8 * c + 6] = bflo(a.w); kv[br][8 * c + 7] = bfhi(a.w);
                    vv[br][8 * c] = bflo(d.x); vv[br][8 * c + 1] = bfhi(d.x); vv[br][8 * c + 2] = bflo(d.y); vv[br][8 * c + 3] = bfhi(d.y); vv[br][8 * c + 4] = bflo(d.z); vv[br][8 * c + 5] = bfhi(d.z); vv[br][8 * c + 6] = bflo(d.w); vv[br][8 * c + 7] = bfhi(d.w); }
            }
        }
#pragma unroll
        for (int br = 0; br < 3; ++br) {
            float s = 0.f;
#pragma unroll
            for (int e = 0; e < 16; ++e) s += q[e] * kv[br][e];
            s += __shfl_xor(s, 1); s += __shfl_xor(s, 2);
            if (!valid) s = -INFINITY;
            const float mn = fmaxf(mrun, s), al = __builtin_amdgcn_exp2f(mrun - mn), p = __builtin_amdgcn_exp2f(s - mn);
            lrun = lrun * al + p; mrun = mn;
#pragma unroll
            for (int e = 0; e < 16; ++e) acc[e] = acc[e] * al + p * vv[br][e];
        }
    }
    float M = mrun;
#pragma unroll
    for (int o = 4; o < 64; o <<= 1) M = fmaxf(M, __shfl_xor(M, o));
    const float f = __builtin_amdgcn_exp2f(mrun - M);
    lrun *= f;
#pragma unroll
    for (int o = 4; o < 64; o <<= 1) lrun += __shfl_xor(lrun, o);
#pragma unroll
    for (int e = 0; e < 16; ++e) { float a = acc[e] * f;
#pragma unroll
        for (int o = 4; o < 64; o <<= 1) a += __shfl_xor(a, o);
        acc[e] = a; }
    LAS float* mrg = (LAS float*)(F.lds) + (F.wave & 3) * 80;
    if (half && grp == 0) {
#pragma unroll
        for (int e = 0; e < 16; ++e) mrg[sub * 16 + e] = acc[e];
        if (sub == 0) { mrg[64] = M; mrg[65] = lrun; }
    }
    LDS_WAIT(); __syncthreads();
    if (!half && grp == 0) {
        const float M2 = mrg[64], l2 = mrg[65], Mx = fmaxf(M, M2), f1 = __builtin_amdgcn_exp2f(M - Mx), f2 = __builtin_amdgcn_exp2f(M2 - Mx);
        const float inv = 1.f / (lrun * f1 + l2 * f2);
#pragma unroll
        for (int e = 0; e < 16; ++e) acc[e] = (acc[e] * f1 + mrg[sub * 16 + e] * f2) * inv;
        u32x4 w0, w1; w0.x = pk2(acc[0], acc[1]); w0.y = pk2(acc[2], acc[3]); w0.z = pk2(acc[4], acc[5]); w0.w = pk2(acc[6], acc[7]);
        w1.x = pk2(acc[8], acc[9]); w1.y = pk2(acc[10], acc[11]); w1.z = pk2(acc[12], acc[13]); w1.w = pk2(acc[14], acc[15]);
        u32x4* op = (u32x4*)(WSP(bf16_t, WS_A2) + (size_t)row * DM + h * 64 + 16 * sub); op[0] = w0; op[1] = w1;
    }
    LDS_WAIT(); __syncthreads();
}

constexpr int GL_A1 = 0  , GL_TOT = 4096  , GL_BT = GL_TOT + 2048  , GL_BC = GL_BT + 256  , GL_QA = GL_BC + 64 * 272  ,
              GL_KB = GL_QA + 64 * 144, GL_VR = GL_KB + 64 * 144  , GL_AM = GL_VR + 64 * 272  , GL_O = GL_AM + 64 * 144  , GL_SP = GL_O + 64 * 132 * 4  , GL_END = GL_SP + 128 * 144;
static_assert(GL_END <= RING_BYTES && GL_BC % 16 == 0 && GL_QA % 16 == 0 && GL_VR % 16 == 0 && GL_O % 16 == 0, "GLA LDS");
struct GlaIn { f32x4 a1; u32x4 kb, qb, vb0, vb1, gb0, gb1; f32x4 hc[4]; };
template <bool P3> __device__ __forceinline__ void gla_fetch(Frame& F, GlaIn& I, int item, int hh, size_t row0) {
    const int tid = F.tid;
    I.a1 = (f32x4){0.f, 0.f, 0.f, 0.f};
    if (tid < 256) I.a1 = *(const f32x4*)(WSP(float, WS_A1) + (row0 + (tid >> 2)) * 16 + 4 * (tid & 3));
    I.kb = *(const u32x4*)(WSP(bf16_t, WS_KB) + (row0 + (tid >> 3)) * 256 + hh * 64 + 8 * (tid & 7));
    I.vb0 = *(const u32x4*)(WSP(bf16_t, WS_VB) + (row0 + (tid >> 4)) * 512 + hh * 128 + 8 * (tid & 15));
    I.vb1 = *(const u32x4*)(WSP(bf16_t, WS_VB) + (row0 + 32 + (tid >> 4)) * 512 + hh * 128 + 8 * (tid & 15));
    if (P3) {
        I.qb = *(const u32x4*)(WSP(bf16_t, WS_QB) + (row0 + (tid >> 3)) * 256 + hh * 64 + 8 * (tid & 7));
        const int i = tid >> 3, sub = tid & 7;
        const u32x4* gp = (const u32x4*)(WSP(bf16_t, WS_GB) + (row0 + i) * 512 + hh * 128 + 16 * sub); I.gb0 = gp[0]; I.gb1 = gp[1];
        const float* hp = WSP(float, WS_HCT) + (size_t)item * 8192 + (size_t)(tid >> 4) * 64 + 4 * (tid & 15);
#pragma unroll
        for (int e = 0; e < 4; ++e) I.hc[e] = *(const f32x4*)(hp + (size_t)e * 32 * 64);
    }
}
__device__ __forceinline__ void gla_decay(Frame& F, const f32x4 a1v, const float (&w2)[16], float bias, float& btot) {
    const int tid = F.tid, k = tid & 63, ig = tid >> 6;
    LAS float* a1s = (LAS float*)(F.lds + GL_A1); LAS float* tot = (LAS float*)(F.lds + GL_TOT); LAS float* BC = (LAS float*)(F.lds + GL_BC); LAS float* BT = (LAS float*)(F.lds + GL_BT);
    if (tid < 256) *(LAS f32x4*)(a1s + tid * 4) = a1v;
    LDS_WAIT(); __syncthreads();
    float run = 0.f, bcum[8];
#pragma unroll
    for (int e = 0; e < 8; ++e) { float pre = bias;
#pragma unroll
        for (int r = 0; r < 16; ++r) pre += a1s[(8 * ig + e) * 16 + r] * w2[r];
        run += logsigf_(pre) * (1.0f / 16.0f); bcum[e] = run; }
    tot[ig * 64 + k] = run;
    LDS_WAIT(); __syncthreads();
    float pre = 0.f, all = 0.f;
#pragma unroll
    for (int g = 0; g < 8; ++g) { const float tv = tot[g * 64 + k]; all += tv; if (g < ig) pre += tv; }
#pragma unroll
    for (int e = 0; e < 8; ++e) BC[(8 * ig + e) * 68 + k] = bcum[e] + pre;
    if (ig == 0) BT[k] = all;
    btot = all;
    LDS_WAIT(); __syncthreads();
}
__device__ __forceinline__ void unpack8(const u32x4 w, float (&x)[8]) { x[0] = bflo(w.x); x[1] = bfhi(w.x); x[2] = bflo(w.y); x[3] = bfhi(w.y); x[4] = bflo(w.z); x[5] = bfhi(w.z); x[6] = bflo(w.w); x[7] = bfhi(w.w); }
__device__ __forceinline__ u32x4 pack8(const float (&x)[8]) { u32x4 w; w.x = pk2(x[0], x[1]); w.y = pk2(x[2], x[3]); w.z = pk2(x[4], x[5]); w.w = pk2(x[6], x[7]); return w; }
__device__ __forceinline__ void gla_store_vr(Frame& F, const u32x4 vb0, const u32x4 vb1) {
    const int tid = F.tid;
    *(LAS u32x4*)(F.lds + GL_VR + (tid >> 4) * 272 + (tid & 15) * 16) = vb0;
    *(LAS u32x4*)(F.lds + GL_VR + (32 + (tid >> 4)) * 272 + (tid & 15) * 16) = vb1;
}
__device__ __forceinline__ bf16x8 tr_frag(LAS const unsigned char* img, int pitch, int col0, int s, int lane) {
    const int q4 = (lane & 15) >> 2, p4 = lane & 3, blk = (lane >> 4) & 1, hi = lane >> 5;
    LAS const unsigned char* p = img + (16 * s + 8 * hi + q4) * pitch + (col0 + 16 * blk + 4 * p4) * 2;
    const s16x4 lo = tr_read(p), hi4 = tr_read(p + 4 * pitch);
    return __builtin_shufflevector(lo, hi4, 0, 1, 2, 3, 4, 5, 6, 7);
}
template <int NIT> __device__ __forceinline__ void gla_p1_items(Frame& F, int item0) {
    const int bh = item0 >> 5, b = bh >> 2, hh = bh & 3;
    const int tid = F.tid, k = tid & 63, ig = tid >> 6, lane = F.lane;
    float w2[16];
#pragma unroll
    for (int r = 0; r < 16; ++r) w2[r] = FIN(12)[r * 256 + hh * 64 + k];
    const float bias = FIN(13)[hh * 64 + k];
    GlaIn nx; gla_fetch<false>(F, nx, item0, hh, (size_t)b * SEQ + 64 * (item0 & 31));
    f32x16 ga; float dsum = 0.f;
#pragma unroll
    for (int i = 0; i < 16; ++i) ga[i] = 0.f;
#pragma nounroll
    for (int it = 0; it < NIT; ++it) {
        const int item = item0 + it;
        const GlaIn cu = nx;
        if (it + 1 < NIT) gla_fetch<false>(F, nx, item + 1, hh, (size_t)b * SEQ + 64 * ((item + 1) & 31));
        float btot; gla_decay(F, cu.a1, w2, bias, btot);
        dsum += btot;
        {
            const int i = tid >> 3, c = tid & 7;
            const f32x4 b0 = *(const LAS f32x4*)(F.lds + GL_BC + (i * 68 + 8 * c) * 4), b1 = *(const LAS f32x4*)(F.lds + GL_BC + (i * 68 + 8 * c + 4) * 4);
            const f32x4 t0 = *(const LAS f32x4*)(F.lds + GL_BT + 8 * c * 4), t1 = *(const LAS f32x4*)(F.lds + GL_BT + (8 * c + 4) * 4);
            float kx[8]; unpack8(cu.kb, kx);
#pragma unroll
            for (int e = 0; e < 4; ++e) { kx[e] *= fexp(t0[e] - b0[e]); kx[4 + e] *= fexp(t1[e] - b1[e]); }
            *(LAS u32x4*)(F.lds + GL_QA + i * 144 + c * 16) = pack8(kx);
        }
        gla_store_vr(F, cu.vb0, cu.vb1);
        if (ig == 0) WSP(float, WS_BTOT)[item * 64 + k] = btot;
        LDS_WAIT(); __syncthreads();
        const int kt = F.wave >> 2, vt = F.wave & 3, r32 = lane & 31, hi = lane >> 5;
        f32x16 acc;
#pragma unroll
        for (int i = 0; i < 16; ++i) acc[i] = 0.f;
#pragma unroll
        for (int q = 0; q < 4; ++q) {
            const bf16x8 a = tr_frag(F.lds + GL_QA, 144, 32 * kt, q, lane);
            const bf16x8 bb = tr_frag(F.lds + GL_VR, 272, 32 * vt, q, lane);
            acc = __builtin_amdgcn_mfma_f32_32x32x16_bf16(a, bb, acc, 0, 0, 0);
        }
        float* hct = WSP(float, WS_HCT) + (size_t)item * 8192 + (size_t)(32 * vt + r32) * 64 + 32 * kt + 4 * hi;
#pragma unroll
        for (int g = 0; g < 4; ++g) { *(f32x4*)(hct + 8 * g) = (f32x4){acc[4 * g], acc[4 * g + 1], acc[4 * g + 2], acc[4 * g + 3]};
            const f32x4 bt = *(const LAS f32x4*)(F.lds + GL_BT + (32 * kt + 8 * g + 4 * hi) * 4);
#pragma unroll
            for (int e = 0; e < 4; ++e) ga[4 * g + e] = fexp(bt[e]) * ga[4 * g + e] + acc[4 * g + e]; }
        LDS_WAIT(); __syncthreads();
    }
    {   const int grp = item0 >> 2, kt = F.wave >> 2, vt = F.wave & 3, r32 = lane & 31, hi = lane >> 5;
        float* gag = WSP(float, WS_GAG) + (size_t)grp * 8192 + (size_t)(32 * vt + r32) * 64 + 32 * kt + 4 * hi;
#pragma unroll
        for (int g = 0; g < 4; ++g) *(f32x4*)(gag + 8 * g) = (f32x4){ga[4 * g], ga[4 * g + 1], ga[4 * g + 2], ga[4 * g + 3]};
        if (ig == 0) WSP(float, WS_DSUM)[grp * 64 + k] = dsum; }
}
template <int NIT> __device__ __forceinline__ void gla_p3_items(Frame& F, int item0) {
    const int bh = item0 >> 5, b = bh >> 2, hh = bh & 3;
    const int tid = F.tid, k = tid & 63, lane = F.lane;
    float w2[16];
#pragma unroll
    for (int r = 0; r < 16; ++r) w2[r] = FIN(12)[r * 256 + hh * 64 + k];
    const float bias = FIN(13)[hh * 64 + k];
    GlaIn nx; gla_fetch<true>(F, nx, item0, hh, (size_t)b * SEQ + 64 * (item0 & 31));
    const int k4 = 4 * (tid & 15), v0 = tid >> 4;
    f32x4 S[4];
#pragma unroll
    for (int e = 0; e < 4; ++e) S[e] = (f32x4){0.f, 0.f, 0.f, 0.f};
    {   const int grp = item0 >> 2, j = grp & 7, grp0 = grp - j;
        const float* gag = WSP(float, WS_GAG) + (size_t)grp0 * 8192 + (size_t)v0 * 64 + k4; const float* dsp = WSP(float, WS_DSUM) + grp0 * 64 + k4;
        f32x4 dec = (f32x4){1.f, 1.f, 1.f, 1.f};
#pragma unroll
        for (int half = 1; half >= 0; --half) {
            f32x4 gv[4][4], dv[4];
#pragma unroll
            for (int q = 3; q >= 0; --q) { const int jp = 4 * half + q;
                if (jp < j && jp < 7) { dv[q] = *(const f32x4*)(dsp + jp * 64);
#pragma unroll
                    for (int e = 0; e < 4; ++e) gv[q][e] = *(const f32x4*)(gag + (size_t)jp * 8192 + (size_t)e * 32 * 64); } }
#pragma unroll
            for (int q = 3; q >= 0; --q) { const int jp = 4 * half + q;
                if (jp < j && jp < 7) {
#pragma unroll
                    for (int e = 0; e < 4; ++e) S[e] += dec * gv[q][e];
#pragma unroll
                    for (int x = 0; x < 4; ++x) dec[x] *= fexp(dv[q][x]); } }
        }
    }
#pragma nounroll
    for (int it = 0; it < NIT; ++it) {
        const int item = item0 + it, c = item & 31; const size_t row0 = (size_t)b * SEQ + 64 * c;
        const GlaIn cu = nx;
        if (it + 1 < NIT) gla_fetch<true>(F, nx, item + 1, hh, (size_t)b * SEQ + 64 * ((item + 1) & 31));
        float btot; gla_decay(F, cu.a1, w2, bias, btot);
        {
            const f32x4 bt = *(const LAS f32x4*)(F.lds + GL_BT + k4 * 4);
#pragma unroll
            for (int e = 0; e < 4; ++e) { u32x2 w; w.x = pk2(S[e][0], S[e][1]); w.y = pk2(S[e][2], S[e][3]); *(LAS u32x2*)(F.lds + GL_SP + (v0 + 32 * e) * 144 + k4 * 2) = w;
#pragma unroll
                for (int x = 0; x < 4; ++x) S[e][x] = fexp(bt[x]) * S[e][x] + cu.hc[e][x]; }
        }
        {
            const int i = tid >> 3, cc = tid & 7;
            const f32x4 b0 = *(const LAS f32x4*)(F.lds + GL_BC + (i * 68 + 8 * cc) * 4), b1 = *(const LAS f32x4*)(F.lds + GL_BC + (i * 68 + 8 * cc + 4) * 4);
            float qx[8], kx[8]; unpack8(cu.qb, qx); unpack8(cu.kb, kx);
#pragma unroll
            for (int e = 0; e < 4; ++e) { const float f0 = fexp(b0[e]), f1 = fexp(b1[e]); qx[e] *= f0; qx[4 + e] *= f1; kx[e] *= __builtin_amdgcn_rcpf(f0); kx[4 + e] *= __builtin_amdgcn_rcpf(f1); }
            *(LAS u32x4*)(F.lds + GL_QA + i * 144 + cc * 16) = pack8(qx);
            *(LAS u32x4*)(F.lds + GL_KB + i * 144 + cc * 16) = pack8(kx);
        }
        gla_store_vr(F, cu.vb0, cu.vb1);
        LDS_WAIT(); __syncthreads();
        const int r32 = lane & 31, hi = lane >> 5;
        if (F.wave < 4) {
            const int it2 = F.wave >> 1, jt = F.wave & 1;
            f32x16 acc;
#pragma unroll
            for (int i = 0; i < 16; ++i) acc[i] = 0.f;
            if (jt <= it2) {
#pragma unroll
                for (int q = 0; q < 4; ++q) {
                    const bf16x8 a = *(const LAS bf16x8*)(F.lds + GL_QA + (32 * it2 + r32) * 144 + (16 * q + 8 * hi) * 2);
                    const bf16x8 bb = *(const LAS bf16x8*)(F.lds + GL_KB + (32 * jt + r32) * 144 + (16 * q + 8 * hi) * 2);
                    acc = __builtin_amdgcn_mfma_f32_32x32x16_bf16(a, bb, acc, 0, 0, 0);
                }
            }
#pragma unroll
            for (int i = 0; i < 16; ++i) { const int ii = 32 * it2 + crow(i, hi), jj = 32 * jt + r32;
                *(LAS bf16_t*)(F.lds + GL_AM + ii * 144 + jj * 2) = (bf16_t)f2bf(jj <= ii ? acc[i] : 0.f); }
        }
        LDS_WAIT(); __syncthreads();
        {
            const int it2 = F.wave >> 2, vt = F.wave & 3;
            f32x16 acc;
#pragma unroll
            for (int i = 0; i < 16; ++i) acc[i] = 0.f;
            if (c > 0) {
#pragma unroll
                for (int q = 0; q < 4; ++q) {
                    const bf16x8 a = *(const LAS bf16x8*)(F.lds + GL_QA + (32 * it2 + r32) * 144 + (16 * q + 8 * hi) * 2);
                    const bf16x8 sb = *(const LAS bf16x8*)(F.lds + GL_SP + (32 * vt + r32) * 144 + (16 * q + 8 * hi) * 2);
                    acc = __builtin_amdgcn_mfma_f32_32x32x16_bf16(a, sb, acc, 0, 0, 0);
                }
            }
#pragma unroll
            for (int q = 0; q < 4; ++q) {
                const bf16x8 a = *(const LAS bf16x8*)(F.lds + GL_AM + (32 * it2 + r32) * 144 + (16 * q + 8 * hi) * 2);
                const bf16x8 bb = tr_frag(F.lds + GL_VR, 272, 32 * vt, q, lane);
                acc = __builtin_amdgcn_mfma_f32_32x32x16_bf16(a, bb, acc, 0, 0, 0);
            }
#pragma unroll
            for (int i = 0; i < 16; ++i) *(LAS float*)(F.lds + GL_O + ((32 * it2 + crow(i, hi)) * 132 + 32 * vt + r32) * 4) = acc[i];
        }
        LDS_WAIT(); __syncthreads();
        {
            const int i = tid >> 3, sub = tid & 7; const size_t rr = row0 + i;
            float o[16]; float ss = 0.f;
#pragma unroll
            for (int q = 0; q < 4; ++q) { const f32x4 x = *(const LAS f32x4*)(F.lds + GL_O + (i * 132 + 16 * sub + 4 * q) * 4);
#pragma unroll
                for (int e = 0; e < 4; ++e) { o[4 * q + e] = x[e]; ss += x[e] * x[e]; } }
            ss += __shfl_xor(ss, 1); ss += __shfl_xor(ss, 2); ss += __shfl_xor(ss, 4);
            const float rn = rsqrtf(ss * (1.0f / 128.0f) + EPS);
            const unsigned gw[8] = {cu.gb0.x, cu.gb0.y, cu.gb0.z, cu.gb0.w, cu.gb1.x, cu.gb1.y, cu.gb1.z, cu.gb1.w};
            const float* go = FIN(14) + 16 * sub;
            unsigned w[8];
#pragma unroll
            for (int e = 0; e < 8; ++e) { const float a = o[2 * e] * rn * go[2 * e] * siluf_(bflo(gw[e])), bq = o[2 * e + 1] * rn * go[2 * e + 1] * siluf_(bfhi(gw[e])); w[e] = pk2(a, bq); }
            u32x4* op = (u32x4*)(WSP(bf16_t, WS_A2) + rr * DM + 512 + hh * 128 + 16 * sub);
            op[0] = (u32x4){w[0], w[1], w[2], w[3]}; op[1] = (u32x4){w[4], w[5], w[6], w[7]};
        }
        LDS_WAIT(); __syncthreads();
    }
    if (((item0 >> 2) & 7) == 7) {
#pragma unroll
        for (int e = 0; e < 4; ++e)
#pragma unroll
            for (int x = 0; x < 4; ++x) F.out[OFF_SGP + ((size_t)bh * 64 + k4 + x) * 128 + v0 + 32 * e] = S[e][x];
    }
}
struct GlaSmp { float S[16], vv4[4], gg, gout; };
__device__ __forceinline__ void gla_sample_load(Frame& F, int item, GlaSmp& R) {
    const int b = item >> 2, hh = item & 3, tid = F.tid, v = tid & 127, kq = tid >> 7;
    LAS float* decs = (LAS float*)(F.lds + 8192); LAS float* qs = decs + 256; LAS float* ks = qs + 256;
    const float* s0 = FIN(4) + ((size_t)item * 64 + 16 * kq) * 128 + v;
#pragma unroll
    for (int e = 0; e < 16; ++e) R.S[e] = s0[e * 128];
#pragma unroll
    for (int t = 0; t < DEC_T; ++t) R.vv4[t] = bf2f(WSP(bf16_t, WS_VB)[((size_t)MPROMPT + 4 * b + t) * 512 + hh * 128 + v]);
    R.gg = bf2f(WSP(bf16_t, WS_GB)[((size_t)MPROMPT + 4 * b + kq) * 512 + hh * 128 + v]);
    R.gout = FIN(14)[v];
    if (tid < 256) {
        const int t = tid >> 6, k = tid & 63; const size_t row = (size_t)MPROMPT + 4 * b + t;
        float pre = FIN(13)[hh * 64 + k];
#pragma unroll
        for (int r = 0; r < 16; ++r) pre += WSP(float, WS_A1)[row * 16 + r] * FIN(12)[r * 256 + hh * 64 + k];
        decs[tid] = fexp(logsigf_(pre) * (1.0f / 16.0f));
        qs[tid] = bf2f(WSP(bf16_t, WS_QB)[row * 256 + hh * 64 + k]);
        ks[tid] = bf2f(WSP(bf16_t, WS_KB)[row * 256 + hh * 64 + k]);
    }
}
__device__ __forceinline__ void gla_sample_finish(Frame& F, int item, GlaSmp& R) {
    const int b = item >> 2, hh = item & 3, tid = F.tid, v = tid & 127, kq = tid >> 7;
    LAS float* part = (LAS float*)(F.lds + 4096);
    LAS float* decs = (LAS float*)(F.lds + 8192); LAS float* qs = decs + 256; LAS float* ks = qs + 256;
    LAS float* red = (LAS float*)(F.lds + 16384);
#pragma unroll
    for (int t = 0; t < DEC_T; ++t) {
        const float vv = R.vv4[t];
        float op = 0.f;
#pragma unroll
        for (int e = 0; e < 16; ++e) { const int k = t * 64 + 16 * kq + e;
            R.S[e] = decs[k] * R.S[e] + ks[k] * vv; op += qs[k] * R.S[e]; }
        red[(t * 4 + kq) * 128 + v] = op;
    }
    float* so = F.out + OFF_SGS + ((size_t)item * 64 + 16 * kq) * 128 + v;
#pragma unroll
    for (int e = 0; e < 16; ++e) so[e * 128] = R.S[e];
    LDS_WAIT(); __syncthreads();
    const float o = (red[(kq * 4 + 0) * 128 + v] + red[(kq * 4 + 1) * 128 + v]) + (red[(kq * 4 + 2) * 128 + v] + red[(kq * 4 + 3) * 128 + v]);
    const float sq = wave_sum(o * o);
    if (F.lane == 0) part[F.wave] = sq;
    LDS_WAIT(); __syncthreads();
    const float rn = rsqrtf((part[2 * kq] + part[2 * kq + 1]) * (1.0f / 128.0f) + EPS);
    const size_t orow = (size_t)MPROMPT + 4 * b + kq;
    WSP(bf16_t, WS_A2)[orow * DM + 512 + hh * 128 + v] = (bf16_t)f2bf(o * rn * R.gout * siluf_(R.gg));
    LDS_WAIT(); __syncthreads();
}

__device__ __forceinline__ void final_norm(Frame& F) {
    const int gw = F.vcu * NWAVES + F.wave, NGW = F.G * NWAVES;
    const bf16_t* H4 = WSP(bf16_t, WS_A2); const unsigned* tot4 = TOT(F.ws, 4);
    f32x4 g[4];
#pragma unroll
    for (int j = 0; j < 4; ++j) g[j] = *((const f32x4*)FIN(22) + F.lane + 64 * j);
    for (int m = MPROMPT + gw; m < MTOT; m += NGW) {
        const float rs = rs_from_tot(tot4[m]);
#pragma unroll
        for (int j = 0; j < 4; ++j) { const u32x2 w = *((const u32x2*)(H4 + (size_t)m * DM) + F.lane + 64 * j);
            const f32x4 x = (f32x4){bflo(w.x), bfhi(w.x), bflo(w.y), bfhi(w.y)};
            __builtin_nontemporal_store(x * rs * g[j], (f32x4*)(F.out + OFF_Y + (size_t)m * DM) + F.lane + 64 * j); }
    }
}

constexpr int NPHASES = 12;
constexpr int CW_BAR = 4096;
__global__ void __launch_bounds__(NWAVES * 64, 2) fwd_kernel(Args args) {
    extern __shared__ __attribute__((aligned(16))) unsigned char lds_raw[];
    Frame F;
    F.lds = (LAS unsigned char*)lds_raw;
    F.tid = threadIdx.x; F.lane = F.tid & 63; F.wave = __builtin_amdgcn_readfirstlane(F.tid >> 6);
    F.G = gridDim.x; { const int bx = blockIdx.x; F.vcu = (F.G % 8 == 0) ? (bx % 8) * (F.G / 8) + bx / 8 : bx; }
    F.a = &args; F.out = args.out; F.ws = args.ws;
    volatile LAS unsigned* MISC = (volatile LAS unsigned*)(F.lds + MISC_OFF);
    for (int u = F.tid; u < (LDS_BYTES - LDSCTL_OFF) / 4; u += NWAVES * 64) ((LAS unsigned*)(F.lds + LDSCTL_OFF))[u] = 0u;
    __syncthreads();
    const int lo = args.ph_lo, hi = args.ph_hi;
    XcdBarrier bar; bar.bar = (unsigned*)(F.ws + WS_CTL) + CW_BAR; bar.x = 0; bar.st = nullptr;
    if (hi - lo > 1) bar = xcd_barrier_post((unsigned*)(F.ws + WS_CTL) + CW_BAR, MISC + 8);
#ifndef REP_MASK
#define REP_MASK 0
#endif

#ifndef PH_MASK
#define PH_MASK 0xFFF
#endif
#define IN(k) ((((PH_MASK) >> (k)) & 1) && lo <= (k) && (k) < hi)
#define SEAM(k) do { if (IN(k) && IN((k) + 1)) xcd_barrier(bar); } while (0)
    LAS unsigned char* ring = F.lds;
    CopyCur cp = copy_cursor_init(args.in[2], args.in[3], args.out, (int)blockIdx.x);
#define DRY_K(k) ((int)((((REP_MASK) >> 12) & 1) && (((REP_MASK) >> (k)) & 1) && rep_ == 0))
#define PHASE_BEGIN() do { F.tid = launder_v(threadIdx.x); F.lane = F.tid & 63; F.wave = __builtin_amdgcn_readfirstlane(F.tid >> 6); } while (0)

    if (IN(0)) for (int rep_ = 0; rep_ <= (((REP_MASK) >> 0) & 1); ++rep_) { if (rep_) xcd_barrier(bar); PHASE_BEGIN(); p0_prologue(F); } SEAM(0);
    if (IN(1)) for (int rep_ = 0; rep_ <= (((REP_MASK) >> 1) & 1); ++rep_) { if (rep_) xcd_barrier(bar); PHASE_BEGIN();
#ifndef NO_G1
        { pg8::Gemm g{WSP(bf16_t, WS_HB), WSP(bf16_t, WS_WGU1), MPROMPT, NGU, DM}; pg8::StaticOrder S; S.init(MPROMPT, NGU, F.G, (int)blockIdx.x);
          pg8::EpiSwiGLU<0> E{F.ws, 0};
          pg8::gemm_phase<pg8::EpiSwiGLU<0>, pg8::StaticOrder, true>(ring, g, S, E, cp); }
#endif
#ifndef NO_G8
        if ((int)blockIdx.x >= 128 || F.G != 256) { pg8::Gemm g{WSP(bf16_t, WS_PB), WSP(bf16_t, WS_WPP), MPROMPT, DM, DPLE}; pg8::StaticOrder S; if (F.G == 256) S.init(MPROMPT, DM, 128, (int)blockIdx.x - 128); else S.init(MPROMPT, DM, F.G, (int)blockIdx.x);
          pg8::EpiPlainBf16 E{F.ws, 0};
          pg8::gemm_phase<pg8::EpiPlainBf16, pg8::StaticOrder, true>(ring, g, S, E, cp); }
#endif
        { const sk::EpiSwiGLU<0> E{F.ws, 0}; for (int t = F.G - 1 - (int)blockIdx.x; t < 2 * (DFF / 32); t += F.G) sk::tile(WSP(bf16_t, WS_HB) + (size_t)MPROMPT * DM, DM, WSP(bf16_t, WS_WGU1), E, t, F.lane, F.wave, ring); }
        { const sk::EpiPlain E{F.ws, 0}; for (int t = F.G - 1 - 2 * (DFF / 32) - (int)blockIdx.x; t < 2 * (DM / 64); t += F.G) if (t >= 0) sk::tile(WSP(bf16_t, WS_PB) + (size_t)MPROMPT * DPLE, DPLE, WSP(bf16_t, WS_WPP), E, t, F.lane, F.wave, ring); }
        if ((int)blockIdx.x >= 128) convert_weights<1>(F, ((int)blockIdx.x - 128) * NWAVES + F.wave, 128 * NWAVES);
    } SEAM(1);
    if (IN(2)) for (int rep_ = 0; rep_ <= (((REP_MASK) >> 2) & 1); ++rep_) { if (rep_) xcd_barrier(bar); PHASE_BEGIN();
        pg8::Gemm g{WSP(bf16_t, WS_ACT), WSP(bf16_t, WS_WD1), MPROMPT, DM, DFF}; pg8::StaticOrder S; S.init(MPROMPT, DM, F.G, (int)blockIdx.x);
        pg8::EpiResid<0, 1, false> E{nullptr, F.ws, 0.5f, DRY_K(2)};
        pg8::gemm_phase<pg8::EpiResid<0, 1, false>, pg8::StaticOrder, true>(ring, g, S, E, cp);
        { const sk::EpiResid<0, 1, false> E2{nullptr, F.ws, 0.5f, DRY_K(2)}; for (int t = F.G - 1 - (int)blockIdx.x; t < 2 * (DM / 64); t += F.G) sk::tile(WSP(bf16_t, WS_ACT) + (size_t)MPROMPT * DFF, DFF, WSP(bf16_t, WS_WD1), E2, t, F.lane, F.wave, ring); }
    } SEAM(2);
    if (IN(3)) for (int rep_ = 0; rep_ <= (((REP_MASK) >> 3) & 1); ++rep_) { if (rep_) xcd_barrier(bar); PHASE_BEGIN();
        { pg8::Gemm g{WSP(bf16_t, WS_HB), WSP(bf16_t, WS_WIN), MPROMPT, 3072, DM}; pg8::StaticOrder S; S.init(MPROMPT, 3072, F.G, (int)blockIdx.x);
          pg8::EpiMix E{F.ws, F.out, 0, 0};
          pg8::gemm_phase<pg8::EpiMix, pg8::StaticOrder, true>(ring, g, S, E, cp); }
        { pg8::Gemm g{WSP(bf16_t, WS_HB), WSP(bf16_t, WS_WIN) + (size_t)3072 * DM, MPROMPT, 256, DM}; pg8::StaticOrder S; S.init(MPROMPT, 256, F.G, (int)blockIdx.x);
          pg8::EpiMix E{F.ws, F.out, 0, 12};
          pg8::gemm_phase<pg8::EpiMix, pg8::StaticOrder, true, true>(ring, g, S, E, cp); }
        { const sk::EpiMix E2{F.ws, F.out, 0}; for (int t = F.G - 1 - (int)blockIdx.x; t < 98; t += F.G) sk::tile(WSP(bf16_t, WS_HB) + (size_t)MPROMPT * DM, DM, WSP(bf16_t, WS_WIN), E2, t, F.lane, F.wave, ring); }
        if ((int)blockIdx.x >= 64) convert_weights<2>(F, ((int)blockIdx.x - 64) * NWAVES + F.wave, 192 * NWAVES);
    } SEAM(3);
    if (IN(4)) for (int rep_ = 0; rep_ <= (((REP_MASK) >> 4) & 1); ++rep_) { if (rep_) xcd_barrier(bar); PHASE_BEGIN();
        if (!(PROBE_VAR == 9 && rep_)) for (int it = F.vcu; it < 256; it += F.G) attn_prompt_item(F, it);
        if (!(PROBE_VAR == 8 && rep_)) for (int it = F.vcu; it < 256; it += F.G) gla_p1_items<4>(F, 4 * it);
    } if (IN(4) && IN(6)) xcd_barrier(bar);
    if (IN(6)) for (int rep_ = 0; rep_ <= (((REP_MASK) >> 6) & 1); ++rep_) { if (rep_) xcd_barrier(bar); PHASE_BEGIN();
        if (!((PROBE_VAR == 11 || PROBE_VAR == 12 || PROBE_VAR == 13) && rep_)) for (int it = F.vcu; it < 256; it += F.G) gla_p3_items<4>(F, 4 * it);
        if (!(PROBE_VAR == 10 && rep_)) {
            for (int it = F.vcu; it < 256; it += F.G) {
                GlaSmp R; const bool has = it < 128;
                if (has) gla_sample_load(F, it, R);
                attn_sample_task(F, ((((it >> 3) << 2) | (F.wave & 3)) << 3) | (it & 7), F.wave >> 2);
                if (has) gla_sample_finish(F, it, R);
            }
        }
    } if (IN(6) && IN(7)) xcd_barrier(bar);
    if (IN(7)) for (int rep_ = 0; rep_ <= (((REP_MASK) >> 7) & 1); ++rep_) { if (rep_) xcd_barrier(bar); PHASE_BEGIN();
        pg8::Gemm g{WSP(bf16_t, WS_A2), WSP(bf16_t, WS_WOUT), MPROMPT, DM, DM}; pg8::StaticOrder S; S.init(MPROMPT, DM, F.G, (int)blockIdx.x);
        pg8::EpiResid<0, 2, false> E{nullptr, F.ws, 1.0f, DRY_K(7)};
        pg8::gemm_phase<pg8::EpiResid<0, 2, false>, pg8::StaticOrder, true>(ring, g, S, E, cp);
        { const sk::EpiResid<0, 2, false> E2{nullptr, F.ws, 1.0f, DRY_K(7)}; for (int t = F.G - 1 - (int)blockIdx.x; t < 2 * (DM / 64); t += F.G) sk::tile(WSP(bf16_t, WS_A2) + (size_t)MPROMPT * DM, DM, WSP(bf16_t, WS_WOUT), E2, t, F.lane, F.wave, ring); }
    } SEAM(7);
    if (IN(8)) for (int rep_ = 0; rep_ <= (((REP_MASK) >> 8) & 1); ++rep_) { if (rep_) xcd_barrier(bar); PHASE_BEGIN();
        pg8::Gemm g{WSP(bf16_t, WS_HB), WSP(bf16_t, WS_WGU2), MPROMPT, NGU, (PROBE_VAR == 4 && !rep_) ? DM / 2 : DM}; if (PROBE_VAR == 7 && !rep_) g.ld = DM + 64; pg8::StaticOrder S; S.init(MPROMPT, (PROBE_VAR == 2 && rep_) ? NGU / 2 : NGU, F.G, (int)blockIdx.x);
        pg8::EpiSwiGLU<2> E{F.ws, 0};
        if (PROBE_VAR == 5 && !rep_) S.same = 1;
        if (PROBE_VAR == 6 && !rep_) { CopyCur cpd = cp; cpd.it = CP_STEPS; pg8::gemm_phase<pg8::EpiSwiGLU<2>, pg8::StaticOrder, true>(ring, g, S, E, cpd); }
        else if (!(PROBE_VAR == 3 && rep_)) pg8::gemm_phase<pg8::EpiSwiGLU<2>, pg8::StaticOrder, true>(ring, g, S, E, cp);
        if (!((PROBE_VAR == 1 || PROBE_VAR == 2) && rep_) && !((PROBE_VAR == 4 || PROBE_VAR == 5 || PROBE_VAR == 6 || PROBE_VAR == 7) && !rep_)) { const sk::EpiSwiGLU<2> E2{F.ws, 0}; for (int t = F.G - 1 - (int)blockIdx.x; t < 2 * (DFF / 32); t += F.G) sk::tile(WSP(bf16_t, WS_HB) + (size_t)MPROMPT * DM, DM, WSP(bf16_t, WS_WGU2), E2, t, F.lane, F.wave, ring); }
    } SEAM(8);
    if (IN(9)) for (int rep_ = 0; rep_ <= (((REP_MASK) >> 9) & 1); ++rep_) { if (rep_) xcd_barrier(bar); PHASE_BEGIN();
        pg8::Gemm g{WSP(bf16_t, WS_ACT), WSP(bf16_t, WS_WD2), MPROMPT, DM, DFF}; pg8::StaticOrder S; S.init(MPROMPT, DM, F.G, (int)blockIdx.x);
        pg8::EpiResid<0, 3, false> E{nullptr, F.ws, 0.5f, DRY_K(9)};
        pg8::gemm_phase<pg8::EpiResid<0, 3, false>, pg8::StaticOrder, true>(ring, g, S, E, cp);
        { const sk::EpiResid<0, 3, false> E2{nullptr, F.ws, 0.5f, DRY_K(9)}; for (int t = F.G - 1 - (int)blockIdx.x; t < 2 * (DM / 64); t += F.G) sk::tile(WSP(bf16_t, WS_ACT) + (size_t)MPROMPT * DFF, DFF, WSP(bf16_t, WS_WD2), E2, t, F.lane, F.wave, ring); }
    } SEAM(9);
    if (IN(10)) for (int rep_ = 0; rep_ <= (((REP_MASK) >> 10) & 1); ++rep_) { if (rep_) xcd_barrier(bar); PHASE_BEGIN();
        pg8::Gemm g{WSP(bf16_t, WS_HB), WSP(bf16_t, WS_WPG), MPROMPT, DM, DM}; pg8::StaticOrder S; S.init(MPROMPT, DM, F.G, (int)blockIdx.x);
        pg8::EpiPleNorm E{F.ws, F.out, FIN(22), 32u * (unsigned)(rep_ + 1), DRY_K(10)};
        pg8::gemm_phase<pg8::EpiPleNorm, pg8::StaticOrder, true>(ring, g, S, E, cp);
        { const sk::EpiResid<1, 4, false> E2{nullptr, F.ws, 1.0f, DRY_K(10)}; for (int t = F.G - 1 - (int)blockIdx.x; t < 2 * (DM / 64); t += F.G) sk::tile(WSP(bf16_t, WS_HB) + (size_t)MPROMPT * DM, DM, WSP(bf16_t, WS_WPG), E2, t, F.lane, F.wave, ring); }
    } SEAM(10);
    if (IN(11)) for (int rep_ = 0; rep_ <= (((REP_MASK) >> 11) & 1); ++rep_) { if (rep_) xcd_barrier(bar); PHASE_BEGIN(); final_norm(F); copy_cleanup(cp, F.tid); }
#undef IN
#undef SEAM
}

extern "C" void kernel_launch(void* const* d_in, const int* in_sizes, int n_in, void* d_out, int out_size, void* d_ws, size_t ws_size, hipStream_t stream) {
    static int grid = 0;
    if (grid == 0) {
        if (n_in != 23 || (size_t)out_size != OUT_TOTAL || ws_size < WS_END) { fprintf(stderr, "kernel_launch: unexpected shapes: n_in %d out %d ws %zu (need %zu)\n", n_in, out_size, ws_size, (size_t)WS_END); grid = -1; return; }
        int dev = 0, cus = 0;
        if (hipGetDevice(&dev) != hipSuccess || hipDeviceGetAttribute(&cus, hipDeviceAttributeMultiprocessorCount, dev) != hipSuccess) { grid = -1; return; }
        if (hipFuncSetAttribute((const void*)fwd_kernel, hipFuncAttributeMaxDynamicSharedMemorySize, LDS_BYTES) != hipSuccess) { fprintf(stderr, "kernel_launch: hipFuncSetAttribute failed\n"); grid = -1; return; }
        int per_cu = 0;
        if (hipOccupancyMaxActiveBlocksPerMultiprocessor(&per_cu, (const void*)fwd_kernel, NWAVES * 64, LDS_BYTES) != hipSuccess || per_cu < 1) { fprintf(stderr, "kernel_launch: occupancy query says %d blocks per CU\n", per_cu); }
        (void)hipGetLastError();
        grid = cus;
        if (grid != 256) { fprintf(stderr, "kernel_launch: built for a 256-CU device (got %d CUs); nothing launched\n", cus); grid = -1; return; }
    }
    if (grid < 0) return;
    static_assert((CW_BAR + XCD_BAR_WORDS) * 4 <= 65536 && (pg8::CW_PANEL + 64 * 64) * 4 <= 65536, "control words inside the memset");
    (void)hipMemsetAsync((char*)d_ws + WS_CTL, 0, 65536, stream);
    Args a{};
    for (int i = 0; i < 23; ++i) a.in[i] = (const float*)d_in[i];
    a.out = (float*)d_out; a.ws = (unsigned char*)d_ws;
#if MK_PER_PHASE
    for (int p = 0; p < NPHASES; ++p) { a.ph_lo = p; a.ph_hi = p + 1; hipLaunchKernelGGL(fwd_kernel, dim3(grid), dim3(NWAVES * 64), LDS_BYTES, stream, a); }
#else
    a.ph_lo = 0; a.ph_hi = NPHASES;
    hipLaunchKernelGGL(fwd_kernel, dim3(grid), dim3(NWAVES * 64), LDS_BYTES, stream, a);
#endif
}
```

```cpp
#include <hip/hip_runtime.h>
#include <cstdio>
#include <cstdint>

#ifndef PROBE_EPI2
#define PROBE_EPI2 0
#endif
#ifndef PROBE_SK2
#define PROBE_SK2 0
#endif
#ifndef PROBE_VAR
#define PROBE_VAR 0
#endif
#ifndef MK_PER_PHASE
#define MK_PER_PHASE 0
#endif

#define LAS __attribute__((address_space(3)))
#define GAS __attribute__((address_space(1)))
typedef unsigned short bf16_t;
typedef short bf16x8 __attribute__((ext_vector_type(8)));
typedef short s16x4 __attribute__((ext_vector_type(4)));
typedef float f32x4 __attribute__((ext_vector_type(4)));
typedef float f32x2 __attribute__((ext_vector_type(2)));
typedef float f32x16 __attribute__((ext_vector_type(16)));
typedef unsigned u32x4 __attribute__((ext_vector_type(4)));
typedef unsigned u32x2 __attribute__((ext_vector_type(2)));

constexpr int DM = 1024, NBATCH = 8, SEQ = 2048, MPROMPT = NBATCH * SEQ, DEC_B = 32, DEC_T = 4, MSAMP = DEC_B * DEC_T;
constexpr int MTOT = MPROMPT + MSAMP  , MPAD = 16640  ;
constexpr int DFF = 2816, NGU = 2 * DFF, NPROJ = 3328  , DPLE = 256, PAST = 8192, WINB = 2048;
constexpr int HA = 8, HDA = 64, HB_ = 4, DKB = 64, DVB = 128;
constexpr float EPS = 1e-6f;
constexpr float C2Q = 0.125f * 1.4426950408889634f;
constexpr size_t OFF_Y = 0, OFF_KWP = (size_t)MTOT * DM, OFF_VWP = OFF_KWP + (size_t)MPROMPT * 512, OFF_SGP = OFF_VWP + (size_t)MPROMPT * 512,
                 OFF_KWS = OFF_SGP + (size_t)NBATCH * 4 * 64 * 128, OFF_VWS = OFF_KWS + (size_t)DEC_B * WINB * 512, OFF_SGS = OFF_VWS + (size_t)DEC_B * WINB * 512,
                 OUT_TOTAL = OFF_SGS + (size_t)DEC_B * 4 * 64 * 128;

constexpr size_t al256(size_t x) { return (x + 255) & ~(size_t)255; }
constexpr size_t WS_CTL = 0, CTL_BYTES = 1u << 20;
constexpr size_t WS_WGU1 = CTL_BYTES,                                   SZ_WGU = (size_t)NGU * DM * 2;
constexpr size_t WS_WGU2 = WS_WGU1 + SZ_WGU;
constexpr size_t WS_WD1 = WS_WGU2 + SZ_WGU,                             SZ_WD = (size_t)DM * DFF * 2;
constexpr size_t WS_WD2 = WS_WD1 + SZ_WD;
constexpr size_t WS_WIN = WS_WD2 + SZ_WD,                               SZ_WIN = (size_t)NPROJ * DM * 2;
constexpr size_t WS_WOUT = WS_WIN + SZ_WIN,                             SZ_W1K = (size_t)DM * DM * 2;
constexpr size_t WS_WPG = WS_WOUT + SZ_W1K;
constexpr size_t WS_WPP = WS_WPG + SZ_W1K,                              SZ_WPP = (size_t)DM * DPLE * 2;
constexpr size_t WS_HB = WS_WPP + SZ_WPP,                               SZ_HB = (size_t)MPAD * DM * 2;
constexpr size_t WS_ACT = WS_HB + SZ_HB,                                SZ_ACT = (size_t)MPAD * DFF * 2;
constexpr size_t WS_H32 = WS_ACT + SZ_ACT,                              SZ_H32 = (size_t)MPAD * DM * 4;
constexpr size_t WS_PROJ = WS_H32 + SZ_H32;
constexpr size_t WS_QA = WS_PROJ + SZ_HB,                               SZ_512 = (size_t)MPAD * 512 * 2, SZ_256 = (size_t)MPAD * 256 * 2;
constexpr size_t WS_KA = WS_QA + SZ_512, WS_VA = WS_KA + SZ_512, WS_QB = WS_VA + SZ_512, WS_KB = WS_QB + SZ_256, WS_VB = WS_KB + SZ_256, WS_GB = WS_VB + SZ_512;
constexpr size_t WS_A1 = WS_GB + SZ_512,                                SZ_A1 = (size_t)MPAD * 16 * 4;
constexpr size_t WS_A2 = WS_A1 + SZ_A1;
constexpr size_t WS_PB = WS_A2 + SZ_HB;
constexpr size_t WS_SSQ = WS_PB + SZ_256,                               SZ_SSQ = (size_t)MPAD * 16 * 4;
constexpr size_t WS_ROPE = WS_SSQ + 5 * SZ_SSQ,                         SZ_ROPE = al256((size_t)2052 * 16 * 4);
constexpr size_t WS_BTOT = WS_ROPE + SZ_ROPE,                           SZ_BTOT = (size_t)1024 * 64 * 4;
constexpr size_t WS_END = WS_BTOT + SZ_BTOT;
constexpr size_t WS_HCT = WS_ACT, SZ_HCT = (size_t)1024 * 8192 * 4;
constexpr size_t WS_SPT = WS_HCT + SZ_HCT, SZ_SPT = (size_t)1024 * 8192 * 2;
constexpr size_t WS_GAG = WS_SPT, WS_DSUM = WS_GAG + (size_t)256 * 8192 * 4;
static_assert(SZ_HCT + SZ_SPT <= SZ_ACT, "overlay fits");
static_assert(WS_END <= (size_t)500 * 1024 * 1024, "workspace budget");

constexpr int RING_BYTES = 131072, LDSCTL_OFF = RING_BYTES, MISC_OFF = LDSCTL_OFF + 320, LDS_BYTES = 147456;
constexpr int NWAVES = 8;

#define LDS_WAIT() asm volatile("s_waitcnt lgkmcnt(0)" ::: "memory")
#define VM_WAIT() asm volatile("s_waitcnt vmcnt(0)" ::: "memory")
__device__ __forceinline__ unsigned f2bf(float f) { unsigned u = __builtin_bit_cast(unsigned, f); return (u + 0x7fffu + ((u >> 16) & 1u)) >> 16; }
__device__ __forceinline__ unsigned pk2(float lo, float hi) { return f2bf(lo) | (f2bf(hi) << 16); }
typedef __bf16 bf16x2_t __attribute__((ext_vector_type(2)));
__device__ __forceinline__ unsigned cvt_pk_bf16(float lo, float hi) { const f32x2 v = {lo, hi}; return __builtin_bit_cast(unsigned, __builtin_convertvector(v, bf16x2_t)); }
__device__ __forceinline__ float bf2f(unsigned short b) { return __uint_as_float(((unsigned)b) << 16); }
__device__ __forceinline__ float bflo(unsigned w) { return __uint_as_float(w << 16); }
__device__ __forceinline__ float bfhi(unsigned w) { return __uint_as_float(w & 0xffff0000u); }
__device__ __forceinline__ float fexp(float x) { return __builtin_amdgcn_exp2f(x * 1.4426950408889634f); }
__device__ __forceinline__ float sigmoidf_(float x) { return __builtin_amdgcn_rcpf(1.f + fexp(-x)); }
__device__ __forceinline__ float siluf_(float x) { return x * sigmoidf_(x); }
__device__ __forceinline__ float logsigf_(float x) { return fminf(x, 0.f) - __logf(1.f + fexp(-fabsf(x))); }
__device__ __forceinline__ float wave_sum(float v) {
#pragma unroll
    for (int o = 1; o < 64; o <<= 1) v += __shfl_xor(v, o);
    return v;
}
__device__ __forceinline__ int launder_v(int x) { asm volatile("" : "+v"(x)); return x; }
template <class T> __device__ __forceinline__ T* launder_s(T* p) { asm volatile("" : "+s"(p)); return p; }
#define TOT(ws_, i) ((unsigned*)((ws_) + WS_SSQ + (size_t)(i) * SZ_SSQ))
constexpr float SSQ_SCALE = 16384.f, SSQ_INV = 1.0f / (16384.f * DM);
__device__ __forceinline__ float rs_from_tot(unsigned t) { return rsqrtf((float)t * SSQ_INV + EPS); }
__device__ __forceinline__ void ssq_add(unsigned* tot, int row, float ss) { __hip_atomic_fetch_add(tot + row, (unsigned)(ss * SSQ_SCALE + 0.5f), __ATOMIC_RELAXED, __HIP_MEMORY_SCOPE_AGENT); }
__device__ __forceinline__ float row_rs(const unsigned* tot, int row) { return rs_from_tot(tot[row]); }
__device__ __forceinline__ void row_tot8(const unsigned* tot, int row0, unsigned (&t)[2][4]) {
    const unsigned* p = tot + row0;
#pragma unroll
    for (int ai = 0; ai < 2; ++ai)
#pragma unroll
        for (int m = 0; m < 4; ++m) asm volatile("global_load_dword %0, %1, off offset:%2" : "=v"(t[ai][m]) : "v"(p), "n"((ai * 128 + m * 16) * 4) : "memory");
}

constexpr int CPQ_ELEMS = (WINB - DEC_T) * 128 / 4  , CP_STEPS = (CPQ_ELEMS + 511) / 512  ;
struct CopyCur { const f32x4* src; f32x4* dst; int it; };
__device__ __forceinline__ CopyCur copy_cursor_init(const float* ck, const float* cv, float* out, int w) {
    const int seg = w >> 2, q = w & 3, tensor = seg >> 5, b = seg & 31;
    CopyCur c; c.src = (const f32x4*)(tensor ? cv : ck) + (size_t)b * (WINB * 128) + DEC_T * 128 + (size_t)q * CPQ_ELEMS;
    c.dst = (f32x4*)(out + (tensor ? OFF_VWS : OFF_KWS)) + (size_t)b * (WINB * 128) + (size_t)q * CPQ_ELEMS; c.it = 0; return c;
}
__device__ __forceinline__ void copy_cleanup(CopyCur& c, int tid) {
    for (; c.it < CP_STEPS; ++c.it) { const int e = c.it * 512 + tid; if (e < CPQ_ELEMS) __builtin_nontemporal_store(__builtin_nontemporal_load(c.src + e), c.dst + e); }
}

namespace pg8 {
constexpr int BM = 256, BK = 64, HALF = 128, HTB = HALF * BK * 2, STAGE_BYTES = 8 * HTB, NXCD = 8, WGM = 8;
__host__ __device__ __forceinline__ int lds_byte(int r, int c) { const int st = (r >> 4) * 2 + (c >> 5), rr = r & 15, cc = c & 31, ob = rr * 64 + cc * 2; return st * 1024 + (ob ^ (((ob >> 9) & 1) << 5)); }
__host__ __device__ __forceinline__ void stage_rc(int b, int& R, int& C) { const int st = b / 1024, sb = b % 1024, swz = sb ^ (((sb >> 9) & 1) << 5); R = (st >> 1) * 16 + swz / 64; C = (st & 1) * 32 + (swz % 64) / 2; }
__host__ __device__ __forceinline__ int perm32(int rho) { const int n = rho >> 4, i = rho & 15; return 8 * (i >> 2) + 4 * n + (i & 3); }
struct Unit { int pm, pn; };
struct Gemm { const bf16_t* A; const bf16_t* Bt; int M, N, K; int ld = 0; };
struct StaticOrder {
    int nM, nN, nwg, G, c, same;
    __host__ __device__ void init(int M, int N, int G_, int c_) { nM = M / BM; nN = N / BM; nwg = nM * nN; G = G_; c = c_; same = 0; }
    __host__ __device__ bool next(int i, Unit& u) const {
        const long L = (long)i * G + c; if (L >= nwg) return false;
        int wgid = (int)L; { const int q = nwg / NXCD, r = nwg % NXCD, xcd = wgid % NXCD, off = wgid / NXCD; wgid = (xcd < r ? xcd * (q + 1) : r * (q + 1) + (xcd - r) * q) + off; }
        const int nig = WGM * nN, gid = wgid / nig, fm = gid * WGM, gsz = (nM - fm) < WGM ? (nM - fm) : WGM;
        u.pm = fm + ((wgid % nig) % gsz); u.pn = (wgid % nig) / gsz;
#if PROBE_VAR == 5
        if (same) { u.pm = c & 7; u.pn = 0; }
#endif
        return true;
    }
    __device__ __forceinline__ void a_ready(const Unit&) const {}
    __device__ __forceinline__ void done(const Unit&) const {}
};

template <class Epi, class Sched, bool ALIGN_EPI, bool LITE = false>
__device__ __forceinline__ void gemm_phase(LAS unsigned char* lds, const Gemm g, const Sched& S, const Epi& E, CopyCur& cp) {
    const int tid = launder_v(threadIdx.x), wid = __builtin_amdgcn_readfirstlane(tid >> 6), lane = tid & 63, wr = wid >> 2, wc = wid & 3, fr = lane & 15, fq = lane >> 4;
    const int nt = g.K / BK, K = g.ld ? g.ld : g.K;
    unsigned voffA[2], voffB[2];
#pragma unroll
    for (int i = 0; i < 2; ++i) { int R, C; stage_rc(tid * 16 + i * 8192, R, C); const int Rb = Epi::PERM ? ((R & ~31) + perm32(R & 31)) : R;
        voffA[i] = (unsigned)(R * K + C) * 2u; voffB[i] = (unsigned)(Rb * K + C) * 2u; }
    const size_t kstep = (size_t)(BK * 2);
    const size_t hstep = (size_t)HALF * K * 2;
    const size_t tstep = 2 * hstep;
    const unsigned ldsw = (unsigned)wid * 1024u;
    const int aoff = lds_byte(wr * 64 + fr, fq * 8), boff = lds_byte(wc * 32 + fr, fq * 8);
#define PG8_SA(b, h) (((b) * 2 + (h)) * HTB)
#define PG8_SB(b, h) ((4 + (b) * 2 + (h)) * HTB)
#define PG8_STAGE(bufoff, gbase, voff) do { _Pragma("unroll") for (int _i = 0; _i < 2; ++_i) \
        __builtin_amdgcn_global_load_lds((const unsigned*)((const char*)(gbase) + (voff)[_i]), (LAS unsigned*)(lds + (bufoff) + ldsw + _i * 8192), 16, 0, 0); } while (0)
#define PG8_LDA(dst, b, h) do { _Pragma("unroll") for (int m = 0; m < 4; ++m) _Pragma("unroll") for (int k = 0; k < 2; ++k) dst[m][k] = *(const LAS bf16x8*)(lds + PG8_SA(b, h) + aoff + m * 2048 + k * 1024); } while (0)
#define PG8_LDB(dst, b, h) do { _Pragma("unroll") for (int n = 0; n < 2; ++n) _Pragma("unroll") for (int k = 0; k < 2; ++k) dst[n][k] = *(const LAS bf16x8*)(lds + PG8_SB(b, h) + boff + n * 2048 + k * 1024); } while (0)
#define PG8_MMA(ai, bj, At, Bt) do { if (LITE && ((bj) != 0 || wc != 0)) break; __builtin_amdgcn_s_setprio(1); _Pragma("unroll") for (int m = 0; m < 4; ++m) _Pragma("unroll") for (int n = 0; n < 2; ++n) _Pragma("unroll") for (int k = 0; k < 2; ++k) \
        acc[ai][bj][m][n] = __builtin_amdgcn_mfma_f32_16x16x32_bf16(Bt[n][k], At[m][k], acc[ai][bj][m][n], 0, 0, 0); __builtin_amdgcn_s_setprio(0); } while (0)
#define PG8_WAIT_V(n) asm volatile("s_waitcnt vmcnt(" #n ")" ::: "memory")
#define PG8_WAIT_VC() do { if (ncp == 0) PG8_WAIT_V(8); else if (ncp == 1) PG8_WAIT_V(9); else PG8_WAIT_V(10); } while (0)
#define PG8_WAIT_L(n) asm volatile("s_waitcnt lgkmcnt(" #n ")" ::: "memory")
#define PG8_BAR __builtin_amdgcn_s_barrier()
#define PG8_SCHED __builtin_amdgcn_sched_barrier(0)
    Unit cur, nxt; int ui = 0;
    if (!S.next(0, cur)) return;
    unsigned pre[2][4] = {{0u, 0u, 0u, 0u}, {0u, 0u, 0u, 0u}};
    if constexpr (Epi::PRE) E.prefetch(cur, wr, fr, pre);
    f32x4 acc[2][2][4][2];
#pragma unroll
    for (int a = 0; a < 2; ++a)
#pragma unroll
        for (int b = 0; b < 2; ++b)
#pragma unroll
            for (int m = 0; m < 4; ++m)
#pragma unroll
                for (int n = 0; n < 2; ++n) acc[a][b][m][n] = (f32x4){0.f, 0.f, 0.f, 0.f};
    bf16x8 At[4][2], B0[2][2], B1[2][2];
    f32x4 cp_data = (f32x4){0.f, 0.f, 0.f, 0.f}; int cp_e = 0; bool cp_pending = false;
    const char* cA = (const char*)g.A + (size_t)cur.pm * tstep; const char* cB = (const char*)g.Bt + (size_t)cur.pn * tstep;
    S.a_ready(cur);
    PG8_STAGE(PG8_SB(0, 0), cB, voffB); PG8_STAGE(PG8_SB(0, 1), cB + hstep, voffB); PG8_STAGE(PG8_SA(0, 0), cA, voffA); PG8_STAGE(PG8_SA(0, 1), cA + hstep, voffA);
    if (wr == 1) PG8_BAR;
    PG8_WAIT_V(2); PG8_BAR;
    PG8_STAGE(PG8_SB(1, 0), cB + kstep, voffB); PG8_STAGE(PG8_SA(1, 0), cA + kstep, voffA); PG8_STAGE(PG8_SB(1, 1), cB + hstep + kstep, voffB);
    PG8_WAIT_V(6); PG8_BAR;
    for (;;) {
        const bool has_next = S.next(ui + 1, nxt);
        const char* nA = has_next ? (const char*)g.A + (size_t)nxt.pm * tstep : cA; const char* nB = has_next ? (const char*)g.Bt + (size_t)nxt.pn * tstep : cB;
#pragma nounroll
        for (int t = 0; t < nt; t += 2) {
            const bool last = (t == nt - 2);
            const char* a1 = cA + (size_t)(t + 1) * kstep;
            const char* a2 = last ? nA : cA + (size_t)(t + 2) * kstep; const char* b2 = last ? nB : cB + (size_t)(t + 2) * kstep;
            const char* a3 = a2 + kstep; const char* b3 = b2 + kstep;
            if (last && has_next) S.a_ready(nxt);
            PG8_LDB(B0, 0, 0); PG8_LDB(B1, 0, 1); PG8_SCHED; PG8_LDA(At, 0, 0); PG8_STAGE(PG8_SA(1, 1), a1 + hstep, voffA);
            int ncp = 0;
            if (cp_pending) { asm volatile("global_store_dwordx4 %0, %1, off nt\n\ts_nop 1" :: "v"(cp.dst + cp_e), "v"(cp_data) : "memory"); ncp = 1; cp_pending = false; }
            if (cp.it < CP_STEPS && !last) {
                cp_e = cp.it * 512 + tid; ++cp.it;
                if (cp.it * 512 - 512 + wid * 64 < CPQ_ELEMS) { asm volatile("global_load_dwordx4 %0, %1, off nt" : "=v"(cp_data) : "v"(cp.src + cp_e) : "memory"); ++ncp; cp_pending = true; }
            }
            PG8_WAIT_VC(); PG8_WAIT_L(0); PG8_BAR; PG8_MMA(0, 0, At, B0); PG8_MMA(0, 1, At, B1); PG8_BAR; PG8_SCHED;
            PG8_LDA(At, 0, 1); PG8_STAGE(PG8_SB(0, 0), b2, voffB); PG8_STAGE(PG8_SB(0, 1), b2 + hstep, voffB); PG8_STAGE(PG8_SA(0, 0), a2, voffA);
            PG8_WAIT_VC(); PG8_WAIT_L(0); PG8_BAR; PG8_MMA(1, 0, At, B0); PG8_MMA(1, 1, At, B1); PG8_BAR; PG8_SCHED;
            PG8_LDB(B0, 1, 0); PG8_LDB(B1, 1, 1); PG8_SCHED; PG8_LDA(At, 1, 0); PG8_STAGE(PG8_SA(0, 1), a2 + hstep, voffA);
            PG8_WAIT_VC(); PG8_WAIT_L(0); PG8_BAR; PG8_MMA(0, 0, At, B0); PG8_MMA(0, 1, At, B1); PG8_BAR; PG8_SCHED;
            PG8_LDA(At, 1, 1); PG8_STAGE(PG8_SB(1, 0), b3, voffB); PG8_STAGE(PG8_SB(1, 1), b3 + hstep, voffB); PG8_STAGE(PG8_SA(1, 0), a3, voffA);
            PG8_WAIT_V(8); PG8_WAIT_L(0); PG8_BAR; PG8_MMA(1, 0, At, B0); PG8_MMA(1, 1, At, B1); PG8_BAR; PG8_SCHED;
        }
        if constexpr (ALIGN_EPI) { if (wr == 0) PG8_BAR; }
#if PROBE_EPI2
        if constexpr (Epi::PROBE2) { Epi Ed = E; Ed.dry = 1; Ed(acc, cur, wr, wc, fr, fq, pre); asm volatile("s_waitcnt vmcnt(0)" ::: "memory"); }
#endif
        if constexpr (Epi::PRE) {
#pragma unroll
            for (int a = 0; a < 2; ++a)
#pragma unroll
                for (int m = 0; m < 4; ++m) asm volatile("" : "+v"(pre[a][m]));
        }
        E(acc, cur, wr, wc, fr, fq, pre); S.done(cur);
        if (!has_next) break;
        if constexpr (Epi::PRE) E.prefetch(nxt, wr, fr, pre);
#pragma unroll
        for (int a = 0; a < 2; ++a)
#pragma unroll
            for (int b = 0; b < 2; ++b)
#pragma unroll
                for (int m = 0; m < 4; ++m)
#pragma unroll
                    for (int n = 0; n < 2; ++n) acc[a][b][m][n] = (f32x4){0.f, 0.f, 0.f, 0.f};
        cur = nxt; cA = nA; cB = nB; ++ui;
        if constexpr (ALIGN_EPI) { if (wr == 1) PG8_BAR; }
    }
    PG8_WAIT_V(0);
    if constexpr (!ALIGN_EPI) { if (wr == 0) PG8_BAR; }
    PG8_BAR;
#undef PG8_SA
#undef PG8_SB
#undef PG8_STAGE
#undef PG8_LDA
#undef PG8_LDB
#undef PG8_MMA
#undef PG8_WAIT_V
#undef PG8_WAIT_VC
#undef PG8_WAIT_L
#undef PG8_BAR
#undef PG8_SCHED
}


template <int SSQI> struct EpiSwiGLU {
    static constexpr bool PERM = true, PROBE2 = true, PRE = true;
    unsigned char* ws; int dry;
    __device__ __forceinline__ void prefetch(const Unit& u, int wr, int fr, unsigned (&pre)[2][4]) const { row_tot8(TOT(ws, SSQI), u.pm * BM + wr * 64 + fr, pre); }
    __device__ __forceinline__ void operator()(const f32x4 (&acc)[2][2][4][2], const Unit& u, int wr, int wc, int fr, int fq, const unsigned (&pre)[2][4]) const {
        bf16_t* O = (bf16_t*)(ws + WS_ACT);
        const int row0 = u.pm * BM + wr * 64 + fr, col0 = u.pn * 128 + wc * 32 + 8 * fq;
#pragma unroll
        for (int ai = 0; ai < 2; ++ai)
#pragma unroll
            for (int m = 0; m < 4; ++m) {
                const int row = row0 + ai * HALF + m * 16; const float rs = rs_from_tot(pre[ai][m]);
                float o[8];
#pragma unroll
                for (int n = 0; n < 2; ++n)
#pragma unroll
                    for (int j = 0; j < 4; ++j) { const float gt = acc[ai][0][m][n][j] * rs, up = acc[ai][1][m][n][j] * rs; o[n * 4 + j] = siluf_(gt) * up; }
                u32x4 w; w.x = cvt_pk_bf16(o[0], o[1]); w.y = cvt_pk_bf16(o[2], o[3]); w.z = cvt_pk_bf16(o[4], o[5]); w.w = cvt_pk_bf16(o[6], o[7]);
                *(u32x4*)(O + (size_t)row * DFF + col0) = w;
            }
    }
};
struct EpiPlainBf16 {
    static constexpr bool PERM = true, PROBE2 = true, PRE = false;
    unsigned char* ws; int dry;
    __device__ __forceinline__ void operator()(const f32x4 (&acc)[2][2][4][2], const Unit& u, int wr, int wc, int fr, int fq, const unsigned (&)[2][4]) const {
        bf16_t* O = (bf16_t*)(ws + WS_PROJ); constexpr int ldc = DM;
        const int row0 = u.pm * BM + wr * 64 + fr, col0 = u.pn * BM + wc * 32 + 8 * fq;
#pragma unroll
        for (int ai = 0; ai < 2; ++ai)
#pragma unroll
            for (int m = 0; m < 4; ++m) { bf16_t* rowp = O + (size_t)(row0 + ai * HALF + m * 16) * ldc + col0;
#pragma unroll
                for (int bj = 0; bj < 2; ++bj) { const f32x4 v0 = acc[ai][bj][m][0], v1 = acc[ai][bj][m][1];
                    u32x4 w; w.x = cvt_pk_bf16(v0[0], v0[1]); w.y = cvt_pk_bf16(v0[2], v0[3]); w.z = cvt_pk_bf16(v1[0], v1[1]); w.w = cvt_pk_bf16(v1[2], v1[3]);
                    *(u32x4*)(rowp + bj * HALF) = w; } }
    }
};
template <int MODE  , int SSQO, bool FROM_X  > struct EpiResid {
    static constexpr bool PERM = true, PROBE2 = true, PRE = false;
    const float* xP; unsigned char* ws; float scale; int dry;
    __device__ __forceinline__ void operator()(const f32x4 (&acc)[2][2][4][2], const Unit& u, int wr, int wc, int fr, int fq, const unsigned (&)[2][4]) const {
        bf16_t* HBp = (bf16_t*)(ws + WS_HB); unsigned* ssq_out = TOT(ws, SSQO);
        const int col0 = u.pn * BM + wc * 32 + 8 * fq, row00 = u.pm * BM + wr * 64 + fr;
        u32x4 bn_[2];
#pragma unroll
        for (int bj = 0; bj < 2; ++bj) bn_[bj] = *(const u32x4*)(HBp + (size_t)row00 * DM + col0 + bj * HALF);
#pragma unroll
        for (int ai = 0; ai < 2; ++ai)
#pragma unroll
            for (int m = 0; m < 4; ++m) {
                const int row = row00 + ai * HALF + m * 16;
                u32x4 bc[2];
#pragma unroll
                for (int bj = 0; bj < 2; ++bj) bc[bj] = bn_[bj];
                if (ai * 4 + m < 7) { const int rown = row00 + ((ai * 4 + m + 1) >> 2) * HALF + ((ai * 4 + m + 1) & 3) * 16;
#pragma unroll
                    for (int bj = 0; bj < 2; ++bj) bn_[bj] = *(const u32x4*)(HBp + (size_t)rown * DM + col0 + bj * HALF); }
                float ss = 0.f;
#pragma unroll
                for (int bj = 0; bj < 2; ++bj) {
                    const u32x4 w0 = bc[bj];
                    const f32x4 v0 = (f32x4){bflo(w0.x), bfhi(w0.x), bflo(w0.y), bfhi(w0.y)} + acc[ai][bj][m][0] * scale;
                    const f32x4 v1 = (f32x4){bflo(w0.z), bfhi(w0.z), bflo(w0.w), bfhi(w0.w)} + acc[ai][bj][m][1] * scale;
                    if (!dry) { u32x4 w; w.x = cvt_pk_bf16(v0[0], v0[1]); w.y = cvt_pk_bf16(v0[2], v0[3]); w.z = cvt_pk_bf16(v1[0], v1[1]); w.w = cvt_pk_bf16(v1[2], v1[3]);
                        *(u32x4*)(HBp + (size_t)row * DM + col0 + bj * HALF) = w; }
                    ss += ((v0[0] * v0[0] + v0[1] * v0[1]) + (v0[2] * v0[2] + v0[3] * v0[3])) + ((v1[0] * v1[0] + v1[1] * v1[1]) + (v1[2] * v1[2] + v1[3] * v1[3])); }
                ss += __shfl_xor(ss, 16); ss += __shfl_xor(ss, 32);
                if (fq == 0 && !dry) ssq_add(ssq_out, row, ss);
            }
    }
};
constexpr int CW_PANEL = 8192;
struct EpiPleNorm {
    static constexpr bool PERM = true, PROBE2 = false, PRE = true;
    unsigned char* ws; float* out; const float* gfin; unsigned want; int dry;
    __device__ __forceinline__ void prefetch(const Unit& u, int wr, int fr, unsigned (&pre)[2][4]) const { row_tot8(TOT(ws, 3), u.pm * BM + wr * 64 + fr, pre); }
    __device__ __forceinline__ void operator()(f32x4 (&acc)[2][2][4][2], const Unit& u, int wr, int wc, int fr, int fq, const unsigned (&pre)[2][4]) const {
        const bf16_t* HBp = (const bf16_t*)(ws + WS_HB); const bf16_t* proj = (const bf16_t*)(ws + WS_PROJ);
        unsigned* ssq4 = TOT(ws, 4);
        const int col0 = u.pn * BM + wc * 32 + 8 * fq, row00 = u.pm * BM + wr * 64 + fr;
        u32x4 pn_[2], bn_[2];
#pragma unroll
        for (int bj = 0; bj < 2; ++bj) { pn_[bj] = *(const u32x4*)(proj + (size_t)row00 * DM + col0 + bj * HALF); bn_[bj] = *(const u32x4*)(HBp + (size_t)row00 * DM + col0 + bj * HALF); }
#pragma unroll
        for (int ai = 0; ai < 2; ++ai)
#pragma unroll
            for (int m = 0; m < 4; ++m) {
                const int row = row00 + ai * HALF + m * 16;
                const float rs = rs_from_tot(pre[ai][m]);
                u32x4 pc[2], bc[2];
#pragma unroll
                for (int bj = 0; bj < 2; ++bj) { pc[bj] = pn_[bj]; bc[bj] = bn_[bj]; }
                if (ai * 4 + m < 7) { const int rown = row00 + ((ai * 4 + m + 1) >> 2) * HALF + ((ai * 4 + m + 1) & 3) * 16;
#pragma unroll
                    for (int bj = 0; bj < 2; ++bj) { pn_[bj] = *(const u32x4*)(proj + (size_t)rown * DM + col0 + bj * HALF); bn_[bj] = *(const u32x4*)(HBp + (size_t)rown * DM + col0 + bj * HALF); } }
                float ss = 0.f;
#pragma unroll
                for (int bj = 0; bj < 2; ++bj) {
                    const u32x4 b0 = bc[bj], p0 = pc[bj];
                    const f32x4 a0 = acc[ai][bj][m][0] * rs, a1 = acc[ai][bj][m][1] * rs; f32x4 v0, v1;
                    v0[0] = bflo(b0.x) + sigmoidf_(a0[0]) * bflo(p0.x); v0[1] = bfhi(b0.x) + sigmoidf_(a0[1]) * bfhi(p0.x); v0[2] = bflo(b0.y) + sigmoidf_(a0[2]) * bflo(p0.y); v0[3] = bfhi(b0.y) + sigmoidf_(a0[3]) * bfhi(p0.y);
                    v1[0] = bflo(b0.z) + sigmoidf_(a1[0]) * bflo(p0.z); v1[1] = bfhi(b0.z) + sigmoidf_(a1[1]) * bfhi(p0.z); v1[2] = bflo(b0.w) + sigmoidf_(a1[2]) * bflo(p0.w); v1[3] = bfhi(b0.w) + sigmoidf_(a1[3]) * bfhi(p0.w);
                    acc[ai][bj][m][0] = v0; acc[ai][bj][m][1] = v1;
                    ss += ((v0[0] * v0[0] + v0[1] * v0[1]) + (v0[2] * v0[2] + v0[3] * v0[3])) + ((v1[0] * v1[0] + v1[1] * v1[1]) + (v1[2] * v1[2] + v1[3] * v1[3])); }
                ss += __shfl_xor(ss, 16); ss += __shfl_xor(ss, 32);
                if (fq == 0 && !dry) ssq_add(ssq4, row, ss);
            }
        asm volatile("s_waitcnt vmcnt(0)" ::: "memory");
        unsigned* cnt = (unsigned*)(ws + WS_CTL) + CW_PANEL + 64 * u.pm;
        if (fr == 0 && fq == 0) __hip_atomic_fetch_add(cnt, 1u, __ATOMIC_RELAXED, __HIP_MEMORY_SCOPE_AGENT);
        if (wr == 0 && wc == 0) {
            unsigned sp = 0;
            while ((unsigned)__builtin_amdgcn_readfirstlane(__hip_atomic_load(cnt, __ATOMIC_RELAXED, __HIP_MEMORY_SCOPE_AGENT)) < want) { __builtin_amdgcn_s_sleep(2); if (++sp > (1u << 20)) break; }
        }
        asm volatile("s_waitcnt vmcnt(0) lgkmcnt(0)" ::: "memory"); __builtin_amdgcn_s_barrier(); asm volatile("" ::: "memory");
        f32x4 g[2][2];
#pragma unroll
        for (int bj = 0; bj < 2; ++bj)
#pragma unroll
            for (int n = 0; n < 2; ++n) g[bj][n] = *(const f32x4*)(gfin + col0 + bj * HALF + n * 4);
#pragma unroll
        for (int ai = 0; ai < 2; ++ai)
#pragma unroll
            for (int m = 0; m < 4; ++m) {
                const int row = row00 + ai * HALF + m * 16;
                const float rs4 = rs_from_tot(__hip_atomic_load(ssq4 + row, __ATOMIC_RELAXED, __HIP_MEMORY_SCOPE_AGENT));
                if (!dry) {
#pragma unroll
                    for (int bj = 0; bj < 2; ++bj)
#pragma unroll
                        for (int n = 0; n < 2; ++n) __builtin_nontemporal_store(acc[ai][bj][m][n] * rs4 * g[bj][n], (f32x4*)(out + OFF_Y + (size_t)row * DM + col0 + bj * HALF + n * 4));
                }
            }
    }
};
struct EpiMix {
    static constexpr bool PERM = true, PROBE2 = true, PRE = true;
    unsigned char* ws; float* out; int dry; int pn_base;
    __device__ __forceinline__ void prefetch(const Unit& u, int wr, int fr, unsigned (&pre)[2][4]) const { row_tot8(TOT(ws, 1), u.pm * BM + wr * 64 + fr, pre); }
    __device__ __forceinline__ void operator()(const f32x4 (&acc)[2][2][4][2], const Unit& u, int wr, int wc, int fr, int fq, const unsigned (&pre)[2][4]) const {
        const float* rope = (const float*)(ws + WS_ROPE);
        bf16_t *QA = (bf16_t*)(ws + WS_QA), *KA = (bf16_t*)(ws + WS_KA), *VA = (bf16_t*)(ws + WS_VA), *QB = (bf16_t*)(ws + WS_QB), *KB = (bf16_t*)(ws + WS_KB), *VB = (bf16_t*)(ws + WS_VB), *GB = (bf16_t*)(ws + WS_GB);
        float* A1 = (float*)(ws + WS_A1);
        const int pn = u.pn + pn_base;
        if (pn == 12 && wc != 0) return;
        const bool do_rope = (pn < 4) && ((wc & 1) == 0);
        const int row00 = u.pm * BM + wr * 64 + fr, cb = wc * 32 + 8 * fq;
        f32x4 tn[4];
#pragma unroll
        for (int k = 0; k < 4; ++k) tn[k] = (f32x4){0.f, 0.f, 0.f, 0.f};
        if (do_rope) { const int posidx = row00 & (SEQ - 1);
#pragma unroll
            for (int k = 0; k < 4; ++k) tn[k] = *(const f32x4*)(rope + (size_t)posidx * 16 + 4 * k); }
#pragma unroll
        for (int ai = 0; ai < 2; ++ai)
#pragma unroll
            for (int m = 0; m < 4; ++m) {
                const int row = row00 + ai * HALF + m * 16;
                const float rs = rs_from_tot(pre[ai][m]);
                f32x4 v[2][2];
#pragma unroll
                for (int bj = 0; bj < 2; ++bj)
#pragma unroll
                    for (int n = 0; n < 2; ++n) v[bj][n] = acc[ai][bj][m][n] * rs;
                if (do_rope) {
                    f32x4 t[4];
#pragma unroll
                    for (int k = 0; k < 4; ++k) t[k] = tn[k];
                    if (ai * 4 + m < 7) { const int rown = row00 + ((ai * 4 + m + 1) >> 2) * HALF + ((ai * 4 + m + 1) & 3) * 16; const int posn = rown & (SEQ - 1);
#pragma unroll
                        for (int k = 0; k < 4; ++k) tn[k] = *(const f32x4*)(rope + (size_t)posn * 16 + 4 * k); }
#pragma unroll
                    for (int bj = 0; bj < 2; ++bj)
#pragma unroll
                        for (int n = 0; n < 2; ++n)
#pragma unroll
                            for (int j = 0; j < 4; ++j) { const float cs = t[2 * n + (j >> 1)][2 * (j & 1)], sn = t[2 * n + (j >> 1)][2 * (j & 1) + 1];
                                const float x = v[bj][n][j], w = __shfl_xor(x, 16);
                                if (fq < 2) v[bj][n][j] = (fq == 0) ? (x * cs - w * sn) : (x * cs + w * sn); }
                }
                if (pn < 6) {
                    const int kind = pn >> 1, c0 = (pn & 1) * 256 + cb;
                    bf16_t* dst = (kind == 0 ? QA : (kind == 1 ? KA : VA)) + (size_t)row * 512 + c0;
                    const float sc = kind == 0 ? C2Q : 1.f;
                    float* fo = kind == 0 ? nullptr : out + (kind == 1 ? OFF_KWP : OFF_VWP) + (size_t)row * 512 + c0;
#pragma unroll
                    for (int bj = 0; bj < 2; ++bj) { const f32x4 x0 = v[bj][0], x1 = v[bj][1];
                        u32x4 w; w.x = cvt_pk_bf16(x0[0] * sc, x0[1] * sc); w.y = cvt_pk_bf16(x0[2] * sc, x0[3] * sc); w.z = cvt_pk_bf16(x1[0] * sc, x1[1] * sc); w.w = cvt_pk_bf16(x1[2] * sc, x1[3] * sc);
                        *(u32x4*)(dst + bj * HALF) = w;
                        if (fo) { __builtin_nontemporal_store(x0, (f32x4*)(fo + bj * HALF)); __builtin_nontemporal_store(x1, (f32x4*)(fo + bj * HALF + 4)); } }
                } else if (pn < 12) {
                    bf16_t* dst; float sc = 1.f;
                    if (pn == 6) { dst = QB + (size_t)row * 256; sc = 0.125f; }
                    else if (pn == 7) dst = KB + (size_t)row * 256;
                    else if (pn < 10) dst = VB + (size_t)row * 512 + (pn - 8) * 256;
                    else dst = GB + (size_t)row * 512 + (pn - 10) * 256;
                    dst += cb;
#pragma unroll
                    for (int bj = 0; bj < 2; ++bj) { const f32x4 x0 = v[bj][0] * sc, x1 = v[bj][1] * sc;
                        u32x4 w; w.x = cvt_pk_bf16(x0[0], x0[1]); w.y = cvt_pk_bf16(x0[2], x0[3]); w.z = cvt_pk_bf16(x1[0], x1[1]); w.w = cvt_pk_bf16(x1[2], x1[3]);
                        *(u32x4*)(dst + bj * HALF) = w; }
                } else if (fq < 2) {
                    *(f32x4*)(A1 + (size_t)row * 16 + 8 * fq) = v[0][0]; *(f32x4*)(A1 + (size_t)row * 16 + 8 * fq + 4) = v[0][1];
                }
            }
    }
};
}


namespace sk {
template <class Epi> __device__ __forceinline__ void tile1(const bf16_t* A, int K, const bf16_t* Bt, const Epi& E, int task, int lane, int wave, LAS unsigned char* lds) {
    const int tn = task >> 1, rh = task & 1, fr = lane & 15, fq = lane >> 4;
    const int kw = K >> 3, nks = kw >> 5;
    const bf16_t* ap = A + (size_t)(64 * rh + fr) * K + wave * kw + 8 * fq;
    const bf16_t* bp[4];
#pragma unroll
    for (int f = 0; f < 4; ++f) bp[f] = Bt + (size_t)Epi::brow(tn, f, fr) * K + wave * kw + 8 * fq;
    f32x4 acc[4][4];
#pragma unroll
    for (int m = 0; m < 4; ++m)
#pragma unroll
        for (int f = 0; f < 4; ++f) acc[m][f] = (f32x4){0.f, 0.f, 0.f, 0.f};
#pragma nounroll
    for (int k0 = 0; k0 < nks; k0 += 4) {
        bf16x8 a[4][4], b[4][4];
#pragma unroll
        for (int q = 0; q < 4; ++q) {
            const int ks = (k0 + q < nks) ? k0 + q : nks - 1;
#pragma unroll
            for (int m = 0; m < 4; ++m) a[q][m] = *(const bf16x8*)(ap + (size_t)m * 16 * K + 32 * ks);
#pragma unroll
            for (int f = 0; f < 4; ++f) b[q][f] = *(const bf16x8*)(bp[f] + 32 * ks);
        }
#pragma unroll
        for (int q = 0; q < 4; ++q) {
            if (k0 + q < nks) {
#pragma unroll
                for (int m = 0; m < 4; ++m)
#pragma unroll
                    for (int f = 0; f < 4; ++f) acc[m][f] = __builtin_amdgcn_mfma_f32_16x16x32_bf16(b[q][f], a[q][m], acc[m][f], 0, 0, 0);
            }
        }
    }
    LAS f32x4* red = (LAS f32x4*)lds;
#pragma unroll
    for (int m = 0; m < 4; ++m)
#pragma unroll
        for (int f = 0; f < 4; ++f) red[(wave * 16 + m * 4 + f) * 64 + lane] = acc[m][f];
    LDS_WAIT(); __syncthreads();
    if (wave < 4) {
        f32x4 r[4];
#pragma unroll
        for (int f = 0; f < 4; ++f) { f32x4 sacc = red[(wave * 4 + f) * 64 + lane];
#pragma unroll
            for (int w = 1; w < 8; ++w) sacc += red[(w * 16 + wave * 4 + f) * 64 + lane];
            r[f] = sacc; }
        E(tn, 64 * rh + 16 * wave + fr, fq, r);
    }
    LDS_WAIT(); __syncthreads();
}
template <class Epi, int MT, int FT> __device__ __forceinline__ void subtile(const bf16_t* A, int K, const bf16_t* Bt, const Epi& E, int task, int lane, int wave, LAS unsigned char* lds) {
    constexpr int NF = 4 / FT, NP = (4 / MT) * NF;
    const int piece = task % NP, t64 = task / NP, tn = t64 >> 1, rh = t64 & 1, mh = piece / NF, fh = piece % NF, fr = lane & 15, fq = lane >> 4;
    const int kw = K >> 3, nks = kw >> 5;
    const bf16_t* ap = A + (size_t)(64 * rh + 16 * MT * mh + fr) * K + wave * kw + 8 * fq;
    const bf16_t* bp[FT];
#pragma unroll
    for (int f = 0; f < FT; ++f) bp[f] = Bt + (size_t)Epi::brow(tn, FT * fh + f, fr) * K + wave * kw + 8 * fq;
    f32x4 acc[MT][FT];
#pragma unroll
    for (int m = 0; m < MT; ++m)
#pragma unroll
        for (int f = 0; f < FT; ++f) acc[m][f] = (f32x4){0.f, 0.f, 0.f, 0.f};
#pragma nounroll
    for (int k0 = 0; k0 < nks; k0 += 4) {
        bf16x8 a[4][MT], b[4][FT];
#pragma unroll
        for (int q = 0; q < 4; ++q) {
            const int ks = (k0 + q < nks) ? k0 + q : nks - 1;
#pragma unroll
            for (int m = 0; m < MT; ++m) a[q][m] = *(const bf16x8*)(ap + (size_t)m * 16 * K + 32 * ks);
#pragma unroll
            for (int f = 0; f < FT; ++f) b[q][f] = *(const bf16x8*)(bp[f] + 32 * ks);
        }
#pragma unroll
        for (int q = 0; q < 4; ++q) {
            if (k0 + q < nks) {
#pragma unroll
                for (int m = 0; m < MT; ++m)
#pragma unroll
                    for (int f = 0; f < FT; ++f) acc[m][f] = __builtin_amdgcn_mfma_f32_16x16x32_bf16(b[q][f], a[q][m], acc[m][f], 0, 0, 0);
            }
        }
    }
    LAS f32x4* red = (LAS f32x4*)lds;
#pragma unroll
    for (int m = 0; m < MT; ++m)
#pragma unroll
        for (int f = 0; f < FT; ++f) red[(wave * (MT * FT) + m * FT + f) * 64 + lane] = acc[m][f];
    LDS_WAIT(); __syncthreads();
    if (wave < MT) {
        f32x4 r[FT];
#pragma unroll
        for (int f = 0; f < FT; ++f) { f32x4 sacc = red[(wave * FT + f) * 64 + lane];
#pragma unroll
            for (int w = 1; w < 8; ++w) sacc += red[(w * (MT * FT) + wave * FT + f) * 64 + lane];
            r[f] = sacc; }
        E.template part<FT>(tn, FT * fh, 64 * rh + 16 * (MT * mh + wave) + fr, fq, r);
    }
    LDS_WAIT(); __syncthreads();
}
template <class Epi> __device__ __forceinline__ void tile(const bf16_t* A, int K, const bf16_t* Bt, const Epi& E, int task, int lane, int wave, LAS unsigned char* lds) {
#if PROBE_SK2
    { Epi Ed = E; Ed.dry = 1; tile1(A, K, Bt, Ed, task, lane, wave, lds); }
#endif
    tile1(A, K, Bt, E, task, lane, wave, lds);
}
__device__ __forceinline__ void st_bf4(bf16_t* p, const f32x4 v) { u32x2 w; w.x = cvt_pk_bf16(v[0], v[1]); w.y = cvt_pk_bf16(v[2], v[3]); *(u32x2*)p = w; }
template <int SSQI> struct EpiSwiGLU {
    unsigned char* ws; int dry;
    static __device__ __forceinline__ int brow(int tn, int f, int n) { const int gc = 32 * tn + 16 * (f & 1) + n; return 256 * (gc >> 7) + 128 * (f >> 1) + (gc & 127); }
    __device__ __forceinline__ void operator()(int tn, int srow, int fq, const f32x4 (&acc)[4]) const {
        const int row = MPROMPT + srow; const float rs = row_rs(TOT(ws, SSQI), row);
        bf16_t* O = (bf16_t*)(ws + WS_ACT) + (size_t)row * DFF + 32 * tn + 4 * fq;
#pragma unroll
        for (int f = 0; f < 2; ++f) { f32x4 o;
#pragma unroll
            for (int j = 0; j < 4; ++j) o[j] = siluf_(acc[f][j] * rs) * (acc[f + 2][j] * rs);
            st_bf4(O + 16 * f, o); }
    }
};
struct EpiPlain {
    unsigned char* ws; int dry;
    static __device__ __forceinline__ int brow(int tn, int f, int n) { return 64 * tn + 16 * f + n; }
    __device__ __forceinline__ void operator()(int tn, int srow, int fq, const f32x4 (&acc)[4]) const {
        bf16_t* O = (bf16_t*)(ws + WS_PROJ) + (size_t)(MPROMPT + srow) * DM + 64 * tn + 4 * fq;
#pragma unroll
        for (int f = 0; f < 4; ++f) st_bf4(O + 16 * f, acc[f]);
    }
};
template <int MODE, int SSQO, bool FROM_X> struct EpiResid {
    const float* xS; unsigned char* ws; float scale; int dry;
    static __device__ __forceinline__ int brow(int tn, int f, int n) { return 64 * tn + 16 * f + n; }
    __device__ __forceinline__ void operator()(int tn, int srow, int fq, const f32x4 (&acc)[4]) const { part<4>(tn, 0, srow, fq, acc); }
    template <int FT> __device__ __forceinline__ void part(int tn, int f0, int srow, int fq, const f32x4 (&acc)[FT]) const {
        const int row = MPROMPT + srow, cb = 64 * tn + 16 * f0 + 4 * fq;
        bf16_t* HBp = (bf16_t*)(ws + WS_HB) + (size_t)row * DM + cb; bf16_t* Out = MODE == 0 ? HBp : (bf16_t*)(ws + WS_A2) + (size_t)row * DM + cb;
        const float* xp = xS + (size_t)srow * DM + cb;
        const bf16_t* pj = (const bf16_t*)(ws + WS_PROJ) + (size_t)row * DM + cb;
        float rs = 1.f; if (MODE == 1) rs = row_rs(TOT(ws, SSQO - 1), row);
        float ss = 0.f;
#pragma unroll
        for (int f = 0; f < FT; ++f) { f32x4 bq;
            if (FROM_X) bq = *(const f32x4*)(xp + 16 * f);
            else { const u32x2 bw = *(const u32x2*)(HBp + 16 * f); bq = (f32x4){bflo(bw.x), bfhi(bw.x), bflo(bw.y), bfhi(bw.y)}; }
            f32x4 v;
            if (MODE == 0) v = bq + acc[f] * scale;
            else { const u32x2 pw = *(const u32x2*)(pj + 16 * f); const f32x4 a = acc[f] * rs;
                v[0] = bq[0] + sigmoidf_(a[0]) * bflo(pw.x); v[1] = bq[1] + sigmoidf_(a[1]) * bfhi(pw.x); v[2] = bq[2] + sigmoidf_(a[2]) * bflo(pw.y); v[3] = bq[3] + sigmoidf_(a[3]) * bfhi(pw.y); }
            if (!dry) st_bf4(Out + 16 * f, v);
            ss += (v[0] * v[0] + v[1] * v[1]) + (v[2] * v[2] + v[3] * v[3]); }
        ss += __shfl_xor(ss, 16); ss += __shfl_xor(ss, 32);
        if (fq == 0 && !dry) ssq_add(TOT(ws, SSQO), row, ss);
    }
};
struct EpiMix {
    unsigned char* ws; float* out; int dry;
    static __device__ __forceinline__ int brow(int tn, int f, int n) { return 64 * tn + 16 * f + n; }
    __device__ __forceinline__ void operator()(int tn, int srow, int fq, const f32x4 (&acc)[4]) const {
        const int row = MPROMPT + srow; const float rs = row_rs(TOT(ws, 1), row);
        f32x4 v[4];
#pragma unroll
        for (int f = 0; f < 4; ++f) v[f] = acc[f] * rs;
        if (tn < 16) {
            const float* rope = (const float*)(ws + WS_ROPE) + (size_t)(2048 + (srow & 3)) * 16 + 8 * (fq & 1);
            const f32x4 t0 = *(const f32x4*)rope, t1 = *(const f32x4*)(rope + 4);
            const float cs[4] = {t0[0], t0[2], t1[0], t1[2]}, sn[4] = {t0[1], t0[3], t1[1], t1[3]};
#pragma unroll
            for (int j = 0; j < 4; ++j) { const float x = v[0][j], w = __shfl_xor(x, 32); v[0][j] = (fq < 2) ? (x * cs[j] - w * sn[j]) : (x * cs[j] + w * sn[j]); }
        }
        if (tn < 24) {
            const int kind = tn >> 3, c0 = (tn & 7) * 64 + 4 * fq;
            bf16_t* dst = (bf16_t*)(ws + (kind == 0 ? WS_QA : (kind == 1 ? WS_KA : WS_VA))) + (size_t)row * 512 + c0;
            const float sc = kind == 0 ? C2Q : 1.f;
            float* fo = kind == 0 ? nullptr : out + (kind == 1 ? OFF_KWS : OFF_VWS) + ((size_t)(srow >> 2) * WINB + (WINB - DEC_T) + (srow & 3)) * 512 + c0;
#pragma unroll
            for (int f = 0; f < 4; ++f) { st_bf4(dst + 16 * f, v[f] * sc); if (fo) *(f32x4*)(fo + 16 * f) = v[f]; }
        } else if (tn < 48) {
            bf16_t* dst; float sc = 1.f;
            if (tn < 28) { dst = (bf16_t*)(ws + WS_QB) + (size_t)row * 256 + (tn - 24) * 64; sc = 0.125f; }
            else if (tn < 32) dst = (bf16_t*)(ws + WS_KB) + (size_t)row * 256 + (tn - 28) * 64;
            else if (tn < 40) dst = (bf16_t*)(ws + WS_VB) + (size_t)row * 512 + (tn - 32) * 64;
            else dst = (bf16_t*)(ws + WS_GB) + (size_t)row * 512 + (tn - 40) * 64;
            dst += 4 * fq;
#pragma unroll
            for (int f = 0; f < 4; ++f) st_bf4(dst + 16 * f, v[f] * sc);
        } else {
            *(f32x4*)((float*)(ws + WS_A1) + (size_t)row * 16 + 4 * fq) = v[0];
        }
    }
};
}

#define XB_TMO      128
#define XB_XCNT(j)  (256  + 64 * (j))
#define XB_XSUB(j)  (1280 + 64 * (j))
#define XB_XGEN(j)  (2304 + 64 * (j))
#define XB_TOP      3328
#define XB_TOPGEN   3392
#define XCD_BAR_WORDS 3456
#define XB_SPIN_CAP (1u << 18)
__device__ __forceinline__ unsigned xb_ld(unsigned* p)              { return __hip_atomic_load(p, __ATOMIC_RELAXED, __HIP_MEMORY_SCOPE_AGENT); }
__device__ __forceinline__ unsigned xb_add(unsigned* p, unsigned v) { return __hip_atomic_fetch_add(p, v, __ATOMIC_RELAXED, __HIP_MEMORY_SCOPE_AGENT); }
__device__ __forceinline__ unsigned xb_xcc_id() { return (unsigned)__builtin_amdgcn_s_getreg((3 << 11) | 20) & 0xFu; }
#define XB_SPIN(cond, bar) do { unsigned _sp = 0; while (cond) { __builtin_amdgcn_s_sleep(1); \
    if ((++_sp & 255u) == 0u) { if (xb_ld(&(bar)[XB_TMO])) break; if (_sp > XB_SPIN_CAP) { atomicAdd(&(bar)[XB_TMO], 1u); break; } } } } while (0)
struct XcdBarrier { unsigned* bar; unsigned x; volatile LAS unsigned* st; };
__device__ __forceinline__ XcdBarrier xcd_barrier_post(unsigned* bar, volatile LAS unsigned* st) {
    XcdBarrier b; b.bar = bar; b.x = xb_xcc_id(); b.st = st;
    if (threadIdx.x == 0) (void)xb_add(&bar[XB_XCNT(b.x)], 1u);
    return b;
}
__device__ __forceinline__ void xcd_barrier_complete(unsigned* bar, unsigned x, unsigned& nloc, unsigned& nx) {
    const unsigned G = gridDim.x * gridDim.y * gridDim.z;
    unsigned sum, cnt, mine, sp = 0u;
    for (;;) {
        sum = 0u; cnt = 0u; mine = 0u;
#pragma unroll
        for (unsigned j = 0; j < 16; ++j) { const unsigned c = xb_ld(&bar[XB_XCNT(j)]); sum += c; cnt += (c > 0u) ? 1u : 0u; mine = (j == x) ? c : mine; }
        if (sum == G) break;
        __builtin_amdgcn_s_sleep(1);
        if ((++sp & 255u) == 0u) { if (xb_ld(&bar[XB_TMO])) break; if (sp > XB_SPIN_CAP) { atomicAdd(&bar[XB_TMO], 1u); break; } }
    }
    nloc = mine > 0u ? mine : 1u; nx = cnt > 0u ? cnt : 1u;
}
__device__ __forceinline__ void xcd_barrier(const XcdBarrier& b) {
    asm volatile("s_waitcnt vmcnt(0)" ::: "memory");
    __syncthreads();
    if (threadIdx.x == 0) {
        unsigned* bar = b.bar;
        __builtin_amdgcn_s_waitcnt(0);
        unsigned nloc = b.st[0], nx = b.st[1];
        if (nloc == 0u) { xcd_barrier_complete(bar, b.x, nloc, nx); b.st[0] = nloc; b.st[1] = nx; }
        const unsigned old = xb_add(&bar[XB_XSUB(b.x)], 1u);
        const unsigned gen = old / nloc;
        if (old + 1u == (gen + 1u) * nloc) {
            __builtin_amdgcn_fence(__ATOMIC_RELEASE, "agent");
            asm volatile("s_waitcnt vmcnt(0)" ::: "memory");
            const unsigned og = xb_add(&bar[XB_TOP], 1u);
            const unsigned tg = og / nx;
            if (og + 1u == (tg + 1u) * nx) xb_add(&bar[XB_TOPGEN], 1u);
            else XB_SPIN(xb_ld(&bar[XB_TOPGEN]) == tg, bar);
            __builtin_amdgcn_fence(__ATOMIC_ACQUIRE, "agent");
            xb_add(&bar[XB_XGEN(b.x)], 1u);
            asm volatile("s_waitcnt vmcnt(0)" ::: "memory");
        } else {
            XB_SPIN(xb_ld(&bar[XB_XGEN(b.x)]) == gen, bar);
            __builtin_amdgcn_fence(__ATOMIC_ACQUIRE, "agent");
            asm volatile("s_waitcnt vmcnt(0)" ::: "memory");
        }
    }
    __syncthreads();
}

struct Args { const float* in[23]; float* out; unsigned char* ws; int ph_lo, ph_hi; };
struct Frame {
    LAS unsigned char* lds;
    int tid, lane, wave, vcu, G;
    const Args* a; float* out; unsigned char* ws;
};
#define FIN(i) (F.a->in[i])
#define WSP(T, off) ((T*)(F.ws + (off)))

__device__ __forceinline__ void tr_item(const float* W, int K, int Nsrc, const float* g, bf16_t* WT, int kind, LAS float* scr, int item, int nblk, int lane) {
    const int kb = item / nblk, nb = item % nblk, k0 = 64 * kb, n0 = 32 * nb;
    int src0 = n0, nval = 32;
    if (kind == 1) { const int pn = n0 >> 8, j = n0 & 255; src0 = (j < 128) ? 128 * pn + j : DFF + 128 * pn + (j - 128); }
    else if (kind == 2) { if (n0 < 2560) src0 = n0; else if (n0 < 3072) src0 = n0 + 16; else if (n0 == 3072) { src0 = 2560; nval = 16; } else { src0 = 0; nval = 0; } }
    const int r8 = lane >> 3, c4 = (lane & 7) * 4;
    f32x4 wv[8];
#pragma unroll
    for (int i = 0; i < 8; ++i) { const int kk = 8 * i + r8; wv[i] = (c4 < nval) ? *(const f32x4*)(W + (size_t)(k0 + kk) * Nsrc + src0 + c4) : (f32x4){0.f, 0.f, 0.f, 0.f}; }
    if (g) {
#pragma unroll
        for (int i = 0; i < 8; ++i) wv[i] = wv[i] * g[k0 + 8 * i + r8];
    }
#pragma unroll
    for (int i = 0; i < 8; ++i) { LAS float* d = scr + (8 * i + r8) * 33 + c4; d[0] = wv[i][0]; d[1] = wv[i][1]; d[2] = wv[i][2]; d[3] = wv[i][3]; }
    LDS_WAIT(); asm volatile("" ::: "memory");
    const int cc = lane & 7;
#pragma unroll
    for (int j = 0; j < 4; ++j) { const int n = (lane >> 3) + 8 * j; const LAS float* s = scr + (8 * cc) * 33 + n;
        u32x4 o; o.x = pk2(s[0 * 33], s[1 * 33]); o.y = pk2(s[2 * 33], s[3 * 33]); o.z = pk2(s[4 * 33], s[5 * 33]); o.w = pk2(s[6 * 33], s[7 * 33]);
        *(u32x4*)(WT + (size_t)(n0 + n) * K + k0 + 8 * cc) = o; }
    LDS_WAIT(); asm volatile("" ::: "memory");
}
__device__ __forceinline__ void sincos_red(double ang, float& c, float& s) {
    const double TWO_PI = 6.283185307179586476925, HALF_PI = 1.5707963267948966192;
    double r = ang - TWO_PI * __builtin_rint(ang / TWO_PI);
    const double q = __builtin_rint(r / HALF_PI); r -= q * HALF_PI;
    const int qi = ((int)q) & 3;
    const double y2 = r * r;
    const double sn = r * (1.0 + y2 * (-1.0 / 6 + y2 * (1.0 / 120 + y2 * (-1.0 / 5040 + y2 * (1.0 / 362880 - y2 * (1.0 / 39916800))))));
    const double cs = 1.0 + y2 * (-0.5 + y2 * (1.0 / 24 + y2 * (-1.0 / 720 + y2 * (1.0 / 40320 + y2 * (-1.0 / 3628800 + y2 * (1.0 / 479001600))))));
    double co, si;
    if (qi == 0) { co = cs; si = sn; } else if (qi == 1) { co = -sn; si = cs; } else if (qi == 2) { co = -cs; si = -sn; } else { co = sn; si = -cs; }
    c = (float)co; s = (float)si;
}
template <int SET> __device__ __forceinline__ void convert_weights(Frame& F, int gw, int NGW) {
    LAS float* scr = (LAS float*)(F.lds + F.wave * 16384);
    constexpr int I_GU = (DM / 64) * (NGU / 32), I_D = (DFF / 64) * (DM / 32), I_IN = (DM / 64) * (NPROJ / 32), I_1K = (DM / 64) * (DM / 32), I_PP = (DPLE / 64) * (DM / 32);
    if (SET == 0) {
        for (int it = gw; it < I_GU + I_PP; it += NGW) {
            if (it < I_GU) tr_item(FIN(8), DM, NGU, FIN(7), WSP(bf16_t, WS_WGU1), 1, scr, it, NGU / 32, F.lane);
            else tr_item(FIN(21), DPLE, DM, nullptr, WSP(bf16_t, WS_WPP), 0, scr, it - I_GU, DM / 32, F.lane);
        }
    } else if (SET == 1) {
        for (int it = gw; it < I_D + I_IN; it += NGW) {
            if (it < I_D) tr_item(FIN(9), DFF, DM, nullptr, WSP(bf16_t, WS_WD1), 0, scr, it, DM / 32, F.lane);
            else tr_item(FIN(11), DM, 3088, FIN(10), WSP(bf16_t, WS_WIN), 2, scr, it - I_D, NPROJ / 32, F.lane);
        }
    } else {
        for (int it = gw; it < I_GU + I_D + 2 * I_1K; it += NGW) {
            int r = it;
            if (r < I_GU) { tr_item(FIN(17), DM, NGU, FIN(16), WSP(bf16_t, WS_WGU2), 1, scr, r, NGU / 32, F.lane); continue; } r -= I_GU;
            if (r < I_D) { tr_item(FIN(18), DFF, DM, nullptr, WSP(bf16_t, WS_WD2), 0, scr, r, DM / 32, F.lane); continue; } r -= I_D;
            if (r < I_1K) { tr_item(FIN(15), DM, DM, nullptr, WSP(bf16_t, WS_WOUT), 0, scr, r, DM / 32, F.lane); continue; } r -= I_1K;
            tr_item(FIN(20), DM, DM, FIN(19), WSP(bf16_t, WS_WPG), 0, scr, r, DM / 32, F.lane);
        }
    }
}
__device__ __forceinline__ void p0_prologue(Frame& F) {
    const int gw = F.vcu * NWAVES + F.wave, NGW = F.G * NWAVES;
    convert_weights<0>(F, gw, NGW);
    bf16_t* HB = WSP(bf16_t, WS_HB); bf16_t* PB = WSP(bf16_t, WS_PB); unsigned* ssq0 = TOT(F.ws, 0);
    for (int e = F.vcu * 512 + F.tid; e < 4 * MPAD; e += F.G * 512) TOT(F.ws, 1 + e / MPAD)[e % MPAD] = 0u;
    for (int m0 = gw; m0 < MTOT; m0 += 4 * NGW) {
        f32x4 v[4][4], pv[4];
#pragma unroll
        for (int u = 0; u < 4; ++u) { const int m = m0 + u * NGW; const bool ok = m < MTOT;
            const float* xr = m < MPROMPT ? FIN(0) + (size_t)m * DM : FIN(1) + (size_t)(m - MPROMPT) * DM;
            const float* pr = m < MPROMPT ? FIN(5) + (size_t)m * DPLE : FIN(6) + (size_t)(m - MPROMPT) * DPLE;
#pragma unroll
            for (int j = 0; j < 4; ++j) v[u][j] = ok ? *((const f32x4*)xr + F.lane + 64 * j) : (f32x4){0.f, 0.f, 0.f, 0.f};
            pv[u] = ok ? *((const f32x4*)pr + F.lane) : (f32x4){0.f, 0.f, 0.f, 0.f}; }
#pragma unroll
        for (int u = 0; u < 4; ++u) { const int m = m0 + u * NGW; if (m >= MTOT) continue;
            float s = 0.f;
#pragma unroll
            for (int j = 0; j < 4; ++j) s += (v[u][j][0] * v[u][j][0] + v[u][j][1] * v[u][j][1]) + (v[u][j][2] * v[u][j][2] + v[u][j][3] * v[u][j][3]);
            s = wave_sum(s);
#pragma unroll
            for (int j = 0; j < 4; ++j) { u32x2 w; w.x = pk2(v[u][j][0], v[u][j][1]); w.y = pk2(v[u][j][2], v[u][j][3]); *((u32x2*)(HB + (size_t)m * DM) + F.lane + 64 * j) = w; }
            if (F.lane == 0) ssq0[m] = (unsigned)(s * SSQ_SCALE + 0.5f);
            u32x2 w; w.x = pk2(pv[u][0], pv[u][1]); w.y = pk2(pv[u][2], pv[u][3]); *((u32x2*)(PB + (size_t)m * DPLE) + F.lane) = w; }
    }
    float* rope = WSP(float, WS_ROPE);
    for (int e = F.vcu * 512 + F.tid; e < 2052 * 8; e += F.G * 512) {
        const int posidx = e >> 3, i = e & 7; const int pos = posidx < 2048 ? posidx : PAST + (posidx - 2048);
        const double inv = exp2(-(double)i * 0.125 * 18.931568569324174087);
        float c, s; sincos_red((double)pos * inv, c, s);
        rope[2 * e] = c; rope[2 * e + 1] = s;
    }
}


constexpr size_t CP_PER_B = (size_t)(WINB - DEC_T) * 512 / 4, CP_TOTAL = (size_t)DEC_B * CP_PER_B, CP_C1 = 0, CP_C3 = (CP_TOTAL * 6 / 10) & ~(size_t)511;
__device__ __forceinline__ void cache_copy_chunk(Frame& F, size_t e0, size_t e1, int rank, int nshare) {
    if (rank < 0) return;
    constexpr int U = 8;
    const size_t stride = (size_t)nshare * 512 * U;
    for (size_t eb = e0 + (size_t)rank * 512 * U + F.tid; eb < e1; eb += stride) {
        f32x4 kv[U], vv[U]; size_t dst[U];
#pragma unroll
        for (int u = 0; u < U; ++u) { const size_t e = eb + (size_t)u * 512; const size_t ec = e < e1 ? e : e1 - 1; const size_t b = ec / CP_PER_B, r = ec - b * CP_PER_B;
            const size_t src = b * ((size_t)WINB * 128) + DEC_T * 128 + r; dst[u] = b * ((size_t)WINB * 128) + r;
            kv[u] = __builtin_nontemporal_load((const f32x4*)FIN(2) + src); vv[u] = __builtin_nontemporal_load((const f32x4*)FIN(3) + src); }
#pragma unroll
        for (int u = 0; u < U; ++u) { __builtin_nontemporal_store(kv[u], (f32x4*)(F.out + OFF_KWS) + dst[u]); __builtin_nontemporal_store(vv[u], (f32x4*)(F.out + OFF_VWS) + dst[u]); }
    }
}

constexpr int AT_VW = 6144  , AT_VPITCH = 192, AT_STO = 8 * AT_VW, AT_SPITCH = 136, AT_SROWS = 528, AT_STM = AT_STO + AT_SROWS * AT_SPITCH, AT_STL = AT_STM + AT_SROWS * 4;
static_assert(AT_STL + AT_SROWS * 4 <= RING_BYTES, "attention LDS");
__device__ __forceinline__ int crow(int r, int hi) { return (r & 3) + 8 * (r >> 2) + 4 * hi; }
__device__ __forceinline__ float xhalf_max(float x) { const auto r = __builtin_amdgcn_permlane32_swap(__float_as_uint(x), __float_as_uint(x), false, false); return fmaxf(__uint_as_float(r[0]), __uint_as_float(r[1])); }
__device__ __forceinline__ float xhalf_sum(float x) { const auto r = __builtin_amdgcn_permlane32_swap(__float_as_uint(x), __float_as_uint(x), false, false); return __uint_as_float(r[0]) + __uint_as_float(r[1]); }
__device__ __forceinline__ s16x4 tr_read(LAS const unsigned char* p) { typedef short v4i16 __attribute__((ext_vector_type(4))); return __builtin_bit_cast(s16x4, __builtin_amdgcn_ds_read_tr16_b64_v4i16((LAS v4i16*)p)); }

template <int NQ> __device__ __forceinline__ void attn_task(Frame& F, int b, int h, int P0, int br, int dil, int r, int s0) {
    const int lane = F.lane, qi = lane & 31, hi = lane >> 5;
    const bf16_t* QA = WSP(bf16_t, WS_QA); const bf16_t* KA = WSP(bf16_t, WS_KA); const bf16_t* VA = WSP(bf16_t, WS_VA);
    LAS unsigned char* Vw = F.lds + F.wave * AT_VW;
    const size_t rowbase = (size_t)b * SEQ;
    const char* Qb = (const char*)(QA + rowbase * 512 + h * 64); const char* Kb = (const char*)(KA + rowbase * 512 + h * 64); const char* Vb = (const char*)(VA + rowbase * 512 + h * 64);
    bf16x8 qf[NQ][4]; f32x16 o0[NQ], o1[NQ]; float mrun[NQ], lrun[NQ];
#define POSQ(n) ((s0 + 32 * (n) + qi) * dil + r)
#define RHO(n) ((((POSQ(n) - P0) & 15) * 33) + ((POSQ(n) - P0) >> 4))
#pragma unroll
    for (int n = 0; n < NQ; ++n) {
        const unsigned qoff = (unsigned)POSQ(n) * 1024u + hi * 16u;
#pragma unroll
        for (int kk = 0; kk < 4; ++kk) qf[n][kk] = *(const bf16x8*)(Qb + qoff + 32 * kk);
        if (br == 0) {
#pragma unroll
            for (int i = 0; i < 16; ++i) { o0[n][i] = 0.f; o1[n][i] = 0.f; }
            mrun[n] = -1e30f; lrun[n] = 0.f;
        } else {
            const LAS unsigned char* sp = F.lds + AT_STO + RHO(n) * AT_SPITCH + 8 * hi;
#pragma unroll
            for (int g = 0; g < 4; ++g) {
                const u32x2 a = *(const LAS u32x2*)(sp + 16 * g), c = *(const LAS u32x2*)(sp + 64 + 16 * g);
                o0[n][4 * g] = bflo(a.x); o0[n][4 * g + 1] = bfhi(a.x); o0[n][4 * g + 2] = bflo(a.y); o0[n][4 * g + 3] = bfhi(a.y);
                o1[n][4 * g] = bflo(c.x); o1[n][4 * g + 1] = bfhi(c.x); o1[n][4 * g + 2] = bflo(c.y); o1[n][4 * g + 3] = bfhi(c.y);
            }
            mrun[n] = *(const LAS float*)(F.lds + AT_STM + RHO(n) * 4); lrun[n] = *(const LAS float*)(F.lds + AT_STL + RHO(n) * 4);
        }
    }
    const int kt0 = s0 >= 128 ? 0 : ((128 - s0) >> 5), ktend = 5 + (NQ - 1);
    const int q4 = (lane & 15) >> 2, p4 = lane & 3, blk = (lane >> 4) & 1;
    const LAS unsigned char* trb = Vw + (4 * hi + q4) * AT_VPITCH + (16 * blk + 4 * p4) * 2;
    bf16x8 kn[4]; u32x4 vr[4];
    {   const int sk0 = s0 - 128 + 32 * kt0;
        const unsigned koff = (unsigned)((sk0 + qi) * dil + r) * 1024u + hi * 16u;
#pragma unroll
        for (int kk = 0; kk < 4; ++kk) kn[kk] = *(const bf16x8*)(Kb + koff + 32 * kk);
#pragma unroll
        for (int c = 0; c < 4; ++c) { const int cid = lane + 64 * c, vrow = cid >> 3, ch = cid & 7;
            vr[c] = *(const u32x4*)(Vb + (unsigned)((sk0 + vrow) * dil + r) * 1024u + ch * 16u); } }
#define AT_STEP(KT, D0, D1) do { const int kt_ = (KT); \
        bf16x8 kf[4]; \
        _Pragma("unroll") for (int kk = 0; kk < 4; ++kk) kf[kk] = kn[kk]; \
        _Pragma("unroll") for (int c = 0; c < 4; ++c) { const int cid = lane + 64 * c, vrow = cid >> 3, ch = cid & 7; *(LAS u32x4*)(Vw + vrow * AT_VPITCH + ch * 16) = vr[c]; } \
        if (kt_ + 1 < ktend) { \
            const int sk1 = s0 - 128 + 32 * (kt_ + 1); \
            const unsigned koff = (unsigned)((sk1 + qi) * dil + r) * 1024u + hi * 16u; \
            _Pragma("unroll") for (int kk = 0; kk < 4; ++kk) kn[kk] = *(const bf16x8*)(Kb + koff + 32 * kk); \
            _Pragma("unroll") for (int c = 0; c < 4; ++c) { const int cid = lane + 64 * c, vrow = cid >> 3, ch = cid & 7; \
                vr[c] = *(const u32x4*)(Vb + (unsigned)((sk1 + vrow) * dil + r) * 1024u + ch * 16u); } \
        } \
        LDS_WAIT(); \
        bf16x8 va[2][2]; \
        _Pragma("unroll") for (int dt = 0; dt < 2; ++dt) { \
            const s16x4 lo0 = tr_read(trb + dt * 64), hi0 = tr_read(trb + dt * 64 + 8 * AT_VPITCH); \
            const s16x4 lo1 = tr_read(trb + dt * 64 + 16 * AT_VPITCH), hi1 = tr_read(trb + dt * 64 + 24 * AT_VPITCH); \
            va[dt][0] = __builtin_shufflevector(lo0, hi0, 0, 1, 2, 3, 4, 5, 6, 7); va[dt][1] = __builtin_shufflevector(lo1, hi1, 0, 1, 2, 3, 4, 5, 6, 7); } \
        f32x16 pp[NQ]; \
        _Pragma("unroll") for (int n = 0; n < NQ; ++n) _Pragma("unroll") for (int i = 0; i < 16; ++i) pp[n][i] = 0.f; \
        _Pragma("unroll") for (int kk = 0; kk < 4; ++kk) { \
            if (D0) pp[0] = __builtin_amdgcn_mfma_f32_32x32x16_bf16(kf[kk], qf[0][kk], pp[0], 0, 0, 0); \
            if (D1) pp[NQ - 1] = __builtin_amdgcn_mfma_f32_32x32x16_bf16(kf[kk], qf[NQ - 1][kk], pp[NQ - 1], 0, 0, 0); } \
        bf16x8 pb[NQ][2]; \
        _Pragma("unroll") for (int n = 0; n < NQ; ++n) { \
            if ((n == 0 && !(D0)) || (n == 1 && !(D1))) continue; \
            const int kr = kt_ - n; \
            if (kr == 0) { _Pragma("unroll") for (int i = 0; i < 16; ++i) if (crow(i, hi) < qi) pp[n][i] = -INFINITY; } \
            else if (kr == 4) { _Pragma("unroll") for (int i = 0; i < 16; ++i) if (crow(i, hi) > qi) pp[n][i] = -INFINITY; } } \
        _Pragma("unroll") for (int n = 0; n < NQ; ++n) { \
            if ((n == 0 && !(D0)) || (n == 1 && !(D1))) continue; \
            float mx = pp[n][0]; \
            _Pragma("unroll") for (int i = 1; i < 16; ++i) mx = fmaxf(mx, pp[n][i]); \
            mx = xhalf_max(mx); \
            if (__builtin_amdgcn_ballot_w64(mx > mrun[n] + 8.0f) != 0ull) {        \
                const float mn = fmaxf(mrun[n], mx), al = __builtin_amdgcn_exp2f(mrun[n] - mn); \
                lrun[n] *= al; mrun[n] = mn; \
                _Pragma("unroll") for (int i = 0; i < 16; ++i) { o0[n][i] *= al; o1[n][i] *= al; } \
            } \
            float rsum = 0.f; \
            _Pragma("unroll") for (int i = 0; i < 16; ++i) { pp[n][i] = __builtin_amdgcn_exp2f(pp[n][i] - mrun[n]); rsum += pp[n][i]; } \
            rsum = xhalf_sum(rsum); \
            lrun[n] += rsum; \
            u32x4 pw0, pw1; \
            pw0.x = cvt_pk_bf16(pp[n][0], pp[n][1]); pw0.y = cvt_pk_bf16(pp[n][2], pp[n][3]); pw0.z = cvt_pk_bf16(pp[n][4], pp[n][5]); pw0.w = cvt_pk_bf16(pp[n][6], pp[n][7]); \
            pw1.x = cvt_pk_bf16(pp[n][8], pp[n][9]); pw1.y = cvt_pk_bf16(pp[n][10], pp[n][11]); pw1.z = cvt_pk_bf16(pp[n][12], pp[n][13]); pw1.w = cvt_pk_bf16(pp[n][14], pp[n][15]); \
            pb[n][0] = __builtin_bit_cast(bf16x8, pw0); pb[n][1] = __builtin_bit_cast(bf16x8, pw1); } \
        _Pragma("unroll") for (int n = 0; n < NQ; ++n) { \
            if ((n == 0 && !(D0)) || (n == 1 && !(D1))) continue; \
            o0[n] = __builtin_amdgcn_mfma_f32_32x32x16_bf16(va[0][0], pb[n][0], o0[n], 0, 0, 0); o1[n] = __builtin_amdgcn_mfma_f32_32x32x16_bf16(va[1][0], pb[n][0], o1[n], 0, 0, 0); } \
        _Pragma("unroll") for (int n = 0; n < NQ; ++n) { \
            if ((n == 0 && !(D0)) || (n == 1 && !(D1))) continue; \
            o0[n] = __builtin_amdgcn_mfma_f32_32x32x16_bf16(va[0][1], pb[n][1], o0[n], 0, 0, 0); o1[n] = __builtin_amdgcn_mfma_f32_32x32x16_bf16(va[1][1], pb[n][1], o1[n], 0, 0, 0); } \
    } while (0)
    if (NQ == 1) {
#pragma nounroll
        for (int kt = kt0; kt < 5; ++kt) AT_STEP(kt, true, false);
    } else {
        int kt = kt0;
        if (kt == 0) { AT_STEP(0, true, false); kt = 1; }
#pragma nounroll
        for (; kt < 5; ++kt) AT_STEP(kt, true, true);
        AT_STEP(5, false, true);
    }
#undef AT_STEP
#pragma unroll
    for (int n = 0; n < NQ; ++n) {
        if (br < 2) {
            LAS unsigned char* sp = F.lds + AT_STO + RHO(n) * AT_SPITCH + 8 * hi;
#pragma unroll
            for (int g = 0; g < 4; ++g) {
                u32x2 a, c; a.x = cvt_pk_bf16(o0[n][4 * g], o0[n][4 * g + 1]); a.y = cvt_pk_bf16(o0[n][4 * g + 2], o0[n][4 * g + 3]); c.x = cvt_pk_bf16(o1[n][4 * g], o1[n][4 * g + 1]); c.y = cvt_pk_bf16(o1[n][4 * g + 2], o1[n][4 * g + 3]);
                *(LAS u32x2*)(sp + 16 * g) = a; *(LAS u32x2*)(sp + 64 + 16 * g) = c;
            }
            if (hi == 0) { *(LAS float*)(F.lds + AT_STM + RHO(n) * 4) = mrun[n]; *(LAS float*)(F.lds + AT_STL + RHO(n) * 4) = lrun[n]; }
        } else {
            const float inv = 1.f / lrun[n];
            bf16_t* op = WSP(bf16_t, WS_A2) + (rowbase + POSQ(n)) * DM + h * 64 + 4 * hi;
#pragma unroll
            for (int g = 0; g < 4; ++g) {
                u32x2 a, c; a.x = cvt_pk_bf16(o0[n][4 * g] * inv, o0[n][4 * g + 1] * inv); a.y = cvt_pk_bf16(o0[n][4 * g + 2] * inv, o0[n][4 * g + 3] * inv);
                c.x = cvt_pk_bf16(o1[n][4 * g] * inv, o1[n][4 * g + 1] * inv); c.y = cvt_pk_bf16(o1[n][4 * g + 2] * inv, o1[n][4 * g + 3] * inv);
                *(u32x2*)(op + 8 * g) = a; *(u32x2*)(op + 32 + 8 * g) = c;
            }
        }
    }
    LDS_WAIT();
#undef POSQ
#undef RHO
}
__device__ __forceinline__ void attn_prompt_item(Frame& F, int item) {
    const int b = item >> 5, h = (item >> 2) & 7, blk = item & 3, P0 = blk * 512;
    attn_task<2>(F, b, h, P0, 0, 1, 0, P0 + 64 * F.wave);
    LDS_WAIT(); __syncthreads();
    attn_task<2>(F, b, h, P0, 1, 4, F.wave & 3, P0 / 4 + 64 * (F.wave >> 2));
    LDS_WAIT(); __syncthreads();
    for (int u = 0; u < 2; ++u) attn_task<1>(F, b, h, P0, 2, 16, F.wave * 2 + u, P0 / 16);
    LDS_WAIT(); __syncthreads();
}

__device__ __forceinline__ void attn_sample_task(Frame& F, int task, int half) {
    const int h = task & 7, bt = task >> 3, b = bt >> 2, t = bt & 3, row = MPROMPT + bt;
    const int lane = F.lane, grp = lane >> 2, sub = lane & 3;
    const bf16_t* KA = WSP(bf16_t, WS_KA); const bf16_t* VA = WSP(bf16_t, WS_VA);
    float q[16];
    { const u32x4* qp = (const u32x4*)(WSP(bf16_t, WS_QA) + (size_t)row * 512 + h * 64 + 16 * sub); const u32x4 a = qp[0], c = qp[1];
      q[0] = bflo(a.x); q[1] = bfhi(a.x); q[2] = bflo(a.y); q[3] = bfhi(a.y); q[4] = bflo(a.z); q[5] = bfhi(a.z); q[6] = bflo(a.w); q[7] = bfhi(a.w);
      q[8] = bflo(c.x); q[9] = bfhi(c.x); q[10] = bflo(c.y); q[11] = bfhi(c.y); q[12] = bflo(c.z); q[13] = bfhi(c.z); q[14] = bflo(c.w); q[15] = bfhi(c.w); }
    float mrun = -1e30f, lrun = 0.f, acc[16];
#pragma unroll
    for (int e = 0; e < 16; ++e) acc[e] = 0.f;
    const int rd0 = half ? 5 : 0, rd1 = half ? 9 : 5;
#pragma nounroll
    for (int rd = rd0; rd < rd1; ++rd) {
        const int j = rd * 16 + grp; const bool valid = j <= 128;
        float kv[3][16], vv[3][16];
#pragma unroll
        for (int br = 0; br < 3; ++br) {
            const int dil = 1 << (2 * br);
            const int idx = WINB + t - (valid ? dil * j : 0);
            if (idx < WINB) {
                const f32x4* kp = (const f32x4*)(FIN(2) + (((size_t)b * WINB + idx) * 8 + h) * 64 + 16 * sub);
                const f32x4* vp = (const f32x4*)(FIN(3) + (((size_t)b * WINB + idx) * 8 + h) * 64 + 16 * sub);
#pragma unroll
                for (int c = 0; c < 4; ++c) { const f32x4 a = kp[c], d = vp[c];
#pragma unroll
                    for (int e = 0; e < 4; ++e) { kv[br][4 * c + e] = a[e]; vv[br][4 * c + e] = d[e]; } }
            } else {
                const size_t nrow = (size_t)MPROMPT + 4 * b + (idx - WINB);
                const u32x4* kp = (const u32x4*)(KA + nrow * 512 + h * 64 + 16 * sub); const u32x4* vp = (const u32x4*)(VA + nrow * 512 + h * 64 + 16 * sub);
#pragma unroll
                for (int c = 0; c < 2; ++c) { const u32x4 a = kp[c], d = vp[c];
                    kv[br][8 * c] = bflo(a.x); kv[br][8 * c + 1] = bfhi(a.x); kv[br][8 * c + 2] = bflo(a.y); kv[br][8 * c + 3] = bfhi(a.y); kv[br][8 * c + 4] = bflo(a.z); kv[br][8 * c + 5] = bfhi(a.z); kv[br][8 * c + 6] = bflo(a.w); kv[br][8 * c + 7] = bfhi(a.w);
                    vv[br][8 * c] = bflo(d.x); vv[br][8 * c + 1] = bfhi(d.x); vv[br][8 * c + 2] = bflo(d.y); vv[br][8 * c + 3] = bfhi(d.y); vv[br][8 * c + 4] = bflo(d.z); vv[br][8 * c + 5] = bfhi(d.z); vv[br][8 * c + 6] = bflo(d.w); vv[br][8 * c + 7] = bfhi(d.w); }
            }
        }
#pragma unroll
        for (int br = 0; br < 3; ++br) {
            float s = 0.f;
#pragma unroll
            for (int e = 0; e < 16; ++e) s += q[e] * kv[br][e];
            s += __shfl_xor(s, 1); s += __shfl_xor(s, 2);
            if (!valid) s = -INFINITY;
            const float mn = fmaxf(mrun, s), al = __builtin_amdgcn_exp2f(mrun - mn), p = __builtin_amdgcn_exp2f(s - mn);
            lrun = lrun * al + p; mrun = mn;
#pragma unroll
            for (int e = 0; e < 16; ++e) acc[e] = acc[e] * al + p * vv[br][e];
        }
    }
    float M = mrun;
#pragma unroll
    for (int o = 4; o < 64; o <<= 1) M = fmaxf(M, __shfl_xor(M, o));
    const float f = __builtin_amdgcn_exp2f(mrun - M);
    lrun *= f;
#pragma unroll
    for (int o = 4; o < 64; o <<= 1) lrun += __shfl_xor(lrun, o);
#pragma unroll
    for (int e = 0; e < 16; ++e) { float a = acc[e] * f;
#pragma unroll
        for (int o = 4; o < 64; o <<= 1) a += __shfl_xor(a, o);
        acc[e] = a; }
    LAS float* mrg = (LAS float*)(F.lds) + (F.wave & 3) * 80;
    if (half && grp == 0) {
#pragma unroll
        for (int e = 0; e < 16; ++e) mrg[sub * 16 + e] = acc[e];
        if (sub == 0) { mrg[64] = M; mrg[65] = lrun; }
    }
    LDS_WAIT(); __syncthreads();
    if (!half && grp == 0) {
        const float M2 = mrg[64], l2 = mrg[65], Mx = fmaxf(M, M2), f1 = __builtin_amdgcn_exp2f(M - Mx), f2 = __builtin_amdgcn_exp2f(M2 - Mx);
        const float inv = 1.f / (lrun * f1 + l2 * f2);
#pragma unroll
        for (int e = 0; e < 16; ++e) acc[e] = (acc[e] * f1 + mrg[sub * 16 + e] * f2) * inv;
        u32x4 w0, w1; w0.x = pk2(acc[0], acc[1]); w0.y = pk2(acc[2], acc[3]); w0.z = pk2(acc[4], acc[5]); w0.w = pk2(acc[6], acc[7]);
        w1.x = pk2(acc[8], acc[9]); w1.y = pk2(acc[10], acc[11]); w1.z = pk2(acc[12], acc[13]); w1.w = pk2(acc[14], acc[15]);
        u32x4* op = (u32x4*)(WSP(bf16_t, WS_A2) + (size_t)row * DM + h * 64 + 16 * sub); op[0] = w0; op[1] = w1;
    }
    LDS_WAIT(); __syncthreads();
}

constexpr int GL_A1 = 0  , GL_TOT = 4096  , GL_BT = GL_TOT + 2048  , GL_BC = GL_BT + 256  , GL_QA = GL_BC + 64 * 272  ,
              GL_KB = GL_QA + 64 * 144, GL_VR = GL_KB + 64 * 144  , GL_AM = GL_VR + 64 * 272  , GL_O = GL_AM + 64 * 144  , GL_SP = GL_O + 64 * 132 * 4  , GL_END = GL_SP + 128 * 144;
static_assert(GL_END <= RING_BYTES && GL_BC % 16 == 0 && GL_QA % 16 == 0 && GL_VR % 16 == 0 && GL_O % 16 == 0, "GLA LDS");
struct GlaIn { f32x4 a1; u32x4 kb, qb, vb0, vb1, gb0, gb1; f32x4 hc[4]; };
template <bool P3> __device__ __forceinline__ void gla_fetch(Frame& F, GlaIn& I, int item, int hh, size_t row0) {
    const int tid = F.tid;
    I.a1 = (f32x4){0.f, 0.f, 0.f, 0.f};
    if (tid < 256) I.a1 = *(const f32x4*)(WSP(float, WS_A1) + (row0 + (tid >> 2)) * 16 + 4 * (tid & 3));
    I.kb = *(const u32x4*)(WSP(bf16_t, WS_KB) + (row0 + (tid >> 3)) * 256 + hh * 64 + 8 * (tid & 7));
    I.vb0 = *(const u32x4*)(WSP(bf16_t, WS_VB) + (row0 + (tid >> 4)) * 512 + hh * 128 + 8 * (tid & 15));
    I.vb1 = *(const u32x4*)(WSP(bf16_t, WS_VB) + (row0 + 32 + (tid >> 4)) * 512 + hh * 128 + 8 * (tid & 15));
    if (P3) {
        I.qb = *(const u32x4*)(WSP(bf16_t, WS_QB) + (row0 + (tid >> 3)) * 256 + hh * 64 + 8 * (tid & 7));
        const int i = tid >> 3, sub = tid & 7;
        const u32x4* gp = (const u32x4*)(WSP(bf16_t, WS_GB) + (row0 + i) * 512 + hh * 128 + 16 * sub); I.gb0 = gp[0]; I.gb1 = gp[1];
        const float* hp = WSP(float, WS_HCT) + (size_t)item * 8192 + (size_t)(tid >> 4) * 64 + 4 * (tid & 15);
#pragma unroll
        for (int e = 0; e < 4; ++e) I.hc[e] = *(const f32x4*)(hp + (size_t)e * 32 * 64);
    }
}
__device__ __forceinline__ void gla_decay(Frame& F, const f32x4 a1v, const float (&w2)[16], float bias, float& btot) {
    const int tid = F.tid, k = tid & 63, ig = tid >> 6;
    LAS float* a1s = (LAS float*)(F.lds + GL_A1); LAS float* tot = (LAS float*)(F.lds + GL_TOT); LAS float* BC = (LAS float*)(F.lds + GL_BC); LAS float* BT = (LAS float*)(F.lds + GL_BT);
    if (tid < 256) *(LAS f32x4*)(a1s + tid * 4) = a1v;
    LDS_WAIT(); __syncthreads();
    float run = 0.f, bcum[8];
#pragma unroll
    for (int e = 0; e < 8; ++e) { float pre = bias;
#pragma unroll
        for (int r = 0; r < 16; ++r) pre += a1s[(8 * ig + e) * 16 + r] * w2[r];
        run += logsigf_(pre) * (1.0f / 16.0f); bcum[e] = run; }
    tot[ig * 64 + k] = run;
    LDS_WAIT(); __syncthreads();
    float pre = 0.f, all = 0.f;
#pragma unroll
    for (int g = 0; g < 8; ++g) { const float tv = tot[g * 64 + k]; all += tv; if (g < ig) pre += tv; }
#pragma unroll
    for (int e = 0; e < 8; ++e) BC[(8 * ig + e) * 68 + k] = bcum[e] + pre;
    if (ig == 0) BT[k] = all;
    btot = all;
    LDS_WAIT(); __syncthreads();
}
__device__ __forceinline__ void unpack8(const u32x4 w, float (&x)[8]) { x[0] = bflo(w.x); x[1] = bfhi(w.x); x[2] = bflo(w.y); x[3] = bfhi(w.y); x[4] = bflo(w.z); x[5] = bfhi(w.z); x[6] = bflo(w.w); x[7] = bfhi(w.w); }
__device__ __forceinline__ u32x4 pack8(const float (&x)[8]) { u32x4 w; w.x = pk2(x[0], x[1]); w.y = pk2(x[2], x[3]); w.z = pk2(x[4], x[5]); w.w = pk2(x[6], x[7]); return w; }
__device__ __forceinline__ void gla_store_vr(Frame& F, const u32x4 vb0, const u32x4 vb1) {
    const int tid = F.tid;
    *(LAS u32x4*)(F.lds + GL_VR + (tid >> 4) * 272 + (tid & 15) * 16) = vb0;
    *(LAS u32x4*)(F.lds + GL_VR + (32 + (tid >> 4)) * 272 + (tid & 15) * 16) = vb1;
}
__device__ __forceinline__ bf16x8 tr_frag(LAS const unsigned char* img, int pitch, int col0, int s, int lane) {
    const int q4 = (lane & 15) >> 2, p4 = lane & 3, blk = (lane >> 4) & 1, hi = lane >> 5;
    LAS const unsigned char* p = img + (16 * s + 8 * hi + q4) * pitch + (col0 + 16 * blk + 4 * p4) * 2;
    const s16x4 lo = tr_read(p), hi4 = tr_read(p + 4 * pitch);
    return __builtin_shufflevector(lo, hi4, 0, 1, 2, 3, 4, 5, 6, 7);
}
template <int NIT> __device__ __forceinline__ void gla_p1_items(Frame& F, int item0) {
    const int bh = item0 >> 5, b = bh >> 2, hh = bh & 3;
    const int tid = F.tid, k = tid & 63, ig = tid >> 6, lane = F.lane;
    float w2[16];
#pragma unroll
    for (int r = 0; r < 16; ++r) w2[r] = FIN(12)[r * 256 + hh * 64 + k];
    const float bias = FIN(13)[hh * 64 + k];
    GlaIn nx; gla_fetch<false>(F, nx, item0, hh, (size_t)b * SEQ + 64 * (item0 & 31));
    f32x16 ga; float dsum = 0.f;
#pragma unroll
    for (int i = 0; i < 16; ++i) ga[i] = 0.f;
#pragma nounroll
    for (int it = 0; it < NIT; ++it) {
        const int item = item0 + it;
        const GlaIn cu = nx;
        if (it + 1 < NIT) gla_fetch<false>(F, nx, item + 1, hh, (size_t)b * SEQ + 64 * ((item + 1) & 31));
        float btot; gla_decay(F, cu.a1, w2, bias, btot);
        dsum += btot;
        {
            const int i = tid >> 3, c = tid & 7;
            const f32x4 b0 = *(const LAS f32x4*)(F.lds + GL_BC + (i * 68 + 8 * c) * 4), b1 = *(const LAS f32x4*)(F.lds + GL_BC + (i * 68 + 8 * c + 4) * 4);
            const f32x4 t0 = *(const LAS f32x4*)(F.lds + GL_BT + 8 * c * 4), t1 = *(const LAS f32x4*)(F.lds + GL_BT + (8 * c + 4) * 4);
            float kx[8]; unpack8(cu.kb, kx);
#pragma unroll
            for (int e = 0; e < 4; ++e) { kx[e] *= fexp(t0[e] - b0[e]); kx[4 + e] *= fexp(t1[e] - b1[e]); }
            *(LAS u32x4*)(F.lds + GL_QA + i * 144 + c * 16) = pack8(kx);
        }
        gla_store_vr(F, cu.vb0, cu.vb1);
        if (ig == 0) WSP(float, WS_BTOT)[item * 64 + k] = btot;
        LDS_WAIT(); __syncthreads();
        const int kt = F.wave >> 2, vt = F.wave & 3, r32 = lane & 31, hi = lane >> 5;
        f32x16 acc;
#pragma unroll
        for (int i = 0; i < 16; ++i) acc[i] = 0.f;
#pragma unroll
        for (int q = 0; q < 4; ++q) {
            const bf16x8 a = tr_frag(F.lds + GL_QA, 144, 32 * kt, q, lane);
            const bf16x8 bb = tr_frag(F.lds + GL_VR, 272, 32 * vt, q, lane);
            acc = __builtin_amdgcn_mfma_f32_32x32x16_bf16(a, bb, acc, 0, 0, 0);
        }
        float* hct = WSP(float, WS_HCT) + (size_t)item * 8192 + (size_t)(32 * vt + r32) * 64 + 32 * kt + 4 * hi;
#pragma unroll
        for (int g = 0; g < 4; ++g) { *(f32x4*)(hct + 8 * g) = (f32x4){acc[4 * g], acc[4 * g + 1], acc[4 * g + 2], acc[4 * g + 3]};
            const f32x4 bt = *(const LAS f32x4*)(F.lds + GL_BT + (32 * kt + 8 * g + 4 * hi) * 4);
#pragma unroll
            for (int e = 0; e < 4; ++e) ga[4 * g + e] = fexp(bt[e]) * ga[4 * g + e] + acc[4 * g + e]; }
        LDS_WAIT(); __syncthreads();
    }
    {   const int grp = item0 >> 2, kt = F.wave >> 2, vt = F.wave & 3, r32 = lane & 31, hi = lane >> 5;
        float* gag = WSP(float, WS_GAG) + (size_t)grp * 8192 + (size_t)(32 * vt + r32) * 64 + 32 * kt + 4 * hi;
#pragma unroll
        for (int g = 0; g < 4; ++g) *(f32x4*)(gag + 8 * g) = (f32x4){ga[4 * g], ga[4 * g + 1], ga[4 * g + 2], ga[4 * g + 3]};
        if (ig == 0) WSP(float, WS_DSUM)[grp * 64 + k] = dsum; }
}
template <int NIT> __device__ __forceinline__ void gla_p3_items(Frame& F, int item0) {
    const int bh = item0 >> 5, b = bh >> 2, hh = bh & 3;
    const int tid = F.tid, k = tid & 63, lane = F.lane;
    float w2[16];
#pragma unroll
    for (int r = 0; r < 16; ++r) w2[r] = FIN(12)[r * 256 + hh * 64 + k];
    const float bias = FIN(13)[hh * 64 + k];
    GlaIn nx; gla_fetch<true>(F, nx, item0, hh, (size_t)b * SEQ + 64 * (item0 & 31));
    const int k4 = 4 * (tid & 15), v0 = tid >> 4;
    f32x4 S[4];
#pragma unroll
    for (int e = 0; e < 4; ++e) S[e] = (f32x4){0.f, 0.f, 0.f, 0.f};
    {   const int grp = item0 >> 2, j = grp & 7, grp0 = grp - j;
        const float* gag = WSP(float, WS_GAG) + (size_t)grp0 * 8192 + (size_t)v0 * 64 + k4; const float* dsp = WSP(float, WS_DSUM) + grp0 * 64 + k4;
        f32x4 dec = (f32x4){1.f, 1.f, 1.f, 1.f};
#pragma unroll
        for (int half = 1; half >= 0; --half) {
            f32x4 gv[4][4], dv[4];
#pragma unroll
            for (int q = 3; q >= 0; --q) { const int jp = 4 * half + q;
                if (jp < j && jp < 7) { dv[q] = *(const f32x4*)(dsp + jp * 64);
#pragma unroll
                    for (int e = 0; e < 4; ++e) gv[q][e] = *(const f32x4*)(gag + (size_t)jp * 8192 + (size_t)e * 32 * 64); } }
#pragma unroll
            for (int q = 3; q >= 0; --q) { const int jp = 4 * half + q;
                if (jp < j && jp < 7) {
#pragma unroll
                    for (int e = 0; e < 4; ++e) S[e] += dec * gv[q][e];
#pragma unroll
                    for (int x = 0; x < 4; ++x) dec[x] *= fexp(dv[q][x]); } }
        }
    }
#pragma nounroll
    for (int it = 0; it < NIT; ++it) {
        const int item = item0 + it, c = item & 31; const size_t row0 = (size_t)b * SEQ + 64 * c;
        const GlaIn cu = nx;
        if (it + 1 < NIT) gla_fetch<true>(F, nx, item + 1, hh, (size_t)b * SEQ + 64 * ((item + 1) & 31));
        float btot; gla_decay(F, cu.a1, w2, bias, btot);
        {
            const f32x4 bt = *(const LAS f32x4*)(F.lds + GL_BT + k4 * 4);
#pragma unroll
            for (int e = 0; e < 4; ++e) { u32x2 w; w.x = pk2(S[e][0], S[e][1]); w.y = pk2(S[e][2], S[e][3]); *(LAS u32x2*)(F.lds + GL_SP + (v0 + 32 * e) * 144 + k4 * 2) = w;
#pragma unroll
                for (int x = 0; x < 4; ++x) S[e][x] = fexp(bt[x]) * S[e][x] + cu.hc[e][x]; }
        }
        {
            const int i = tid >> 3, cc = tid & 7;
            const f32x4 b0 = *(const LAS f32x4*)(F.lds + GL_BC + (i * 68 + 8 * cc) * 4), b1 = *(const LAS f32x4*)(F.lds + GL_BC + (i * 68 + 8 * cc + 4) * 4);
            float qx[8], kx[8]; unpack8(cu.qb, qx); unpack8(cu.kb, kx);
#pragma unroll
            for (int e = 0; e < 4; ++e) { const float f0 = fexp(b0[e]), f1 = fexp(b1[e]); qx[e] *= f0; qx[4 + e] *= f1; kx[e] *= __builtin_amdgcn_rcpf(f0); kx[4 + e] *= __builtin_amdgcn_rcpf(f1); }
            *(LAS u32x4*)(F.lds + GL_QA + i * 144 + cc * 16) = pack8(qx);
            *(LAS u32x4*)(F.lds + GL_KB + i * 144 + cc * 16) = pack8(kx);
        }
        gla_store_vr(F, cu.vb0, cu.vb1);
        LDS_WAIT(); __syncthreads();
        const int r32 = lane & 31, hi = lane >> 5;
        if (F.wave < 4) {
            const int it2 = F.wave >> 1, jt = F.wave & 1;
            f32x16 acc;
#pragma unroll
            for (int i = 0; i < 16; ++i) acc[i] = 0.f;
            if (jt <= it2) {
#pragma unroll
                for (int q = 0; q < 4; ++q) {
                    const bf16x8 a = *(const LAS bf16x8*)(F.lds + GL_QA + (32 * it2 + r32) * 144 + (16 * q + 8 * hi) * 2);
                    const bf16x8 bb = *(const LAS bf16x8*)(F.lds + GL_KB + (32 * jt + r32) * 144 + (16 * q + 8 * hi) * 2);
                    acc = __builtin_amdgcn_mfma_f32_32x32x16_bf16(a, bb, acc, 0, 0, 0);
                }
            }
#pragma unroll
            for (int i = 0; i < 16; ++i) { const int ii = 32 * it2 + crow(i, hi), jj = 32 * jt + r32;
                *(LAS bf16_t*)(F.lds + GL_AM + ii * 144 + jj * 2) = (bf16_t)f2bf(jj <= ii ? acc[i] : 0.f); }
        }
        LDS_WAIT(); __syncthreads();
        {
            const int it2 = F.wave >> 2, vt = F.wave & 3;
            f32x16 acc;
#pragma unroll
            for (int i = 0; i < 16; ++i) acc[i] = 0.f;
            if (c > 0) {
#pragma unroll
                for (int q = 0; q < 4; ++q) {
                    const bf16x8 a = *(const LAS bf16x8*)(F.lds + GL_QA + (32 * it2 + r32) * 144 + (16 * q + 8 * hi) * 2);
                    const bf16x8 sb = *(const LAS bf16x8*)(F.lds + GL_SP + (32 * vt + r32) * 144 + (16 * q + 8 * hi) * 2);
                    acc = __builtin_amdgcn_mfma_f32_32x32x16_bf16(a, sb, acc, 0, 0, 0);
                }
            }
#pragma unroll
            for (int q = 0; q < 4; ++q) {
                const bf16x8 a = *(const LAS bf16x8*)(F.lds + GL_AM + (32 * it2 + r32) * 144 + (16 * q + 8 * hi) * 2);
                const bf16x8 bb = tr_frag(F.lds + GL_VR, 272, 32 * vt, q, lane);
                acc = __builtin_amdgcn_mfma_f32_32x32x16_bf16(a, bb, acc, 0, 0, 0);
            }
#pragma unroll
            for (int i = 0; i < 16; ++i) *(LAS float*)(F.lds + GL_O + ((32 * it2 + crow(i, hi)) * 132 + 32 * vt + r32) * 4) = acc[i];
        }
        LDS_WAIT(); __syncthreads();
        {
            const int i = tid >> 3, sub = tid & 7; const size_t rr = row0 + i;
            float o[16]; float ss = 0.f;
#pragma unroll
            for (int q = 0; q < 4; ++q) { const f32x4 x = *(const LAS f32x4*)(F.lds + GL_O + (i * 132 + 16 * sub + 4 * q) * 4);
#pragma unroll
                for (int e = 0; e < 4; ++e) { o[4 * q + e] = x[e]; ss += x[e] * x[e]; } }
            ss += __shfl_xor(ss, 1); ss += __shfl_xor(ss, 2); ss += __shfl_xor(ss, 4);
            const float rn = rsqrtf(ss * (1.0f / 128.0f) + EPS);
            const unsigned gw[8] = {cu.gb0.x, cu.gb0.y, cu.gb0.z, cu.gb0.w, cu.gb1.x, cu.gb1.y, cu.gb1.z, cu.gb1.w};
            const float* go = FIN(14) + 16 * sub;
            unsigned w[8];
#pragma unroll
            for (int e = 0; e < 8; ++e) { const float a = o[2 * e] * rn * go[2 * e] * siluf_(bflo(gw[e])), bq = o[2 * e + 1] * rn * go[2 * e + 1] * siluf_(bfhi(gw[e])); w[e] = pk2(a, bq); }
            u32x4* op = (u32x4*)(WSP(bf16_t, WS_A2) + rr * DM + 512 + hh * 128 + 16 * sub);
            op[0] = (u32x4){w[0], w[1], w[2], w[3]}; op[1] = (u32x4){w[4], w[5], w[6], w[7]};
        }
        LDS_WAIT(); __syncthreads();
    }
    if (((item0 >> 2) & 7) == 7) {
#pragma unroll
        for (int e = 0; e < 4; ++e)
#pragma unroll
            for (int x = 0; x < 4; ++x) F.out[OFF_SGP + ((size_t)bh * 64 + k4 + x) * 128 + v0 + 32 * e] = S[e][x];
    }
}
struct GlaSmp { float S[16], vv4[4], gg, gout; };
__device__ __forceinline__ void gla_sample_load(Frame& F, int item, GlaSmp& R) {
    const int b = item >> 2, hh = item & 3, tid = F.tid, v = tid & 127, kq = tid >> 7;
    LAS float* decs = (LAS float*)(F.lds + 8192); LAS float* qs = decs + 256; LAS float* ks = qs + 256;
    const float* s0 = FIN(4) + ((size_t)item * 64 + 16 * kq) * 128 + v;
#pragma unroll
    for (int e = 0; e < 16; ++e) R.S[e] = s0[e * 128];
#pragma unroll
    for (int t = 0; t < DEC_T; ++t) R.vv4[t] = bf2f(WSP(bf16_t, WS_VB)[((size_t)MPROMPT + 4 * b + t) * 512 + hh * 128 + v]);
    R.gg = bf2f(WSP(bf16_t, WS_GB)[((size_t)MPROMPT + 4 * b + kq) * 512 + hh * 128 + v]);
    R.gout = FIN(14)[v];
    if (tid < 256) {
        const int t = tid >> 6, k = tid & 63; const size_t row = (size_t)MPROMPT + 4 * b + t;
        float pre = FIN(13)[hh * 64 + k];
#pragma unroll
        for (int r = 0; r < 16; ++r) pre += WSP(float, WS_A1)[row * 16 + r] * FIN(12)[r * 256 + hh * 64 + k];
        decs[tid] = fexp(logsigf_(pre) * (1.0f / 16.0f));
        qs[tid] = bf2f(WSP(bf16_t, WS_QB)[row * 256 + hh * 64 + k]);
        ks[tid] = bf2f(WSP(bf16_t, WS_KB)[row * 256 + hh * 64 + k]);
    }
}
__device__ __forceinline__ void gla_sample_finish(Frame& F, int item, GlaSmp& R) {
    const int b = item >> 2, hh = item & 3, tid = F.tid, v = tid & 127, kq = tid >> 7;
    LAS float* part = (LAS float*)(F.lds + 4096);
    LAS float* decs = (LAS float*)(F.lds + 8192); LAS float* qs = decs + 256; LAS float* ks = qs + 256;
    LAS float* red = (LAS float*)(F.lds + 16384);
#pragma unroll
    for (int t = 0; t < DEC_T; ++t) {
        const float vv = R.vv4[t];
        float op = 0.f;
#pragma unroll
        for (int e = 0; e < 16; ++e) { const int k = t * 64 + 16 * kq + e;
            R.S[e] = decs[k] * R.S[e] + ks[k] * vv; op += qs[k] * R.S[e]; }
        red[(t * 4 + kq) * 128 + v] = op;
    }
    float* so = F.out + OFF_SGS + ((size_t)item * 64 + 16 * kq) * 128 + v;
#pragma unroll
    for (int e = 0; e < 16; ++e) so[e * 128] = R.S[e];
    LDS_WAIT(); __syncthreads();
    const float o = (red[(kq * 4 + 0) * 128 + v] + red[(kq * 4 + 1) * 128 + v]) + (red[(kq * 4 + 2) * 128 + v] + red[(kq * 4 + 3) * 128 + v]);
    const float sq = wave_sum(o * o);
    if (F.lane == 0) part[F.wave] = sq;
    LDS_WAIT(); __syncthreads();
    const float rn = rsqrtf((part[2 * kq] + part[2 * kq + 1]) * (1.0f / 128.0f) + EPS);
    const size_t orow = (size_t)MPROMPT + 4 * b + kq;
    WSP(bf16_t, WS_A2)[orow * DM + 512 + hh * 128 + v] = (bf16_t)f2bf(o * rn * R.gout * siluf_(R.gg));
    LDS_WAIT(); __syncthreads();
}

__device__ __forceinline__ void final_norm(Frame& F) {
    const int gw = F.vcu * NWAVES + F.wave, NGW = F.G * NWAVES;
    const bf16_t* H4 = WSP(bf16_t, WS_A2); const unsigned* tot4 = TOT(F.ws, 4);
    f32x4 g[4];
#pragma unroll
    for (int j = 0; j < 4; ++j) g[j] = *((const f32x4*)FIN(22) + F.lane + 64 * j);
    for (int m = MPROMPT + gw; m < MTOT; m += NGW) {
        const float rs = rs_from_tot(tot4[m]);
#pragma unroll
        for (int j = 0; j < 4; ++j) { const u32x2 w = *((const u32x2*)(H4 + (size_t)m * DM) + F.lane + 64 * j);
            const f32x4 x = (f32x4){bflo(w.x), bfhi(w.x), bflo(w.y), bfhi(w.y)};
            __builtin_nontemporal_store(x * rs * g[j], (f32x4*)(F.out + OFF_Y + (size_t)m * DM) + F.lane + 64 * j); }
    }
}

constexpr int NPHASES = 12;
constexpr int CW_BAR = 4096;
__global__ void __launch_bounds__(NWAVES * 64, 2) fwd_kernel(Args args) {
    extern __shared__ __attribute__((aligned(16))) unsigned char lds_raw[];
    Frame F;
    F.lds = (LAS unsigned char*)lds_raw;
    F.tid = threadIdx.x; F.lane = F.tid & 63; F.wave = __builtin_amdgcn_readfirstlane(F.tid >> 6);
    F.G = gridDim.x; { const int bx = blockIdx.x; F.vcu = (F.G % 8 == 0) ? (bx % 8) * (F.G / 8) + bx / 8 : bx; }
    F.a = &args; F.out = args.out; F.ws = args.ws;
    volatile LAS unsigned* MISC = (volatile LAS unsigned*)(F.lds + MISC_OFF);
    for (int u = F.tid; u < (LDS_BYTES - LDSCTL_OFF) / 4; u += NWAVES * 64) ((LAS unsigned*)(F.lds + LDSCTL_OFF))[u] = 0u;
    __syncthreads();
    const int lo = args.ph_lo, hi = args.ph_hi;
    XcdBarrier bar; bar.bar = (unsigned*)(F.ws + WS_CTL) + CW_BAR; bar.x = 0; bar.st = nullptr;
    if (hi - lo > 1) bar = xcd_barrier_post((unsigned*)(F.ws + WS_CTL) + CW_BAR, MISC + 8);
#ifndef REP_MASK
#define REP_MASK 0
#endif

#ifndef PH_MASK
#define PH_MASK 0xFFF
#endif
#define IN(k) ((((PH_MASK) >> (k)) & 1) && lo <= (k) && (k) < hi)
#define SEAM(k) do { if (IN(k) && IN((k) + 1)) xcd_barrier(bar); } while (0)
    LAS unsigned char* ring = F.lds;
    CopyCur cp = copy_cursor_init(args.in[2], args.in[3], args.out, (int)blockIdx.x);
#define DRY_K(k) ((int)((((REP_MASK) >> 12) & 1) && (((REP_MASK) >> (k)) & 1) && rep_ == 0))
#define PHASE_BEGIN() do { F.tid = launder_v(threadIdx.x); F.lane = F.tid & 63; F.wave = __builtin_amdgcn_readfirstlane(F.tid >> 6); } while (0)

    if (IN(0)) for (int rep_ = 0; rep_ <= (((REP_MASK) >> 0) & 1); ++rep_) { if (rep_) xcd_barrier(bar); PHASE_BEGIN(); p0_prologue(F); } SEAM(0);
    if (IN(1)) for (int rep_ = 0; rep_ <= (((REP_MASK) >> 1) & 1); ++rep_) { if (rep_) xcd_barrier(bar); PHASE_BEGIN();
#ifndef NO_G1
        { pg8::Gemm g{WSP(bf16_t, WS_HB), WSP(bf16_t, WS_WGU1), MPROMPT, NGU, DM}; pg8::StaticOrder S; S.init(MPROMPT, NGU, F.G, (int)blockIdx.x);
          pg8::EpiSwiGLU<0> E{F.ws, 0};
          pg8::gemm_phase<pg8::EpiSwiGLU<0>, pg8::StaticOrder, true>(ring, g, S, E, cp); }
#endif
#ifndef NO_G8
        if ((int)blockIdx.x >= 128 || F.G != 256) { pg8::Gemm g{WSP(bf16_t, WS_PB), WSP(bf16_t, WS_WPP), MPROMPT, DM, DPLE}; pg8::StaticOrder S; if (F.G == 256) S.init(MPROMPT, DM, 128, (int)blockIdx.x - 128); else S.init(MPROMPT, DM, F.G, (int)blockIdx.x);
          pg8::EpiPlainBf16 E{F.ws, 0};
          pg8::gemm_phase<pg8::EpiPlainBf16, pg8::StaticOrder, true>(ring, g, S, E, cp); }
#endif
        { const sk::EpiSwiGLU<0> E{F.ws, 0}; for (int t = F.G - 1 - (int)blockIdx.x; t < 2 * (DFF / 32); t += F.G) sk::tile(WSP(bf16_t, WS_HB) + (size_t)MPROMPT * DM, DM, WSP(bf16_t, WS_WGU1), E, t, F.lane, F.wave, ring); }
        { const sk::EpiPlain E{F.ws, 0}; for (int t = F.G - 1 - 2 * (DFF / 32) - (int)blockIdx.x; t < 2 * (DM / 64); t += F.G) if (t >= 0) sk::tile(WSP(bf16_t, WS_PB) + (size_t)MPROMPT * DPLE, DPLE, WSP(bf16_t, WS_WPP), E, t, F.lane, F.wave, ring); }
        if ((int)blockIdx.x >= 128) convert_weights<1>(F, ((int)blockIdx.x - 128) * NWAVES + F.wave, 128 * NWAVES);
    } SEAM(1);
    if (IN(2)) for (int rep_ = 0; rep_ <= (((REP_MASK) >> 2) & 1); ++rep_) { if (rep_) xcd_barrier(bar); PHASE_BEGIN();
        pg8::Gemm g{WSP(bf16_t, WS_ACT), WSP(bf16_t, WS_WD1), MPROMPT, DM, DFF}; pg8::StaticOrder S; S.init(MPROMPT, DM, F.G, (int)blockIdx.x);
        pg8::EpiResid<0, 1, false> E{nullptr, F.ws, 0.5f, DRY_K(2)};
        pg8::gemm_phase<pg8::EpiResid<0, 1, false>, pg8::StaticOrder, true>(ring, g, S, E, cp);
        { const sk::EpiResid<0, 1, false> E2{nullptr, F.ws, 0.5f, DRY_K(2)}; for (int t = F.G - 1 - (int)blockIdx.x; t < 16 * (DM / 64); t += F.G) sk::subtile<sk::EpiResid<0, 1, false>, 2, 1>(WSP(bf16_t, WS_ACT) + (size_t)MPROMPT * DFF, DFF, WSP(bf16_t, WS_WD1), E2, t, F.lane, F.wave, ring); }
    } SEAM(2);
    if (IN(3)) for (int rep_ = 0; rep_ <= (((REP_MASK) >> 3) & 1); ++rep_) { if (rep_) xcd_barrier(bar); PHASE_BEGIN();
        { pg8::Gemm g{WSP(bf16_t, WS_HB), WSP(bf16_t, WS_WIN), MPROMPT, 3072, DM}; pg8::StaticOrder S; S.init(MPROMPT, 3072, F.G, (int)blockIdx.x);
          pg8::EpiMix E{F.ws, F.out, 0, 0};
          pg8::gemm_phase<pg8::EpiMix, pg8::StaticOrder, true>(ring, g, S, E, cp); }
        { pg8::Gemm g{WSP(bf16_t, WS_HB), WSP(bf16_t, WS_WIN) + (size_t)3072 * DM, MPROMPT, 256, DM}; pg8::StaticOrder S; S.init(MPROMPT, 256, F.G, (int)blockIdx.x);
          pg8::EpiMix E{F.ws, F.out, 0, 12};
          pg8::gemm_phase<pg8::EpiMix, pg8::StaticOrder, true, true>(ring, g, S, E, cp); }
        { const sk::EpiMix E2{F.ws, F.out, 0}; for (int t = F.G - 1 - (int)blockIdx.x; t < 98; t += F.G) sk::tile(WSP(bf16_t, WS_HB) + (size_t)MPROMPT * DM, DM, WSP(bf16_t, WS_WIN), E2, t, F.lane, F.wave, ring); }
        if ((int)blockIdx.x >= 64) convert_weights<2>(F, ((int)blockIdx.x - 64) * NWAVES + F.wave, 192 * NWAVES);
    } SEAM(3);
    if (IN(4)) for (int rep_ = 0; rep_ <= (((REP_MASK) >> 4) & 1); ++rep_) { if (rep_) xcd_barrier(bar); PHASE_BEGIN();
        if (!(PROBE_VAR == 9 && rep_)) for (int it = F.vcu; it < 256; it += F.G) attn_prompt_item(F, it);
        if (!(PROBE_VAR == 8 && rep_)) for (int it = F.vcu; it < 256; it += F.G) gla_p1_items<4>(F, 4 * it);
    } if (IN(4) && IN(6)) xcd_barrier(bar);
    if (IN(6)) for (int rep_ = 0; rep_ <= (((REP_MASK) >> 6) & 1); ++rep_) { if (rep_) xcd_barrier(bar); PHASE_BEGIN();
        if (!((PROBE_VAR == 11 || PROBE_VAR == 12 || PROBE_VAR == 13) && rep_)) for (int it = F.vcu; it < 256; it += F.G) gla_p3_items<4>(F, 4 * it);
        if (!(PROBE_VAR == 10 && rep_)) {
            for (int it = F.vcu; it < 256; it += F.G) {
                GlaSmp R; const bool has = it < 128;
                if (has) gla_sample_load(F, it, R);
                attn_sample_task(F, ((((it >> 3) << 2) | (F.wave & 3)) << 3) | (it & 7), F.wave >> 2);
                if (has) gla_sample_finish(F, it, R);
            }
        }
    } if (IN(6) && IN(7)) xcd_barrier(bar);
    if (IN(7)) for (int rep_ = 0; rep_ <= (((REP_MASK) >> 7) & 1); ++rep_) { if (rep_) xcd_barrier(bar); PHASE_BEGIN();
        pg8::Gemm g{WSP(bf16_t, WS_A2), WSP(bf16_t, WS_WOUT), MPROMPT, DM, DM}; pg8::StaticOrder S; S.init(MPROMPT, DM, F.G, (int)blockIdx.x);
        pg8::EpiResid<0, 2, false> E{nullptr, F.ws, 1.0f, DRY_K(7)};
        pg8::gemm_phase<pg8::EpiResid<0, 2, false>, pg8::StaticOrder, true>(ring, g, S, E, cp);
        { const sk::EpiResid<0, 2, false> E2{nullptr, F.ws, 1.0f, DRY_K(7)}; for (int t = F.G - 1 - (int)blockIdx.x; t < 16 * (DM / 64); t += F.G) sk::subtile<sk::EpiResid<0, 2, false>, 2, 1>(WSP(bf16_t, WS_A2) + (size_t)MPROMPT * DM, DM, WSP(bf16_t, WS_WOUT), E2, t, F.lane, F.wave, ring); }
    } SEAM(7);
    if (IN(8)) for (int rep_ = 0; rep_ <= (((REP_MASK) >> 8) & 1); ++rep_) { if (rep_) xcd_barrier(bar); PHASE_BEGIN();
        pg8::Gemm g{WSP(bf16_t, WS_HB), WSP(bf16_t, WS_WGU2), MPROMPT, NGU, (PROBE_VAR == 4 && !rep_) ? DM / 2 : DM}; if (PROBE_VAR == 7 && !rep_) g.ld = DM + 64; pg8::StaticOrder S; S.init(MPROMPT, (PROBE_VAR == 2 && rep_) ? NGU / 2 : NGU, F.G, (int)blockIdx.x);
        pg8::EpiSwiGLU<2> E{F.ws, 0};
        if (PROBE_VAR == 5 && !rep_) S.same = 1;
        if (PROBE_VAR == 6 && !rep_) { CopyCur cpd = cp; cpd.it = CP_STEPS; pg8::gemm_phase<pg8::EpiSwiGLU<2>, pg8::StaticOrder, true>(ring, g, S, E, cpd); }
        else if (!(PROBE_VAR == 3 && rep_)) pg8::gemm_phase<pg8::EpiSwiGLU<2>, pg8::StaticOrder, true>(ring, g, S, E, cp);
        if (!((PROBE_VAR == 1 || PROBE_VAR == 2) && rep_) && !((PROBE_VAR == 4 || PROBE_VAR == 5 || PROBE_VAR == 6 || PROBE_VAR == 7) && !rep_)) { const sk::EpiSwiGLU<2> E2{F.ws, 0};
          for (int t = (F.G == 256) ? ((int)blockIdx.x >= 128 ? 255 - (int)blockIdx.x : 1 << 30) : F.G - 1 - (int)blockIdx.x; t < 2 * (DFF / 32); t += (F.G == 256) ? 128 : F.G) sk::tile(WSP(bf16_t, WS_HB) + (size_t)MPROMPT * DM, DM, WSP(bf16_t, WS_WGU2), E2, t, F.lane, F.wave, ring); }
    } SEAM(8);
    if (IN(9)) for (int rep_ = 0; rep_ <= (((REP_MASK) >> 9) & 1); ++rep_) { if (rep_) xcd_barrier(bar); PHASE_BEGIN();
        pg8::Gemm g{WSP(bf16_t, WS_ACT), WSP(bf16_t, WS_WD2), MPROMPT, DM, DFF}; pg8::StaticOrder S; S.init(MPROMPT, DM, F.G, (int)blockIdx.x);
        pg8::EpiResid<0, 3, false> E{nullptr, F.ws, 0.5f, DRY_K(9)};
        pg8::gemm_phase<pg8::EpiResid<0, 3, false>, pg8::StaticOrder, true>(ring, g, S, E, cp);
        { const sk::EpiResid<0, 3, false> E2{nullptr, F.ws, 0.5f, DRY_K(9)}; for (int t = F.G - 1 - (int)blockIdx.x; t < 16 * (DM / 64); t += F.G) sk::subtile<sk::EpiResid<0, 3, false>, 2, 1>(WSP(bf16_t, WS_ACT) + (size_t)MPROMPT * DFF, DFF, WSP(bf16_t, WS_WD2), E2, t, F.lane, F.wave, ring); }
    } SEAM(9);
    if (IN(10)) for (int rep_ = 0; rep_ <= (((REP_MASK) >> 10) & 1); ++rep_) { if (rep_) xcd_barrier(bar); PHASE_BEGIN();
        pg8::Gemm g{WSP(bf16_t, WS_HB), WSP(bf16_t, WS_WPG), MPROMPT, DM, DM}; pg8::StaticOrder S; S.init(MPROMPT, DM, F.G, (int)blockIdx.x);
        pg8::EpiPleNorm E{F.ws, F.out, FIN(22), 32u * (unsigned)(rep_ + 1), DRY_K(10)};
        pg8::gemm_phase<pg8::EpiPleNorm, pg8::StaticOrder, true>(ring, g, S, E, cp);
        { const sk::EpiResid<1, 4, false> E2{nullptr, F.ws, 1.0f, DRY_K(10)}; for (int t = F.G - 1 - (int)blockIdx.x; t < 16 * (DM / 64); t += F.G) sk::subtile<sk::EpiResid<1, 4, false>, 2, 1>(WSP(bf16_t, WS_HB) + (size_t)MPROMPT * DM, DM, WSP(bf16_t, WS_WPG), E2, t, F.lane, F.wave, ring); }
    } SEAM(10);
    if (IN(11)) for (int rep_ = 0; rep_ <= (((REP_MASK) >> 11) & 1); ++rep_) { if (rep_) xcd_barrier(bar); PHASE_BEGIN(); final_norm(F); copy_cleanup(cp, F.tid); }
#undef IN
#undef SEAM
}

extern "C" void kernel_launch(void* const* d_in, const int* in_sizes, int n_in, void* d_out, int out_size, void* d_ws, size_t ws_size, hipStream_t stream) {
    static int grid = 0;
    if (grid == 0) {
        if (n_in != 23 || (size_t)out_size != OUT_TOTAL || ws_size < WS_END) { fprintf(stderr, "kernel_launch: unexpected shapes: n_in %d out %d ws %zu (need %zu)\n", n_in, out_size, ws_size, (size_t)WS_END); grid = -1; return; }
        int dev = 0, cus = 0;
        if (hipGetDevice(&dev) != hipSuccess || hipDeviceGetAttribute(&cus, hipDeviceAttributeMultiprocessorCount, dev) != hipSuccess) { grid = -1; return; }
        if (hipFuncSetAttribute((const void*)fwd_kernel, hipFuncAttributeMaxDynamicSharedMemorySize, LDS_BYTES) != hipSuccess) { fprintf(stderr, "kernel_launch: hipFuncSetAttribute failed\n"); grid = -1; return; }
        int per_cu = 0;
        if (hipOccupancyMaxActiveBlocksPerMultiprocessor(&per_cu, (const void*)fwd_kernel, NWAVES * 64, LDS_BYTES) != hipSuccess || per_cu < 1) { fprintf(stderr, "kernel_launch: occupancy query says %d blocks per CU\n", per_cu); }
        (void)hipGetLastError();
        grid = cus;
        if (grid != 256) { fprintf(stderr, "kernel_launch: built for a 256-CU device (got %d CUs); nothing launched\n", cus); grid = -1; return; }
    }
    if (grid < 0) return;
    static_assert((CW_BAR + XCD_BAR_WORDS) * 4 <= 65536 && (pg8::CW_PANEL + 64 * 64) * 4 <= 65536, "control words inside the memset");
    (void)hipMemsetAsync((char*)d_ws + WS_CTL, 0, 65536, stream);
    Args a{};
    for (int i = 0; i < 23; ++i) a.in[i] = (const float*)d_in[i];
    a.out = (float*)d_out; a.ws = (unsigned char*)d_ws;
#if MK_PER_PHASE
    for (int p = 0; p < NPHASES; ++p) { a.ph_lo = p; a.ph_hi = p + 1; hipLaunchKernelGGL(fwd_kernel, dim3(grid), dim3(NWAVES * 64), LDS_BYTES, stream, a); }
#else
    a.ph_lo = 0; a.ph_hi = NPHASES;
    hipLaunchKernelGGL(fwd_kernel, dim3(grid), dim3(NWAVES * 64), LDS_BYTES, stream, a);
#endif
}
```
